# Optimizing an MI355X kernel written in HIP

```python
import jax, jax.numpy as jnp
from jax import lax
import numpy as np

D_MODEL = 1024
BATCH = 2
SEQ = 8192
DEPTH = 1

N_META = 16
HEAD_DIM = 64
FOX_HEADS = 8
RWKV_HEADS = 8
FOX_WIDTH = FOX_HEADS * HEAD_DIM
RWKV_WIDTH = RWKV_HEADS * HEAD_DIM
MIX_WIDTH = FOX_WIDTH + RWKV_WIDTH
Q_BLOCK = 128
DECAY_LORA = 64
AAA_LORA = 64
GATE_LORA = 128
FOX_COLS = 3 * FOX_WIDTH + FOX_HEADS
RWKV_COLS = 3 * RWKV_WIDTH + DECAY_LORA + AAA_LORA + GATE_LORA
IN_COLS = FOX_COLS + RWKV_COLS
N_EXPERTS = 32
TOP_K = 4
D_EXPERT = D_MODEL
SWIGLU_LIMIT = 7.0
SWIGLU_ALPHA = 1.702
MOE_BLOCK = 128
DEEPNORM_ALPHA = float((2 * DEPTH) ** 0.25)
DEEPNORM_BETA = float((8 * DEPTH) ** -0.25)
LN_EPS = 1e-5
GN_EPS = 64e-5
RMS_EPS = 1e-6
NEG_BIG = -1e30

kernel_name = "fox_rwkv7_hymba_moe_deepnorm"


def layer_norm(h, g, b):
    hf = h.astype(jnp.float32)
    mu = hf.mean(-1, keepdims=True)
    var = jnp.square(hf - mu).mean(-1, keepdims=True)
    return ((hf - mu) * lax.rsqrt(var + LN_EPS) * g + b).astype(h.dtype)


def fox_attention(q, k, v, logf):
    B, L, H, Dh = q.shape
    pad = Q_BLOCK - N_META
    pw = ((0, 0), (pad, 0), (0, 0), (0, 0))
    q, k, v = jnp.pad(q, pw), jnp.pad(k, pw), jnp.pad(v, pw)
    c = jnp.cumsum(jnp.pad(logf.astype(jnp.float32), ((0, 0), (pad, 0), (0, 0))), axis=1)
    Lp = q.shape[1]
    nb = Lp // Q_BLOCK
    cT = c.transpose(0, 2, 1)
    kpos = jnp.arange(Lp)
    qb = q.reshape(B, nb, Q_BLOCK, H, Dh).transpose(1, 0, 2, 3, 4)
    cb = c.reshape(B, nb, Q_BLOCK, H).transpose(1, 0, 3, 2)
    scale = HEAD_DIM ** -0.5

    def one_block(args):
        q_i, c_i, i = args
        s = jnp.einsum('bqhd,bkhd->bhqk', q_i, k).astype(jnp.float32) * scale
        s = s + c_i[..., None] - cT[:, :, None, :]
        qpos = i * Q_BLOCK + jnp.arange(Q_BLOCK)
        mask = (kpos[None, :] <= qpos[:, None]) & (kpos[None, :] >= pad)
        p = jax.nn.softmax(jnp.where(mask, s, NEG_BIG), axis=-1)
        return jnp.einsum('bhqk,bkhd->bqhd', p.astype(v.dtype), v)

    o = lax.map(one_block, (qb, cb, jnp.arange(nb)))
    return o.transpose(1, 0, 2, 3, 4).reshape(B, Lp, H, Dh)[:, pad:]


def rwkv7_scan(r, w, k, v, kk, a):
    B, L, H, N = r.shape
    xs = tuple(jnp.moveaxis(t.astype(jnp.float32), 1, 0) for t in (r, w, k, v, kk, a))

    def step(S, inp):
        r_t, w_t, k_t, v_t, kk_t, a_t = inp
        sa = jnp.einsum('bhij,bhj->bhi', S, -kk_t)
        S = S * w_t[:, :, None, :] + sa[..., None] * (kk_t * a_t)[:, :, None, :] \
            + v_t[..., None] * k_t[:, :, None, :]
        return S, jnp.einsum('bhij,bhj->bhi', S, r_t)

    S0 = jnp.zeros((B, H, N, N), jnp.float32)
    _, y = lax.scan(step, S0, xs)
    return jnp.moveaxis(y, 0, 1)


def hybrid_mixer(h, w_in, b_fgate, fox_norm_g, rwkv_mu, w0, w2, a0, a2, g2,
                 k_k, k_a, r_k, lnx_g, lnx_b, w_out):
    B, L, _ = h.shape
    z = h @ w_in
    z_fox, z_rwkv = z[..., :FOX_COLS], z[..., FOX_COLS:]

    q, kf, vf, f_logit = jnp.split(z_fox, [FOX_WIDTH, 2 * FOX_WIDTH, 3 * FOX_WIDTH], axis=-1)
    to_heads = lambda t: t.reshape(B, L, -1, HEAD_DIM)
    logf = jax.nn.log_sigmoid((f_logit + b_fgate).astype(jnp.float32))
    o_fox = fox_attention(to_heads(q), to_heads(kf), to_heads(vf), logf).astype(jnp.float32)
    o_fox = o_fox * lax.rsqrt(jnp.mean(jnp.square(o_fox), -1, keepdims=True) + RMS_EPS)
    o_fox = (o_fox.reshape(B, L, FOX_WIDTH) * fox_norm_g).astype(h.dtype)

    z_prev = jnp.pad(z_rwkv, ((0, 0), (1, 0), (0, 0)))[:, :-1]
    zs = z_rwkv + (z_prev - z_rwkv) * rwkv_mu
    r, kr, vr, dw, da, dg = jnp.split(
        zs, [RWKV_WIDTH, 2 * RWKV_WIDTH, 3 * RWKV_WIDTH, 3 * RWKV_WIDTH + DECAY_LORA,
             3 * RWKV_WIDTH + DECAY_LORA + AAA_LORA], axis=-1)
    w_log = -jax.nn.softplus(-(w0 + jnp.tanh(dw) @ w2)) - 0.5
    decay = jnp.exp(-jnp.exp(w_log.astype(jnp.float32)))
    a = jax.nn.sigmoid(a0 + da @ a2)
    g = jax.nn.sigmoid(dg) @ g2
    kk = to_heads(kr * k_k).astype(jnp.float32)
    kk = kk / jnp.maximum(jnp.linalg.norm(kk, axis=-1, keepdims=True), 1e-12)
    kr = kr * (1.0 + (a - 1.0) * k_a)
    rh, kh, vh, ah = to_heads(r), to_heads(kr), to_heads(vr), to_heads(a)
    y = rwkv7_scan(rh, to_heads(decay), kh, vh, kk, ah)
    mu = y.mean(-1, keepdims=True)
    var = jnp.square(y - mu).mean(-1, keepdims=True)
    y = ((y - mu) * lax.rsqrt(var + GN_EPS)).reshape(B, L, RWKV_WIDTH) * lnx_g + lnx_b
    bonus = jnp.sum(rh.astype(jnp.float32) * kh.astype(jnp.float32) * r_k, -1, keepdims=True) \
        * vh.astype(jnp.float32)
    y = ((y + bonus.reshape(B, L, RWKV_WIDTH)) * g).astype(h.dtype)

    return jnp.concatenate([o_fox, y], axis=-1) @ w_out


def moe_ffn(h, w_router, b_router, w_gu, b_gu, w_down, b_down):
    n, D = h.shape
    logits = (h @ w_router + b_router).astype(jnp.float32)
    top_vals, top_idx = lax.top_k(logits, TOP_K)
    gates = jax.nn.softmax(top_vals, axis=-1)
    flat_e = top_idx.reshape(-1)
    flat_tok = jnp.arange(n * TOP_K, dtype=jnp.int32) // TOP_K
    flat_g = gates.reshape(-1)
    order = jnp.argsort(flat_e, stable=True)
    e_sorted = flat_e[order]
    counts = jnp.bincount(flat_e, length=N_EXPERTS)
    start = jnp.cumsum(counts) - counts
    pcounts = (counts + MOE_BLOCK - 1) // MOE_BLOCK * MOE_BLOCK
    pend = jnp.cumsum(pcounts)
    pstart = pend - pcounts
    rank = jnp.arange(n * TOP_K) - start[e_sorted]
    dest = pstart[e_sorted] + rank
    n_blocks = -(-(n * TOP_K) // MOE_BLOCK) + N_EXPERTS
    cap = n_blocks * MOE_BLOCK
    slot_tok = jnp.full((cap,), n, jnp.int32).at[dest].set(flat_tok[order])
    slot_gate = jnp.zeros((cap,), jnp.float32).at[dest].set(flat_g[order])
    block_expert = jnp.minimum(
        jnp.searchsorted(pend, jnp.arange(n_blocks) * MOE_BLOCK, side='right'), N_EXPERTS - 1)
    h_pad = jnp.concatenate([h, jnp.zeros((1, D), h.dtype)], axis=0)
    xb = h_pad[slot_tok].reshape(n_blocks, MOE_BLOCK, D)

    def expert_block(args):
        xblk, e = args
        gu = xblk @ w_gu[e] + b_gu[e]
        gate, up = gu[:, :D_EXPERT], gu[:, D_EXPERT:]
        gate = jnp.minimum(gate, SWIGLU_LIMIT)
        up = jnp.clip(up, -SWIGLU_LIMIT, SWIGLU_LIMIT)
        act = (up + 1.0) * (gate * jax.nn.sigmoid(gate * SWIGLU_ALPHA))
        return act @ w_down[e] + b_down[e]

    yb = lax.map(expert_block, (xb, block_expert)).reshape(cap, D)
    y = jax.ops.segment_sum(yb * slot_gate[:, None].astype(yb.dtype), slot_tok, num_segments=n + 1)
    return y[:n].astype(h.dtype)


def setup_inputs(seed: int = 0) -> dict:
    key = jax.random.key(seed)
    ks = iter(jax.random.split(key, 40))
    nrm = lambda shape, s: jax.random.normal(next(ks), shape, jnp.float32) * s
    uni = lambda shape, lo, hi: jax.random.uniform(next(ks), shape, jnp.float32, lo, hi)
    Ld = DEPTH
    return {
        "x": nrm((BATCH, SEQ, D_MODEL), 1.0),
        "meta": nrm((N_META, D_MODEL), 1.0),
        "ln0_g": 1.0 + nrm((D_MODEL,), 0.02),
        "ln0_b": nrm((D_MODEL,), 0.01),
        "w_in": nrm((Ld, D_MODEL, IN_COLS), D_MODEL ** -0.5),
        "b_fgate": uni((Ld, FOX_HEADS), 1.0, 6.0),
        "fox_norm_g": 1.0 + nrm((Ld, FOX_WIDTH), 0.02),
        "rwkv_mu": uni((Ld, RWKV_COLS), 0.0, 1.0),
        "w0": uni((Ld, RWKV_WIDTH), -6.0, 0.0),
        "w2": nrm((Ld, DECAY_LORA, RWKV_WIDTH), 0.1 * DECAY_LORA ** -0.5),
        "a0": nrm((Ld, RWKV_WIDTH), 0.1),
        "a2": nrm((Ld, AAA_LORA, RWKV_WIDTH), 0.1 * AAA_LORA ** -0.5),
        "g2": nrm((Ld, GATE_LORA, RWKV_WIDTH), GATE_LORA ** -0.5),
        "k_k": 0.85 + nrm((Ld, RWKV_WIDTH), 0.02),
        "k_a": 1.0 + nrm((Ld, RWKV_WIDTH), 0.02),
        "r_k": nrm((Ld, RWKV_HEADS, HEAD_DIM), 0.1),
        "lnx_g": 1.0 + nrm((Ld, RWKV_WIDTH), 0.02),
        "lnx_b": nrm((Ld, RWKV_WIDTH), 0.01),
        "w_out": nrm((Ld, MIX_WIDTH, D_MODEL), MIX_WIDTH ** -0.5 * DEEPNORM_BETA),
        "ln1_g": 1.0 + nrm((Ld, D_MODEL), 0.02),
        "ln1_b": nrm((Ld, D_MODEL), 0.01),
        "w_router": nrm((Ld, D_MODEL, N_EXPERTS), D_MODEL ** -0.5),
        "b_router": nrm((Ld, N_EXPERTS), 0.01),
        "w_gu": nrm((Ld, N_EXPERTS, D_MODEL, 2 * D_EXPERT), D_MODEL ** -0.5),
        "b_gu": nrm((Ld, N_EXPERTS, 2 * D_EXPERT), 0.01),
        "w_down": nrm((Ld, N_EXPERTS, D_EXPERT, D_MODEL), D_EXPERT ** -0.5 * DEEPNORM_BETA),
        "b_down": nrm((Ld, N_EXPERTS, D_MODEL), 0.01),
        "ln2_g": 1.0 + nrm((Ld, D_MODEL), 0.02),
        "ln2_b": nrm((Ld, D_MODEL), 0.01),
    }


def reference(x, meta, ln0_g, ln0_b, w_in, b_fgate, fox_norm_g, rwkv_mu, w0, w2, a0, a2, g2,
              k_k, k_a, r_k, lnx_g, lnx_b, w_out, ln1_g, ln1_b, w_router, b_router,
              w_gu, b_gu, w_down, b_down, ln2_g, ln2_b):
    B = x.shape[0]
    h = jnp.concatenate([jnp.broadcast_to(meta[None].astype(x.dtype), (B, N_META, D_MODEL)), x], axis=1)
    h = layer_norm(h, ln0_g, ln0_b)
    for l in range(DEPTH):
        mix = hybrid_mixer(h, w_in[l], b_fgate[l], fox_norm_g[l], rwkv_mu[l], w0[l], w2[l],
                           a0[l], a2[l], g2[l], k_k[l], k_a[l], r_k[l], lnx_g[l], lnx_b[l], w_out[l])
        h = layer_norm(DEEPNORM_ALPHA * h + mix, ln1_g[l], ln1_b[l])
        Bh, L, D = h.shape
        ff = moe_ffn(h.reshape(Bh * L, D), w_router[l], b_router[l], w_gu[l], b_gu[l],
                     w_down[l], b_down[l]).reshape(Bh, L, D)
        h = layer_norm(DEEPNORM_ALPHA * h + ff, ln2_g[l], ln2_b[l])
    return h[:, N_META:]
```

```cpp
#include <hip/hip_runtime.h>
#include <hip/hip_cooperative_groups.h>
#include <stdint.h>
#include <stdio.h>

#define DEVI __device__ __forceinline__
typedef unsigned short bf16_t;
typedef short bf16x8 __attribute__((ext_vector_type(8)));
typedef float f32x4 __attribute__((ext_vector_type(4)));
typedef float f32x16 __attribute__((ext_vector_type(16)));
typedef unsigned u32x4 __attribute__((ext_vector_type(4)));
typedef unsigned u32x2 __attribute__((ext_vector_type(2)));

constexpr int BATCH = 2, SEQ = 8192, DM = 1024, NMETA = 16;
constexpr int LTOK = SEQ + NMETA;
constexpr int PADL = 112;
constexpr int LP = LTOK + PADL;
constexpr int NP = BATCH * LP;
constexpr int NQB = LP / 128;
constexpr int NH = 8, HD = 64;
constexpr int FOXW = 512, RWW = 512;
constexpr int RWKV_COLS = 1792;
constexpr int IN_COLS = 3336;
constexpr int WIN_N = 3456;
constexpr int NEXP = 32, TOPK = 4;
constexpr int CAP = BATCH * LTOK;
constexpr int MAXBLK = (BATCH * LTOK * TOPK) / 128 + NEXP;
constexpr float ALPHA = 1.189207115002721f;
constexpr float LN_EPS = 1e-5f, GN_EPS = 64e-5f, RMS_EPS = 1e-6f;
constexpr float LOG2E = 1.4426950408889634f;
constexpr float QSCALE = 0.125f * LOG2E;
constexpr float NEGBIG = -1e30f;

constexpr size_t MiB = 1u << 20;
constexpr size_t al256(size_t x) { return (x + 255) & ~(size_t)255; }
constexpr size_t WS_CTL = 0;
constexpr size_t WS_WINT = 1 * MiB;
constexpr size_t WS_WOUTT = WS_WINT + (size_t)WIN_N * 1024 * 2;
constexpr size_t WS_W2T = WS_WOUTT + (size_t)1024 * 1024 * 2;
constexpr size_t WS_A2T = WS_W2T + 512 * 64 * 2;
constexpr size_t WS_G2T = WS_A2T + 512 * 64 * 2;
constexpr size_t WS_WGUT = al256(WS_G2T + 512 * 128 * 2);
constexpr size_t WS_WDT = WS_WGUT + (size_t)32 * 2048 * 1024 * 2;
constexpr size_t WS_H1F = WS_WDT + (size_t)32 * 1024 * 1024 * 2;
constexpr size_t WS_H1B = WS_H1F + (size_t)NP * 1024 * 4;
constexpr size_t WS_RTE = WS_H1B + (size_t)NP * 1024 * 2;
constexpr size_t WS_RTR = WS_RTE + (size_t)NP * 16;
constexpr size_t WS_LTOK = WS_RTR + (size_t)NP * 16;
constexpr size_t WS_LGATE = WS_LTOK + (size_t)32 * CAP * 4;
constexpr size_t WS_EARLY = al256(WS_LGATE + (size_t)32 * CAP * 4);
constexpr size_t WS_H0F = WS_EARLY;
constexpr size_t WS_H0B = WS_H0F + (size_t)NP * 1024 * 4;
constexpr size_t WS_QB = WS_H0B + (size_t)NP * 1024 * 2;
constexpr size_t WS_KB = WS_QB + (size_t)NP * 512 * 2;
constexpr size_t WS_VT = WS_KB + (size_t)NP * 512 * 2;
constexpr size_t WS_ZR = WS_VT + (size_t)NP * 512 * 2;
constexpr size_t WS_LF = WS_ZR + (size_t)NP * 1792 * 4;
constexpr size_t WS_CS = WS_LF + (size_t)NP * 8 * 4;
constexpr size_t WS_R = WS_CS + (size_t)NP * 8 * 4;
constexpr size_t WS_KR = WS_R + (size_t)NP * 512 * 4;
constexpr size_t WS_VR = WS_KR + (size_t)NP * 512 * 4;
constexpr size_t WS_KK = WS_VR + (size_t)NP * 512 * 4;
constexpr size_t WS_TW = WS_KK + (size_t)NP * 512 * 4;
constexpr size_t WS_DA = WS_TW + (size_t)NP * 64 * 2;
constexpr size_t WS_SG = WS_DA + (size_t)NP * 64 * 2;
constexpr size_t WS_RW = WS_SG + (size_t)NP * 128 * 2;
constexpr size_t WS_RB = WS_RW + (size_t)NP * 512 * 4;
constexpr size_t WS_RK2 = WS_RB + (size_t)NP * 512 * 4;
constexpr size_t WS_G = WS_RK2 + (size_t)NP * 512 * 4;
constexpr size_t WS_Y = WS_G + (size_t)NP * 512 * 4;
constexpr size_t WS_MIX = WS_Y + (size_t)NP * 512 * 4;
constexpr size_t WS_PRE1 = WS_MIX + (size_t)NP * 1024 * 2;
constexpr size_t WS_EARLY_END = WS_PRE1 + (size_t)NP * 1024 * 4;
constexpr size_t WS_ACT = WS_EARLY;
constexpr size_t WS_YB = WS_ACT + (size_t)MAXBLK * 128 * 1024 * 2;
constexpr size_t WS_LATE_END = WS_YB + (size_t)MAXBLK * 128 * 1024 * 4;
constexpr size_t WS_NEED = WS_EARLY_END > WS_LATE_END ? WS_EARLY_END : WS_LATE_END;
constexpr int CW_CNT = 0;
constexpr int CW_QATT = 64;

struct P {
    const float *x, *meta, *ln0_g, *ln0_b, *w_in, *b_fgate, *fox_norm_g, *rwkv_mu, *w0, *w2, *a0, *a2, *g2, *k_k, *k_a, *r_k, *lnx_g,
        *lnx_b, *w_out, *ln1_g, *ln1_b, *w_router, *b_router, *w_gu, *b_gu, *w_down, *b_down, *ln2_g, *ln2_b;
    float* out;
    unsigned char* ws;
};
#define WSP(T, off) ((T*)(p.ws + (off)))

DEVI unsigned f2bf(float f) { unsigned u = __float_as_uint(f); u += 0x7fffu + ((u >> 16) & 1u); return u >> 16; }
DEVI unsigned pk2(float lo, float hi) { return f2bf(lo) | (f2bf(hi) << 16); }
DEVI float wave_sum(float v) {
#pragma unroll
    for (int o = 32; o > 0; o >>= 1) v += __shfl_xor(v, o);
    return v;
}
DEVI float sum16(float v) {
#pragma unroll
    for (int o = 8; o > 0; o >>= 1) v += __shfl_xor(v, o);
    return v;
}
DEVI float dpp_add(float v, int) { return v; }
template <int CTRL> DEVI float dpp_mov(float v) { return __int_as_float(__builtin_amdgcn_update_dpp(0, __float_as_int(v), CTRL, 0xF, 0xF, false)); }
DEVI float rowsum16_dpp(float v) {
    v += dpp_mov<0xB1>(v);
    v += dpp_mov<0x4E>(v);
    v += dpp_mov<0x141>(v);
    v += dpp_mov<0x140>(v);
    return v;
}
DEVI float softplusf(float x) { return fmaxf(x, 0.f) + log1pf(__expf(-fabsf(x))); }
DEVI float sigmoidf(float x) { return 1.f / (1.f + __expf(-x)); }

template <bool SWAP, class Epi>
DEVI void gemm128(const bf16_t* (&ap)[4], const bf16_t* (&bp)[4], int K, char* lds, Epi&& epi) {
    const int tid = threadIdx.x, lane = tid & 63, wid = tid >> 6, wm = wid >> 1, wn = wid & 1;
    const int l15 = lane & 15, lq = lane >> 4;
    const int srow = tid >> 3, skc = tid & 7;
    const int soff = srow * 128 + ((skc ^ ((srow >> 1) & 7)) << 4);
    f32x4 acc[4][4];
#pragma unroll
    for (int i = 0; i < 4; ++i)
#pragma unroll
        for (int j = 0; j < 4; ++j) acc[i][j] = (f32x4){0.f, 0.f, 0.f, 0.f};
    u32x4 ra[4], rb[4];
    const int nk = K / 64;
#pragma unroll
    for (int i = 0; i < 4; ++i) { ra[i] = *(const u32x4*)(ap[i]); rb[i] = *(const u32x4*)(bp[i]); }
#pragma unroll
    for (int i = 0; i < 4; ++i) { *(u32x4*)(lds + soff + i * 4096) = ra[i]; *(u32x4*)(lds + 16384 + soff + i * 4096) = rb[i]; }
    __syncthreads();
    const int aoff = (wm * 64 + l15) * 128, boff = 16384 + (wn * 64 + l15) * 128, sw = l15 >> 1;
    for (int kt = 0; kt < nk; ++kt) {
        const int s = kt & 1;
        if (kt + 1 < nk) {
#pragma unroll
            for (int i = 0; i < 4; ++i) { ra[i] = *(const u32x4*)(ap[i] + (kt + 1) * 64); rb[i] = *(const u32x4*)(bp[i] + (kt + 1) * 64); }
        }
        const char* base = lds + s * 32768;
#pragma unroll
        for (int ks = 0; ks < 2; ++ks) {
            bf16x8 af[4], bfr[4];
            const int co = ((ks * 4 + lq) ^ sw) << 4;
#pragma unroll
            for (int t = 0; t < 4; ++t) { af[t] = *(const bf16x8*)(base + aoff + t * 2048 + co); bfr[t] = *(const bf16x8*)(base + boff + t * 2048 + co); }
#pragma unroll
            for (int mt = 0; mt < 4; ++mt)
#pragma unroll
                for (int nt = 0; nt < 4; ++nt) {
                    if (SWAP) acc[mt][nt] = __builtin_amdgcn_mfma_f32_16x16x32_bf16(af[mt], bfr[nt], acc[mt][nt], 0, 0, 0);
                    else acc[mt][nt] = __builtin_amdgcn_mfma_f32_16x16x32_bf16(bfr[nt], af[mt], acc[mt][nt], 0, 0, 0);
                }
        }
        if (kt + 1 < nk) {
            char* nb = lds + (s ^ 1) * 32768;
#pragma unroll
            for (int i = 0; i < 4; ++i) { *(u32x4*)(nb + soff + i * 4096) = ra[i]; *(u32x4*)(nb + 16384 + soff + i * 4096) = rb[i]; }
        }
        __syncthreads();
    }
    epi(acc, wm, wn, l15, lq);
}

DEVI int srccol(int kind, int n) {
    if (kind == 0) return n;
    if (kind == 1) { if (n < 1536) return n; if (n < 3328) return n + 8; if (n < 3336) return 1536 + (n - 3328); return -1; }
    const int T = n >> 5, w = n & 31;
    return w < 16 ? T * 16 + w : 1024 + T * 16 + (w - 16);
}
DEVI void conv_tile(const float* src, int K, int NS, bf16_t* dst, int kind, int kt, int nt, float* scr  ) {
    const int tid = threadIdx.x;
    const int nl = tid & 63, n = nt * 64 + nl, sc = srccol(kind, n);
#pragma unroll 4
    for (int i = 0; i < 16; ++i) { const int k = i * 4 + (tid >> 6); scr[k * 65 + nl] = sc >= 0 ? src[(size_t)(kt * 64 + k) * NS + sc] : 0.f; }
    __syncthreads();
    const int on = tid >> 2, kc = (tid & 3) * 16;
    u32x4 o0, o1;
    const float* s = scr + kc * 65 + on;
    o0.x = pk2(s[0 * 65], s[1 * 65]); o0.y = pk2(s[2 * 65], s[3 * 65]); o0.z = pk2(s[4 * 65], s[5 * 65]); o0.w = pk2(s[6 * 65], s[7 * 65]);
    o1.x = pk2(s[8 * 65], s[9 * 65]); o1.y = pk2(s[10 * 65], s[11 * 65]); o1.z = pk2(s[12 * 65], s[13 * 65]); o1.w = pk2(s[14 * 65], s[15 * 65]);
    bf16_t* d = dst + (size_t)(nt * 64 + on) * K + kt * 64 + kc;
    *(u32x4*)d = o0; *(u32x4*)(d + 8) = o1;
    __syncthreads();
}
DEVI void phase0(const P& p, int bid, int nb, char* lds) {
    const int tid = threadIdx.x, lane = tid & 63, wid = tid >> 6;
    if (bid == 0 && tid < 128) WSP(unsigned, WS_CTL)[tid] = 0u;
    {
        float* H0F = WSP(float, WS_H0F); bf16_t* H0B = WSP(bf16_t, WS_H0B);
        for (int row = bid * 4 + wid; row < NP; row += nb * 4) {
            const int b = row / LP, pp = row % LP;
            f32x4* hf = (f32x4*)(H0F + (size_t)row * 1024) + lane; u32x2* hb = (u32x2*)(H0B + (size_t)row * 1024) + lane;
            if (pp < PADL) {
#pragma unroll
                for (int j = 0; j < 4; ++j) { hf[64 * j] = (f32x4){0.f, 0.f, 0.f, 0.f}; hb[64 * j] = (u32x2){0u, 0u}; }
                continue;
            }
            const int t = pp - PADL;
            const float* src = t < NMETA ? p.meta + (size_t)t * 1024 : p.x + ((size_t)b * SEQ + (t - NMETA)) * 1024;
            f32x4 v[4]; float s = 0.f;
#pragma unroll
            for (int j = 0; j < 4; ++j) { v[j] = ((const f32x4*)src)[lane + 64 * j]; s += (v[j].x + v[j].y) + (v[j].z + v[j].w); }
            const float mean = wave_sum(s) * (1.f / 1024.f); float s2 = 0.f;
#pragma unroll
            for (int j = 0; j < 4; ++j) { v[j] = v[j] - mean; s2 += (v[j].x * v[j].x + v[j].y * v[j].y) + (v[j].z * v[j].z + v[j].w * v[j].w); }
            const float rstd = rsqrtf(wave_sum(s2) * (1.f / 1024.f) + LN_EPS);
#pragma unroll
            for (int j = 0; j < 4; ++j) {
                const f32x4 g = ((const f32x4*)p.ln0_g)[lane + 64 * j], bb = ((const f32x4*)p.ln0_b)[lane + 64 * j];
                const f32x4 o = v[j] * rstd * g + bb;
                hf[64 * j] = o; hb[64 * j] = (u32x2){pk2(o.x, o.y), pk2(o.z, o.w)};
            }
        }
    }
    {
        float* scr = (float*)lds;
        constexpr int T_IN = 16 * 54, T_OUT = 16 * 16, T_GU = 32 * 16 * 32, T_DN = 32 * 16 * 16, T_W2 = 8, T_A2 = 8, T_G2 = 16;
        constexpr int TOT = T_IN + T_OUT + T_GU + T_DN + T_W2 + T_A2 + T_G2;
        for (int it = bid; it < TOT; it += nb) {
            int r = it;
            if (r < T_IN) { conv_tile(p.w_in, 1024, IN_COLS, WSP(bf16_t, WS_WINT), 1, r / 54, r % 54, scr); continue; } r -= T_IN;
            if (r < T_OUT) { conv_tile(p.w_out, 1024, 1024, WSP(bf16_t, WS_WOUTT), 0, r / 16, r % 16, scr); continue; } r -= T_OUT;
            if (r < T_GU) { const int e = r / 512, q = r % 512; conv_tile(p.w_gu + (size_t)e * 1024 * 2048, 1024, 2048, WSP(bf16_t, WS_WGUT) + (size_t)e * 2048 * 1024, 2, q / 32, q % 32, scr); continue; } r -= T_GU;
            if (r < T_DN) { const int e = r / 256, q = r % 256; conv_tile(p.w_down + (size_t)e * 1024 * 1024, 1024, 1024, WSP(bf16_t, WS_WDT) + (size_t)e * 1024 * 1024, 0, q / 16, q % 16, scr); continue; } r -= T_DN;
            if (r < T_W2) { conv_tile(p.w2, 64, 512, WSP(bf16_t, WS_W2T), 0, 0, r, scr); continue; } r -= T_W2;
            if (r < T_A2) { conv_tile(p.a2, 64, 512, WSP(bf16_t, WS_A2T), 0, 0, r, scr); continue; } r -= T_A2;
            conv_tile(p.g2, 128, 512, WSP(bf16_t, WS_G2T), 0, r / 8, r % 8, scr);
        }
    }
}

struct EpiInProj {
    const P& p; int tm, tn;
    DEVI void operator()(f32x4 (&acc)[4][4], int wm, int wn, int l15, int lq) const {
        if (tn < 8) {
            bf16_t* dst = tn < 4 ? WSP(bf16_t, WS_QB) : WSP(bf16_t, WS_KB); const float sc = tn < 4 ? QSCALE : 1.f;
            const int cb = (tn & 3) * 128 + wn * 64 + 4 * lq;
#pragma unroll
            for (int mt = 0; mt < 4; ++mt) { const size_t row = (size_t)tm * 128 + wm * 64 + mt * 16 + l15;
#pragma unroll
                for (int nt = 0; nt < 4; ++nt) { const f32x4 a = acc[mt][nt] * sc; *(u32x2*)(dst + row * 512 + cb + nt * 16) = (u32x2){pk2(a.x, a.y), pk2(a.z, a.w)}; } }
        } else if (tn < 12) {
            bf16_t* VT = WSP(bf16_t, WS_VT); const int b = tm / NQB, pp0 = (tm % NQB) * 128;
#pragma unroll
            for (int mt = 0; mt < 4; ++mt)
#pragma unroll
                for (int nt = 0; nt < 4; ++nt) { const int n = (tn - 8) * 128 + wn * 64 + nt * 16 + l15, pp = pp0 + wm * 64 + mt * 16 + 4 * lq; const f32x4 a = acc[mt][nt];
                    *(u32x2*)(VT + (size_t)(b * 512 + n) * LP + pp) = (u32x2){pk2(a.x, a.y), pk2(a.z, a.w)}; }
        } else if (tn < 26) {
            float* ZR = WSP(float, WS_ZR); const int cb = (tn - 12) * 128 + wn * 64 + 4 * lq;
#pragma unroll
            for (int mt = 0; mt < 4; ++mt) { const size_t row = (size_t)tm * 128 + wm * 64 + mt * 16 + l15;
#pragma unroll
                for (int nt = 0; nt < 4; ++nt) *(f32x4*)(ZR + row * RWKV_COLS + cb + nt * 16) = acc[mt][nt]; }
        } else {
            if (wn == 0 && lq < 2) { float* LF = WSP(float, WS_LF);
#pragma unroll
                for (int mt = 0; mt < 4; ++mt) { const int row = tm * 128 + wm * 64 + mt * 16 + l15; const bool pad = (row % LP) < PADL; f32x4 o;
#pragma unroll
                    for (int r = 0; r < 4; ++r) { const float xv = acc[mt][0][r] + p.b_fgate[4 * lq + r]; o[r] = pad ? 0.f : -softplusf(-xv); }
                    *(f32x4*)(LF + (size_t)row * 8 + 4 * lq) = o; } }
        }
    }
};
DEVI void phase1(const P& p, int bid, int nb, char* lds) {
    const int tid = threadIdx.x, srow = tid >> 3, skc = tid & 7;
    for (int it = bid; it < 130 * 27; it += nb) {
        const int tm = it / 27, tn = it % 27;
        const bf16_t *ap[4], *bp[4];
#pragma unroll
        for (int i = 0; i < 4; ++i) { ap[i] = WSP(bf16_t, WS_H0B) + (size_t)(tm * 128 + srow + 32 * i) * 1024 + skc * 8; bp[i] = WSP(bf16_t, WS_WINT) + (size_t)(tn * 128 + srow + 32 * i) * 1024 + skc * 8; }
        if (tn >= 8 && tn < 12) gemm128<true>(ap, bp, 1024, lds, EpiInProj{p, tm, tn});
        else gemm128<false>(ap, bp, 1024, lds, EpiInProj{p, tm, tn});
    }
}

DEVI void phase2a(const P& p, int bid, int nb, char* lds) {
    const int tid = threadIdx.x, lane = tid & 63, wid = tid >> 6;
    if (bid < 16) {
        const int b = bid >> 3, h = bid & 7; float* part = (float*)lds;
        const float* LF = WSP(float, WS_LF); float* CS = WSP(float, WS_CS);
        const int r0 = tid * 33, r1 = min(r0 + 33, LP); float s = 0.f;
        for (int r = r0; r < r1; ++r) s += LF[((size_t)b * LP + r) * 8 + h];
        part[tid] = s; __syncthreads();
        float pre = 0.f; for (int i = 0; i < tid; ++i) pre += part[i];
        for (int r = r0; r < r1; ++r) { pre += LF[((size_t)b * LP + r) * 8 + h]; CS[((size_t)b * LP + r) * 8 + h] = pre * LOG2E; }
        __syncthreads();
    }
    const float* ZR = WSP(float, WS_ZR);
    for (int row = bid * 4 + wid; row < NP; row += nb * 4) {
        const int pp = row % LP; const bool hasprev = pp > 0;
        const f32x4* z = (const f32x4*)(ZR + (size_t)row * RWKV_COLS) + lane; const f32x4* zp = (const f32x4*)(ZR + (size_t)(row - (hasprev ? 1 : 0)) * RWKV_COLS) + lane;
        const f32x4* mu = (const f32x4*)p.rwkv_mu + lane;
#pragma unroll
        for (int j = 0; j < 7; ++j) {
            const f32x4 zc = z[64 * j]; f32x4 zq = zp[64 * j]; if (!hasprev) zq = (f32x4){0.f, 0.f, 0.f, 0.f};
            const f32x4 zs = zc + (zq - zc) * mu[64 * j];
            const int c = (lane * 4 + 256 * j) & 511;
            if (j < 2) *(f32x4*)(WSP(float, WS_R) + (size_t)row * 512 + c) = zs;
            else if (j < 4) {
                *(f32x4*)(WSP(float, WS_KR) + (size_t)row * 512 + c) = zs;
                const f32x4 kr = zs * *(const f32x4*)(p.k_k + c);
                const float ss = sum16((kr.x * kr.x + kr.y * kr.y) + (kr.z * kr.z + kr.w * kr.w));
                const float inv = 1.f / fmaxf(sqrtf(ss), 1e-12f);
                *(f32x4*)(WSP(float, WS_KK) + (size_t)row * 512 + c) = kr * inv;
            } else if (j < 6) *(f32x4*)(WSP(float, WS_VR) + (size_t)row * 512 + c) = zs;
            else {
                if (lane < 16) *(u32x2*)(WSP(bf16_t, WS_TW) + (size_t)row * 64 + lane * 4) = (u32x2){pk2(tanhf(zs.x), tanhf(zs.y)), pk2(tanhf(zs.z), tanhf(zs.w))};
                else if (lane < 32) *(u32x2*)(WSP(bf16_t, WS_DA) + (size_t)row * 64 + (lane - 16) * 4) = (u32x2){pk2(zs.x, zs.y), pk2(zs.z, zs.w)};
                else *(u32x2*)(WSP(bf16_t, WS_SG) + (size_t)row * 128 + (lane - 32) * 4) = (u32x2){pk2(sigmoidf(zs.x), sigmoidf(zs.y)), pk2(sigmoidf(zs.z), sigmoidf(zs.w))};
            }
        }
    }
}

struct EpiLora {
    const P& p; int which, tm, tn;
    DEVI void operator()(f32x4 (&acc)[4][4], int wm, int wn, int l15, int lq) const {
#pragma unroll
        for (int mt = 0; mt < 4; ++mt) { const size_t row = (size_t)tm * 128 + wm * 64 + mt * 16 + l15;
#pragma unroll
            for (int nt = 0; nt < 4; ++nt) { const int c = tn * 128 + wn * 64 + nt * 16 + 4 * lq; const f32x4 a = acc[mt][nt];
                if (which == 0) { const f32x4 w0v = *(const f32x4*)(p.w0 + c); f32x4 o;
#pragma unroll
                    for (int r = 0; r < 4; ++r) { const float lw = w0v[r] + a[r]; const float wl = -softplusf(-lw) - 0.5f; o[r] = __expf(-__expf(wl)); }
                    *(f32x4*)(WSP(float, WS_RW) + row * 512 + c) = o;
                } else if (which == 1) { const f32x4 a0v = *(const f32x4*)(p.a0 + c), kav = *(const f32x4*)(p.k_a + c);
                    const f32x4 kk = *(const f32x4*)(WSP(float, WS_KK) + row * 512 + c), kr = *(const f32x4*)(WSP(float, WS_KR) + row * 512 + c); f32x4 ob, ok;
#pragma unroll
                    for (int r = 0; r < 4; ++r) { const float av = sigmoidf(a0v[r] + a[r]); ob[r] = kk[r] * av; ok[r] = kr[r] * (1.f + (av - 1.f) * kav[r]); }
                    *(f32x4*)(WSP(float, WS_RB) + row * 512 + c) = ob; *(f32x4*)(WSP(float, WS_RK2) + row * 512 + c) = ok;
                } else *(f32x4*)(WSP(float, WS_G) + row * 512 + c) = a;
            } }
    }
};
DEVI void phase2b(const P& p, int bid, int nb, char* lds) {
    const int tid = threadIdx.x, srow = tid >> 3, skc = tid & 7;
    for (int it = bid; it < 130 * 12; it += nb) {
        const int tm = it / 12, r = it % 12, which = r >> 2, tn = r & 3;
        const int K = which == 2 ? 128 : 64;
        const bf16_t* A = which == 0 ? WSP(bf16_t, WS_TW) : which == 1 ? WSP(bf16_t, WS_DA) : WSP(bf16_t, WS_SG);
        const bf16_t* Bt = which == 0 ? WSP(bf16_t, WS_W2T) : which == 1 ? WSP(bf16_t, WS_A2T) : WSP(bf16_t, WS_G2T);
        const bf16_t *ap[4], *bp[4];
#pragma unroll
        for (int i = 0; i < 4; ++i) { ap[i] = A + (size_t)(tm * 128 + srow + 32 * i) * K + skc * 8; bp[i] = Bt + (size_t)(tn * 128 + srow + 32 * i) * K + skc * 8; }
        gemm128<false>(ap, bp, K, lds, EpiLora{p, which, tm, tn});
    }
}

DEVI int pi_swap(int i) { return (i & ~12) | ((i & 4) << 1) | ((i & 8) >> 1); }
DEVI void attn_item(const P& p, int b, int h, int qb, char* lds) {
    const int tid = threadIdx.x, lane = tid & 63, wid = tid >> 6, ql = lane & 31, hi = lane >> 5;
    const int q_pp = qb * 128 + wid * 32 + ql; const size_t qrow = (size_t)b * LP + q_pp;
    const bf16_t* QB = WSP(bf16_t, WS_QB); const bf16_t* KB = WSP(bf16_t, WS_KB); const bf16_t* VT = WSP(bf16_t, WS_VT); const float* CS = WSP(float, WS_CS);
    bf16x8 qf[4];
#pragma unroll
    for (int d0 = 0; d0 < 4; ++d0) qf[d0] = *(const bf16x8*)(QB + qrow * 512 + h * 64 + 16 * d0 + 8 * hi);
    const float cref = CS[((size_t)b * LP + qb * 128) * 8 + h];
    const int r0 = tid >> 3, kc = tid & 7;
    const int soff = r0 * 128 + ((kc ^ ((r0 >> 1) & 7)) << 4);
    const bf16_t* ksrc = KB + ((size_t)b * LP + r0) * 512 + h * 64 + kc * 8;
    const bf16_t* vsrc = VT + (size_t)(b * 512 + h * 64 + r0) * LP + kc * 8;
    const float* csrc = CS + ((size_t)b * LP + (tid & 63)) * 8 + h;
    const int nkt = 2 * qb + 1;
    u32x4 rk[2], rv[2]; float rc = 0.f;
    auto gload = [&](int kt) {
#pragma unroll
        for (int i = 0; i < 2; ++i) { rk[i] = *(const u32x4*)(ksrc + (size_t)(64 * kt + 32 * i) * 512); rv[i] = *(const u32x4*)(vsrc + 64 * kt + (size_t)i * 32 * LP); }
        if (tid < 64) rc = csrc[(size_t)64 * kt * 8] - cref;
    };
    auto swrite = [&](int s) {
        char* bs = lds + s * 16640;
#pragma unroll
        for (int i = 0; i < 2; ++i) { *(u32x4*)(bs + soff + i * 4096) = rk[i]; *(u32x4*)(bs + 8192 + soff + i * 4096) = rv[i]; }
        if (tid < 64) *(float*)(bs + 16384 + tid * 4) = rc;
    };
    float m = NEGBIG, l = 0.f; f32x16 o[2];
#pragma unroll
    for (int r = 0; r < 16; ++r) { o[0][r] = 0.f; o[1][r] = 0.f; }
    const int krow0 = pi_swap(ql);
    const int koff = krow0 * 128, ksw = (krow0 >> 1) & 7;
    const int voff = 8192 + ql * 128, vsw = (ql >> 1) & 7;
    gload(1); swrite(1 & 1); __syncthreads();
    for (int kt = 1; kt <= nkt; ++kt) {
        const int s = kt & 1;
        if (kt < nkt) gload(kt + 1);
        if (64 * kt <= qb * 128 + wid * 32 + 31) {
            const char* bs = lds + s * 16640;
            f32x16 sc[2];
#pragma unroll
            for (int kh = 0; kh < 2; ++kh) {
#pragma unroll
                for (int r = 0; r < 16; ++r) sc[kh][r] = 0.f;
#pragma unroll
                for (int d0 = 0; d0 < 4; ++d0) { const bf16x8 kf = *(const bf16x8*)(bs + kh * 4096 + koff + (((2 * d0 + hi) ^ ksw) << 4));
                    sc[kh] = __builtin_amdgcn_mfma_f32_32x32x16_bf16(kf, qf[d0], sc[kh], 0, 0, 0); }
            }
            const float* csl = (const float*)(bs + 16384);
            const bool needmask = (kt == 1) || (kt >= 2 * qb);
            float mloc = NEGBIG;
#pragma unroll
            for (int kh = 0; kh < 2; ++kh)
#pragma unroll
                for (int g = 0; g < 4; ++g) { const int key0 = 32 * kh + 16 * (g >> 1) + 8 * hi + 4 * (g & 1); const f32x4 cv = *(const f32x4*)(csl + key0);
#pragma unroll
                    for (int c = 0; c < 4; ++c) { float xv = sc[kh][4 * g + c] - cv[c];
                        if (needmask) { const int kp = 64 * kt + key0 + c; if (kp > q_pp || kp < PADL) xv = NEGBIG; }
                        sc[kh][4 * g + c] = xv; mloc = fmaxf(mloc, xv); } }
            mloc = fmaxf(mloc, __shfl_xor(mloc, 32));
            const float mnew = fmaxf(m, mloc); const float f = __builtin_amdgcn_exp2f(m - mnew); m = mnew; l *= f;
#pragma unroll
            for (int r = 0; r < 16; ++r) { o[0][r] *= f; o[1][r] *= f; }
            bf16x8 pf[2][2]; float ls = 0.f;
#pragma unroll
            for (int kh = 0; kh < 2; ++kh)
#pragma unroll
                for (int s2 = 0; s2 < 2; ++s2) { u32x4 w;
#pragma unroll
                    for (int j = 0; j < 4; ++j) { const float e0 = __builtin_amdgcn_exp2f(sc[kh][8 * s2 + 2 * j] - mnew), e1 = __builtin_amdgcn_exp2f(sc[kh][8 * s2 + 2 * j + 1] - mnew); ls += e0 + e1; w[j] = pk2(e0, e1); }
                    pf[kh][s2] = __builtin_bit_cast(bf16x8, w); }
            l += ls;
#pragma unroll
            for (int dh = 0; dh < 2; ++dh)
#pragma unroll
                for (int kh = 0; kh < 2; ++kh)
#pragma unroll
                    for (int s2 = 0; s2 < 2; ++s2) { const bf16x8 vf = *(const bf16x8*)(bs + voff + dh * 4096 + (((4 * kh + 2 * s2 + hi) ^ vsw) << 4));
                        o[dh] = __builtin_amdgcn_mfma_f32_32x32x16_bf16(vf, pf[kh][s2], o[dh], 0, 0, 0); }
        }
        if (kt < nkt) swrite((kt + 1) & 1);
        __syncthreads();
    }
    l += __shfl_xor(l, 32);
    const float inv = 1.f / l; float ss = 0.f;
#pragma unroll
    for (int r = 0; r < 16; ++r) { o[0][r] *= inv; o[1][r] *= inv; ss += o[0][r] * o[0][r] + o[1][r] * o[1][r]; }
    ss += __shfl_xor(ss, 32);
    const float rs = rsqrtf(ss * (1.f / 64.f) + RMS_EPS);
    bf16_t* MIX = WSP(bf16_t, WS_MIX); const bool padq = q_pp < PADL;
#pragma unroll
    for (int dh = 0; dh < 2; ++dh)
#pragma unroll
        for (int g = 0; g < 4; ++g) { const int d = 32 * dh + 8 * g + 4 * hi; const f32x4 gn = *(const f32x4*)(p.fox_norm_g + h * 64 + d);
            float v0 = o[dh][4 * g] * rs * gn.x, v1 = o[dh][4 * g + 1] * rs * gn.y, v2 = o[dh][4 * g + 2] * rs * gn.z, v3 = o[dh][4 * g + 3] * rs * gn.w;
            if (padq) { v0 = v1 = v2 = v3 = 0.f; }
            *(u32x2*)(MIX + qrow * 1024 + h * 64 + d) = (u32x2){pk2(v0, v1), pk2(v2, v3)}; }
}
DEVI void phase3a(const P& p, int bid, int nb, char* lds) {
    for (int it = bid; it < 16 * NQB; it += nb) { const int qb = NQB - 1 - it / 16, bh = it % 16; attn_item(p, bh >> 3, bh & 7, qb, lds); }
}

DEVI void scan_job(const P& p, int j, char* lds) {
    const int tid = threadIdx.x, lane = tid & 63, wid = tid >> 6;
    const int bh = j >> 2, b = bh >> 3, h = bh & 7, i0 = (j & 3) * 16;
    const int rowl = wid * 4 + (lane >> 4), jg = lane & 15;
    const size_t rowbase = (size_t)b * LP + PADL; const int col0 = h * 64;
    const float* arr[5] = {WSP(float, WS_RW), WSP(float, WS_KK), WSP(float, WS_RB), WSP(float, WS_RK2), WSP(float, WS_R)};
    const float* VR = WSP(float, WS_VR); float* Y = WSP(float, WS_Y);
    const int sstep = tid >> 4, sc4 = tid & 15;
    f32x4 rg[5]; float rvv;
    auto gload = [&](int c) {
        const size_t ro = (rowbase + 16 * c + sstep) * 512 + col0;
#pragma unroll
        for (int a = 0; a < 5; ++a) rg[a] = *(const f32x4*)(arr[a] + ro + sc4 * 4);
        rvv = VR[ro + i0 + sc4];
    };
    auto swrite = [&](int s) {
        float* bs = (float*)(lds + s * 21504);
#pragma unroll
        for (int a = 0; a < 5; ++a) *(f32x4*)(bs + (a * 16 + sstep) * 64 + sc4 * 4) = rg[a];
        bs[5120 + sstep * 16 + sc4] = rvv;
    };
    f32x4 S = (f32x4){0.f, 0.f, 0.f, 0.f};
    constexpr int NCH = LTOK / 16;
    gload(0); swrite(0); __syncthreads();
    for (int c = 0; c < NCH; ++c) {
        const int s = c & 1;
        if (c + 1 < NCH) gload(c + 1);
        const float* bs = (const float*)(lds + s * 21504);
#pragma unroll 4
        for (int t = 0; t < 16; ++t) {
            const f32x4 w4 = *(const f32x4*)(bs + (0 * 16 + t) * 64 + jg * 4), kk4 = *(const f32x4*)(bs + (1 * 16 + t) * 64 + jg * 4), bb4 = *(const f32x4*)(bs + (2 * 16 + t) * 64 + jg * 4),
                        k4 = *(const f32x4*)(bs + (3 * 16 + t) * 64 + jg * 4), r4 = *(const f32x4*)(bs + (4 * 16 + t) * 64 + jg * 4);
            const float vv = bs[5120 + t * 16 + rowl];
            float d = (S.x * kk4.x + S.y * kk4.y) + (S.z * kk4.z + S.w * kk4.w);
            d = rowsum16_dpp(d);
            const float sa = -d;
            S = S * w4 + sa * bb4 + vv * k4;
            float y = (S.x * r4.x + S.y * r4.y) + (S.z * r4.z + S.w * r4.w);
            y = rowsum16_dpp(y);
            if (jg == 0) Y[(rowbase + 16 * c + t) * 512 + col0 + i0 + rowl] = y;
        }
        if (c + 1 < NCH) swrite(s ^ 1);
        __syncthreads();
    }
}

DEVI void phase4a(const P& p, int bid, int nb, char*) {
    const int tid = threadIdx.x, lane = tid & 63, wid = tid >> 6;
    for (int row = bid * 4 + wid; row < NP; row += nb * 4) {
        const bool pad = (row % LP) < PADL;
#pragma unroll
        for (int j = 0; j < 2; ++j) {
            const int c = lane * 4 + 256 * j; const size_t o = (size_t)row * 512 + c;
            u32x2 outv = (u32x2){0u, 0u};
            if (!pad) {
                const f32x4 y = *(const f32x4*)(WSP(float, WS_Y) + o), r = *(const f32x4*)(WSP(float, WS_R) + o), k2 = *(const f32x4*)(WSP(float, WS_RK2) + o), v = *(const f32x4*)(WSP(float, WS_VR) + o), g = *(const f32x4*)(WSP(float, WS_G) + o);
                const f32x4 rk = *(const f32x4*)(p.r_k + c), lg = *(const f32x4*)(p.lnx_g + c), lb = *(const f32x4*)(p.lnx_b + c);
                const float mu = sum16((y.x + y.y) + (y.z + y.w)) * (1.f / 64.f);
                const f32x4 dy = y - mu;
                const float var = sum16((dy.x * dy.x + dy.y * dy.y) + (dy.z * dy.z + dy.w * dy.w)) * (1.f / 64.f);
                const float rs = rsqrtf(var + GN_EPS);
                const float bonus = sum16((r.x * k2.x * rk.x + r.y * k2.y * rk.y) + (r.z * k2.z * rk.z + r.w * k2.w * rk.w));
                const f32x4 ov = (dy * rs * lg + lb + bonus * v) * g;
                outv = (u32x2){pk2(ov.x, ov.y), pk2(ov.z, ov.w)};
            }
            *(u32x2*)(WSP(bf16_t, WS_MIX) + (size_t)row * 1024 + 512 + c) = outv;
        }
    }
}

struct EpiOutProj {
    const P& p; int tm, tn;
    DEVI void operator()(f32x4 (&acc)[4][4], int wm, int wn, int l15, int lq) const {
#pragma unroll
        for (int mt = 0; mt < 4; ++mt) { const size_t row = (size_t)tm * 128 + wm * 64 + mt * 16 + l15;
#pragma unroll
            for (int nt = 0; nt < 4; ++nt) { const size_t o = row * 1024 + tn * 128 + wn * 64 + nt * 16 + 4 * lq;
                *(f32x4*)(WSP(float, WS_PRE1) + o) = *(const f32x4*)(WSP(float, WS_H0F) + o) * ALPHA + acc[mt][nt]; } }
    }
};
DEVI void phase4b(const P& p, int bid, int nb, char* lds) {
    const int tid = threadIdx.x, srow = tid >> 3, skc = tid & 7;
    for (int it = bid; it < 130 * 8; it += nb) {
        const int tm = it / 8, tn = it % 8;
        const bf16_t *ap[4], *bp[4];
#pragma unroll
        for (int i = 0; i < 4; ++i) { ap[i] = WSP(bf16_t, WS_MIX) + (size_t)(tm * 128 + srow + 32 * i) * 1024 + skc * 8; bp[i] = WSP(bf16_t, WS_WOUTT) + (size_t)(tn * 128 + srow + 32 * i) * 1024 + skc * 8; }
        gemm128<false>(ap, bp, 1024, lds, EpiOutProj{p, tm, tn});
    }
}

DEVI void phase4c(const P& p, int bid, int nb, char* lds) {
    const int tid = threadIdx.x, lane = tid & 63, wid = tid >> 6;
    float* hrow = (float*)lds + wid * 1024;
    unsigned* cnt = WSP(unsigned, WS_CTL) + CW_CNT;
    for (int row = bid * 4 + wid; row < NP; row += nb * 4) {
        f32x4* hf = (f32x4*)(WSP(float, WS_H1F) + (size_t)row * 1024) + lane; u32x2* hb = (u32x2*)(WSP(bf16_t, WS_H1B) + (size_t)row * 1024) + lane;
        if ((row % LP) < PADL) {
#pragma unroll
            for (int j = 0; j < 4; ++j) { hf[64 * j] = (f32x4){0.f, 0.f, 0.f, 0.f}; hb[64 * j] = (u32x2){0u, 0u}; }
            continue;
        }
        const f32x4* src = (const f32x4*)(WSP(float, WS_PRE1) + (size_t)row * 1024) + lane;
        f32x4 v[4]; float s = 0.f;
#pragma unroll
        for (int j = 0; j < 4; ++j) { v[j] = src[64 * j]; s += (v[j].x + v[j].y) + (v[j].z + v[j].w); }
        const float mean = wave_sum(s) * (1.f / 1024.f); float s2 = 0.f;
#pragma unroll
        for (int j = 0; j < 4; ++j) { v[j] = v[j] - mean; s2 += (v[j].x * v[j].x + v[j].y * v[j].y) + (v[j].z * v[j].z + v[j].w * v[j].w); }
        const float rstd = rsqrtf(wave_sum(s2) * (1.f / 1024.f) + LN_EPS);
#pragma unroll
        for (int j = 0; j < 4; ++j) {
            const f32x4 g = ((const f32x4*)p.ln1_g)[lane + 64 * j], bb = ((const f32x4*)p.ln1_b)[lane + 64 * j];
            const f32x4 o = v[j] * rstd * g + bb;
            hf[64 * j] = o; hb[64 * j] = (u32x2){pk2(o.x, o.y), pk2(o.z, o.w)};
            *(f32x4*)(hrow + lane * 4 + 256 * j) = o;
        }
        const int e = lane & 31, half = lane >> 5;
        const float* wr = p.w_router + (size_t)half * 512 * 32 + e; const float* hh = hrow + half * 512;
        float a0 = 0.f, a1 = 0.f, a2 = 0.f, a3 = 0.f;
        for (int k = 0; k < 512; k += 4) { a0 += hh[k] * wr[(size_t)k * 32]; a1 += hh[k + 1] * wr[(size_t)(k + 1) * 32]; a2 += hh[k + 2] * wr[(size_t)(k + 2) * 32]; a3 += hh[k + 3] * wr[(size_t)(k + 3) * 32]; }
        float logit = (a0 + a1) + (a2 + a3);
        logit += __shfl_xor(logit, 32);
        logit += p.b_router[e];
        float cur = logit; float tv[4]; int ti[4];
#pragma unroll
        for (int k = 0; k < 4; ++k) {
            float bv = cur; int bi = e;
#pragma unroll
            for (int o = 16; o > 0; o >>= 1) { const float ov = __shfl_xor(bv, o); const int oi = __shfl_xor(bi, o); if (ov > bv || (ov == bv && oi < bi)) { bv = ov; bi = oi; } }
            tv[k] = bv; ti[k] = bi; if (e == bi) cur = -INFINITY;
        }
        const float e1 = __expf(tv[1] - tv[0]), e2 = __expf(tv[2] - tv[0]), e3 = __expf(tv[3] - tv[0]); const float inv = 1.f / (1.f + e1 + e2 + e3);
        if (lane < 4) {
            const int ex = lane == 0 ? ti[0] : lane == 1 ? ti[1] : lane == 2 ? ti[2] : ti[3];
            const float gt = (lane == 0 ? 1.f : lane == 1 ? e1 : lane == 2 ? e2 : e3) * inv;
            const unsigned rank = atomicAdd(cnt + ex, 1u);
            WSP(int, WS_LTOK)[(size_t)ex * CAP + rank] = row; WSP(float, WS_LGATE)[(size_t)ex * CAP + rank] = gt;
            WSP(int, WS_RTE)[(size_t)row * 4 + lane] = ex; WSP(int, WS_RTR)[(size_t)row * 4 + lane] = (int)rank;
        }
    }
}

DEVI void moe_prefix(const P& p, int* pb, int* cn) {
    if (threadIdx.x == 0) { const unsigned* cnt = WSP(unsigned, WS_CTL) + CW_CNT; int acc = 0; for (int e = 0; e < NEXP; ++e) { const int c = (int)cnt[e]; cn[e] = c; pb[e] = acc; acc += (c + 127) >> 7; } pb[NEXP] = acc; }
    __syncthreads();
}
DEVI int find_expert(const int* pb, int mbg) { int e = 0; while (e < NEXP - 1 && pb[e + 1] <= mbg) ++e; return e; }

struct EpiGU {
    const P& p; int e, mbg, tn;
    DEVI void operator()(f32x4 (&acc)[4][4], int wm, int wn, int l15, int lq) const {
        const float* bg = p.b_gu + (size_t)e * 2048;
#pragma unroll
        for (int mt = 0; mt < 4; ++mt) { const size_t row = (size_t)mbg * 128 + wm * 64 + mt * 16 + l15;
#pragma unroll
            for (int np = 0; np < 2; ++np) { const int jc = tn * 64 + wn * 32 + np * 16 + 4 * lq;
                const f32x4 bgt = *(const f32x4*)(bg + jc), bup = *(const f32x4*)(bg + 1024 + jc); float ov[4];
#pragma unroll
                for (int r = 0; r < 4; ++r) { const float gate = fminf(acc[mt][2 * np][r] + bgt[r], 7.f); const float up = fminf(fmaxf(acc[mt][2 * np + 1][r] + bup[r], -7.f), 7.f);
                    ov[r] = (up + 1.f) * (gate * sigmoidf(gate * 1.702f)); }
                *(u32x2*)(WSP(bf16_t, WS_ACT) + row * 1024 + jc) = (u32x2){pk2(ov[0], ov[1]), pk2(ov[2], ov[3])}; } }
    }
};
DEVI void phase5(const P& p, int bid, int nb, char* lds) {
    int* pb = (int*)(lds + 65536); int* cn = pb + 40;
    moe_prefix(p, pb, cn);
    const int tid = threadIdx.x, srow = tid >> 3, skc = tid & 7; const int total = pb[NEXP] * 16;
    for (int it = bid; it < total; it += nb) {
        const int mbg = it >> 4, tn = it & 15, e = find_expert(pb, mbg), mb = mbg - pb[e];
        const bf16_t *ap[4], *bp[4];
#pragma unroll
        for (int i = 0; i < 4; ++i) { const int idx = mb * 128 + srow + 32 * i; const int tok = idx < cn[e] ? WSP(int, WS_LTOK)[(size_t)e * CAP + idx] : 0;
            ap[i] = WSP(bf16_t, WS_H1B) + (size_t)tok * 1024 + skc * 8; bp[i] = WSP(bf16_t, WS_WGUT) + ((size_t)e * 2048 + tn * 128 + srow + 32 * i) * 1024 + skc * 8; }
        gemm128<false>(ap, bp, 1024, lds, EpiGU{p, e, mbg, tn});
    }
}
struct EpiDown {
    const P& p; int e, mbg, mb, cnt_e, tn;
    DEVI void operator()(f32x4 (&acc)[4][4], int wm, int wn, int l15, int lq) const {
        const float* bd = p.b_down + (size_t)e * 1024;
#pragma unroll
        for (int mt = 0; mt < 4; ++mt) { const int ml = wm * 64 + mt * 16 + l15; const int idx = mb * 128 + ml; const float gt = idx < cnt_e ? WSP(float, WS_LGATE)[(size_t)e * CAP + idx] : 0.f;
            const size_t row = (size_t)mbg * 128 + ml;
#pragma unroll
            for (int nt = 0; nt < 4; ++nt) { const int c = tn * 128 + wn * 64 + nt * 16 + 4 * lq; *(f32x4*)(WSP(float, WS_YB) + row * 1024 + c) = (acc[mt][nt] + *(const f32x4*)(bd + c)) * gt; } }
    }
};
DEVI void phase6(const P& p, int bid, int nb, char* lds) {
    int* pb = (int*)(lds + 65536); int* cn = pb + 40;
    moe_prefix(p, pb, cn);
    const int tid = threadIdx.x, srow = tid >> 3, skc = tid & 7; const int total = pb[NEXP] * 8;
    for (int it = bid; it < total; it += nb) {
        const int mbg = it >> 3, tn = it & 7, e = find_expert(pb, mbg), mb = mbg - pb[e];
        const bf16_t *ap[4], *bp[4];
#pragma unroll
        for (int i = 0; i < 4; ++i) { ap[i] = WSP(bf16_t, WS_ACT) + ((size_t)mbg * 128 + srow + 32 * i) * 1024 + skc * 8; bp[i] = WSP(bf16_t, WS_WDT) + ((size_t)e * 1024 + tn * 128 + srow + 32 * i) * 1024 + skc * 8; }
        gemm128<false>(ap, bp, 1024, lds, EpiDown{p, e, mbg, mb, cn[e], tn});
    }
}
DEVI void phase7(const P& p, int bid, int nb, char* lds) {
    int* pb = (int*)(lds + 65536); int* cn = pb + 40;
    moe_prefix(p, pb, cn);
    const int tid = threadIdx.x, lane = tid & 63, wid = tid >> 6;
    for (int row = bid * 4 + wid; row < NP; row += nb * 4) {
        const int b = row / LP, pp = row % LP; if (pp < PADL + NMETA) continue;
        const int t = pp - PADL - NMETA;
        const f32x4* h1 = (const f32x4*)(WSP(float, WS_H1F) + (size_t)row * 1024) + lane;
        f32x4 v[4];
#pragma unroll
        for (int j = 0; j < 4; ++j) v[j] = h1[64 * j] * ALPHA;
#pragma unroll
        for (int k = 0; k < 4; ++k) { const int e = WSP(int, WS_RTE)[(size_t)row * 4 + k], rk = WSP(int, WS_RTR)[(size_t)row * 4 + k];
            const f32x4* yb = (const f32x4*)(WSP(float, WS_YB) + ((size_t)pb[e] * 128 + rk) * 1024) + lane;
#pragma unroll
            for (int j = 0; j < 4; ++j) v[j] += yb[64 * j]; }
        float s = 0.f;
#pragma unroll
        for (int j = 0; j < 4; ++j) s += (v[j].x + v[j].y) + (v[j].z + v[j].w);
        const float mean = wave_sum(s) * (1.f / 1024.f); float s2 = 0.f;
#pragma unroll
        for (int j = 0; j < 4; ++j) { v[j] = v[j] - mean; s2 += (v[j].x * v[j].x + v[j].y * v[j].y) + (v[j].z * v[j].z + v[j].w * v[j].w); }
        const float rstd = rsqrtf(wave_sum(s2) * (1.f / 1024.f) + LN_EPS);
        f32x4* o = (f32x4*)(p.out + ((size_t)b * SEQ + t) * 1024) + lane;
#pragma unroll
        for (int j = 0; j < 4; ++j) o[64 * j] = v[j] * rstd * ((const f32x4*)p.ln2_g)[lane + 64 * j] + ((const f32x4*)p.ln2_b)[lane + 64 * j];
    }
}

constexpr int LDS_BYTES = 65536 + 512;
template <int PH> __global__ void __launch_bounds__(256, 2) k_phase(P p) {
    __shared__ __attribute__((aligned(16))) char lds[LDS_BYTES];
    const int bid = blockIdx.x, nb = gridDim.x;
    if (PH == 0) phase0(p, bid, nb, lds);
    if (PH == 1) phase1(p, bid, nb, lds);
    if (PH == 2) phase2a(p, bid, nb, lds);
    if (PH == 3) phase2b(p, bid, nb, lds);
    if (PH == 4) phase3a(p, bid, nb, lds);
    if (PH == 5) scan_job(p, bid, lds);
    if (PH == 6) phase4a(p, bid, nb, lds);
    if (PH == 7) phase4b(p, bid, nb, lds);
    if (PH == 8) phase4c(p, bid, nb, lds);
    if (PH == 9) phase5(p, bid, nb, lds);
    if (PH == 10) phase6(p, bid, nb, lds);
    if (PH == 11) phase7(p, bid, nb, lds);
}

extern "C" void kernel_launch(void* const* d_in, const int* in_sizes, int n_in, void* d_out, int out_size, void* d_ws, size_t ws_size, hipStream_t stream) {
    if (n_in != 29 || ws_size < WS_NEED) { fprintf(stderr, "kernel_launch: unexpected n_in %d or ws_size %zu (need %zu)\n", n_in, ws_size, (size_t)WS_NEED); return; }
    P p{};
    const float** pf = (const float**)&p;
    for (int i = 0; i < 29; ++i) pf[i] = (const float*)d_in[i];
    p.out = (float*)d_out; p.ws = (unsigned char*)d_ws;
    k_phase<0><<<2048, 256, 0, stream>>>(p);
    k_phase<1><<<130 * 27, 256, 0, stream>>>(p);
    k_phase<2><<<2048, 256, 0, stream>>>(p);
    k_phase<3><<<130 * 12, 256, 0, stream>>>(p);
    k_phase<4><<<16 * NQB, 256, 0, stream>>>(p);
    k_phase<5><<<64, 256, 0, stream>>>(p);
    k_phase<6><<<2048, 256, 0, stream>>>(p);
    k_phase<7><<<130 * 8, 256, 0, stream>>>(p);
    k_phase<8><<<2048, 256, 0, stream>>>(p);
    k_phase<9><<<2048, 256, 0, stream>>>(p);
    k_phase<10><<<2048, 256, 0, stream>>>(p);
    k_phase<11><<<2048, 256, 0, stream>>>(p);
}
```

```cpp
#include <hip/hip_runtime.h>
#include <hip/hip_cooperative_groups.h>
#include <stdint.h>
#include <stdio.h>

#define DEVI __device__ __forceinline__
typedef unsigned short bf16_t;
typedef short bf16x8 __attribute__((ext_vector_type(8)));
typedef float f32x4 __attribute__((ext_vector_type(4)));
typedef float f32x16 __attribute__((ext_vector_type(16)));
typedef unsigned u32x4 __attribute__((ext_vector_type(4)));
typedef unsigned u32x2 __attribute__((ext_vector_type(2)));

constexpr int BATCH = 2, SEQ = 8192, DM = 1024, NMETA = 16;
constexpr int LTOK = SEQ + NMETA;
constexpr int PADL = 112;
constexpr int LP = LTOK + PADL;
constexpr int NP = BATCH * LP;
constexpr int NQB = LP / 128;
constexpr int NH = 8, HD = 64;
constexpr int FOXW = 512, RWW = 512;
constexpr int RWKV_COLS = 1792;
constexpr int IN_COLS = 3336;
constexpr int WIN_N = 3456;
constexpr int NEXP = 32, TOPK = 4;
constexpr int CAP = BATCH * LTOK;
constexpr int MAXBLK = (BATCH * LTOK * TOPK) / 256 + NEXP + 1;
constexpr float ALPHA = 1.189207115002721f;
constexpr float LN_EPS = 1e-5f, GN_EPS = 64e-5f, RMS_EPS = 1e-6f;
constexpr float LOG2E = 1.4426950408889634f;
constexpr float QSCALE = 0.125f * LOG2E;
constexpr float NEGBIG = -1e30f;

constexpr size_t MiB = 1u << 20;
constexpr size_t al256(size_t x) { return (x + 255) & ~(size_t)255; }
constexpr size_t WS_CTL = 0;
constexpr size_t WS_WINT = 1 * MiB;
constexpr size_t WS_WOUTT = WS_WINT + (size_t)WIN_N * 1024 * 2;
constexpr size_t WS_W2T = WS_WOUTT + (size_t)1024 * 1024 * 2;
constexpr size_t WS_A2T = WS_W2T + 512 * 64 * 2;
constexpr size_t WS_G2T = WS_A2T + 512 * 64 * 2;
constexpr size_t WS_WGUT = al256(WS_G2T + 512 * 128 * 2);
constexpr size_t WS_WDT = WS_WGUT + (size_t)32 * 2048 * 1024 * 2;
constexpr size_t WS_ST1 = WS_WDT + (size_t)32 * 1024 * 1024 * 2;
constexpr size_t WS_H1B = WS_ST1 + (size_t)NP * 2 * 4;
constexpr size_t WS_RTE = WS_H1B + (size_t)NP * 1024 * 2;
constexpr size_t WS_RTR = WS_RTE + (size_t)NP * 16;
constexpr size_t WS_LTOK = WS_RTR + (size_t)NP * 16;
constexpr size_t WS_LGATE = WS_LTOK + (size_t)32 * CAP * 4;
constexpr size_t WS_PRE1 = al256(WS_LGATE + (size_t)32 * CAP * 4);
constexpr size_t WS_EARLY = WS_PRE1 + (size_t)NP * 1024 * 4;
constexpr size_t WS_H0B = WS_EARLY;
constexpr size_t WS_QB = WS_H0B + (size_t)NP * 1024 * 2;
constexpr size_t WS_KB = WS_QB + (size_t)NP * 512 * 2;
constexpr size_t WS_VT = WS_KB + (size_t)NP * 512 * 2;
constexpr size_t WS_ZR = WS_VT + (size_t)NP * 512 * 2;
constexpr size_t WS_LF = WS_ZR + (size_t)NP * 1792 * 4;
constexpr size_t WS_CS = WS_LF + (size_t)NP * 8 * 4;
constexpr size_t WS_R = WS_CS + (size_t)NP * 8 * 4;
constexpr size_t WS_CHK = WS_R;
static_assert((size_t)16 * 129 * 32768 <= (size_t)4 * NP * 512 * 2, "chunk buffers fit");
constexpr size_t WS_KR = WS_R + (size_t)NP * 512 * 2;
constexpr size_t WS_VR = WS_KR + (size_t)NP * 512 * 2;
constexpr size_t WS_KK = WS_VR + (size_t)NP * 512 * 2;
constexpr size_t WS_TW = WS_KK + (size_t)NP * 512 * 2;
constexpr size_t WS_DA = WS_TW + (size_t)NP * 64 * 2;
constexpr size_t WS_SG = WS_DA + (size_t)NP * 64 * 2;
constexpr size_t WS_RW = WS_SG + (size_t)NP * 128 * 2;
constexpr size_t WS_RB = WS_RW + (size_t)NP * 512 * 4;
constexpr size_t WS_RK2 = WS_RB + (size_t)NP * 512 * 2;
constexpr size_t WS_G = WS_RK2 + (size_t)NP * 512 * 2;
constexpr size_t WS_Y = WS_G + (size_t)NP * 512 * 2;
constexpr size_t WS_MIX = WS_Y + (size_t)NP * 512 * 4;
constexpr size_t WS_LGS = WS_MIX + (size_t)NP * 1024 * 2;
constexpr size_t WS_EARLY_END = WS_LGS + (size_t)1024 * 32768;
constexpr size_t WS_ACT = WS_EARLY;
constexpr size_t WS_YB = WS_ACT + (size_t)MAXBLK * 256 * 1024 * 2;
constexpr size_t WS_LATE_END = WS_YB + (size_t)MAXBLK * 256 * 1024 * 2;
constexpr size_t WS_NEED = WS_EARLY_END > WS_LATE_END ? WS_EARLY_END : WS_LATE_END;
constexpr int CW_CNT = 0;
constexpr int CW_QATT = 64;
constexpr int CW_XRANK = 1024;

struct P {
    const float *x, *meta, *ln0_g, *ln0_b, *w_in, *b_fgate, *fox_norm_g, *rwkv_mu, *w0, *w2, *a0, *a2, *g2, *k_k, *k_a, *r_k, *lnx_g,
        *lnx_b, *w_out, *ln1_g, *ln1_b, *w_router, *b_router, *w_gu, *b_gu, *w_down, *b_down, *ln2_g, *ln2_b;
    float* out;
    unsigned char* ws;
};
#define WSP(T, off) ((T*)(p.ws + (off)))

#define LBAR() do { asm volatile("s_waitcnt lgkmcnt(0)" ::: "memory"); __builtin_amdgcn_s_barrier(); asm volatile("" ::: "memory"); } while (0)
DEVI int otid() { int t = threadIdx.x; asm volatile("" : "+v"(t)); return t; }
DEVI unsigned f2bf(float f) { unsigned u = __float_as_uint(f); u += 0x7fffu + ((u >> 16) & 1u); return u >> 16; }
typedef float f32x2 __attribute__((ext_vector_type(2)));
typedef __bf16 bf16x2_t __attribute__((ext_vector_type(2)));
DEVI unsigned pk2(float lo, float hi) { const f32x2 v = {lo, hi}; const bf16x2_t b = __builtin_convertvector(v, bf16x2_t); return __builtin_bit_cast(unsigned, b); }
DEVI f32x4 ld4bf(const bf16_t* p) { const u32x2 w = *(const u32x2*)p; return (f32x4){__uint_as_float(w.x << 16), __uint_as_float(w.x & 0xffff0000u), __uint_as_float(w.y << 16), __uint_as_float(w.y & 0xffff0000u)}; }
DEVI void st4bf(bf16_t* p, f32x4 v) { *(u32x2*)p = (u32x2){pk2(v.x, v.y), pk2(v.z, v.w)}; }
DEVI float ld1bf(const bf16_t* p) { return __uint_as_float((unsigned)(*p) << 16); }
DEVI float wave_sum(float v) {
#pragma unroll
    for (int o = 32; o > 0; o >>= 1) v += __shfl_xor(v, o);
    return v;
}
DEVI float sum16(float v) {
#pragma unroll
    for (int o = 8; o > 0; o >>= 1) v += __shfl_xor(v, o);
    return v;
}
DEVI float dpp_add(float v, int) { return v; }
template <int CTRL> DEVI float dpp_mov(float v) { return __int_as_float(__builtin_amdgcn_update_dpp(0, __float_as_int(v), CTRL, 0xF, 0xF, false)); }
DEVI float rowsum16_dpp(float v) {
    v += dpp_mov<0xB1>(v);
    v += dpp_mov<0x4E>(v);
    v += dpp_mov<0x141>(v);
    v += dpp_mov<0x140>(v);
    return v;
}
DEVI float softplusf(float x) { return fmaxf(x, 0.f) + log1pf(__expf(-fabsf(x))); }
DEVI float sigmoidf(float x) { return __builtin_amdgcn_rcpf(1.f + __expf(-x)); }
DEVI float tanh_fast(float x) { return 1.f - 2.f * __builtin_amdgcn_rcpf(__expf(2.f * x) + 1.f); }
DEVI f32x4 zs4(const bf16_t* zrow, int col, const float* mu) { const f32x4 zc = ld4bf(zrow + col), zp = ld4bf(zrow - RWKV_COLS + col); return zc + (zp - zc) * *(const f32x4*)(mu + col); }
DEVI float softplus_fast(float x) { return fmaxf(x, 0.f) + __logf(1.f + __expf(-fabsf(x))); }

template <bool SWAP, class Epi>
DEVI void gemm128(const bf16_t* (&ap)[4], const bf16_t* (&bp)[4], int K, char* lds, Epi&& epi) {
    typedef __attribute__((address_space(3))) unsigned lds_u32;
    const int tid = otid(), lane = tid & 63, wid = __builtin_amdgcn_readfirstlane(tid >> 6), wm = wid >> 1, wn = wid & 1;
    const int l15 = lane & 15, lq = lane >> 4;
    const int srow = tid >> 3, skc = tid & 7;
    const int gko = ((skc ^ ((srow >> 1) & 7)) << 3);
    f32x4 acc[4][4];
#pragma unroll
    for (int i = 0; i < 4; ++i)
#pragma unroll
        for (int j = 0; j < 4; ++j) acc[i][j] = (f32x4){0.f, 0.f, 0.f, 0.f};
    const int nk = K / 64;
    auto stage = [&](int kt, int s) {
        char* base = lds + s * 32768 + wid * 1024;
#pragma unroll
        for (int i = 0; i < 4; ++i) {
            __builtin_amdgcn_global_load_lds((const unsigned*)(ap[i] + kt * 64 + gko), (lds_u32*)(base + i * 4096), 16, 0, 0);
            __builtin_amdgcn_global_load_lds((const unsigned*)(bp[i] + kt * 64 + gko), (lds_u32*)(base + 16384 + i * 4096), 16, 0, 0);
        }
    };
    stage(0, 0);
    asm volatile("s_waitcnt vmcnt(0)" ::: "memory"); __builtin_amdgcn_s_barrier(); asm volatile("" ::: "memory");
    const int aoff = (wm * 64 + l15) * 128, boff = 16384 + (wn * 64 + l15) * 128, sw = l15 >> 1;
    for (int kt = 0; kt < nk; ++kt) {
        const int s = kt & 1;
        if (kt + 1 < nk) stage(kt + 1, s ^ 1);
        const char* base = lds + s * 32768;
#pragma unroll
        for (int ks = 0; ks < 2; ++ks) {
            bf16x8 af[4], bfr[4];
            const int co = ((ks * 4 + lq) ^ sw) << 4;
#pragma unroll
            for (int t = 0; t < 4; ++t) { af[t] = *(const bf16x8*)(base + aoff + t * 2048 + co); bfr[t] = *(const bf16x8*)(base + boff + t * 2048 + co); }
#pragma unroll
            for (int mt = 0; mt < 4; ++mt)
#pragma unroll
                for (int nt = 0; nt < 4; ++nt) {
                    if (SWAP) acc[mt][nt] = __builtin_amdgcn_mfma_f32_16x16x32_bf16(af[mt], bfr[nt], acc[mt][nt], 0, 0, 0);
                    else acc[mt][nt] = __builtin_amdgcn_mfma_f32_16x16x32_bf16(bfr[nt], af[mt], acc[mt][nt], 0, 0, 0);
                }
        }
        asm volatile("s_waitcnt vmcnt(0) lgkmcnt(0)" ::: "memory"); __builtin_amdgcn_s_barrier(); asm volatile("" ::: "memory");
    }
    epi(acc, wm, wn, l15, lq);
}

constexpr int G2_STAGE = 24576;
constexpr int LDS_BYTES = 73728 + 1024;
constexpr int LX = 73728;
DEVI int xf4(int r) { return (0x78 >> (2 * ((r >> 2) & 3))) & 3; }
template <bool SWAP, int MT, class Epi>
DEVI void gemm256(const bf16_t* (&ap)[4], const bf16_t* (&bp)[2], int K, char* lds, Epi&& epi) {
    typedef __attribute__((address_space(3))) unsigned lds_u32;
    constexpr int NA = MT / 2 < 1 ? 1 : MT / 2;
    const int tid = otid(), lane = tid & 63, wid = __builtin_amdgcn_readfirstlane(tid >> 6), wm = wid >> 1, wn = wid & 1;
    const int l15 = lane & 15, lq = lane >> 4;
    const int gko = ((lane & 3) ^ xf4(lane >> 2)) << 3;
    f32x4 acc[MT][4];
#pragma unroll
    for (int i = 0; i < MT; ++i)
#pragma unroll
        for (int j = 0; j < 4; ++j) acc[i][j] = (f32x4){0.f, 0.f, 0.f, 0.f};
    const int nk = K / 32;
#define G2_DMA_A(kt, s, i) __builtin_amdgcn_global_load_lds((const unsigned*)(ap[i] + (kt) * 32 + gko), (lds_u32*)(lds + (s) * G2_STAGE + wid * 1024 + (i) * 4096), 16, 0, 0)
#define G2_DMA_B(kt, s, i) __builtin_amdgcn_global_load_lds((const unsigned*)(bp[i] + (kt) * 32 + gko), (lds_u32*)(lds + (s) * G2_STAGE + wid * 1024 + 16384 + (i) * 4096), 16, 0, 0)
#define G2_MMA(mt) do { _Pragma("unroll") for (int nt = 0; nt < 4; ++nt) { \
        if (SWAP) acc[mt][nt] = __builtin_amdgcn_mfma_f32_16x16x32_bf16(af[mt], bfr[nt], acc[mt][nt], 0, 0, 0); \
        else acc[mt][nt] = __builtin_amdgcn_mfma_f32_16x16x32_bf16(bfr[nt], af[mt], acc[mt][nt], 0, 0, 0); } } while (0)
#pragma unroll
    for (int st = 0; st < 2; ++st) { if (st < nk) {
#pragma unroll
        for (int i = 0; i < NA; ++i) G2_DMA_A(st, st, i);
        G2_DMA_B(st, st, 0); G2_DMA_B(st, st, 1); } }
    const int co = (lq ^ xf4(l15)) << 4;
    const int aoff = (wm * (16 * MT) + l15) * 64 + co, boff = 16384 + (wn * 64 + l15) * 64 + co;
    int s = 0;
    for (int kt = 0; kt < nk; ++kt) {
        if (kt + 1 < nk) { if (MT == 8) asm volatile("s_waitcnt vmcnt(6)" ::: "memory"); else if (MT == 4) asm volatile("s_waitcnt vmcnt(4)" ::: "memory"); else asm volatile("s_waitcnt vmcnt(3)" ::: "memory"); }
        else asm volatile("s_waitcnt vmcnt(0)" ::: "memory");
        __builtin_amdgcn_s_barrier(); asm volatile("" ::: "memory");
        const char* base = lds + s * G2_STAGE;
        bf16x8 af[MT], bfr[4];
#pragma unroll
        for (int t = 0; t < 4; ++t) bfr[t] = *(const bf16x8*)(base + boff + t * 1024);
#pragma unroll
        for (int t = 0; t < (MT < 4 ? MT : 4); ++t) af[t] = *(const bf16x8*)(base + aoff + t * 1024);
        const bool pre = kt + 2 < nk; int s2 = s + 2; if (s2 >= 3) s2 -= 3;
        __builtin_amdgcn_sched_barrier(0); __builtin_amdgcn_s_setprio(1);
        G2_MMA(0); __builtin_amdgcn_sched_barrier(0);
        if (MT == 8) {
#pragma unroll
            for (int t = 4; t < MT; ++t) af[t] = *(const bf16x8*)(base + aoff + t * 1024);
            if (pre) G2_DMA_A(kt + 2, s2, 0); __builtin_amdgcn_sched_barrier(0);
            G2_MMA(1); if (pre) G2_DMA_A(kt + 2, s2, 1); __builtin_amdgcn_sched_barrier(0);
            G2_MMA(2); if (pre) G2_DMA_A(kt + 2, s2, 2); __builtin_amdgcn_sched_barrier(0);
            G2_MMA(3); if (pre) G2_DMA_A(kt + 2, s2, 3); __builtin_amdgcn_sched_barrier(0);
            G2_MMA(4); if (pre) G2_DMA_B(kt + 2, s2, 0); __builtin_amdgcn_sched_barrier(0);
            G2_MMA(5); if (pre) G2_DMA_B(kt + 2, s2, 1); __builtin_amdgcn_sched_barrier(0);
            G2_MMA(6); G2_MMA(7);
        } else if (MT == 4) {
            if (pre) G2_DMA_A(kt + 2, s2, 0); __builtin_amdgcn_sched_barrier(0);
            G2_MMA(1); if (pre) G2_DMA_A(kt + 2, s2, 1); __builtin_amdgcn_sched_barrier(0);
            G2_MMA(2); if (pre) { G2_DMA_B(kt + 2, s2, 0); G2_DMA_B(kt + 2, s2, 1); } __builtin_amdgcn_sched_barrier(0);
            G2_MMA(3);
        } else {
            if (pre) { G2_DMA_A(kt + 2, s2, 0); G2_DMA_B(kt + 2, s2, 0); G2_DMA_B(kt + 2, s2, 1); } __builtin_amdgcn_sched_barrier(0);
            G2_MMA(1);
        }
        __builtin_amdgcn_s_setprio(0);
        asm volatile("s_waitcnt lgkmcnt(0)" ::: "memory");
        s = s == 2 ? 0 : s + 1;
    }
#undef G2_DMA_A
#undef G2_DMA_B
#undef G2_MMA
    __builtin_amdgcn_s_barrier(); asm volatile("" ::: "memory");
    epi(acc, wm, wn, l15, lq);
}

DEVI int srccol(int kind, int n) {
    if (kind == 0) return n;
    if (kind == 1) { if (n < 1536) return n; if (n < 3328) return n + 8; if (n < 3336) return 1536 + (n - 3328); return -1; }
    const int T = n >> 5, w = n & 31;
    return w < 16 ? T * 16 + w : 1024 + T * 16 + (w - 16);
}
DEVI void conv_tile(const float* src, int K, int NS, bf16_t* dst, int kind, int kt, int nt, float* scr  ) {
    const int tid = otid();
    const int nl = tid & 63, n = nt * 64 + nl, sc = srccol(kind, n);
    float v[16];
#pragma unroll
    for (int i = 0; i < 16; ++i) { const int k = i * 4 + (tid >> 6); v[i] = sc >= 0 ? src[(size_t)(kt * 64 + k) * NS + sc] : 0.f; }
#pragma unroll
    for (int i = 0; i < 16; ++i) { const int k = i * 4 + (tid >> 6); scr[k * 65 + nl] = v[i]; }
    LBAR();
    const int on = tid >> 2, kc = (tid & 3) * 16;
    u32x4 o0, o1;
    const float* s = scr + kc * 65 + on;
    o0.x = pk2(s[0 * 65], s[1 * 65]); o0.y = pk2(s[2 * 65], s[3 * 65]); o0.z = pk2(s[4 * 65], s[5 * 65]); o0.w = pk2(s[6 * 65], s[7 * 65]);
    o1.x = pk2(s[8 * 65], s[9 * 65]); o1.y = pk2(s[10 * 65], s[11 * 65]); o1.z = pk2(s[12 * 65], s[13 * 65]); o1.w = pk2(s[14 * 65], s[15 * 65]);
    bf16_t* d = dst + (size_t)(nt * 64 + on) * K + kt * 64 + kc;
    *(u32x4*)d = o0; *(u32x4*)(d + 8) = o1;
    LBAR();
}
DEVI void phase0(const P& p, int bid, int nb, char* lds) {
    const int tid = otid(), lane = tid & 63, wid = tid >> 6;
    {
        bf16_t* H0B = WSP(bf16_t, WS_H0B);
        for (int row = bid * 4 + wid; row < NP; row += nb * 4) {
            const int b = row / LP, pp = row % LP;
            u32x2* hb = (u32x2*)(H0B + (size_t)row * 1024) + lane;
            if (pp < PADL) {
#pragma unroll
                for (int j = 0; j < 4; ++j) hb[64 * j] = (u32x2){0u, 0u};
                continue;
            }
            const int t = pp - PADL;
            const float* src = t < NMETA ? p.meta + (size_t)t * 1024 : p.x + ((size_t)b * SEQ + (t - NMETA)) * 1024;
            f32x4 v[4]; float s = 0.f;
#pragma unroll
            for (int j = 0; j < 4; ++j) { v[j] = ((const f32x4*)src)[lane + 64 * j]; s += (v[j].x + v[j].y) + (v[j].z + v[j].w); }
            const float mean = wave_sum(s) * (1.f / 1024.f); float s2 = 0.f;
#pragma unroll
            for (int j = 0; j < 4; ++j) { v[j] = v[j] - mean; s2 += (v[j].x * v[j].x + v[j].y * v[j].y) + (v[j].z * v[j].z + v[j].w * v[j].w); }
            const float rstd = rsqrtf(wave_sum(s2) * (1.f / 1024.f) + LN_EPS);
#pragma unroll
            for (int j = 0; j < 4; ++j) {
                const f32x4 g = ((const f32x4*)p.ln0_g)[lane + 64 * j], bb = ((const f32x4*)p.ln0_b)[lane + 64 * j];
                const f32x4 o = v[j] * rstd * g + bb;
                hb[64 * j] = (u32x2){pk2(o.x, o.y), pk2(o.z, o.w)};
            }
        }
    }
    {
        float* scr = (float*)lds;
        constexpr int T_IN = 16 * 54, T_OUT = 16 * 16, T_W2 = 8, T_A2 = 8, T_G2 = 16;
        constexpr int TOT = T_IN + T_OUT + T_W2 + T_A2 + T_G2;
        for (int it = bid; it < TOT; it += nb) {
            int r = it;
            if (r < T_IN) { conv_tile(p.w_in, 1024, IN_COLS, WSP(bf16_t, WS_WINT), 1, r / 54, r % 54, scr); continue; } r -= T_IN;
            if (r < T_OUT) { conv_tile(p.w_out, 1024, 1024, WSP(bf16_t, WS_WOUTT), 0, r / 16, r % 16, scr); continue; } r -= T_OUT;
            if (r < T_W2) { conv_tile(p.w2, 64, 512, WSP(bf16_t, WS_W2T), 0, 0, r, scr); continue; } r -= T_W2;
            if (r < T_A2) { conv_tile(p.a2, 64, 512, WSP(bf16_t, WS_A2T), 0, 0, r, scr); continue; } r -= T_A2;
            conv_tile(p.g2, 128, 512, WSP(bf16_t, WS_G2T), 0, r / 8, r % 8, scr);
        }
    }
}
DEVI void conv_wide(const float* src, int NS, bf16_t* dst, int kind, int kt, int nt, float* scr) {
    const int tid = otid();
    const int n = nt * 256 + tid, sc = srccol(kind, n);
    const float* sp = src + (size_t)(kt * 64) * NS + sc;
    float v[64];
#pragma unroll
    for (int k = 0; k < 64; ++k) v[k] = sp[(size_t)k * NS];
#pragma unroll
    for (int k = 0; k < 64; ++k) scr[k * 257 + tid] = v[k];
    LBAR();
    const int ch = tid & 7, r0 = tid >> 3;
#pragma unroll
    for (int j = 0; j < 8; ++j) { const int row = j * 32 + r0; const float* s = scr + (8 * ch) * 257 + row;
        *(u32x4*)(dst + (size_t)(nt * 256 + row) * 1024 + kt * 64 + 8 * ch) = (u32x4){pk2(s[0], s[257]), pk2(s[2 * 257], s[3 * 257]), pk2(s[4 * 257], s[5 * 257]), pk2(s[6 * 257], s[7 * 257])}; }
    LBAR();
}
constexpr int CONV_TILES = 12, N_CONV_ITEMS = (32 * 16 * 8 + 32 * 16 * 4) / CONV_TILES;
static_assert(2 * N_CONV_ITEMS <= 16 * (NQB - 1), "interleave pattern needs 2 attention items per conversion item");
DEVI void conv_moe_item(const P& p, int item, char* lds) {
    float* scr = (float*)lds;
    for (int t = 0; t < CONV_TILES; ++t) {
        int r = item * CONV_TILES + t;
        if (r < 32 * 128) { const int e = r / 128, q = r % 128; conv_wide(p.w_gu + (size_t)e * 1024 * 2048, 2048, WSP(bf16_t, WS_WGUT) + (size_t)e * 2048 * 1024, 2, q / 8, q % 8, scr); }
        else { r -= 32 * 128; const int e = r / 64, q = r % 64; conv_wide(p.w_down + (size_t)e * 1024 * 1024, 1024, WSP(bf16_t, WS_WDT) + (size_t)e * 1024 * 1024, 0, q / 4, q % 4, scr); }
    }
}

struct Sched { int x, rank, nloc, nxcd; };
template <class F> DEVI void for_xcd_items(const Sched& sc, F&& f) {
    const int x0 = sc.nxcd == 8 ? sc.x : 0, x1 = sc.nxcd == 8 ? sc.x + 1 : 8;
    for (int x = x0; x < x1; ++x) f(x, sc.rank, sc.nloc);
}

struct EpiInProj {
    const P& p; int tm, tn;
    DEVI void operator()(f32x4 (&acc)[8][4], int wm, int wn, int l15, int lq) const {
        if (tn < 8) {
            bf16_t* dst = tn < 4 ? WSP(bf16_t, WS_QB) : WSP(bf16_t, WS_KB); const float sc = tn < 4 ? QSCALE : 1.f;
            const int cb = (tn & 3) * 128 + wn * 64 + 4 * lq;
#pragma unroll
            for (int mt = 0; mt < 8; ++mt) { const size_t row = (size_t)tm * 256 + wm * 128 + mt * 16 + l15;
#pragma unroll
                for (int nt = 0; nt < 4; ++nt) { const f32x4 a = acc[mt][nt] * sc; *(u32x2*)(dst + row * 512 + cb + nt * 16) = (u32x2){pk2(a.x, a.y), pk2(a.z, a.w)}; } }
        } else if (tn < 12) {
            bf16_t* VT = WSP(bf16_t, WS_VT); const int row0 = tm * 256 + wm * 128;
#pragma unroll
            for (int mt = 0; mt < 8; ++mt) { const int row = row0 + mt * 16 + 4 * lq, b = row / LP, pp = row % LP;
#pragma unroll
                for (int nt = 0; nt < 4; ++nt) { const int n = (tn - 8) * 128 + wn * 64 + nt * 16 + l15; const f32x4 a = acc[mt][nt];
                    *(u32x2*)(VT + (size_t)(b * 512 + n) * LP + pp) = (u32x2){pk2(a.x, a.y), pk2(a.z, a.w)}; } }
        } else if (tn < 26) {
            bf16_t* ZR = WSP(bf16_t, WS_ZR); const int cb = (tn - 12) * 128 + wn * 64 + 4 * lq;
#pragma unroll
            for (int mt = 0; mt < 8; ++mt) { const size_t row = (size_t)tm * 256 + wm * 128 + mt * 16 + l15;
#pragma unroll
                for (int nt = 0; nt < 4; ++nt) st4bf(ZR + row * RWKV_COLS + cb + nt * 16, acc[mt][nt]); }
        } else {
            if (wn == 0 && lq < 2) { float* LF = WSP(float, WS_LF);
#pragma unroll
                for (int mt = 0; mt < 8; ++mt) { const int row = tm * 256 + wm * 128 + mt * 16 + l15; const bool pad = (row % LP) < PADL; f32x4 o;
#pragma unroll
                    for (int r = 0; r < 4; ++r) { const float xv = acc[mt][0][r] + p.b_fgate[4 * lq + r]; o[r] = pad ? 0.f : -softplusf(-xv); }
                    *(f32x4*)(LF + (size_t)row * 8 + 4 * lq) = o; } }
        }
    }
};
DEVI void phase1(const P& p, const Sched& sc, char* lds) {
    const int tid = otid(), lane = tid & 63, wid = tid >> 6, srow_ = 16 * wid + (lane >> 2);
    for_xcd_items(sc, [&](int x, int rank, int nloc) __attribute__((always_inline)) {
        const int xr = x >> 2, xc = x & 3, c0 = 7 * xc, cnt = xc == 3 ? 6 : 7, r0 = 33 * xr, nr = xr ? 32 : 33;
        for (int i = rank; i < nr * cnt; i += nloc) {
            const int tm = r0 + i / cnt, tn = c0 + i % cnt;
            const bf16_t *ap[4], *bp[2];
            int srow = srow_; asm volatile("" : "+v"(srow));
#pragma unroll
            for (int q = 0; q < 4; ++q) ap[q] = WSP(bf16_t, WS_H0B) + (size_t)(tm * 256 + srow + 64 * q) * 1024;
#pragma unroll
            for (int q = 0; q < 2; ++q) bp[q] = WSP(bf16_t, WS_WINT) + (size_t)(tn * 128 + srow + 64 * q) * 1024;
            if (tn >= 8 && tn < 12) gemm256<true, 8>(ap, bp, 1024, lds, EpiInProj{p, tm, tn});
            else gemm256<false, 8>(ap, bp, 1024, lds, EpiInProj{p, tm, tn});
        }
    });
}

DEVI void phase2a(const P& p, int bid, int nb, char* lds) {
    const int tid = otid(), lane = tid & 63, wid = tid >> 6;
    if (bid < 16) {
        const int b = bid >> 3, h = bid & 7; float* part = (float*)lds;
        const float* LF = WSP(float, WS_LF); float* CS = WSP(float, WS_CS);
        const int r0 = tid * 33, r1 = min(r0 + 33, LP); float s = 0.f;
        for (int r = r0; r < r1; ++r) s += LF[((size_t)b * LP + r) * 8 + h];
        part[tid] = s; __syncthreads();
        float pre = 0.f; for (int i = 0; i < tid; ++i) pre += part[i];
        for (int r = r0; r < r1; ++r) { pre += LF[((size_t)b * LP + r) * 8 + h]; CS[((size_t)b * LP + r) * 8 + h] = pre * LOG2E; }
        __syncthreads();
    }
    const bf16_t* ZR = WSP(bf16_t, WS_ZR);
    for (int row = bid * 4 + wid; row < NP; row += nb * 4) {
        const int pp = row % LP; const bool hasprev = pp > 0;
        const bf16_t* z = ZR + (size_t)row * RWKV_COLS + lane * 4; const bf16_t* zp = ZR + (size_t)(row - (hasprev ? 1 : 0)) * RWKV_COLS + lane * 4;
        const f32x4* mu = (const f32x4*)p.rwkv_mu + lane;
#pragma unroll
        for (int j = 0; j < 7; ++j) {
            const f32x4 zc = ld4bf(z + 256 * j); f32x4 zq = ld4bf(zp + 256 * j); if (!hasprev) zq = (f32x4){0.f, 0.f, 0.f, 0.f};
            const f32x4 zs = zc + (zq - zc) * mu[64 * j];
            const int c = (lane * 4 + 256 * j) & 511;
            if (j < 2) st4bf(WSP(bf16_t, WS_R) + (size_t)row * 512 + c, zs);
            else if (j < 4) {
                st4bf(WSP(bf16_t, WS_KR) + (size_t)row * 512 + c, zs);
                const f32x4 kr = zs * *(const f32x4*)(p.k_k + c);
                const float ss = sum16((kr.x * kr.x + kr.y * kr.y) + (kr.z * kr.z + kr.w * kr.w));
                const float inv = 1.f / fmaxf(sqrtf(ss), 1e-12f);
                st4bf(WSP(bf16_t, WS_KK) + (size_t)row * 512 + c, kr * inv);
            } else if (j < 6) st4bf(WSP(bf16_t, WS_VR) + (size_t)row * 512 + c, zs);
            else {
                if (lane < 16) *(u32x2*)(WSP(bf16_t, WS_TW) + (size_t)row * 64 + lane * 4) = (u32x2){pk2(tanhf(zs.x), tanhf(zs.y)), pk2(tanhf(zs.z), tanhf(zs.w))};
                else if (lane < 32) *(u32x2*)(WSP(bf16_t, WS_DA) + (size_t)row * 64 + (lane - 16) * 4) = (u32x2){pk2(zs.x, zs.y), pk2(zs.z, zs.w)};
                else *(u32x2*)(WSP(bf16_t, WS_SG) + (size_t)row * 128 + (lane - 32) * 4) = (u32x2){pk2(sigmoidf(zs.x), sigmoidf(zs.y)), pk2(sigmoidf(zs.z), sigmoidf(zs.w))};
            }
        }
    }
}

struct EpiLora {
    const P& p; int which, tm, tn;
    DEVI void operator()(f32x4 (&acc)[4][4], int wm, int wn, int l15, int lq) const {
#pragma unroll
        for (int mt = 0; mt < 4; ++mt) { const size_t row = (size_t)tm * 128 + wm * 64 + mt * 16 + l15;
#pragma unroll
            for (int nt = 0; nt < 4; ++nt) { const int c = tn * 128 + wn * 64 + nt * 16 + 4 * lq; const f32x4 a = acc[mt][nt];
                if (which == 0) { const f32x4 w0v = *(const f32x4*)(p.w0 + c); f32x4 o;
#pragma unroll
                    for (int r = 0; r < 4; ++r) { const float lw = w0v[r] + a[r]; const float wl = -softplusf(-lw) - 0.5f; o[r] = -__expf(wl); }
                    *(f32x4*)(WSP(float, WS_RW) + row * 512 + c) = o;
                } else if (which == 1) { const f32x4 a0v = *(const f32x4*)(p.a0 + c), kav = *(const f32x4*)(p.k_a + c);
                    const f32x4 kk = ld4bf(WSP(bf16_t, WS_KK) + row * 512 + c), kr = ld4bf(WSP(bf16_t, WS_KR) + row * 512 + c); f32x4 ob, ok;
#pragma unroll
                    for (int r = 0; r < 4; ++r) { const float av = sigmoidf(a0v[r] + a[r]); ob[r] = kk[r] * av; ok[r] = kr[r] * (1.f + (av - 1.f) * kav[r]); }
                    st4bf(WSP(bf16_t, WS_RB) + row * 512 + c, ob); st4bf(WSP(bf16_t, WS_RK2) + row * 512 + c, ok);
                } else st4bf(WSP(bf16_t, WS_G) + row * 512 + c, a);
            } }
    }
};
DEVI void phase2b(const P& p, int bid, int nb, char* lds) {
    const int tid = otid(), srow = tid >> 3, skc = tid & 7;
    for (int it = bid; it < 130 * 12; it += nb) {
        const int tm = it / 12, r = it % 12, which = r >> 2, tn = r & 3;
        const int K = which == 2 ? 128 : 64;
        const bf16_t* A = which == 0 ? WSP(bf16_t, WS_TW) : which == 1 ? WSP(bf16_t, WS_DA) : WSP(bf16_t, WS_SG);
        const bf16_t* Bt = which == 0 ? WSP(bf16_t, WS_W2T) : which == 1 ? WSP(bf16_t, WS_A2T) : WSP(bf16_t, WS_G2T);
        const bf16_t *ap[4], *bp[4];
#pragma unroll
        for (int i = 0; i < 4; ++i) { ap[i] = A + (size_t)(tm * 128 + srow + 32 * i) * K; bp[i] = Bt + (size_t)(tn * 128 + srow + 32 * i) * K; }
        gemm128<false>(ap, bp, K, lds, EpiLora{p, which, tm, tn});
    }
}

DEVI int pi_swap(int i) { return (i & ~12) | ((i & 4) << 1) | ((i & 8) >> 1); }
DEVI void attn_item(const P& p, int b, int h, int qb, char* lds) {
    const int tid = otid(), lane = tid & 63, wid = tid >> 6, ql = lane & 31, hi = lane >> 5;
    const int q_pp = qb * 128 + wid * 32 + ql; const size_t qrow = (size_t)b * LP + q_pp;
    const bf16_t* QB = WSP(bf16_t, WS_QB); const bf16_t* KB = WSP(bf16_t, WS_KB); const bf16_t* VT = WSP(bf16_t, WS_VT); const float* CS = WSP(float, WS_CS);
    bf16x8 qf[4];
#pragma unroll
    for (int d0 = 0; d0 < 4; ++d0) qf[d0] = *(const bf16x8*)(QB + qrow * 512 + h * 64 + 16 * d0 + 8 * hi);
    const float cref = CS[((size_t)b * LP + qb * 128) * 8 + h];
    const int r0 = tid >> 3, kc = tid & 7;
    const int soff = r0 * 128 + ((kc ^ ((r0 >> 1) & 7)) << 4);
    const bf16_t* ksrc = KB + ((size_t)b * LP + r0) * 512 + h * 64 + kc * 8;
    const bf16_t* vsrc = VT + (size_t)(b * 512 + h * 64 + r0) * LP + kc * 8;
    const float* csrc = CS + ((size_t)b * LP + (tid & 63)) * 8 + h;
    const int nkt = 2 * qb + 1;
    u32x4 rk[2], rv[2]; float rc = 0.f;
    auto gload = [&](int kt) {
#pragma unroll
        for (int i = 0; i < 2; ++i) { rk[i] = *(const u32x4*)(ksrc + (size_t)(64 * kt + 32 * i) * 512); rv[i] = *(const u32x4*)(vsrc + 64 * kt + (size_t)i * 32 * LP); }
        if (tid < 64) rc = csrc[(size_t)64 * kt * 8];
    };
    auto swrite = [&](int s) {
        char* bs = lds + s * 16640;
#pragma unroll
        for (int i = 0; i < 2; ++i) { *(u32x4*)(bs + soff + i * 4096) = rk[i]; *(u32x4*)(bs + 8192 + soff + i * 4096) = rv[i]; }
        if (tid < 64) *(float*)(bs + 16384 + tid * 4) = rc - cref;
    };
    float m = NEGBIG, l = 0.f; f32x16 o[2];
#pragma unroll
    for (int r = 0; r < 16; ++r) { o[0][r] = 0.f; o[1][r] = 0.f; }
    const int krow0 = pi_swap(ql);
    const int koff = krow0 * 128, ksw = (krow0 >> 1) & 7;
    const int voff = 8192 + ql * 128, vsw = (ql >> 1) & 7;
    gload(1); swrite(1 & 1); __syncthreads();
    for (int kt = 1; kt <= nkt; ++kt) {
        const int s = kt & 1;
        if (kt < nkt) gload(kt + 1);
        if (64 * kt <= qb * 128 + wid * 32 + 31) {
            const char* bs = lds + s * 16640;
            f32x16 sc[2];
#pragma unroll
            for (int kh = 0; kh < 2; ++kh) {
#pragma unroll
                for (int r = 0; r < 16; ++r) sc[kh][r] = 0.f;
#pragma unroll
                for (int d0 = 0; d0 < 4; ++d0) { const bf16x8 kf = *(const bf16x8*)(bs + kh * 4096 + koff + (((2 * d0 + hi) ^ ksw) << 4));
                    sc[kh] = __builtin_amdgcn_mfma_f32_32x32x16_bf16(kf, qf[d0], sc[kh], 0, 0, 0); }
            }
            const float* csl = (const float*)(bs + 16384);
            const bool needmask = (kt == 1) || (kt >= 2 * qb);
            f32x2 xv[2][8];
#pragma unroll
            for (int kh = 0; kh < 2; ++kh)
#pragma unroll
                for (int g = 0; g < 4; ++g) { const int key0 = 32 * kh + 16 * (g >> 1) + 8 * hi + 4 * (g & 1); const f32x4 cv = *(const f32x4*)(csl + key0);
                    xv[kh][2 * g] = (f32x2){sc[kh][4 * g], sc[kh][4 * g + 1]} - (f32x2){cv.x, cv.y};
                    xv[kh][2 * g + 1] = (f32x2){sc[kh][4 * g + 2], sc[kh][4 * g + 3]} - (f32x2){cv.z, cv.w}; }
            if (needmask) {
#pragma unroll
                for (int kh = 0; kh < 2; ++kh)
#pragma unroll
                    for (int g = 0; g < 4; ++g) { const int key0 = 32 * kh + 16 * (g >> 1) + 8 * hi + 4 * (g & 1);
#pragma unroll
                        for (int c = 0; c < 4; ++c) { const int kp = 64 * kt + key0 + c; if (kp > q_pp || kp < PADL) xv[kh][2 * g + (c >> 1)][c & 1] = NEGBIG; } }
            }
            float mloc;
            { float a = __builtin_fmaxf(__builtin_fmaxf(xv[0][0].x, xv[0][0].y), xv[1][0].x), bq = __builtin_fmaxf(__builtin_fmaxf(xv[0][1].x, xv[0][1].y), xv[1][0].y);
              a = __builtin_fmaxf(__builtin_fmaxf(a, xv[1][1].x), xv[1][1].y);
#pragma unroll
              for (int i = 2; i < 8; i += 2) { a = __builtin_fmaxf(__builtin_fmaxf(a, xv[0][i].x), xv[0][i].y); bq = __builtin_fmaxf(__builtin_fmaxf(bq, xv[0][i + 1].x), xv[0][i + 1].y);
                  a = __builtin_fmaxf(__builtin_fmaxf(a, xv[1][i].x), xv[1][i].y); bq = __builtin_fmaxf(__builtin_fmaxf(bq, xv[1][i + 1].x), xv[1][i + 1].y); }
              mloc = __builtin_fmaxf(a, bq); }
            { const auto rr = __builtin_amdgcn_permlane32_swap(__float_as_uint(mloc), __float_as_uint(mloc), false, false); mloc = fmaxf(__uint_as_float(rr[0]), __uint_as_float(rr[1])); }
            if (__any(mloc > m + 8.f)) {
                const float mnew = fmaxf(m, mloc); const float f = __builtin_amdgcn_exp2f(m - mnew); m = mnew; l *= f;
#pragma unroll
                for (int r = 0; r < 16; ++r) { o[0][r] *= f; o[1][r] *= f; }
            }
            bf16x8 pf[2][2]; f32x2 ls2 = (f32x2){0.f, 0.f}; const f32x2 m2 = (f32x2){m, m};
#pragma unroll
            for (int kh = 0; kh < 2; ++kh)
#pragma unroll
                for (int s2 = 0; s2 < 2; ++s2) { u32x4 w;
#pragma unroll
                    for (int j = 0; j < 4; ++j) { const f32x2 d = xv[kh][4 * s2 + j] - m2; f32x2 e; e.x = __builtin_amdgcn_exp2f(d.x); e.y = __builtin_amdgcn_exp2f(d.y); ls2 += e; w[j] = pk2(e.x, e.y); }
                    pf[kh][s2] = __builtin_bit_cast(bf16x8, w); }
            l += ls2.x + ls2.y;
#pragma unroll
            for (int dh = 0; dh < 2; ++dh)
#pragma unroll
                for (int kh = 0; kh < 2; ++kh)
#pragma unroll
                    for (int s2 = 0; s2 < 2; ++s2) { const bf16x8 vf = *(const bf16x8*)(bs + voff + dh * 4096 + (((4 * kh + 2 * s2 + hi) ^ vsw) << 4));
                        o[dh] = __builtin_amdgcn_mfma_f32_32x32x16_bf16(vf, pf[kh][s2], o[dh], 0, 0, 0); }
        }
        if (kt < nkt) swrite((kt + 1) & 1);
        __syncthreads();
    }
    l += __shfl_xor(l, 32);
    const float inv = 1.f / l; float ss = 0.f;
#pragma unroll
    for (int r = 0; r < 16; ++r) { o[0][r] *= inv; o[1][r] *= inv; ss += o[0][r] * o[0][r] + o[1][r] * o[1][r]; }
    ss += __shfl_xor(ss, 32);
    const float rs = rsqrtf(ss * (1.f / 64.f) + RMS_EPS);
    bf16_t* MIX = WSP(bf16_t, WS_MIX); const bool padq = q_pp < PADL;
#pragma unroll
    for (int dh = 0; dh < 2; ++dh)
#pragma unroll
        for (int g = 0; g < 4; ++g) { const int d = 32 * dh + 8 * g + 4 * hi; const f32x4 gn = *(const f32x4*)(p.fox_norm_g + h * 64 + d);
            float v0 = o[dh][4 * g] * rs * gn.x, v1 = o[dh][4 * g + 1] * rs * gn.y, v2 = o[dh][4 * g + 2] * rs * gn.z, v3 = o[dh][4 * g + 3] * rs * gn.w;
            if (padq) { v0 = v1 = v2 = v3 = 0.f; }
            *(u32x2*)(MIX + qrow * 1024 + h * 64 + d) = (u32x2){pk2(v0, v1), pk2(v2, v3)}; }
}
DEVI void phase3a(const P& p, int bid, int nb, char* lds) {
    for (int it = bid; it < 16 * NQB; it += nb) { const int qb = NQB - 1 - it / 16, bh = it % 16; attn_item(p, bh >> 3, bh & 7, qb, lds); }
}

constexpr int NCHUNK = 129;
constexpr int CHUNK_BYTES = 32768;
constexpr int C_XL = 32768, C_LG = 50176, C_PART = 67584, C_END = 68608;
DEVI int swz(int row, int chunk) { return row * 128 + ((chunk ^ ((row >> 1) & 7)) << 4); }
DEVI int crow(int r, int h) { return (r & 3) + 8 * (r >> 2) + 4 * h; }
DEVI bf16x8 frag(const char* base, int row, int ks, int h) { return *(const bf16x8*)(base + swz(row, 2 * ks + h)); }
DEVI void chunk_job(const P& p, int job, char* lds) {
    int tid_ = threadIdx.x; asm volatile("" : "+v"(tid_));
    const int tid = tid_, lane = tid & 63, wid = tid >> 6, l31 = lane & 31, h = lane >> 5, rb = wid >> 1, cb = wid & 1;
    const int bh = job / NCHUNK, c = job % NCHUNK, b = bh >> 3, hh = bh & 7;
    const size_t row0 = (size_t)b * LP + 64 + 64 * c; const int col0 = hh * 64;
    const bf16_t* BB = WSP(bf16_t, WS_RB) + row0 * 512 + col0; const bf16_t* K2 = WSP(bf16_t, WS_RK2) + row0 * 512 + col0;
    const bf16_t* ZRb = WSP(bf16_t, WS_ZR) + row0 * RWKV_COLS;
    float* LgG = WSP(float, WS_LGS) + (size_t)blockIdx.x * 8192;
    char* chk = (char*)p.ws + WS_CHK + (size_t)job * CHUNK_BYTES;
    char* R1 = lds; float* XL = (float*)(lds + C_XL); float* Lg = (float*)(lds + C_LG); float* part = (float*)(lds + C_PART);
    {
        const int t = tid >> 2, q = tid & 3; const bf16_t* zrow = ZRb + (size_t)t * RWKV_COLS; char* dst = R1 + q * 8192;
#pragma unroll 4
        for (int i = 0; i < 16; ++i) { f32x4 z = zs4(zrow, 1536 + 64 * q + 4 * i, p.rwkv_mu);
            if (q == 0) z = (f32x4){tanh_fast(z.x), tanh_fast(z.y), tanh_fast(z.z), tanh_fast(z.w)};
            else if (q >= 2) z = (f32x4){sigmoidf(z.x), sigmoidf(z.y), sigmoidf(z.z), sigmoidf(z.w)};
            *(u32x2*)(dst + swz(t, i >> 1) + (i & 1) * 8) = (u32x2){pk2(z.x, z.y), pk2(z.z, z.w)}; }
    }
    LBAR();
    {
        const bf16_t* W2T = WSP(bf16_t, WS_W2T) + (size_t)(col0 + 32 * cb + l31) * 64 + 8 * h; const bf16_t* A2T = WSP(bf16_t, WS_A2T) + (size_t)(col0 + 32 * cb + l31) * 64 + 8 * h;
        const bf16_t* G2T = WSP(bf16_t, WS_G2T) + (size_t)(col0 + 32 * cb + l31) * 128 + 8 * h;
        f32x16 dw, da, dg;
#pragma unroll
        for (int r = 0; r < 16; ++r) { dw[r] = 0.f; da[r] = 0.f; dg[r] = 0.f; }
#pragma unroll
        for (int ks = 0; ks < 4; ++ks) {
            dw = __builtin_amdgcn_mfma_f32_32x32x16_bf16(frag(R1, 32 * rb + l31, ks, h), *(const bf16x8*)(W2T + 16 * ks), dw, 0, 0, 0);
            da = __builtin_amdgcn_mfma_f32_32x32x16_bf16(frag(R1 + 8192, 32 * rb + l31, ks, h), *(const bf16x8*)(A2T + 16 * ks), da, 0, 0, 0);
        }
#pragma unroll
        for (int ks = 0; ks < 8; ++ks) dg = __builtin_amdgcn_mfma_f32_32x32x16_bf16(frag(R1 + 16384 + (ks >> 2) * 8192, 32 * rb + l31, ks & 3, h), *(const bf16x8*)(G2T + 16 * ks), dg, 0, 0, 0);
        LBAR();
        const int j = 32 * cb + l31; const float w0v = p.w0[col0 + j], a0v = p.a0[col0 + j]; float* At = (float*)R1;
#pragma unroll
        for (int r = 0; r < 16; ++r) { const int t = 32 * rb + crow(r, h);
            const float wl = -softplus_fast(-(w0v + dw[r])) - 0.5f; Lg[t * 64 + j] = -__expf(wl);
            At[t * 64 + j] = sigmoidf(a0v + da[r]);
            (WSP(bf16_t, WS_G) + row0 * 512 + col0)[(size_t)t * 512 + j] = (bf16_t)f2bf(dg[r]); }
    }
    LBAR();
    {
        const int cq = tid >> 6, cj = tid & 63; float cs[16]; float run = 0.f;
#pragma unroll
        for (int u = 0; u < 16; ++u) { run += Lg[(16 * cq + u) * 64 + cj]; cs[u] = run; }
        part[cq * 64 + cj] = run; LBAR();
        float off = 0.f;
        for (int q = 0; q < cq; ++q) off += part[q * 64 + cj];
#pragma unroll
        for (int u = 0; u < 16; ++u) { Lg[(16 * cq + u) * 64 + cj] = cs[u] + off; LgG[(16 * cq + u) * 64 + cj] = cs[u] + off; }
        LBAR();
    }
    {
        const int t = tid >> 2, jr = (tid & 3) * 16;
        f32x4 av4[4];
#pragma unroll
        for (int e4 = 0; e4 < 4; ++e4) av4[e4] = *(const f32x4*)((const float*)R1 + t * 64 + jr + 4 * e4);
        LBAR();
        const bf16_t* zrow = ZRb + (size_t)t * RWKV_COLS;
        f32x4 kr4[4], kk4[4], rr4[4], ka4[4]; float ss = 0.f;
        const int tp = t > 0 ? t - 1 : 0; const float pm = t > 0 ? 1.f : 0.f;
#pragma unroll
        for (int e4 = 0; e4 < 4; ++e4) { const int j = jr + 4 * e4;
            kr4[e4] = zs4(zrow, 512 + col0 + j, p.rwkv_mu); rr4[e4] = zs4(zrow, col0 + j, p.rwkv_mu); ka4[e4] = *(const f32x4*)(p.k_a + col0 + j);
            kk4[e4] = kr4[e4] * *(const f32x4*)(p.k_k + col0 + j);
            ss += (kk4[e4].x * kk4[e4].x + kk4[e4].y * kk4[e4].y) + (kk4[e4].z * kk4[e4].z + kk4[e4].w * kk4[e4].w); }
        ss += dpp_mov<0xB1>(ss); ss += dpp_mov<0x4E>(ss);
        const float kinv = 1.f / fmaxf(sqrtf(ss), 1e-12f);
#pragma unroll
        for (int e4 = 0; e4 < 4; ++e4) {
            const int j = jr + 4 * e4;
            const f32x4 lg = *(const f32x4*)(Lg + t * 64 + j), lgp = *(const f32x4*)(Lg + tp * 64 + j) * pm;
            const f32x4 kk = kk4[e4] * kinv, kr = kr4[e4], rr = rr4[e4], ka = ka4[e4];
            const f32x4 bb = kk * av4[e4], k2 = kr * (1.f + (av4[e4] - 1.f) * ka);
            st4bf((bf16_t*)BB + (size_t)t * 512 + j, bb); st4bf((bf16_t*)K2 + (size_t)t * 512 + j, k2);
            float at[4], rt[4], bt[4], kt[4];
#pragma unroll
            for (int q = 0; q < 4; ++q) { const float en = __expf(-lg[q]); at[q] = -kk[q] * __expf(lgp[q]); rt[q] = rr[q] * __expf(lg[q]); bt[q] = bb[q] * en; kt[q] = k2[q] * en; }
            const int o = swz(t, j >> 3) + (j & 7) * 2;
            *(u32x2*)(R1 + 0 + o) = (u32x2){pk2(bt[0], bt[1]), pk2(bt[2], bt[3])};
            *(u32x2*)(R1 + 8192 + o) = (u32x2){pk2(kt[0], kt[1]), pk2(kt[2], kt[3])};
            *(u32x2*)(R1 + 16384 + o) = (u32x2){pk2(at[0], at[1]), pk2(at[2], at[3])};
            *(u32x2*)(R1 + 24576 + o) = (u32x2){pk2(rt[0], rt[1]), pk2(rt[2], rt[3])};
#pragma unroll
            for (int q = 0; q < 4; ++q) XL[(j + q) * 68 + t] = at[q];
        }
    }
    LBAR();
    {
        f32x16 tb, tk, qb, hy;
#pragma unroll
        for (int r = 0; r < 16; ++r) { tb[r] = 0.f; tk[r] = 0.f; qb[r] = 0.f; hy[r] = 0.f; }
#pragma unroll
        for (int ks = 0; ks < 4; ++ks) {
            const bf16x8 aB = frag(R1, 32 * rb + l31, ks, h), aK = frag(R1 + 8192, 32 * rb + l31, ks, h), bA = frag(R1 + 16384, 32 * cb + l31, ks, h), bR = frag(R1 + 24576, 32 * cb + l31, ks, h);
            tb = __builtin_amdgcn_mfma_f32_32x32x16_bf16(aB, bA, tb, 0, 0, 0); tk = __builtin_amdgcn_mfma_f32_32x32x16_bf16(aK, bA, tk, 0, 0, 0);
            qb = __builtin_amdgcn_mfma_f32_32x32x16_bf16(aB, bR, qb, 0, 0, 0); hy = __builtin_amdgcn_mfma_f32_32x32x16_bf16(aK, bR, hy, 0, 0, 0);
        }
        const int t = 32 * cb + l31;
#pragma unroll
        for (int r = 0; r < 16; ++r) { const int s = 32 * rb + crow(r, h); if (!(s < t)) { tb[r] = 0.f; tk[r] = 0.f; } if (!(s <= t)) { qb[r] = 0.f; hy[r] = 0.f; } }
        LBAR();
        float* TbT = (float*)R1;
#pragma unroll
        for (int g = 0; g < 4; ++g) { const int s0 = 32 * rb + 8 * g + 4 * h;
            *(f32x4*)(TbT + t * 68 + s0) = (f32x4){tb[4 * g], tb[4 * g + 1], tb[4 * g + 2], tb[4 * g + 3]};
#pragma unroll
            for (int q = 0; q < 4; ++q) XL[(64 + s0 + q) * 68 + t] = tk[4 * g + q];
            *(u32x2*)(R1 + 17408 + swz(t, 4 * rb + g) + 8 * h) = (u32x2){pk2(qb[4 * g], qb[4 * g + 1]), pk2(qb[4 * g + 2], qb[4 * g + 3])};
            *(f32x4*)(LgG + 4096 + ((wid * 4 + g) * 64 + lane) * 4) = (f32x4){hy[4 * g], hy[4 * g + 1], hy[4 * g + 2], hy[4 * g + 3]}; }
    }
    LBAR();
    {
        const int row = tid >> 1, hf = tid & 1; float* xr = XL + row * 68; const float* TbT = (const float*)R1;
        for (int bj = 0; bj < 4; ++bj) {
            float y[16];
#pragma unroll
            for (int q = 0; q < 4; ++q) { const f32x4 v = *(const f32x4*)(xr + 16 * bj + 4 * q); y[4 * q] = v.x; y[4 * q + 1] = v.y; y[4 * q + 2] = v.z; y[4 * q + 3] = v.w; }
            float acc[16];
#pragma unroll
            for (int t = 0; t < 16; ++t) acc[t] = 0.f;
            for (int bi = 0; bi < bj; ++bi) {
                float xp[8];
#pragma unroll
                for (int q = 0; q < 2; ++q) { const f32x4 v = *(const f32x4*)(xr + 16 * bi + 8 * hf + 4 * q); xp[4 * q] = v.x; xp[4 * q + 1] = v.y; xp[4 * q + 2] = v.z; xp[4 * q + 3] = v.w; }
                const float* tb0 = TbT + (16 * bj) * 68 + 16 * bi + 8 * hf;
#pragma unroll
                for (int t = 0; t < 16; ++t) { float a0 = 0.f, a1 = 0.f;
#pragma unroll
                    for (int u = 0; u < 8; u += 2) { a0 += xp[u] * tb0[t * 68 + u]; a1 += xp[u + 1] * tb0[t * 68 + u + 1]; }
                    acc[t] += a0 + a1; }
            }
#pragma unroll
            for (int t = 0; t < 16; ++t) y[t] += acc[t] + dpp_mov<0xB1>(acc[t]);
            const float* td = TbT + (16 * bj) * 68 + 16 * bj;
#pragma unroll
            for (int t = 1; t < 16; ++t) { float a0 = y[t];
#pragma unroll
                for (int u = 0; u < 16; ++u) if (u < t) a0 += y[u] * td[t * 68 + u];
                y[t] = a0; }
            if (hf == 0) {
#pragma unroll
                for (int q = 0; q < 4; ++q) *(f32x4*)(xr + 16 * bj + 4 * q) = (f32x4){y[4 * q], y[4 * q + 1], y[4 * q + 2], y[4 * q + 3]};
            }
            asm volatile("s_waitcnt lgkmcnt(0)" ::: "memory");
        }
    }
    LBAR();
    {
        const int row = tid >> 1, hf = tid & 1; const float* xr = XL + row * 68 + 32 * hf; char* dst = R1 + (row >> 6) * 8192;
#pragma unroll
        for (int c8 = 0; c8 < 4; ++c8) { const f32x4 a = *(const f32x4*)(xr + 8 * c8), bq = *(const f32x4*)(xr + 8 * c8 + 4);
            *(u32x4*)(dst + swz(row & 63, 4 * hf + c8)) = (u32x4){pk2(a.x, a.y), pk2(a.z, a.w), pk2(bq.x, bq.y), pk2(bq.z, bq.w)}; }
    }
    __syncthreads();
    {
        const int t = tid >> 2, jr = (tid & 3) * 16; char* BbT = lds + 32768; char* VT = lds + 40960;
        f32x4 lgA[4], lcA[4], bbA[4], vvA[4];
#pragma unroll
        for (int e4 = 0; e4 < 4; ++e4) { const int j = jr + 4 * e4;
            lgA[e4] = *(const f32x4*)(LgG + t * 64 + j); lcA[e4] = *(const f32x4*)(LgG + 63 * 64 + j); bbA[e4] = ld4bf(BB + (size_t)t * 512 + j); vvA[e4] = zs4(ZRb + (size_t)t * RWKV_COLS, 1024 + col0 + j, p.rwkv_mu); }
#pragma unroll
        for (int e4 = 0; e4 < 4; ++e4) {
            const int j = jr + 4 * e4;
            const f32x4 lg = lgA[e4], lc = lcA[e4], bb = bbA[e4], vv = vvA[e4];
#pragma unroll
            for (int q = 0; q < 4; ++q) { const int o2 = swz(j + q, t >> 3) + (t & 7) * 2; *(bf16_t*)(BbT + o2) = (bf16_t)f2bf(bb[q] * __expf(lc[q] - lg[q])); *(bf16_t*)(VT + o2) = (bf16_t)f2bf(vv[q]); }
        }
    }
    LBAR();
    {
        f32x16 gy, gs, hs, hy;
#pragma unroll
        for (int g = 0; g < 4; ++g) { const f32x4 q4 = *(const f32x4*)(LgG + 4096 + ((wid * 4 + g) * 64 + lane) * 4); hy[4 * g] = q4.x; hy[4 * g + 1] = q4.y; hy[4 * g + 2] = q4.z; hy[4 * g + 3] = q4.w; }
        {
            const int tq = 32 * cb + l31;
            const float lcq = LgG[63 * 64 + tq]; const float elc = __expf(lcq);
#pragma unroll
            for (int g = 0; g < 4; ++g) { const int j0 = 32 * rb + 8 * g + 4 * h; const f32x4 r4 = zs4(ZRb + (size_t)tq * RWKV_COLS, col0 + j0, p.rwkv_mu), l4 = *(const f32x4*)(LgG + tq * 64 + j0);
#pragma unroll
                for (int q = 0; q < 4; ++q) { gy[4 * g + q] = r4[q] * __expf(l4[q]); gs[4 * g + q] = (j0 + q == tq) ? elc : 0.f;
                    const int s = j0 + q; hs[4 * g + q] = ld1bf(K2 + (size_t)s * 512 + tq) * __expf(lcq - LgG[s * 64 + tq]); } }
        }
#pragma unroll
        for (int ks = 0; ks < 4; ++ks) {
            const bf16x8 aA = frag(R1, 32 * rb + l31, ks, h), aW = frag(R1 + 8192, 32 * rb + l31, ks, h), bQ = frag(R1 + 17408, 32 * cb + l31, ks, h), bB = frag(lds + 32768, 32 * cb + l31, ks, h);
            gy = __builtin_amdgcn_mfma_f32_32x32x16_bf16(aA, bQ, gy, 0, 0, 0); gs = __builtin_amdgcn_mfma_f32_32x32x16_bf16(aA, bB, gs, 0, 0, 0);
            hy = __builtin_amdgcn_mfma_f32_32x32x16_bf16(aW, bQ, hy, 0, 0, 0); hs = __builtin_amdgcn_mfma_f32_32x32x16_bf16(aW, bB, hs, 0, 0, 0);
        }
        const int cc = 32 * cb + l31;
#pragma unroll
        for (int g = 0; g < 4; ++g) { const int r0 = 32 * rb + 8 * g + 4 * h;
            *(u32x2*)(chk + swz(cc, 4 * rb + g) + 8 * h) = (u32x2){pk2(gy[4 * g], gy[4 * g + 1]), pk2(gy[4 * g + 2], gy[4 * g + 3])};
            *(u32x2*)(chk + 8192 + swz(cc, 4 * rb + g) + 8 * h) = (u32x2){pk2(gs[4 * g], gs[4 * g + 1]), pk2(gs[4 * g + 2], gs[4 * g + 3])};
            *(u32x2*)(lds + 49152 + swz(cc, 4 * rb + g) + 8 * h) = (u32x2){pk2(hs[4 * g], hs[4 * g + 1]), pk2(hs[4 * g + 2], hs[4 * g + 3])};
            *(u32x2*)(lds + 57344 + swz(cc, 4 * rb + g) + 8 * h) = (u32x2){pk2(hy[4 * g], hy[4 * g + 1]), pk2(hy[4 * g + 2], hy[4 * g + 3])}; }
    }
    LBAR();
    {
        f32x16 sl, yl;
#pragma unroll
        for (int r = 0; r < 16; ++r) { sl[r] = 0.f; yl[r] = 0.f; }
#pragma unroll
        for (int ks = 0; ks < 4; ++ks) {
            const bf16x8 aS = frag(lds + 49152, 32 * rb + l31, ks, h), aY = frag(lds + 57344, 32 * rb + l31, ks, h), bV = frag(lds + 40960, 32 * cb + l31, ks, h);
            sl = __builtin_amdgcn_mfma_f32_32x32x16_bf16(aS, bV, sl, 0, 0, 0); yl = __builtin_amdgcn_mfma_f32_32x32x16_bf16(aY, bV, yl, 0, 0, 0);
        }
#pragma unroll
        for (int q = 0; q < 2; ++q) {
            *(u32x4*)(chk + 16384 + wid * 2048 + lane * 32 + q * 16) = (u32x4){pk2(sl[8 * q], sl[8 * q + 1]), pk2(sl[8 * q + 2], sl[8 * q + 3]), pk2(sl[8 * q + 4], sl[8 * q + 5]), pk2(sl[8 * q + 6], sl[8 * q + 7])};
            *(u32x4*)(chk + 24576 + wid * 2048 + lane * 32 + q * 16) = (u32x4){pk2(yl[8 * q], yl[8 * q + 1]), pk2(yl[8 * q + 2], yl[8 * q + 3]), pk2(yl[8 * q + 4], yl[8 * q + 5]), pk2(yl[8 * q + 6], yl[8 * q + 7])}; }
    }
    LBAR();
}
DEVI void cumsum_job(const P& p, int bh, char* lds) {
    const int tid = otid(), lane = tid & 63, wid = tid >> 6, b = bh >> 3, h = bh & 7; float* part = (float*)lds;
    const float* LF = WSP(float, WS_LF) + (size_t)b * LP * 8 + h; float* CS = WSP(float, WS_CS) + (size_t)b * LP * 8 + h;
    const int r0 = tid * 33; float v[33]; float s = 0.f;
#pragma unroll
    for (int i = 0; i < 33; ++i) v[i] = (r0 + i < LP) ? LF[(size_t)(r0 + i) * 8] : 0.f;
#pragma unroll
    for (int i = 0; i < 33; ++i) s += v[i];
    part[tid] = s; LBAR();
    if (wid == 0) { const f32x4 a = *(const f32x4*)(part + 4 * lane); const float tot = (a.x + a.y) + (a.z + a.w); float inc = tot;
#pragma unroll
        for (int o = 1; o < 64; o <<= 1) { const float u = __shfl_up(inc, o); if (lane >= o) inc += u; }
        const float ex = inc - tot; *(f32x4*)(part + 4 * lane) = (f32x4){ex, ex + a.x, ex + a.x + a.y, ex + a.x + a.y + a.z}; }
    LBAR();
    float pre = part[tid];
#pragma unroll
    for (int i = 0; i < 33; ++i) { pre += v[i]; if (r0 + i < LP) CS[(size_t)(r0 + i) * 8] = pre * LOG2E; }
    LBAR();
}
DEVI void phase2c(const P& p, int bid, int nb, char* lds) {
    if (bid < 16) cumsum_job(p, bid, lds);
    for (int q = bid; q < 16 * (NCHUNK - 1); q += nb) chunk_job(p, (q >> 7) * NCHUNK + 1 + (q & 127), lds);
}

DEVI void scanB_job(const P& p, int bh, char* lds) {
    typedef __attribute__((address_space(3))) unsigned lds_u32;
    const int tid = otid(), lane = tid & 63, wid = __builtin_amdgcn_readfirstlane(tid >> 6), l31 = lane & 31, h = lane >> 5, rb = wid >> 1, cb = wid & 1;
    const int b = bh >> 3, hh = bh & 7; const int col0 = hh * 64;
    float* Yo = WSP(float, WS_Y) + ((size_t)b * LP + 64) * 512 + col0 + 32 * cb + l31;
    const char* chk = (const char*)p.ws + WS_CHK + (size_t)bh * NCHUNK * CHUNK_BYTES + wid * 8192 + lane * 16;
    f32x16 accS, accY;
#pragma unroll
    for (int r = 0; r < 16; ++r) { accS[r] = 0.f; accY[r] = 0.f; }
    auto dma = [&](int c, int slot) __attribute__((always_inline)) {
        const char* g = chk + (size_t)c * CHUNK_BYTES; char* d = lds + 8192 + slot * 32768 + wid * 8192;
#pragma unroll
        for (int i = 0; i < 8; ++i) __builtin_amdgcn_global_load_lds((const unsigned*)(g + i * 1024), (lds_u32*)(d + i * 1024), 16, 0, 0);
    };
    dma(0, 0); dma(1, 1);
    for (int c = 0; c < NCHUNK; ++c) {
        const int slot = c & 1;
        if (c + 1 < NCHUNK) asm volatile("s_waitcnt vmcnt(8)" ::: "memory"); else asm volatile("s_waitcnt vmcnt(0)" ::: "memory");
        if (c > 0) {
#pragma unroll
            for (int r = 0; r < 16; ++r) Yo[(size_t)(64 * (c - 1) + 32 * rb + crow(r, h)) * 512] = accY[r];
            asm volatile("" ::: "memory");
        }
#pragma unroll
        for (int g = 0; g < 4; ++g) *(u32x2*)(lds + swz(32 * cb + l31, 4 * rb + g) + 8 * h) = (u32x2){pk2(accS[4 * g], accS[4 * g + 1]), pk2(accS[4 * g + 2], accS[4 * g + 3])};
        asm volatile("s_waitcnt lgkmcnt(0)" ::: "memory"); __builtin_amdgcn_s_barrier(); asm volatile("" ::: "memory");
        const char* sl = lds + 8192 + slot * 32768;
        bf16x8 sb[4], gsf[4], gyf[4];
#pragma unroll
        for (int ks = 0; ks < 4; ++ks) { sb[ks] = frag(lds, 32 * cb + l31, ks, h); gyf[ks] = frag(sl, 32 * rb + l31, ks, h); gsf[ks] = frag(sl + 8192, 32 * rb + l31, ks, h); }
#pragma unroll
        for (int q = 0; q < 2; ++q) { const u32x4 ws = *(const u32x4*)(sl + 16384 + wid * 2048 + lane * 32 + q * 16), wy = *(const u32x4*)(sl + 24576 + wid * 2048 + lane * 32 + q * 16);
#pragma unroll
            for (int j = 0; j < 4; ++j) { accS[8 * q + 2 * j] = __uint_as_float(ws[j] << 16); accS[8 * q + 2 * j + 1] = __uint_as_float(ws[j] & 0xffff0000u);
                accY[8 * q + 2 * j] = __uint_as_float(wy[j] << 16); accY[8 * q + 2 * j + 1] = __uint_as_float(wy[j] & 0xffff0000u); } }
#pragma unroll
        for (int ks = 0; ks < 4; ++ks) { accS = __builtin_amdgcn_mfma_f32_32x32x16_bf16(gsf[ks], sb[ks], accS, 0, 0, 0); accY = __builtin_amdgcn_mfma_f32_32x32x16_bf16(gyf[ks], sb[ks], accY, 0, 0, 0); }
        asm volatile("s_waitcnt lgkmcnt(0)" ::: "memory"); __builtin_amdgcn_s_barrier(); asm volatile("" ::: "memory");
        if (c + 2 < NCHUNK) dma(c + 2, slot);
    }
#pragma unroll
    for (int r = 0; r < 16; ++r) Yo[(size_t)(64 * (NCHUNK - 1) + 32 * rb + crow(r, h)) * 512] = accY[r];
}

DEVI void phase4a(const P& p, int bid, int nb, char*) {
    const int tid = otid(), lane = tid & 63, wid = tid >> 6;
    for (int row = bid * 4 + wid; row < NP; row += nb * 4) {
        const bool pad = (row % LP) < PADL + NMETA;
#pragma unroll
        for (int j = 0; j < 2; ++j) {
            const int c = lane * 4 + 256 * j; const size_t o = (size_t)row * 512 + c;
            u32x2 outv = (u32x2){0u, 0u};
            if (!pad) {
                const bf16_t* zrow = WSP(bf16_t, WS_ZR) + (size_t)row * RWKV_COLS;
                const f32x4 y = *(const f32x4*)(WSP(float, WS_Y) + o), r = zs4(zrow, c, p.rwkv_mu), k2 = ld4bf(WSP(bf16_t, WS_RK2) + o), v = zs4(zrow, 1024 + c, p.rwkv_mu), g = ld4bf(WSP(bf16_t, WS_G) + o);
                const f32x4 rk = *(const f32x4*)(p.r_k + c), lg = *(const f32x4*)(p.lnx_g + c), lb = *(const f32x4*)(p.lnx_b + c);
                const float mu = sum16((y.x + y.y) + (y.z + y.w)) * (1.f / 64.f);
                const f32x4 dy = y - mu;
                const float var = sum16((dy.x * dy.x + dy.y * dy.y) + (dy.z * dy.z + dy.w * dy.w)) * (1.f / 64.f);
                const float rs = rsqrtf(var + GN_EPS);
                const float bonus = sum16((r.x * k2.x * rk.x + r.y * k2.y * rk.y) + (r.z * k2.z * rk.z + r.w * k2.w * rk.w));
                const f32x4 ov = (dy * rs * lg + lb + bonus * v) * g;
                outv = (u32x2){pk2(ov.x, ov.y), pk2(ov.z, ov.w)};
            }
            *(u32x2*)(WSP(bf16_t, WS_MIX) + (size_t)row * 1024 + 512 + c) = outv;
        }
    }
}

struct EpiOutProj {
    const P& p; int tm, tn;
    DEVI void operator()(f32x4 (&acc)[4][4], int wm, int wn, int l15, int lq) const {
#pragma unroll
        for (int mt = 0; mt < 4; ++mt) { const size_t row = (size_t)tm * 128 + wm * 64 + mt * 16 + l15;
#pragma unroll
            for (int nt = 0; nt < 4; ++nt) { const size_t o = row * 1024 + tn * 128 + wn * 64 + nt * 16 + 4 * lq;
                const u32x2 w = *(const u32x2*)(WSP(bf16_t, WS_H0B) + o);
                const f32x4 h0 = (f32x4){__uint_as_float(w.x << 16), __uint_as_float(w.x & 0xffff0000u), __uint_as_float(w.y << 16), __uint_as_float(w.y & 0xffff0000u)};
                *(f32x4*)(WSP(float, WS_PRE1) + o) = h0 * ALPHA + acc[mt][nt]; } }
    }
};
DEVI void phase4b(const P& p, const Sched& sc, char* lds) {
    const int tid = otid(), srow = 16 * (tid >> 6) + ((tid & 63) >> 2);
    for_xcd_items(sc, [&](int x, int rank, int nloc) __attribute__((always_inline)) {
        const int r0 = 16 * x;
        for (int i = rank; i < 16 * 8; i += nloc) {
            const int tr = r0 + (i >> 3), tn = i & 7, tm = (tr >> 6) * NQB + 1 + (tr & 63);
            const bf16_t *ap[4], *bp[2];
#pragma unroll
            for (int q = 0; q < 2; ++q) { ap[q] = WSP(bf16_t, WS_MIX) + (size_t)(tm * 128 + srow + 64 * q) * 1024; bp[q] = WSP(bf16_t, WS_WOUTT) + (size_t)(tn * 128 + srow + 64 * q) * 1024; }
            ap[2] = ap[3] = ap[0];
            gemm256<false, 4>(ap, bp, 1024, lds, EpiOutProj{p, tm, tn});
        }
    });
}

DEVI void phase4c(const P& p, int bid, int nb, char* lds) {
    const int tid = otid(), lane = tid & 63, wid = tid >> 6;
    const int e = tid & 31, ks = tid >> 5;
    float* hrow = (float*)lds;
    float* part = (float*)(lds + 16384);
    unsigned* cnt = WSP(unsigned, WS_CTL) + CW_CNT;
    float wreg[128];
#pragma unroll
    for (int k = 0; k < 128; ++k) wreg[k] = p.w_router[(size_t)(ks * 128 + k) * 32 + e];
    const float br = p.b_router[e];
    for (int base = bid * 4; base < NP; base += nb * 4) {
        const int row = base + wid;
        const bool pad = (row % LP) < PADL + NMETA;
        {
            u32x2* hb = (u32x2*)(WSP(bf16_t, WS_H1B) + (size_t)row * 1024) + lane;
            if (pad) {
#pragma unroll
                for (int j = 0; j < 4; ++j) { hb[64 * j] = (u32x2){0u, 0u}; *(f32x4*)(hrow + wid * 1024 + lane * 4 + 256 * j) = (f32x4){0.f, 0.f, 0.f, 0.f}; }
            } else {
                const f32x4* src = (const f32x4*)(WSP(float, WS_PRE1) + (size_t)row * 1024) + lane;
                f32x4 v[4]; float s = 0.f;
#pragma unroll
                for (int j = 0; j < 4; ++j) { v[j] = src[64 * j]; s += (v[j].x + v[j].y) + (v[j].z + v[j].w); }
                const float mean = wave_sum(s) * (1.f / 1024.f); float s2 = 0.f;
#pragma unroll
                for (int j = 0; j < 4; ++j) { v[j] = v[j] - mean; s2 += (v[j].x * v[j].x + v[j].y * v[j].y) + (v[j].z * v[j].z + v[j].w * v[j].w); }
                const float rstd = rsqrtf(wave_sum(s2) * (1.f / 1024.f) + LN_EPS);
                if (lane == 0) { WSP(float, WS_ST1)[(size_t)row * 2] = mean; WSP(float, WS_ST1)[(size_t)row * 2 + 1] = rstd; }
#pragma unroll
                for (int j = 0; j < 4; ++j) {
                    const f32x4 g = ((const f32x4*)p.ln1_g)[lane + 64 * j], bb = ((const f32x4*)p.ln1_b)[lane + 64 * j];
                    const f32x4 o = v[j] * rstd * g + bb;
                    hb[64 * j] = (u32x2){pk2(o.x, o.y), pk2(o.z, o.w)};
                    *(f32x4*)(hrow + wid * 1024 + lane * 4 + 256 * j) = o;
                }
            }
        }
        LBAR();
        {
            float a0 = 0.f, a1 = 0.f, a2 = 0.f, a3 = 0.f;
            const float* h0 = hrow + ks * 128;
#pragma unroll
            for (int k = 0; k < 128; k += 4) {
                const f32x4 x0 = *(const f32x4*)(h0 + k), x1 = *(const f32x4*)(h0 + 1024 + k), x2 = *(const f32x4*)(h0 + 2048 + k), x3 = *(const f32x4*)(h0 + 3072 + k);
#pragma unroll
                for (int q = 0; q < 4; ++q) { a0 += wreg[k + q] * x0[q]; a1 += wreg[k + q] * x1[q]; a2 += wreg[k + q] * x2[q]; a3 += wreg[k + q] * x3[q]; }
            }
            part[(0 * 8 + ks) * 32 + e] = a0; part[(1 * 8 + ks) * 32 + e] = a1; part[(2 * 8 + ks) * 32 + e] = a2; part[(3 * 8 + ks) * 32 + e] = a3;
        }
        LBAR();
        {
            const int ee = lane & 31;
            float logit = br;
#pragma unroll
            for (int q = 0; q < 8; ++q) logit += part[(wid * 8 + q) * 32 + ee];
            float cur = logit; float tv[4]; int ti[4];
#pragma unroll
            for (int k = 0; k < 4; ++k) {
                float bv = cur; int bi = ee;
#pragma unroll
                for (int o = 16; o > 0; o >>= 1) { const float ov = __shfl_xor(bv, o); const int oi = __shfl_xor(bi, o); if (ov > bv || (ov == bv && oi < bi)) { bv = ov; bi = oi; } }
                tv[k] = bv; ti[k] = bi; if (ee == bi) cur = -INFINITY;
            }
            const float e1 = __expf(tv[1] - tv[0]), e2 = __expf(tv[2] - tv[0]), e3 = __expf(tv[3] - tv[0]); const float inv = 1.f / (1.f + e1 + e2 + e3);
            if (lane < 4 && !pad) {
                const int ex = lane == 0 ? ti[0] : lane == 1 ? ti[1] : lane == 2 ? ti[2] : ti[3];
                const float gt = (lane == 0 ? 1.f : lane == 1 ? e1 : lane == 2 ? e2 : e3) * inv;
                const unsigned rank = atomicAdd(cnt + ex, 1u);
                WSP(int, WS_LTOK)[(size_t)ex * CAP + rank] = row; WSP(float, WS_LGATE)[(size_t)ex * CAP + rank] = gt;
                WSP(int, WS_RTE)[(size_t)row * 4 + lane] = ex; WSP(int, WS_RTR)[(size_t)row * 4 + lane] = (int)rank;
            }
        }
    }
}

struct MoeTab { int* rb; int* cn; int* nf; int* ng; };
DEVI MoeTab moe_prefix(const P& p, char* lds) {
    MoeTab t; t.rb = (int*)(lds + LX); t.cn = t.rb + 33; t.nf = t.cn + 32; t.ng = t.nf + 32;
    if (threadIdx.x == 0) { const unsigned* cnt = WSP(unsigned, WS_CTL) + CW_CNT; int acc = 0;
        for (int e = 0; e < NEXP; ++e) { const int c = (int)cnt[e]; int f = c >> 8, g = 0; const int rem = c & 255; if (rem > 128) ++f; else g = (rem + 63) >> 6;
            t.cn[e] = c; t.nf[e] = f; t.ng[e] = g; t.rb[e] = acc; acc += f * 256 + g * 64; }
        t.rb[NEXP] = acc; }
    __syncthreads();
    return t;
}

template <int MT> struct EpiGU {
    const P& p; int e, row0, tn;
    DEVI void operator()(f32x4 (&acc)[MT][4], int wm, int wn, int l15, int lq) const {
        const float* bg = p.b_gu + (size_t)e * 2048;
#pragma unroll
        for (int mt = 0; mt < MT; ++mt) { const size_t row = (size_t)row0 + wm * (16 * MT) + mt * 16 + l15;
#pragma unroll
            for (int np = 0; np < 2; ++np) { const int jc = tn * 64 + wn * 32 + np * 16 + 4 * lq;
                const f32x4 bgt = *(const f32x4*)(bg + jc), bup = *(const f32x4*)(bg + 1024 + jc); float ov[4];
#pragma unroll
                for (int r = 0; r < 4; ++r) { const float gate = fminf(acc[mt][2 * np][r] + bgt[r], 7.f); const float up = fminf(fmaxf(acc[mt][2 * np + 1][r] + bup[r], -7.f), 7.f);
                    ov[r] = (up + 1.f) * (gate * sigmoidf(gate * 1.702f)); }
                *(u32x2*)(WSP(bf16_t, WS_ACT) + row * 1024 + jc) = (u32x2){pk2(ov[0], ov[1]), pk2(ov[2], ov[3])}; } }
    }
};
template <int MT> struct EpiDown {
    const P& p; int e, row0, idx0, cnt_e, tn;
    DEVI void operator()(f32x4 (&acc)[MT][4], int wm, int wn, int l15, int lq) const {
        const float* bd = p.b_down + (size_t)e * 1024;
#pragma unroll
        for (int mt = 0; mt < MT; ++mt) { const int ml = wm * (16 * MT) + mt * 16 + l15; const int idx = idx0 + ml; const float gt = idx < cnt_e ? WSP(float, WS_LGATE)[(size_t)e * CAP + idx] : 0.f;
            const size_t row = (size_t)row0 + ml;
#pragma unroll
            for (int nt = 0; nt < 4; ++nt) { const int c = tn * 128 + wn * 64 + nt * 16 + 4 * lq; const f32x4 o = (acc[mt][nt] + *(const f32x4*)(bd + c)) * gt; *(u32x2*)(WSP(bf16_t, WS_YB) + row * 1024 + c) = (u32x2){pk2(o.x, o.y), pk2(o.z, o.w)}; } }
    }
};
template <int NT, class FullFn, class SmallFn>
DEVI void moe_items(const MoeTab& T, int x, int rank, int nloc, FullFn&& full, SmallFn&& small) {
    const int f0 = T.nf[x], f1 = f0 + T.nf[x + 8], f2 = f1 + T.nf[x + 16], f3 = f2 + T.nf[x + 24];
    const int g0 = T.ng[x], g1 = g0 + T.ng[x + 8], g2 = g1 + T.ng[x + 16], g3 = g2 + T.ng[x + 24];
    for (int i = rank; i < (f3 + g3) * NT; i += nloc) {
        if (i < f3 * NT) { const int rbk = i / NT, tn = i % NT; const int j = rbk < f0 ? 0 : rbk < f1 ? 1 : rbk < f2 ? 2 : 3; const int e = x + 8 * j, mb = rbk - (j == 0 ? 0 : j == 1 ? f0 : j == 2 ? f1 : f2);
            full(e, mb * 256, tn); }
        else { const int k = i - f3 * NT, gk = k / NT, tn = k % NT; const int j = gk < g0 ? 0 : gk < g1 ? 1 : gk < g2 ? 2 : 3; const int e = x + 8 * j, gi = gk - (j == 0 ? 0 : j == 1 ? g0 : j == 2 ? g1 : g2);
            small(e, T.nf[e] * 256 + gi * 64, tn); }
    }
}
DEVI void phase5(const P& p, const Sched& sc, char* lds) {
    const MoeTab T = moe_prefix(p, lds);
    const int tid = otid(), lane = tid & 63, wid = tid >> 6, srow = 16 * wid + (lane >> 2);
    for_xcd_items(sc, [&](int x, int rank, int nloc) __attribute__((always_inline)) {
        moe_items<16>(T, x, rank, nloc,
            [&](int e, int idx0, int tn) __attribute__((always_inline)) {
                const bf16_t *ap[4], *bp[2];
#pragma unroll
                for (int q = 0; q < 4; ++q) { const int idx = idx0 + srow + 64 * q; const int tok = idx < T.cn[e] ? WSP(int, WS_LTOK)[(size_t)e * CAP + idx] : 0; ap[q] = WSP(bf16_t, WS_H1B) + (size_t)tok * 1024; }
#pragma unroll
                for (int q = 0; q < 2; ++q) bp[q] = WSP(bf16_t, WS_WGUT) + ((size_t)e * 2048 + tn * 128 + srow + 64 * q) * 1024;
                gemm256<false, 8>(ap, bp, 1024, lds, EpiGU<8>{p, e, T.rb[e] + idx0, tn}); },
            [&](int e, int idx0, int tn) __attribute__((always_inline)) {
                const bf16_t *ap[4], *bp[2];
                { const int idx = idx0 + srow; const int tok = idx < T.cn[e] ? WSP(int, WS_LTOK)[(size_t)e * CAP + idx] : 0; ap[0] = WSP(bf16_t, WS_H1B) + (size_t)tok * 1024; ap[1] = ap[2] = ap[3] = ap[0]; }
#pragma unroll
                for (int q = 0; q < 2; ++q) bp[q] = WSP(bf16_t, WS_WGUT) + ((size_t)e * 2048 + tn * 128 + srow + 64 * q) * 1024;
                gemm256<false, 2>(ap, bp, 1024, lds, EpiGU<2>{p, e, T.rb[e] + idx0, tn}); });
    });
}
DEVI void phase6(const P& p, const Sched& sc, char* lds) {
    const MoeTab T = moe_prefix(p, lds);
    const int tid = otid(), lane = tid & 63, wid = tid >> 6, srow = 16 * wid + (lane >> 2);
    for_xcd_items(sc, [&](int x, int rank, int nloc) __attribute__((always_inline)) {
        moe_items<8>(T, x, rank, nloc,
            [&](int e, int idx0, int tn) __attribute__((always_inline)) {
                const bf16_t *ap[4], *bp[2];
#pragma unroll
                for (int q = 0; q < 4; ++q) ap[q] = WSP(bf16_t, WS_ACT) + ((size_t)T.rb[e] + idx0 + srow + 64 * q) * 1024;
#pragma unroll
                for (int q = 0; q < 2; ++q) bp[q] = WSP(bf16_t, WS_WDT) + ((size_t)e * 1024 + tn * 128 + srow + 64 * q) * 1024;
                gemm256<false, 8>(ap, bp, 1024, lds, EpiDown<8>{p, e, T.rb[e] + idx0, idx0, T.cn[e], tn}); },
            [&](int e, int idx0, int tn) __attribute__((always_inline)) {
                const bf16_t *ap[4], *bp[2];
                ap[0] = WSP(bf16_t, WS_ACT) + ((size_t)T.rb[e] + idx0 + srow) * 1024; ap[1] = ap[2] = ap[3] = ap[0];
#pragma unroll
                for (int q = 0; q < 2; ++q) bp[q] = WSP(bf16_t, WS_WDT) + ((size_t)e * 1024 + tn * 128 + srow + 64 * q) * 1024;
                gemm256<false, 2>(ap, bp, 1024, lds, EpiDown<2>{p, e, T.rb[e] + idx0, idx0, T.cn[e], tn}); });
    });
}
DEVI void phase7(const P& p, int bid, int nb, char* lds) {
    const MoeTab T = moe_prefix(p, lds);
    const int tid = otid(), lane = tid & 63, wid = tid >> 6;
    for (int row = bid * 4 + wid; row < NP; row += nb * 4) {
        const int b = row / LP, pp = row % LP; if (pp < PADL + NMETA) continue;
        const int t = pp - PADL - NMETA;
        const f32x4* pre = (const f32x4*)(WSP(float, WS_PRE1) + (size_t)row * 1024) + lane;
        const float mean1 = WSP(float, WS_ST1)[(size_t)row * 2], rstd1 = WSP(float, WS_ST1)[(size_t)row * 2 + 1];
        f32x4 v[4];
#pragma unroll
        for (int j = 0; j < 4; ++j) v[j] = ((pre[64 * j] - mean1) * rstd1 * ((const f32x4*)p.ln1_g)[lane + 64 * j] + ((const f32x4*)p.ln1_b)[lane + 64 * j]) * ALPHA;
#pragma unroll
        for (int k = 0; k < 4; ++k) { const int e = WSP(int, WS_RTE)[(size_t)row * 4 + k], rk = WSP(int, WS_RTR)[(size_t)row * 4 + k];
            const u32x2* yb = (const u32x2*)(WSP(bf16_t, WS_YB) + ((size_t)T.rb[e] + rk) * 1024) + lane;
#pragma unroll
            for (int j = 0; j < 4; ++j) { const u32x2 w = yb[64 * j]; v[j] += (f32x4){__uint_as_float(w.x << 16), __uint_as_float(w.x & 0xffff0000u), __uint_as_float(w.y << 16), __uint_as_float(w.y & 0xffff0000u)}; } }
        float s = 0.f;
#pragma unroll
        for (int j = 0; j < 4; ++j) s += (v[j].x + v[j].y) + (v[j].z + v[j].w);
        const float mean = wave_sum(s) * (1.f / 1024.f); float s2 = 0.f;
#pragma unroll
        for (int j = 0; j < 4; ++j) { v[j] = v[j] - mean; s2 += (v[j].x * v[j].x + v[j].y * v[j].y) + (v[j].z * v[j].z + v[j].w * v[j].w); }
        const float rstd = rsqrtf(wave_sum(s2) * (1.f / 1024.f) + LN_EPS);
        f32x4* o = (f32x4*)(p.out + ((size_t)b * SEQ + t) * 1024) + lane;
#pragma unroll
        for (int j = 0; j < 4; ++j) o[64 * j] = v[j] * rstd * ((const f32x4*)p.ln2_g)[lane + 64 * j] + ((const f32x4*)p.ln2_b)[lane + 64 * j];
    }
}

#define LAS __attribute__((address_space(3)))
#define XB_TMO      128
#define XB_XCNT(j)  (256  + 64 * (j))
#define XB_XSUB(j)  (1280 + 64 * (j))
#define XB_XGEN(j)  (2304 + 64 * (j))
#define XB_TOP      3328
#define XB_TOPGEN   3392
#define XCD_BAR_WORDS 3456
#define XB_SPIN_CAP (1u << 18)
__device__ __forceinline__ unsigned xb_ld(unsigned* p)              { return __hip_atomic_load(p, __ATOMIC_RELAXED, __HIP_MEMORY_SCOPE_AGENT); }
__device__ __forceinline__ unsigned xb_add(unsigned* p, unsigned v) { return __hip_atomic_fetch_add(p, v, __ATOMIC_RELAXED, __HIP_MEMORY_SCOPE_AGENT); }
__device__ __forceinline__ unsigned xb_xcc_id() { return (unsigned)__builtin_amdgcn_s_getreg((3 << 11) | 20) & 0xFu; }
#define XB_SPIN(cond, bar) do { unsigned _sp = 0; while (cond) { __builtin_amdgcn_s_sleep(1); \
    if ((++_sp & 255u) == 0u) { if (xb_ld(&(bar)[XB_TMO])) break; if (_sp > XB_SPIN_CAP) { atomicAdd(&(bar)[XB_TMO], 1u); break; } } } } while (0)
struct XcdBarrier { unsigned* bar; unsigned x; volatile LAS unsigned* st; };
__device__ __forceinline__ XcdBarrier xcd_barrier_post(unsigned* bar, volatile LAS unsigned* st) {
    XcdBarrier b; b.bar = bar; b.x = xb_xcc_id(); b.st = st;
    if (threadIdx.x == 0) (void)xb_add(&bar[XB_XCNT(b.x)], 1u);
    return b;
}
__device__ __forceinline__ void xcd_barrier_complete(unsigned* bar, unsigned x, unsigned& nloc, unsigned& nx) {
    const unsigned G = gridDim.x * gridDim.y * gridDim.z;
    unsigned sum, cnt, mine, sp = 0u;
    for (;;) {
        sum = 0u; cnt = 0u; mine = 0u;
#pragma unroll
        for (unsigned j = 0; j < 16; ++j) { const unsigned c = xb_ld(&bar[XB_XCNT(j)]); sum += c; cnt += (c > 0u) ? 1u : 0u; mine = (j == x) ? c : mine; }
        if (sum == G) break;
        __builtin_amdgcn_s_sleep(1);
        if ((++sp & 255u) == 0u) { if (xb_ld(&bar[XB_TMO])) break; if (sp > XB_SPIN_CAP) { atomicAdd(&bar[XB_TMO], 1u); break; } }
    }
    nloc = mine > 0u ? mine : 1u; nx = cnt > 0u ? cnt : 1u;
}
__device__ __forceinline__ void xcd_barrier(const XcdBarrier& b) {
    asm volatile("s_waitcnt vmcnt(0)" ::: "memory");
    __syncthreads();
    if (threadIdx.x == 0) {
        unsigned* bar = b.bar;
        __builtin_amdgcn_s_waitcnt(0);
        unsigned nloc = b.st[0], nx = b.st[1];
        if (nloc == 0u) { xcd_barrier_complete(bar, b.x, nloc, nx); b.st[0] = nloc; b.st[1] = nx; }
        const unsigned old = xb_add(&bar[XB_XSUB(b.x)], 1u);
        const unsigned gen = old / nloc;
        if (old + 1u == (gen + 1u) * nloc) {
            __builtin_amdgcn_fence(__ATOMIC_RELEASE, "agent");
            asm volatile("s_waitcnt vmcnt(0)" ::: "memory");
            const unsigned og = xb_add(&bar[XB_TOP], 1u);
            const unsigned tg = og / nx;
            if (og + 1u == (tg + 1u) * nx) xb_add(&bar[XB_TOPGEN], 1u);
            else XB_SPIN(xb_ld(&bar[XB_TOPGEN]) == tg, bar);
            __builtin_amdgcn_fence(__ATOMIC_ACQUIRE, "agent");
            xb_add(&bar[XB_XGEN(b.x)], 1u);
            asm volatile("s_waitcnt vmcnt(0)" ::: "memory");
        } else {
            XB_SPIN(xb_ld(&bar[XB_XGEN(b.x)]) == gen, bar);
            __builtin_amdgcn_fence(__ATOMIC_ACQUIRE, "agent");
            asm volatile("s_waitcnt vmcnt(0)" ::: "memory");
        }
    }
    __syncthreads();
}

namespace cg = cooperative_groups;
constexpr int CW_BAR = 4096;
constexpr size_t CTL_ZERO_BYTES = 65536;
constexpr int N_SCAN_JOBS = 16, N_ATT_ITEMS = 16 * (NQB - 1);
DEVI void phase3(const P& p, char* lds, int qoff) {
    int* s_item = (int*)(lds + LX + 992);
    unsigned* q = WSP(unsigned, WS_CTL) + CW_QATT + qoff;
    for (;;) {
        if (threadIdx.x == 0) *s_item = (int)atomicAdd(q, 1u);
        __syncthreads();
        const int it = __builtin_amdgcn_readfirstlane(*s_item);
        __syncthreads();
        if (it >= N_SCAN_JOBS + N_ATT_ITEMS + N_CONV_ITEMS) break;
        if (it < N_SCAN_JOBS) {
            chunk_job(p, it * NCHUNK, lds);
            __threadfence(); __syncthreads();
            __builtin_amdgcn_s_setprio(3); scanB_job(p, it, lds); __builtin_amdgcn_s_setprio(0); continue; }
        const int r = it - N_SCAN_JOBS; int a;
        if (r < 3 * N_CONV_ITEMS) { if (r % 3 == 2) { conv_moe_item(p, r / 3, lds); continue; } a = 2 * (r / 3) + (r % 3); }
        else a = r - N_CONV_ITEMS;
        { const int qb = NQB - 1 - a / 16, bh = a % 16; attn_item(p, bh >> 3, bh & 7, qb, lds); }
    }
}
__global__ void __launch_bounds__(256, 2) k_mega(P p) {
    __shared__ __attribute__((aligned(16))) char lds[LDS_BYTES];
    const int bid = blockIdx.x, nb = gridDim.x;
    volatile LAS unsigned* st = (volatile LAS unsigned*)(LAS char*)(lds + LX + 1008);
    if (threadIdx.x < 2) st[threadIdx.x] = 0u;
    __syncthreads();
    if (p.ws == nullptr) cg::this_grid().sync();
    const XcdBarrier bar = xcd_barrier_post(WSP(unsigned, WS_CTL) + CW_BAR, st);
    int* s_rank = (int*)(lds + LX + 976);
    if (threadIdx.x == 0) *s_rank = (int)atomicAdd(WSP(unsigned, WS_CTL) + CW_XRANK + 64 * (bar.x & 15), 1u);
#ifndef PROBE_MASK
#define PROBE_MASK 0
#endif
#define RUNP(k, call) do { call; if (PROBE_MASK & (1 << (k))) { xcd_barrier(bar); call; } } while (0)
    RUNP(0, phase0(p, bid, nb, lds));  xcd_barrier(bar);
    Sched sc;
    { const int nloc = __builtin_amdgcn_readfirstlane((int)st[0]), nx = __builtin_amdgcn_readfirstlane((int)st[1]), rk = __builtin_amdgcn_readfirstlane(*s_rank); const bool ok = nx == 8 && bar.x < 8 && rk < nloc;
      sc.x = ok ? (int)bar.x : 0; sc.rank = ok ? rk : bid; sc.nloc = ok ? nloc : nb; sc.nxcd = ok ? 8 : 0; }
    RUNP(1, phase1(p, sc, lds));  xcd_barrier(bar);
    RUNP(4, phase2c(p, bid, nb, lds)); xcd_barrier(bar);
    phase3(p, lds, 0); if (PROBE_MASK & (1 << 5)) { xcd_barrier(bar); phase3(p, lds, 64); } xcd_barrier(bar);
    RUNP(6, phase4a(p, bid, nb, lds)); xcd_barrier(bar);
    RUNP(7, phase4b(p, sc, lds)); xcd_barrier(bar);
    phase4c(p, bid, nb, lds); xcd_barrier(bar);
    RUNP(9, phase5(p, sc, lds));  xcd_barrier(bar);
    RUNP(10, phase6(p, sc, lds));  xcd_barrier(bar);
    RUNP(11, phase7(p, bid, nb, lds));
}

extern "C" void kernel_launch(void* const* d_in, const int* in_sizes, int n_in, void* d_out, int out_size, void* d_ws, size_t ws_size, hipStream_t stream) {
    if (n_in != 29 || ws_size < WS_NEED) { fprintf(stderr, "kernel_launch: unexpected n_in %d or ws_size %zu (need %zu)\n", n_in, ws_size, (size_t)WS_NEED); return; }
    static int grid_blocks = 0;
    if (!grid_blocks) {
        int dev = 0, cus = 0, per_cu = 0;
        (void)hipGetDevice(&dev);
        (void)hipDeviceGetAttribute(&cus, hipDeviceAttributeMultiprocessorCount, dev);
        (void)hipOccupancyMaxActiveBlocksPerMultiprocessor(&per_cu, k_mega, 256, 0);
        if (per_cu > 2) per_cu = 2;
        grid_blocks = cus * per_cu;
        if (grid_blocks <= 0) { fprintf(stderr, "kernel_launch: occupancy query gave %d x %d\n", cus, per_cu); grid_blocks = 0; return; }
    }
    (void)hipMemsetAsync((char*)d_ws + WS_CTL, 0, CTL_ZERO_BYTES, stream);
    P p{};
    const float** pf = (const float**)&p;
    for (int i = 0; i < 29; ++i) pf[i] = (const float*)d_in[i];
    p.out = (float*)d_out; p.ws = (unsigned char*)d_ws;
    void* args[] = {&p};
    hipError_t e = hipLaunchCooperativeKernel((void*)k_mega, dim3(grid_blocks), dim3(256), args, 0, stream);
    if (e != hipSuccess) fprintf(stderr, "cooperative launch failed: %s (grid %d)\n", hipGetErrorString(e), grid_blocks);
}
```

```cpp
#include <hip/hip_runtime.h>
#include <hip/hip_cooperative_groups.h>
#include <stdint.h>
#include <stdio.h>

#define DEVI __device__ __forceinline__
typedef unsigned short bf16_t;
typedef short bf16x8 __attribute__((ext_vector_type(8)));
typedef float f32x4 __attribute__((ext_vector_type(4)));
typedef float f32x16 __attribute__((ext_vector_type(16)));
typedef unsigned u32x4 __attribute__((ext_vector_type(4)));
typedef unsigned u32x2 __attribute__((ext_vector_type(2)));

constexpr int BATCH = 2, SEQ = 8192, DM = 1024, NMETA = 16;
constexpr int LTOK = SEQ + NMETA;
constexpr int PADL = 112;
constexpr int LP = LTOK + PADL;
constexpr int NP = BATCH * LP;
constexpr int NQB = LP / 128;
constexpr int NH = 8, HD = 64;
constexpr int FOXW = 512, RWW = 512;
constexpr int RWKV_COLS = 1792;
constexpr int IN_COLS = 3336;
constexpr int WIN_N = 3456;
constexpr int NEXP = 32, TOPK = 4;
constexpr int CAP = BATCH * LTOK;
constexpr int MAXBLK = (BATCH * LTOK * TOPK) / 256 + NEXP + 1;
constexpr float ALPHA = 1.189207115002721f;
constexpr float LN_EPS = 1e-5f, GN_EPS = 64e-5f, RMS_EPS = 1e-6f;
constexpr float LOG2E = 1.4426950408889634f;
constexpr float QSCALE = 0.125f * LOG2E;
constexpr float NEGBIG = -1e30f;

constexpr size_t MiB = 1u << 20;
constexpr size_t al256(size_t x) { return (x + 255) & ~(size_t)255; }
constexpr size_t WS_CTL = 0;
constexpr size_t WS_WINT = 1 * MiB;
constexpr size_t WS_WOUTT = WS_WINT + (size_t)WIN_N * 1024 * 2;
constexpr size_t WS_W2T = WS_WOUTT + (size_t)1024 * 1024 * 2;
constexpr size_t WS_A2T = WS_W2T + 512 * 64 * 2;
constexpr size_t WS_G2T = WS_A2T + 512 * 64 * 2;
constexpr size_t WS_WGUT = al256(WS_G2T + 512 * 128 * 2);
constexpr size_t WS_WDT = WS_WGUT + (size_t)32 * 2048 * 1024 * 2;
constexpr size_t WS_ST1 = WS_WDT + (size_t)32 * 1024 * 1024 * 2;
constexpr size_t WS_H1B = WS_ST1 + (size_t)NP * 2 * 4;
constexpr size_t WS_RTE = WS_H1B + (size_t)NP * 1024 * 2;
constexpr size_t WS_RTR = WS_RTE + (size_t)NP * 16;
constexpr size_t WS_LTOK = WS_RTR + (size_t)NP * 16;
constexpr size_t WS_LGATE = WS_LTOK + (size_t)32 * CAP * 4;
constexpr size_t WS_PRE1 = al256(WS_LGATE + (size_t)32 * CAP * 4);
constexpr size_t WS_EARLY = WS_PRE1 + (size_t)NP * 1024 * 4;
constexpr size_t WS_H0B = WS_EARLY;
constexpr size_t WS_QB = WS_H0B + (size_t)NP * 1024 * 2;
constexpr size_t WS_KB = WS_QB + (size_t)NP * 512 * 2;
constexpr size_t WS_VT = WS_KB + (size_t)NP * 512 * 2;
constexpr size_t WS_ZR = WS_VT + (size_t)NP * 512 * 2;
constexpr size_t WS_LF = WS_ZR + (size_t)NP * 1792 * 4;
constexpr size_t WS_CS = WS_LF + (size_t)NP * 8 * 4;
constexpr size_t WS_R = WS_CS + (size_t)NP * 8 * 4;
constexpr size_t WS_CHK = WS_R;
static_assert((size_t)16 * 129 * 32768 <= (size_t)4 * NP * 512 * 2, "chunk buffers fit");
constexpr size_t WS_KR = WS_R + (size_t)NP * 512 * 2;
constexpr size_t WS_VR = WS_KR + (size_t)NP * 512 * 2;
constexpr size_t WS_KK = WS_VR + (size_t)NP * 512 * 2;
constexpr size_t WS_TW = WS_KK + (size_t)NP * 512 * 2;
constexpr size_t WS_DA = WS_TW + (size_t)NP * 64 * 2;
constexpr size_t WS_SG = WS_DA + (size_t)NP * 64 * 2;
constexpr size_t WS_RW = WS_SG + (size_t)NP * 128 * 2;
constexpr size_t WS_RB = WS_RW + (size_t)NP * 512 * 4;
constexpr size_t WS_RK2 = WS_RB + (size_t)NP * 512 * 2;
constexpr size_t WS_G = WS_RK2 + (size_t)NP * 512 * 2;
constexpr size_t WS_Y = WS_G + (size_t)NP * 512 * 2;
constexpr size_t WS_MIX = WS_Y + (size_t)NP * 512 * 4;
constexpr size_t WS_LGS = WS_MIX + (size_t)NP * 1024 * 2;
constexpr size_t WS_EARLY_END = WS_LGS + (size_t)1024 * 32768;
constexpr size_t WS_ACT = WS_EARLY;
constexpr size_t WS_YB = WS_ACT + (size_t)MAXBLK * 256 * 1024 * 2;
constexpr size_t WS_LATE_END = WS_YB + (size_t)MAXBLK * 256 * 1024 * 2;
constexpr size_t WS_NEED = WS_EARLY_END > WS_LATE_END ? WS_EARLY_END : WS_LATE_END;
constexpr int CW_CNT = 0;
constexpr int CW_QATT = 64;
constexpr int CW_QK2 = 320;
constexpr int CW_XRANK = 1024;

struct P {
    const float *x, *meta, *ln0_g, *ln0_b, *w_in, *b_fgate, *fox_norm_g, *rwkv_mu, *w0, *w2, *a0, *a2, *g2, *k_k, *k_a, *r_k, *lnx_g,
        *lnx_b, *w_out, *ln1_g, *ln1_b, *w_router, *b_router, *w_gu, *b_gu, *w_down, *b_down, *ln2_g, *ln2_b;
    float* out;
    unsigned char* ws;
};
#define WSP(T, off) ((T*)(p.ws + (off)))

#define LBAR() do { asm volatile("s_waitcnt lgkmcnt(0)" ::: "memory"); __builtin_amdgcn_s_barrier(); asm volatile("" ::: "memory"); } while (0)
DEVI int otid() { int t = threadIdx.x; asm volatile("" : "+v"(t)); return t; }
DEVI unsigned f2bf(float f) { unsigned u = __float_as_uint(f); u += 0x7fffu + ((u >> 16) & 1u); return u >> 16; }
typedef float f32x2 __attribute__((ext_vector_type(2)));
typedef __bf16 bf16x2_t __attribute__((ext_vector_type(2)));
DEVI unsigned pk2(float lo, float hi) { const f32x2 v = {lo, hi}; const bf16x2_t b = __builtin_convertvector(v, bf16x2_t); return __builtin_bit_cast(unsigned, b); }
DEVI f32x4 ld4bf(const bf16_t* p) { const u32x2 w = *(const u32x2*)p; return (f32x4){__uint_as_float(w.x << 16), __uint_as_float(w.x & 0xffff0000u), __uint_as_float(w.y << 16), __uint_as_float(w.y & 0xffff0000u)}; }
DEVI void st4bf(bf16_t* p, f32x4 v) { *(u32x2*)p = (u32x2){pk2(v.x, v.y), pk2(v.z, v.w)}; }
DEVI float ld1bf(const bf16_t* p) { return __uint_as_float((unsigned)(*p) << 16); }
DEVI float wave_sum(float v) {
#pragma unroll
    for (int o = 32; o > 0; o >>= 1) v += __shfl_xor(v, o);
    return v;
}
DEVI float sum16(float v) {
#pragma unroll
    for (int o = 8; o > 0; o >>= 1) v += __shfl_xor(v, o);
    return v;
}
DEVI float dpp_add(float v, int) { return v; }
template <int CTRL> DEVI float dpp_mov(float v) { return __int_as_float(__builtin_amdgcn_update_dpp(0, __float_as_int(v), CTRL, 0xF, 0xF, false)); }
DEVI float rowsum16_dpp(float v) {
    v += dpp_mov<0xB1>(v);
    v += dpp_mov<0x4E>(v);
    v += dpp_mov<0x141>(v);
    v += dpp_mov<0x140>(v);
    return v;
}
DEVI float softplusf(float x) { return fmaxf(x, 0.f) + log1pf(__expf(-fabsf(x))); }
DEVI float sigmoidf(float x) { return __builtin_amdgcn_rcpf(1.f + __expf(-x)); }
DEVI float tanh_fast(float x) { return 1.f - 2.f * __builtin_amdgcn_rcpf(__expf(2.f * x) + 1.f); }
DEVI f32x4 zs4(const bf16_t* zrow, int col, const float* mu) { const f32x4 zc = ld4bf(zrow + col), zp = ld4bf(zrow - RWKV_COLS + col); return zc + (zp - zc) * *(const f32x4*)(mu + col); }
DEVI float softplus_fast(float x) { return fmaxf(x, 0.f) + __logf(1.f + __expf(-fabsf(x))); }

template <bool SWAP, class Epi>
DEVI void gemm128(const bf16_t* (&ap)[4], const bf16_t* (&bp)[4], int K, char* lds, Epi&& epi) {
    typedef __attribute__((address_space(3))) unsigned lds_u32;
    const int tid = otid(), lane = tid & 63, wid = __builtin_amdgcn_readfirstlane(tid >> 6), wm = wid >> 1, wn = wid & 1;
    const int l15 = lane & 15, lq = lane >> 4;
    const int srow = tid >> 3, skc = tid & 7;
    const int gko = ((skc ^ ((srow >> 1) & 7)) << 3);
    f32x4 acc[4][4];
#pragma unroll
    for (int i = 0; i < 4; ++i)
#pragma unroll
        for (int j = 0; j < 4; ++j) acc[i][j] = (f32x4){0.f, 0.f, 0.f, 0.f};
    const int nk = K / 64;
    auto stage = [&](int kt, int s) {
        char* base = lds + s * 32768 + wid * 1024;
#pragma unroll
        for (int i = 0; i < 4; ++i) {
            __builtin_amdgcn_global_load_lds((const unsigned*)(ap[i] + kt * 64 + gko), (lds_u32*)(base + i * 4096), 16, 0, 0);
            __builtin_amdgcn_global_load_lds((const unsigned*)(bp[i] + kt * 64 + gko), (lds_u32*)(base + 16384 + i * 4096), 16, 0, 0);
        }
    };
    stage(0, 0);
    asm volatile("s_waitcnt vmcnt(0)" ::: "memory"); __builtin_amdgcn_s_barrier(); asm volatile("" ::: "memory");
    const int aoff = (wm * 64 + l15) * 128, boff = 16384 + (wn * 64 + l15) * 128, sw = l15 >> 1;
    for (int kt = 0; kt < nk; ++kt) {
        const int s = kt & 1;
        if (kt + 1 < nk) stage(kt + 1, s ^ 1);
        const char* base = lds + s * 32768;
#pragma unroll
        for (int ks = 0; ks < 2; ++ks) {
            bf16x8 af[4], bfr[4];
            const int co = ((ks * 4 + lq) ^ sw) << 4;
#pragma unroll
            for (int t = 0; t < 4; ++t) { af[t] = *(const bf16x8*)(base + aoff + t * 2048 + co); bfr[t] = *(const bf16x8*)(base + boff + t * 2048 + co); }
#pragma unroll
            for (int mt = 0; mt < 4; ++mt)
#pragma unroll
                for (int nt = 0; nt < 4; ++nt) {
                    if (SWAP) acc[mt][nt] = __builtin_amdgcn_mfma_f32_16x16x32_bf16(af[mt], bfr[nt], acc[mt][nt], 0, 0, 0);
                    else acc[mt][nt] = __builtin_amdgcn_mfma_f32_16x16x32_bf16(bfr[nt], af[mt], acc[mt][nt], 0, 0, 0);
                }
        }
        asm volatile("s_waitcnt vmcnt(0) lgkmcnt(0)" ::: "memory"); __builtin_amdgcn_s_barrier(); asm volatile("" ::: "memory");
    }
    epi(acc, wm, wn, l15, lq);
}

constexpr int G2_STAGE = 24576;
constexpr int LDS_BYTES = 73728 + 1024;
constexpr int LX = 73728;
DEVI int xf4(int r) { return (0x78 >> (2 * ((r >> 2) & 3))) & 3; }
template <bool SWAP, int MT, class Epi>
DEVI void gemm256(const bf16_t* (&ap)[4], const bf16_t* (&bp)[2], int K, char* lds, Epi&& epi) {
    typedef __attribute__((address_space(3))) unsigned lds_u32;
    constexpr int NA = MT / 2 < 1 ? 1 : MT / 2;
    const int tid = otid(), lane = tid & 63, wid = __builtin_amdgcn_readfirstlane(tid >> 6), wm = wid >> 1, wn = wid & 1;
    const int l15 = lane & 15, lq = lane >> 4;
    const int gko = ((lane & 3) ^ xf4(lane >> 2)) << 3;
    f32x4 acc[MT][4];
#pragma unroll
    for (int i = 0; i < MT; ++i)
#pragma unroll
        for (int j = 0; j < 4; ++j) acc[i][j] = (f32x4){0.f, 0.f, 0.f, 0.f};
    const int nk = K / 32;
#define G2_DMA_A(kt, s, i) __builtin_amdgcn_global_load_lds((const unsigned*)(ap[i] + (kt) * 32 + gko), (lds_u32*)(lds + (s) * G2_STAGE + wid * 1024 + (i) * 4096), 16, 0, 0)
#define G2_DMA_B(kt, s, i) __builtin_amdgcn_global_load_lds((const unsigned*)(bp[i] + (kt) * 32 + gko), (lds_u32*)(lds + (s) * G2_STAGE + wid * 1024 + 16384 + (i) * 4096), 16, 0, 0)
#define G2_MMA(mt) do { _Pragma("unroll") for (int nt = 0; nt < 4; ++nt) { \
        if (SWAP) acc[mt][nt] = __builtin_amdgcn_mfma_f32_16x16x32_bf16(af[mt], bfr[nt], acc[mt][nt], 0, 0, 0); \
        else acc[mt][nt] = __builtin_amdgcn_mfma_f32_16x16x32_bf16(bfr[nt], af[mt], acc[mt][nt], 0, 0, 0); } } while (0)
#pragma unroll
    for (int st = 0; st < 2; ++st) { if (st < nk) {
#pragma unroll
        for (int i = 0; i < NA; ++i) G2_DMA_A(st, st, i);
        G2_DMA_B(st, st, 0); G2_DMA_B(st, st, 1); } }
    const int co = (lq ^ xf4(l15)) << 4;
    const int aoff = (wm * (16 * MT) + l15) * 64 + co, boff = 16384 + (wn * 64 + l15) * 64 + co;
    int s = 0;
    for (int kt = 0; kt < nk; ++kt) {
        if (kt + 1 < nk) { if (MT == 8) asm volatile("s_waitcnt vmcnt(6)" ::: "memory"); else if (MT == 4) asm volatile("s_waitcnt vmcnt(4)" ::: "memory"); else asm volatile("s_waitcnt vmcnt(3)" ::: "memory"); }
        else asm volatile("s_waitcnt vmcnt(0)" ::: "memory");
        __builtin_amdgcn_s_barrier(); asm volatile("" ::: "memory");
        const char* base = lds + s * G2_STAGE;
        bf16x8 af[MT], bfr[4];
#pragma unroll
        for (int t = 0; t < 4; ++t) bfr[t] = *(const bf16x8*)(base + boff + t * 1024);
#pragma unroll
        for (int t = 0; t < (MT < 4 ? MT : 4); ++t) af[t] = *(const bf16x8*)(base + aoff + t * 1024);
        const bool pre = kt + 2 < nk; int s2 = s + 2; if (s2 >= 3) s2 -= 3;
        __builtin_amdgcn_sched_barrier(0); __builtin_amdgcn_s_setprio(1);
        G2_MMA(0); __builtin_amdgcn_sched_barrier(0);
        if constexpr (MT == 8) {
#pragma unroll
            for (int t = 4; t < MT; ++t) af[t] = *(const bf16x8*)(base + aoff + t * 1024);
            if (pre) G2_DMA_A(kt + 2, s2, 0); __builtin_amdgcn_sched_barrier(0);
            G2_MMA(1); if (pre) G2_DMA_A(kt + 2, s2, 1); __builtin_amdgcn_sched_barrier(0);
            G2_MMA(2); if (pre) G2_DMA_A(kt + 2, s2, 2); __builtin_amdgcn_sched_barrier(0);
            G2_MMA(3); if (pre) G2_DMA_A(kt + 2, s2, 3); __builtin_amdgcn_sched_barrier(0);
            G2_MMA(4); if (pre) G2_DMA_B(kt + 2, s2, 0); __builtin_amdgcn_sched_barrier(0);
            G2_MMA(5); if (pre) G2_DMA_B(kt + 2, s2, 1); __builtin_amdgcn_sched_barrier(0);
            G2_MMA(6); G2_MMA(7);
        } else if constexpr (MT == 4) {
            if (pre) G2_DMA_A(kt + 2, s2, 0); __builtin_amdgcn_sched_barrier(0);
            G2_MMA(1); if (pre) G2_DMA_A(kt + 2, s2, 1); __builtin_amdgcn_sched_barrier(0);
            G2_MMA(2); if (pre) { G2_DMA_B(kt + 2, s2, 0); G2_DMA_B(kt + 2, s2, 1); } __builtin_amdgcn_sched_barrier(0);
            G2_MMA(3);
        } else {
            if (pre) { G2_DMA_A(kt + 2, s2, 0); G2_DMA_B(kt + 2, s2, 0); G2_DMA_B(kt + 2, s2, 1); } __builtin_amdgcn_sched_barrier(0);
            G2_MMA(1);
        }
        __builtin_amdgcn_s_setprio(0);
        asm volatile("s_waitcnt lgkmcnt(0)" ::: "memory");
        s = s == 2 ? 0 : s + 1;
    }
#undef G2_DMA_A
#undef G2_DMA_B
#undef G2_MMA
    __builtin_amdgcn_s_barrier(); asm volatile("" ::: "memory");
    epi(acc, wm, wn, l15, lq);
}

DEVI int srccol(int kind, int n) {
    if (kind == 0) return n;
    if (kind == 1) { if (n < 1536) return n; if (n < 3328) return n + 8; if (n < 3336) return 1536 + (n - 3328); return -1; }
    const int T = n >> 5, w = n & 31;
    return w < 16 ? T * 16 + w : 1024 + T * 16 + (w - 16);
}
DEVI void conv_tile(const float* src, int K, int NS, bf16_t* dst, int kind, int kt, int nt, float* scr  ) {
    const int tid = otid();
    const int nl = tid & 63, n = nt * 64 + nl, sc = srccol(kind, n);
    float v[16];
#pragma unroll
    for (int i = 0; i < 16; ++i) { const int k = i * 4 + (tid >> 6); v[i] = sc >= 0 ? src[(size_t)(kt * 64 + k) * NS + sc] : 0.f; }
#pragma unroll
    for (int i = 0; i < 16; ++i) { const int k = i * 4 + (tid >> 6); scr[k * 65 + nl] = v[i]; }
    LBAR();
    const int on = tid >> 2, kc = (tid & 3) * 16;
    u32x4 o0, o1;
    const float* s = scr + kc * 65 + on;
    o0.x = pk2(s[0 * 65], s[1 * 65]); o0.y = pk2(s[2 * 65], s[3 * 65]); o0.z = pk2(s[4 * 65], s[5 * 65]); o0.w = pk2(s[6 * 65], s[7 * 65]);
    o1.x = pk2(s[8 * 65], s[9 * 65]); o1.y = pk2(s[10 * 65], s[11 * 65]); o1.z = pk2(s[12 * 65], s[13 * 65]); o1.w = pk2(s[14 * 65], s[15 * 65]);
    bf16_t* d = dst + (size_t)(nt * 64 + on) * K + kt * 64 + kc;
    *(u32x4*)d = o0; *(u32x4*)(d + 8) = o1;
    LBAR();
}
DEVI void phase0(const P& p, int bid, int nb, char* lds) {
    const int tid = otid(), lane = tid & 63, wid = tid >> 6;
    {
        bf16_t* H0B = WSP(bf16_t, WS_H0B);
        for (int row = bid * 4 + wid; row < NP; row += nb * 4) {
            const int b = row / LP, pp = row % LP;
            u32x2* hb = (u32x2*)(H0B + (size_t)row * 1024) + lane;
            if (pp < PADL) {
#pragma unroll
                for (int j = 0; j < 4; ++j) hb[64 * j] = (u32x2){0u, 0u};
                continue;
            }
            const int t = pp - PADL;
            const float* src = t < NMETA ? p.meta + (size_t)t * 1024 : p.x + ((size_t)b * SEQ + (t - NMETA)) * 1024;
            f32x4 v[4]; float s = 0.f;
#pragma unroll
            for (int j = 0; j < 4; ++j) { v[j] = ((const f32x4*)src)[lane + 64 * j]; s += (v[j].x + v[j].y) + (v[j].z + v[j].w); }
            const float mean = wave_sum(s) * (1.f / 1024.f); float s2 = 0.f;
#pragma unroll
            for (int j = 0; j < 4; ++j) { v[j] = v[j] - mean; s2 += (v[j].x * v[j].x + v[j].y * v[j].y) + (v[j].z * v[j].z + v[j].w * v[j].w); }
            const float rstd = rsqrtf(wave_sum(s2) * (1.f / 1024.f) + LN_EPS);
#pragma unroll
            for (int j = 0; j < 4; ++j) {
                const f32x4 g = ((const f32x4*)p.ln0_g)[lane + 64 * j], bb = ((const f32x4*)p.ln0_b)[lane + 64 * j];
                const f32x4 o = v[j] * rstd * g + bb;
                hb[64 * j] = (u32x2){pk2(o.x, o.y), pk2(o.z, o.w)};
            }
        }
    }
    {
        float* scr = (float*)lds;
        constexpr int T_IN = 16 * 54, T_OUT = 16 * 16, T_W2 = 8, T_A2 = 8, T_G2 = 16;
        constexpr int TOT = T_IN + T_OUT + T_W2 + T_A2 + T_G2;
        for (int it = bid; it < TOT; it += nb) {
            int r = it;
            if (r < T_IN) { conv_tile(p.w_in, 1024, IN_COLS, WSP(bf16_t, WS_WINT), 1, r / 54, r % 54, scr); continue; } r -= T_IN;
            if (r < T_OUT) { conv_tile(p.w_out, 1024, 1024, WSP(bf16_t, WS_WOUTT), 0, r / 16, r % 16, scr); continue; } r -= T_OUT;
            if (r < T_W2) { conv_tile(p.w2, 64, 512, WSP(bf16_t, WS_W2T), 0, 0, r, scr); continue; } r -= T_W2;
            if (r < T_A2) { conv_tile(p.a2, 64, 512, WSP(bf16_t, WS_A2T), 0, 0, r, scr); continue; } r -= T_A2;
            conv_tile(p.g2, 128, 512, WSP(bf16_t, WS_G2T), 0, r / 8, r % 8, scr);
        }
    }
}
DEVI void conv_wide(const float* src, int NS, bf16_t* dst, int kind, int kt, int nt, float* scr) {
    const int tid = otid();
    const int n = nt * 256 + tid, sc = srccol(kind, n);
    const float* sp = src + (size_t)(kt * 64) * NS + sc;
    float v[64];
#pragma unroll
    for (int k = 0; k < 64; ++k) v[k] = sp[(size_t)k * NS];
#pragma unroll
    for (int k = 0; k < 64; ++k) scr[k * 257 + tid] = v[k];
    LBAR();
    const int ch = tid & 7, r0 = tid >> 3;
#pragma unroll
    for (int j = 0; j < 8; ++j) { const int row = j * 32 + r0; const float* s = scr + (8 * ch) * 257 + row;
        *(u32x4*)(dst + (size_t)(nt * 256 + row) * 1024 + kt * 64 + 8 * ch) = (u32x4){pk2(s[0], s[257]), pk2(s[2 * 257], s[3 * 257]), pk2(s[4 * 257], s[5 * 257]), pk2(s[6 * 257], s[7 * 257])}; }
    LBAR();
}
constexpr int CONV_TILES = 12, N_CONV_ITEMS = (32 * 16 * 8 + 32 * 16 * 4) / CONV_TILES;
static_assert(2 * N_CONV_ITEMS <= 16 * (NQB - 1), "interleave pattern needs 2 attention items per conversion item");
DEVI void conv_moe_item(const P& p, int item, char* lds) {
    float* scr = (float*)lds;
    for (int t = 0; t < CONV_TILES; ++t) {
        int r = item * CONV_TILES + t;
        if (r < 32 * 128) { const int e = r / 128, q = r % 128; conv_wide(p.w_gu + (size_t)e * 1024 * 2048, 2048, WSP(bf16_t, WS_WGUT) + (size_t)e * 2048 * 1024, 2, q / 8, q % 8, scr); }
        else { r -= 32 * 128; const int e = r / 64, q = r % 64; conv_wide(p.w_down + (size_t)e * 1024 * 1024, 1024, WSP(bf16_t, WS_WDT) + (size_t)e * 1024 * 1024, 0, q / 4, q % 4, scr); }
    }
}

struct Sched { int x, rank, nloc, nxcd; };
template <class F> DEVI void for_xcd_items(const Sched& sc, F&& f) {
    const int x0 = sc.nxcd == 8 ? sc.x : 0, x1 = sc.nxcd == 8 ? sc.x + 1 : 8;
    for (int x = x0; x < x1; ++x) f(x, sc.rank, sc.nloc);
}

struct EpiInProj {
    const P& p; int tm, tn;
    DEVI void operator()(f32x4 (&acc)[8][4], int wm, int wn, int l15, int lq) const {
        if (tn < 8) {
            bf16_t* dst = tn < 4 ? WSP(bf16_t, WS_QB) : WSP(bf16_t, WS_KB); const float sc = tn < 4 ? QSCALE : 1.f;
            const int cb = (tn & 3) * 128 + wn * 64 + 4 * lq;
            float mx = 0.f;
#pragma unroll
            for (int mt = 0; mt < 8; ++mt) { const size_t row = (size_t)tm * 256 + wm * 128 + mt * 16 + l15; float ssq = 0.f;
#pragma unroll
                for (int nt = 0; nt < 4; ++nt) { const f32x4 a = acc[mt][nt] * sc; ssq += (a.x * a.x + a.y * a.y) + (a.z * a.z + a.w * a.w); *(u32x2*)(dst + row * 512 + cb + nt * 16) = (u32x2){pk2(a.x, a.y), pk2(a.z, a.w)}; }
                ssq += __shfl_xor(ssq, 16); ssq += __shfl_xor(ssq, 32); mx = fmaxf(mx, ssq); }
#pragma unroll
            for (int o = 1; o < 16; o <<= 1) mx = fmaxf(mx, __shfl_xor(mx, o));
            if ((threadIdx.x & 63) == 0) atomicMax(WSP(unsigned, WS_CTL) + CW_QK2 + (tn < 4 ? 0 : 8) + 2 * (tn & 3) + wn, __float_as_uint(mx));
        } else if (tn < 12) {
            bf16_t* VT = WSP(bf16_t, WS_VT); const int row0 = tm * 256 + wm * 128;
#pragma unroll
            for (int mt = 0; mt < 8; ++mt) { const int row = row0 + mt * 16 + 4 * lq, b = row / LP, pp = row % LP;
#pragma unroll
                for (int nt = 0; nt < 4; ++nt) { const int n = (tn - 8) * 128 + wn * 64 + nt * 16 + l15; const f32x4 a = acc[mt][nt];
                    *(u32x2*)(VT + (size_t)(b * 512 + n) * LP + pp) = (u32x2){pk2(a.x, a.y), pk2(a.z, a.w)}; } }
        } else if (tn < 26) {
            bf16_t* ZR = WSP(bf16_t, WS_ZR); const int cb = (tn - 12) * 128 + wn * 64 + 4 * lq;
#pragma unroll
            for (int mt = 0; mt < 8; ++mt) { const size_t row = (size_t)tm * 256 + wm * 128 + mt * 16 + l15;
#pragma unroll
                for (int nt = 0; nt < 4; ++nt) st4bf(ZR + row * RWKV_COLS + cb + nt * 16, acc[mt][nt]); }
        } else {
            if (wn == 0 && lq < 2) { float* LF = WSP(float, WS_LF);
#pragma unroll
                for (int mt = 0; mt < 8; ++mt) { const int row = tm * 256 + wm * 128 + mt * 16 + l15; const bool pad = (row % LP) < PADL; f32x4 o;
#pragma unroll
                    for (int r = 0; r < 4; ++r) { const float xv = acc[mt][0][r] + p.b_fgate[4 * lq + r]; o[r] = pad ? 0.f : -softplusf(-xv); }
                    *(f32x4*)(LF + (size_t)row * 8 + 4 * lq) = o; } }
        }
    }
};
DEVI void phase1(const P& p, const Sched& sc, char* lds) {
    const int tid = otid(), lane = tid & 63, wid = tid >> 6, srow_ = 16 * wid + (lane >> 2);
    for_xcd_items(sc, [&](int x, int rank, int nloc) __attribute__((always_inline)) {
        const int xr = x >> 2, xc = x & 3, c0 = 7 * xc, cnt = xc == 3 ? 6 : 7, r0 = 33 * xr, nr = xr ? 32 : 33;
        for (int i = rank; i < nr * cnt; i += nloc) {
            const int tm = r0 + i / cnt, tn = c0 + i % cnt;
            const bf16_t *ap[4], *bp[2];
            int srow = srow_; asm volatile("" : "+v"(srow));
#pragma unroll
            for (int q = 0; q < 4; ++q) ap[q] = WSP(bf16_t, WS_H0B) + (size_t)(tm * 256 + srow + 64 * q) * 1024;
#pragma unroll
            for (int q = 0; q < 2; ++q) bp[q] = WSP(bf16_t, WS_WINT) + (size_t)(tn * 128 + srow + 64 * q) * 1024;
            if (tn >= 8 && tn < 12) gemm256<true, 8>(ap, bp, 1024, lds, EpiInProj{p, tm, tn});
            else gemm256<false, 8>(ap, bp, 1024, lds, EpiInProj{p, tm, tn});
        }
    });
}

DEVI void phase2a(const P& p, int bid, int nb, char* lds) {
    const int tid = otid(), lane = tid & 63, wid = tid >> 6;
    if (bid < 16) {
        const int b = bid >> 3, h = bid & 7; float* part = (float*)lds;
        const float* LF = WSP(float, WS_LF); float* CS = WSP(float, WS_CS);
        const int r0 = tid * 33, r1 = min(r0 + 33, LP); float s = 0.f;
        for (int r = r0; r < r1; ++r) s += LF[((size_t)b * LP + r) * 8 + h];
        part[tid] = s; __syncthreads();
        float pre = 0.f; for (int i = 0; i < tid; ++i) pre += part[i];
        for (int r = r0; r < r1; ++r) { pre += LF[((size_t)b * LP + r) * 8 + h]; CS[((size_t)b * LP + r) * 8 + h] = pre * LOG2E; }
        __syncthreads();
    }
    const bf16_t* ZR = WSP(bf16_t, WS_ZR);
    for (int row = bid * 4 + wid; row < NP; row += nb * 4) {
        const int pp = row % LP; const bool hasprev = pp > 0;
        const bf16_t* z = ZR + (size_t)row * RWKV_COLS + lane * 4; const bf16_t* zp = ZR + (size_t)(row - (hasprev ? 1 : 0)) * RWKV_COLS + lane * 4;
        const f32x4* mu = (const f32x4*)p.rwkv_mu + lane;
#pragma unroll
        for (int j = 0; j < 7; ++j) {
            const f32x4 zc = ld4bf(z + 256 * j); f32x4 zq = ld4bf(zp + 256 * j); if (!hasprev) zq = (f32x4){0.f, 0.f, 0.f, 0.f};
            const f32x4 zs = zc + (zq - zc) * mu[64 * j];
            const int c = (lane * 4 + 256 * j) & 511;
            if (j < 2) st4bf(WSP(bf16_t, WS_R) + (size_t)row * 512 + c, zs);
            else if (j < 4) {
                st4bf(WSP(bf16_t, WS_KR) + (size_t)row * 512 + c, zs);
                const f32x4 kr = zs * *(const f32x4*)(p.k_k + c);
                const float ss = sum16((kr.x * kr.x + kr.y * kr.y) + (kr.z * kr.z + kr.w * kr.w));
                const float inv = 1.f / fmaxf(sqrtf(ss), 1e-12f);
                st4bf(WSP(bf16_t, WS_KK) + (size_t)row * 512 + c, kr * inv);
            } else if (j < 6) st4bf(WSP(bf16_t, WS_VR) + (size_t)row * 512 + c, zs);
            else {
                if (lane < 16) *(u32x2*)(WSP(bf16_t, WS_TW) + (size_t)row * 64 + lane * 4) = (u32x2){pk2(tanhf(zs.x), tanhf(zs.y)), pk2(tanhf(zs.z), tanhf(zs.w))};
                else if (lane < 32) *(u32x2*)(WSP(bf16_t, WS_DA) + (size_t)row * 64 + (lane - 16) * 4) = (u32x2){pk2(zs.x, zs.y), pk2(zs.z, zs.w)};
                else *(u32x2*)(WSP(bf16_t, WS_SG) + (size_t)row * 128 + (lane - 32) * 4) = (u32x2){pk2(sigmoidf(zs.x), sigmoidf(zs.y)), pk2(sigmoidf(zs.z), sigmoidf(zs.w))};
            }
        }
    }
}

struct EpiLora {
    const P& p; int which, tm, tn;
    DEVI void operator()(f32x4 (&acc)[4][4], int wm, int wn, int l15, int lq) const {
#pragma unroll
        for (int mt = 0; mt < 4; ++mt) { const size_t row = (size_t)tm * 128 + wm * 64 + mt * 16 + l15;
#pragma unroll
            for (int nt = 0; nt < 4; ++nt) { const int c = tn * 128 + wn * 64 + nt * 16 + 4 * lq; const f32x4 a = acc[mt][nt];
                if (which == 0) { const f32x4 w0v = *(const f32x4*)(p.w0 + c); f32x4 o;
#pragma unroll
                    for (int r = 0; r < 4; ++r) { const float lw = w0v[r] + a[r]; const float wl = -softplusf(-lw) - 0.5f; o[r] = -__expf(wl); }
                    *(f32x4*)(WSP(float, WS_RW) + row * 512 + c) = o;
                } else if (which == 1) { const f32x4 a0v = *(const f32x4*)(p.a0 + c), kav = *(const f32x4*)(p.k_a + c);
                    const f32x4 kk = ld4bf(WSP(bf16_t, WS_KK) + row * 512 + c), kr = ld4bf(WSP(bf16_t, WS_KR) + row * 512 + c); f32x4 ob, ok;
#pragma unroll
                    for (int r = 0; r < 4; ++r) { const float av = sigmoidf(a0v[r] + a[r]); ob[r] = kk[r] * av; ok[r] = kr[r] * (1.f + (av - 1.f) * kav[r]); }
                    st4bf(WSP(bf16_t, WS_RB) + row * 512 + c, ob); st4bf(WSP(bf16_t, WS_RK2) + row * 512 + c, ok);
                } else st4bf(WSP(bf16_t, WS_G) + row * 512 + c, a);
            } }
    }
};
DEVI void phase2b(const P& p, int bid, int nb, char* lds) {
    const int tid = otid(), srow = tid >> 3, skc = tid & 7;
    for (int it = bid; it < 130 * 12; it += nb) {
        const int tm = it / 12, r = it % 12, which = r >> 2, tn = r & 3;
        const int K = which == 2 ? 128 : 64;
        const bf16_t* A = which == 0 ? WSP(bf16_t, WS_TW) : which == 1 ? WSP(bf16_t, WS_DA) : WSP(bf16_t, WS_SG);
        const bf16_t* Bt = which == 0 ? WSP(bf16_t, WS_W2T) : which == 1 ? WSP(bf16_t, WS_A2T) : WSP(bf16_t, WS_G2T);
        const bf16_t *ap[4], *bp[4];
#pragma unroll
        for (int i = 0; i < 4; ++i) { ap[i] = A + (size_t)(tm * 128 + srow + 32 * i) * K; bp[i] = Bt + (size_t)(tn * 128 + srow + 32 * i) * K; }
        gemm128<false>(ap, bp, K, lds, EpiLora{p, which, tm, tn});
    }
}

DEVI int pi_swap(int i) { return (i & ~12) | ((i & 4) << 1) | ((i & 8) >> 1); }
DEVI void attn_item(const P& p, int b, int h, int qb, char* lds) {
    const int tid = otid(), lane = tid & 63, wid = tid >> 6, ql = lane & 31, hi = lane >> 5;
    const int q_pp = qb * 128 + wid * 32 + ql; const size_t qrow = (size_t)b * LP + q_pp;
    const bf16_t* QB = WSP(bf16_t, WS_QB); const bf16_t* KB = WSP(bf16_t, WS_KB); const bf16_t* VT = WSP(bf16_t, WS_VT); const float* CS = WSP(float, WS_CS);
    bf16x8 qf[4];
#pragma unroll
    for (int d0 = 0; d0 < 4; ++d0) qf[d0] = *(const bf16x8*)(QB + qrow * 512 + h * 64 + 16 * d0 + 8 * hi);
    const float cref = CS[((size_t)b * LP + qb * 128) * 8 + h];
    const int r0 = tid >> 3, kc = tid & 7;
    const int soff = r0 * 128 + ((kc ^ ((r0 >> 1) & 7)) << 4);
    const bf16_t* ksrc = KB + ((size_t)b * LP + r0) * 512 + h * 64 + kc * 8;
    const bf16_t* vsrc = VT + (size_t)(b * 512 + h * 64 + r0) * LP + kc * 8;
    const float* csrc = CS + ((size_t)b * LP + (tid & 63)) * 8 + h;
    const int nkt = 2 * qb + 1;
    int kstart = 1;
    {
        const unsigned* qk2 = WSP(unsigned, WS_CTL) + CW_QK2;
        const float bnd = 150.f + 2.04f * sqrtf(__uint_as_float(qk2[h]) * __uint_as_float(qk2[8 + h]));
        const int kt = tid + 1; bool skip = false;
        if (kt <= nkt) skip = CS[((size_t)b * LP + 64 * kt + 63) * 8 + h] - cref > bnd;
        int* s_cnt = (int*)(lds + LX + 944);
        if (tid == 0) *s_cnt = 0;
        __syncthreads();
        const int c = __popcll(__ballot(skip));
        if (lane == 0 && c) atomicAdd(s_cnt, c);
        __syncthreads();
        kstart = 1 + __builtin_amdgcn_readfirstlane(*s_cnt);
        if (kstart > 2 * qb) kstart = 2 * qb;
    }
    u32x4 rk[2], rv[2]; float rc = 0.f;
    auto gload = [&](int kt) {
#pragma unroll
        for (int i = 0; i < 2; ++i) { rk[i] = *(const u32x4*)(ksrc + (size_t)(64 * kt + 32 * i) * 512); rv[i] = *(const u32x4*)(vsrc + 64 * kt + (size_t)i * 32 * LP); }
        if (tid < 64) rc = csrc[(size_t)64 * kt * 8];
    };
    auto swrite = [&](int s) {
        char* bs = lds + s * 16640;
#pragma unroll
        for (int i = 0; i < 2; ++i) { *(u32x4*)(bs + soff + i * 4096) = rk[i]; *(u32x4*)(bs + 8192 + soff + i * 4096) = rv[i]; }
        if (tid < 64) *(float*)(bs + 16384 + tid * 4) = rc - cref;
    };
    float m = NEGBIG, l = 0.f; f32x16 o[2];
#pragma unroll
    for (int r = 0; r < 16; ++r) { o[0][r] = 0.f; o[1][r] = 0.f; }
    const int krow0 = pi_swap(ql);
    const int koff = krow0 * 128, ksw = (krow0 >> 1) & 7;
    const int voff = 8192 + ql * 128, vsw = (ql >> 1) & 7;
    gload(kstart); swrite(kstart & 1); __syncthreads();
    for (int kt = kstart; kt <= nkt; ++kt) {
        const int s = kt & 1;
        if (kt < nkt) gload(kt + 1);
        if (64 * kt <= qb * 128 + wid * 32 + 31) {
            const char* bs = lds + s * 16640;
            f32x16 sc[2];
#pragma unroll
            for (int kh = 0; kh < 2; ++kh) {
#pragma unroll
                for (int r = 0; r < 16; ++r) sc[kh][r] = 0.f;
#pragma unroll
                for (int d0 = 0; d0 < 4; ++d0) { const bf16x8 kf = *(const bf16x8*)(bs + kh * 4096 + koff + (((2 * d0 + hi) ^ ksw) << 4));
                    sc[kh] = __builtin_amdgcn_mfma_f32_32x32x16_bf16(kf, qf[d0], sc[kh], 0, 0, 0); }
            }
            const float* csl = (const float*)(bs + 16384);
            const bool needmask = (kt == 1) || (kt >= 2 * qb);
            f32x2 xv[2][8];
#pragma unroll
            for (int kh = 0; kh < 2; ++kh)
#pragma unroll
                for (int g = 0; g < 4; ++g) { const int key0 = 32 * kh + 16 * (g >> 1) + 8 * hi + 4 * (g & 1); const f32x4 cv = *(const f32x4*)(csl + key0);
                    xv[kh][2 * g] = (f32x2){sc[kh][4 * g], sc[kh][4 * g + 1]} - (f32x2){cv.x, cv.y};
                    xv[kh][2 * g + 1] = (f32x2){sc[kh][4 * g + 2], sc[kh][4 * g + 3]} - (f32x2){cv.z, cv.w}; }
            if (needmask) {
#pragma unroll
                for (int kh = 0; kh < 2; ++kh)
#pragma unroll
                    for (int g = 0; g < 4; ++g) { const int key0 = 32 * kh + 16 * (g >> 1) + 8 * hi + 4 * (g & 1);
#pragma unroll
                        for (int c = 0; c < 4; ++c) { const int kp = 64 * kt + key0 + c; if (kp > q_pp || kp < PADL) xv[kh][2 * g + (c >> 1)][c & 1] = NEGBIG; } }
            }
            float mloc;
            { float a = __builtin_fmaxf(__builtin_fmaxf(xv[0][0].x, xv[0][0].y), xv[1][0].x), bq = __builtin_fmaxf(__builtin_fmaxf(xv[0][1].x, xv[0][1].y), xv[1][0].y);
              a = __builtin_fmaxf(__builtin_fmaxf(a, xv[1][1].x), xv[1][1].y);
#pragma unroll
              for (int i = 2; i < 8; i += 2) { a = __builtin_fmaxf(__builtin_fmaxf(a, xv[0][i].x), xv[0][i].y); bq = __builtin_fmaxf(__builtin_fmaxf(bq, xv[0][i + 1].x), xv[0][i + 1].y);
                  a = __builtin_fmaxf(__builtin_fmaxf(a, xv[1][i].x), xv[1][i].y); bq = __builtin_fmaxf(__builtin_fmaxf(bq, xv[1][i + 1].x), xv[1][i + 1].y); }
              mloc = __builtin_fmaxf(a, bq); }
            { const auto rr = __builtin_amdgcn_permlane32_swap(__float_as_uint(mloc), __float_as_uint(mloc), false, false); mloc = fmaxf(__uint_as_float(rr[0]), __uint_as_float(rr[1])); }
            if (__any(mloc > m + 8.f)) {
                const float mnew = fmaxf(m, mloc); const float f = __builtin_amdgcn_exp2f(m - mnew); m = mnew; l *= f;
#pragma unroll
                for (int r = 0; r < 16; ++r) { o[0][r] *= f; o[1][r] *= f; }
            }
            bf16x8 pf[2][2]; f32x2 ls2 = (f32x2){0.f, 0.f}; const f32x2 m2 = (f32x2){m, m};
#pragma unroll
            for (int kh = 0; kh < 2; ++kh)
#pragma unroll
                for (int s2 = 0; s2 < 2; ++s2) { u32x4 w;
#pragma unroll
                    for (int j = 0; j < 4; ++j) { const f32x2 d = xv[kh][4 * s2 + j] - m2; f32x2 e; e.x = __builtin_amdgcn_exp2f(d.x); e.y = __builtin_amdgcn_exp2f(d.y); ls2 += e; w[j] = pk2(e.x, e.y); }
                    pf[kh][s2] = __builtin_bit_cast(bf16x8, w); }
            l += ls2.x + ls2.y;
#pragma unroll
            for (int dh = 0; dh < 2; ++dh)
#pragma unroll
                for (int kh = 0; kh < 2; ++kh)
#pragma unroll
                    for (int s2 = 0; s2 < 2; ++s2) { const bf16x8 vf = *(const bf16x8*)(bs + voff + dh * 4096 + (((4 * kh + 2 * s2 + hi) ^ vsw) << 4));
                        o[dh] = __builtin_amdgcn_mfma_f32_32x32x16_bf16(vf, pf[kh][s2], o[dh], 0, 0, 0); }
        }
        if (kt < nkt) swrite((kt + 1) & 1);
        __syncthreads();
    }
    l += __shfl_xor(l, 32);
    const float inv = 1.f / l; float ss = 0.f;
#pragma unroll
    for (int r = 0; r < 16; ++r) { o[0][r] *= inv; o[1][r] *= inv; ss += o[0][r] * o[0][r] + o[1][r] * o[1][r]; }
    ss += __shfl_xor(ss, 32);
    const float rs = rsqrtf(ss * (1.f / 64.f) + RMS_EPS);
    bf16_t* MIX = WSP(bf16_t, WS_MIX); const bool padq = q_pp < PADL;
#pragma unroll
    for (int dh = 0; dh < 2; ++dh)
#pragma unroll
        for (int g = 0; g < 4; ++g) { const int d = 32 * dh + 8 * g + 4 * hi; const f32x4 gn = *(const f32x4*)(p.fox_norm_g + h * 64 + d);
            float v0 = o[dh][4 * g] * rs * gn.x, v1 = o[dh][4 * g + 1] * rs * gn.y, v2 = o[dh][4 * g + 2] * rs * gn.z, v3 = o[dh][4 * g + 3] * rs * gn.w;
            if (padq) { v0 = v1 = v2 = v3 = 0.f; }
            *(u32x2*)(MIX + qrow * 1024 + h * 64 + d) = (u32x2){pk2(v0, v1), pk2(v2, v3)}; }
}
DEVI void phase3a(const P& p, int bid, int nb, char* lds) {
    for (int it = bid; it < 16 * NQB; it += nb) { const int qb = NQB - 1 - it / 16, bh = it % 16; attn_item(p, bh >> 3, bh & 7, qb, lds); }
}

constexpr int NCHUNK = 129;
constexpr int CHUNK_BYTES = 32768;
constexpr int C_XL = 32768, C_LG = 50176, C_PART = 67584, C_END = 68608;
DEVI int swz(int row, int chunk) { return row * 128 + ((chunk ^ ((row >> 1) & 7)) << 4); }
DEVI int crow(int r, int h) { return (r & 3) + 8 * (r >> 2) + 4 * h; }
DEVI bf16x8 frag(const char* base, int row, int ks, int h) { return *(const bf16x8*)(base + swz(row, 2 * ks + h)); }
DEVI void chunk_job(const P& p, int job, char* lds) {
    int tid_ = threadIdx.x; asm volatile("" : "+v"(tid_));
    const int tid = tid_, lane = tid & 63, wid = tid >> 6, l31 = lane & 31, h = lane >> 5, rb = wid >> 1, cb = wid & 1;
    const int bh = job / NCHUNK, c = job % NCHUNK, b = bh >> 3, hh = bh & 7;
    const size_t row0 = (size_t)b * LP + 64 + 64 * c; const int col0 = hh * 64;
    const bf16_t* BB = WSP(bf16_t, WS_RB) + row0 * 512 + col0; const bf16_t* K2 = WSP(bf16_t, WS_RK2) + row0 * 512 + col0;
    const bf16_t* ZRb = WSP(bf16_t, WS_ZR) + row0 * RWKV_COLS;
    float* LgG = WSP(float, WS_LGS) + (size_t)blockIdx.x * 8192;
    char* chk = (char*)p.ws + WS_CHK + (size_t)job * CHUNK_BYTES;
    char* R1 = lds; float* XL = (float*)(lds + C_XL); float* Lg = (float*)(lds + C_LG); float* part = (float*)(lds + C_PART);
    {
        const int t = tid >> 2, q = tid & 3; const bf16_t* zrow = ZRb + (size_t)t * RWKV_COLS; char* dst = R1 + q * 8192;
#pragma unroll 4
        for (int i = 0; i < 16; ++i) { f32x4 z = zs4(zrow, 1536 + 64 * q + 4 * i, p.rwkv_mu);
            if (q == 0) z = (f32x4){tanh_fast(z.x), tanh_fast(z.y), tanh_fast(z.z), tanh_fast(z.w)};
            else if (q >= 2) z = (f32x4){sigmoidf(z.x), sigmoidf(z.y), sigmoidf(z.z), sigmoidf(z.w)};
            *(u32x2*)(dst + swz(t, i >> 1) + (i & 1) * 8) = (u32x2){pk2(z.x, z.y), pk2(z.z, z.w)}; }
    }
    LBAR();
    {
        const bf16_t* W2T = WSP(bf16_t, WS_W2T) + (size_t)(col0 + 32 * cb + l31) * 64 + 8 * h; const bf16_t* A2T = WSP(bf16_t, WS_A2T) + (size_t)(col0 + 32 * cb + l31) * 64 + 8 * h;
        const bf16_t* G2T = WSP(bf16_t, WS_G2T) + (size_t)(col0 + 32 * cb + l31) * 128 + 8 * h;
        f32x16 dw, da, dg;
#pragma unroll
        for (int r = 0; r < 16; ++r) { dw[r] = 0.f; da[r] = 0.f; dg[r] = 0.f; }
#pragma unroll
        for (int ks = 0; ks < 4; ++ks) {
            dw = __builtin_amdgcn_mfma_f32_32x32x16_bf16(frag(R1, 32 * rb + l31, ks, h), *(const bf16x8*)(W2T + 16 * ks), dw, 0, 0, 0);
            da = __builtin_amdgcn_mfma_f32_32x32x16_bf16(frag(R1 + 8192, 32 * rb + l31, ks, h), *(const bf16x8*)(A2T + 16 * ks), da, 0, 0, 0);
        }
#pragma unroll
        for (int ks = 0; ks < 8; ++ks) dg = __builtin_amdgcn_mfma_f32_32x32x16_bf16(frag(R1 + 16384 + (ks >> 2) * 8192, 32 * rb + l31, ks & 3, h), *(const bf16x8*)(G2T + 16 * ks), dg, 0, 0, 0);
        LBAR();
        const int j = 32 * cb + l31; const float w0v = p.w0[col0 + j], a0v = p.a0[col0 + j]; float* At = (float*)R1;
#pragma unroll
        for (int r = 0; r < 16; ++r) { const int t = 32 * rb + crow(r, h);
            const float wl = -softplus_fast(-(w0v + dw[r])) - 0.5f; Lg[t * 64 + j] = -__expf(wl);
            At[t * 64 + j] = sigmoidf(a0v + da[r]);
            (WSP(bf16_t, WS_G) + row0 * 512 + col0)[(size_t)t * 512 + j] = (bf16_t)f2bf(dg[r]); }
    }
    LBAR();
    {
        const int cq = tid >> 6, cj = tid & 63; float cs[16]; float run = 0.f;
#pragma unroll
        for (int u = 0; u < 16; ++u) { run += Lg[(16 * cq + u) * 64 + cj]; cs[u] = run; }
        part[cq * 64 + cj] = run; LBAR();
        float off = 0.f;
        for (int q = 0; q < cq; ++q) off += part[q * 64 + cj];
#pragma unroll
        for (int u = 0; u < 16; ++u) { Lg[(16 * cq + u) * 64 + cj] = cs[u] + off; LgG[(16 * cq + u) * 64 + cj] = cs[u] + off; }
        LBAR();
    }
    {
        const int t = tid >> 2, jr = (tid & 3) * 16;
        f32x4 av4[4];
#pragma unroll
        for (int e4 = 0; e4 < 4; ++e4) av4[e4] = *(const f32x4*)((const float*)R1 + t * 64 + jr + 4 * e4);
        LBAR();
        const bf16_t* zrow = ZRb + (size_t)t * RWKV_COLS;
        f32x4 kr4[4], kk4[4], rr4[4], ka4[4]; float ss = 0.f;
        const int tp = t > 0 ? t - 1 : 0; const float pm = t > 0 ? 1.f : 0.f;
#pragma unroll
        for (int e4 = 0; e4 < 4; ++e4) { const int j = jr + 4 * e4;
            kr4[e4] = zs4(zrow, 512 + col0 + j, p.rwkv_mu); rr4[e4] = zs4(zrow, col0 + j, p.rwkv_mu); ka4[e4] = *(const f32x4*)(p.k_a + col0 + j);
            kk4[e4] = kr4[e4] * *(const f32x4*)(p.k_k + col0 + j);
            ss += (kk4[e4].x * kk4[e4].x + kk4[e4].y * kk4[e4].y) + (kk4[e4].z * kk4[e4].z + kk4[e4].w * kk4[e4].w); }
        ss += dpp_mov<0xB1>(ss); ss += dpp_mov<0x4E>(ss);
        const float kinv = 1.f / fmaxf(sqrtf(ss), 1e-12f);
#pragma unroll
        for (int e4 = 0; e4 < 4; ++e4) {
            const int j = jr + 4 * e4;
            const f32x4 lg = *(const f32x4*)(Lg + t * 64 + j), lgp = *(const f32x4*)(Lg + tp * 64 + j) * pm;
            const f32x4 kk = kk4[e4] * kinv, kr = kr4[e4], rr = rr4[e4], ka = ka4[e4];
            const f32x4 bb = kk * av4[e4], k2 = kr * (1.f + (av4[e4] - 1.f) * ka);
            st4bf((bf16_t*)BB + (size_t)t * 512 + j, bb); st4bf((bf16_t*)K2 + (size_t)t * 512 + j, k2);
            float at[4], rt[4], bt[4], kt[4];
#pragma unroll
            for (int q = 0; q < 4; ++q) { const float en = __expf(-lg[q]); at[q] = -kk[q] * __expf(lgp[q]); rt[q] = rr[q] * __expf(lg[q]); bt[q] = bb[q] * en; kt[q] = k2[q] * en; }
            const int o = swz(t, j >> 3) + (j & 7) * 2;
            *(u32x2*)(R1 + 0 + o) = (u32x2){pk2(bt[0], bt[1]), pk2(bt[2], bt[3])};
            *(u32x2*)(R1 + 8192 + o) = (u32x2){pk2(kt[0], kt[1]), pk2(kt[2], kt[3])};
            *(u32x2*)(R1 + 16384 + o) = (u32x2){pk2(at[0], at[1]), pk2(at[2], at[3])};
            *(u32x2*)(R1 + 24576 + o) = (u32x2){pk2(rt[0], rt[1]), pk2(rt[2], rt[3])};
#pragma unroll
            for (int q = 0; q < 4; ++q) XL[(j + q) * 68 + t] = at[q];
        }
    }
    LBAR();
    {
        f32x16 tb, tk, qb, hy;
#pragma unroll
        for (int r = 0; r < 16; ++r) { tb[r] = 0.f; tk[r] = 0.f; qb[r] = 0.f; hy[r] = 0.f; }
#pragma unroll
        for (int ks = 0; ks < 4; ++ks) {
            const bf16x8 aB = frag(R1, 32 * rb + l31, ks, h), aK = frag(R1 + 8192, 32 * rb + l31, ks, h), bA = frag(R1 + 16384, 32 * cb + l31, ks, h), bR = frag(R1 + 24576, 32 * cb + l31, ks, h);
            tb = __builtin_amdgcn_mfma_f32_32x32x16_bf16(aB, bA, tb, 0, 0, 0); tk = __builtin_amdgcn_mfma_f32_32x32x16_bf16(aK, bA, tk, 0, 0, 0);
            qb = __builtin_amdgcn_mfma_f32_32x32x16_bf16(aB, bR, qb, 0, 0, 0); hy = __builtin_amdgcn_mfma_f32_32x32x16_bf16(aK, bR, hy, 0, 0, 0);
        }
        const int t = 32 * cb + l31;
#pragma unroll
        for (int r = 0; r < 16; ++r) { const int s = 32 * rb + crow(r, h); if (!(s < t)) { tb[r] = 0.f; tk[r] = 0.f; } if (!(s <= t)) { qb[r] = 0.f; hy[r] = 0.f; } }
        LBAR();
        float* TbT = (float*)R1;
#pragma unroll
        for (int g = 0; g < 4; ++g) { const int s0 = 32 * rb + 8 * g + 4 * h;
            *(f32x4*)(TbT + t * 68 + s0) = (f32x4){tb[4 * g], tb[4 * g + 1], tb[4 * g + 2], tb[4 * g + 3]};
#pragma unroll
            for (int q = 0; q < 4; ++q) XL[(64 + s0 + q) * 68 + t] = tk[4 * g + q];
            *(u32x2*)(R1 + 17408 + swz(t, 4 * rb + g) + 8 * h) = (u32x2){pk2(qb[4 * g], qb[4 * g + 1]), pk2(qb[4 * g + 2], qb[4 * g + 3])};
            *(f32x4*)(LgG + 4096 + ((wid * 4 + g) * 64 + lane) * 4) = (f32x4){hy[4 * g], hy[4 * g + 1], hy[4 * g + 2], hy[4 * g + 3]}; }
    }
    LBAR();
    {
        const int row = tid >> 1, hf = tid & 1; float* xr = XL + row * 68; const float* TbT = (const float*)R1;
        for (int bj = 0; bj < 4; ++bj) {
            float y[16];
#pragma unroll
            for (int q = 0; q < 4; ++q) { const f32x4 v = *(const f32x4*)(xr + 16 * bj + 4 * q); y[4 * q] = v.x; y[4 * q + 1] = v.y; y[4 * q + 2] = v.z; y[4 * q + 3] = v.w; }
            float acc[16];
#pragma unroll
            for (int t = 0; t < 16; ++t) acc[t] = 0.f;
            for (int bi = 0; bi < bj; ++bi) {
                float xp[8];
#pragma unroll
                for (int q = 0; q < 2; ++q) { const f32x4 v = *(const f32x4*)(xr + 16 * bi + 8 * hf + 4 * q); xp[4 * q] = v.x; xp[4 * q + 1] = v.y; xp[4 * q + 2] = v.z; xp[4 * q + 3] = v.w; }
                const float* tb0 = TbT + (16 * bj) * 68 + 16 * bi + 8 * hf;
#pragma unroll
                for (int t = 0; t < 16; ++t) { float a0 = 0.f, a1 = 0.f;
#pragma unroll
                    for (int u = 0; u < 8; u += 2) { a0 += xp[u] * tb0[t * 68 + u]; a1 += xp[u + 1] * tb0[t * 68 + u + 1]; }
                    acc[t] += a0 + a1; }
            }
#pragma unroll
            for (int t = 0; t < 16; ++t) y[t] += acc[t] + dpp_mov<0xB1>(acc[t]);
            const float* td = TbT + (16 * bj) * 68 + 16 * bj;
#pragma unroll
            for (int t = 1; t < 16; ++t) { float a0 = y[t];
#pragma unroll
                for (int u = 0; u < 16; ++u) if (u < t) a0 += y[u] * td[t * 68 + u];
                y[t] = a0; }
            if (hf == 0) {
#pragma unroll
                for (int q = 0; q < 4; ++q) *(f32x4*)(xr + 16 * bj + 4 * q) = (f32x4){y[4 * q], y[4 * q + 1], y[4 * q + 2], y[4 * q + 3]};
            }
            asm volatile("s_waitcnt lgkmcnt(0)" ::: "memory");
        }
    }
    LBAR();
    {
        const int row = tid >> 1, hf = tid & 1; const float* xr = XL + row * 68 + 32 * hf; char* dst = R1 + (row >> 6) * 8192;
#pragma unroll
        for (int c8 = 0; c8 < 4; ++c8) { const f32x4 a = *(const f32x4*)(xr + 8 * c8), bq = *(const f32x4*)(xr + 8 * c8 + 4);
            *(u32x4*)(dst + swz(row & 63, 4 * hf + c8)) = (u32x4){pk2(a.x, a.y), pk2(a.z, a.w), pk2(bq.x, bq.y), pk2(bq.z, bq.w)}; }
    }
    __syncthreads();
    {
        const int t = tid >> 2, jr = (tid & 3) * 16; char* BbT = lds + 32768; char* VT = lds + 40960;
        f32x4 lgA[4], lcA[4], bbA[4], vvA[4];
#pragma unroll
        for (int e4 = 0; e4 < 4; ++e4) { const int j = jr + 4 * e4;
            lgA[e4] = *(const f32x4*)(LgG + t * 64 + j); lcA[e4] = *(const f32x4*)(LgG + 63 * 64 + j); bbA[e4] = ld4bf(BB + (size_t)t * 512 + j); vvA[e4] = zs4(ZRb + (size_t)t * RWKV_COLS, 1024 + col0 + j, p.rwkv_mu); }
#pragma unroll
        for (int e4 = 0; e4 < 4; ++e4) {
            const int j = jr + 4 * e4;
            const f32x4 lg = lgA[e4], lc = lcA[e4], bb = bbA[e4], vv = vvA[e4];
#pragma unroll
            for (int q = 0; q < 4; ++q) { const int o2 = swz(j + q, t >> 3) + (t & 7) * 2; *(bf16_t*)(BbT + o2) = (bf16_t)f2bf(bb[q] * __expf(lc[q] - lg[q])); *(bf16_t*)(VT + o2) = (bf16_t)f2bf(vv[q]); }
        }
    }
    LBAR();
    {
        f32x16 gy, gs, hs, hy;
#pragma unroll
        for (int g = 0; g < 4; ++g) { const f32x4 q4 = *(const f32x4*)(LgG + 4096 + ((wid * 4 + g) * 64 + lane) * 4); hy[4 * g] = q4.x; hy[4 * g + 1] = q4.y; hy[4 * g + 2] = q4.z; hy[4 * g + 3] = q4.w; }
        {
            const int tq = 32 * cb + l31;
            const float lcq = LgG[63 * 64 + tq]; const float elc = __expf(lcq);
#pragma unroll
            for (int g = 0; g < 4; ++g) { const int j0 = 32 * rb + 8 * g + 4 * h; const f32x4 r4 = zs4(ZRb + (size_t)tq * RWKV_COLS, col0 + j0, p.rwkv_mu), l4 = *(const f32x4*)(LgG + tq * 64 + j0);
#pragma unroll
                for (int q = 0; q < 4; ++q) { gy[4 * g + q] = r4[q] * __expf(l4[q]); gs[4 * g + q] = (j0 + q == tq) ? elc : 0.f;
                    const int s = j0 + q; hs[4 * g + q] = ld1bf(K2 + (size_t)s * 512 + tq) * __expf(lcq - LgG[s * 64 + tq]); } }
        }
#pragma unroll
        for (int ks = 0; ks < 4; ++ks) {
            const bf16x8 aA = frag(R1, 32 * rb + l31, ks, h), aW = frag(R1 + 8192, 32 * rb + l31, ks, h), bQ = frag(R1 + 17408, 32 * cb + l31, ks, h), bB = frag(lds + 32768, 32 * cb + l31, ks, h);
            gy = __builtin_amdgcn_mfma_f32_32x32x16_bf16(aA, bQ, gy, 0, 0, 0); gs = __builtin_amdgcn_mfma_f32_32x32x16_bf16(aA, bB, gs, 0, 0, 0);
            hy = __builtin_amdgcn_mfma_f32_32x32x16_bf16(aW, bQ, hy, 0, 0, 0); hs = __builtin_amdgcn_mfma_f32_32x32x16_bf16(aW, bB, hs, 0, 0, 0);
        }
        const int cc = 32 * cb + l31;
#pragma unroll
        for (int g = 0; g < 4; ++g) { const int r0 = 32 * rb + 8 * g + 4 * h;
            *(u32x2*)(chk + swz(cc, 4 * rb + g) + 8 * h) = (u32x2){pk2(gy[4 * g], gy[4 * g + 1]), pk2(gy[4 * g + 2], gy[4 * g + 3])};
            *(u32x2*)(chk + 8192 + swz(cc, 4 * rb + g) + 8 * h) = (u32x2){pk2(gs[4 * g], gs[4 * g + 1]), pk2(gs[4 * g + 2], gs[4 * g + 3])};
            *(u32x2*)(lds + 49152 + swz(cc, 4 * rb + g) + 8 * h) = (u32x2){pk2(hs[4 * g], hs[4 * g + 1]), pk2(hs[4 * g + 2], hs[4 * g + 3])};
            *(u32x2*)(lds + 57344 + swz(cc, 4 * rb + g) + 8 * h) = (u32x2){pk2(hy[4 * g], hy[4 * g + 1]), pk2(hy[4 * g + 2], hy[4 * g + 3])}; }
    }
    LBAR();
    {
        f32x16 sl, yl;
#pragma unroll
        for (int r = 0; r < 16; ++r) { sl[r] = 0.f; yl[r] = 0.f; }
#pragma unroll
        for (int ks = 0; ks < 4; ++ks) {
            const bf16x8 aS = frag(lds + 49152, 32 * rb + l31, ks, h), aY = frag(lds + 57344, 32 * rb + l31, ks, h), bV = frag(lds + 40960, 32 * cb + l31, ks, h);
            sl = __builtin_amdgcn_mfma_f32_32x32x16_bf16(aS, bV, sl, 0, 0, 0); yl = __builtin_amdgcn_mfma_f32_32x32x16_bf16(aY, bV, yl, 0, 0, 0);
        }
#pragma unroll
        for (int q = 0; q < 2; ++q) {
            *(u32x4*)(chk + 16384 + wid * 2048 + lane * 32 + q * 16) = (u32x4){pk2(sl[8 * q], sl[8 * q + 1]), pk2(sl[8 * q + 2], sl[8 * q + 3]), pk2(sl[8 * q + 4], sl[8 * q + 5]), pk2(sl[8 * q + 6], sl[8 * q + 7])};
            *(u32x4*)(chk + 24576 + wid * 2048 + lane * 32 + q * 16) = (u32x4){pk2(yl[8 * q], yl[8 * q + 1]), pk2(yl[8 * q + 2], yl[8 * q + 3]), pk2(yl[8 * q + 4], yl[8 * q + 5]), pk2(yl[8 * q + 6], yl[8 * q + 7])}; }
    }
    LBAR();
}
DEVI void cumsum_job(const P& p, int bh, char* lds) {
    const int tid = otid(), lane = tid & 63, wid = tid >> 6, b = bh >> 3, h = bh & 7; float* part = (float*)lds;
    const float* LF = WSP(float, WS_LF) + (size_t)b * LP * 8 + h; float* CS = WSP(float, WS_CS) + (size_t)b * LP * 8 + h;
    const int r0 = tid * 33; float v[33]; float s = 0.f;
#pragma unroll
    for (int i = 0; i < 33; ++i) v[i] = (r0 + i < LP) ? LF[(size_t)(r0 + i) * 8] : 0.f;
#pragma unroll
    for (int i = 0; i < 33; ++i) s += v[i];
    part[tid] = s; LBAR();
    if (wid == 0) { const f32x4 a = *(const f32x4*)(part + 4 * lane); const float tot = (a.x + a.y) + (a.z + a.w); float inc = tot;
#pragma unroll
        for (int o = 1; o < 64; o <<= 1) { const float u = __shfl_up(inc, o); if (lane >= o) inc += u; }
        const float ex = inc - tot; *(f32x4*)(part + 4 * lane) = (f32x4){ex, ex + a.x, ex + a.x + a.y, ex + a.x + a.y + a.z}; }
    LBAR();
    float pre = part[tid];
#pragma unroll
    for (int i = 0; i < 33; ++i) { pre += v[i]; if (r0 + i < LP) CS[(size_t)(r0 + i) * 8] = pre * LOG2E; }
    LBAR();
}
DEVI void phase2c(const P& p, int bid, int nb, char* lds) {
    if (bid < 16) cumsum_job(p, bid, lds);
    for (int q = bid; q < 16 * (NCHUNK - 1); q += nb) chunk_job(p, (q >> 7) * NCHUNK + 1 + (q & 127), lds);
}

DEVI void scanB_job(const P& p, int bh, char* lds) {
    typedef __attribute__((address_space(3))) unsigned lds_u32;
    const int tid = otid(), lane = tid & 63, wid = __builtin_amdgcn_readfirstlane(tid >> 6), l31 = lane & 31, h = lane >> 5, rb = wid >> 1, cb = wid & 1;
    const int b = bh >> 3, hh = bh & 7; const int col0 = hh * 64;
    float* Yo = WSP(float, WS_Y) + ((size_t)b * LP + 64) * 512 + col0 + 32 * cb + l31;
    const char* chk = (const char*)p.ws + WS_CHK + (size_t)bh * NCHUNK * CHUNK_BYTES + wid * 8192 + lane * 16;
    f32x16 accS, accY;
#pragma unroll
    for (int r = 0; r < 16; ++r) { accS[r] = 0.f; accY[r] = 0.f; }
    auto dma = [&](int c, int slot) __attribute__((always_inline)) {
        const char* g = chk + (size_t)c * CHUNK_BYTES; char* d = lds + 8192 + slot * 32768 + wid * 8192;
#pragma unroll
        for (int i = 0; i < 8; ++i) __builtin_amdgcn_global_load_lds((const unsigned*)(g + i * 1024), (lds_u32*)(d + i * 1024), 16, 0, 0);
    };
    dma(0, 0); dma(1, 1);
    for (int c = 0; c < NCHUNK; ++c) {
        const int slot = c & 1;
        if (c + 1 < NCHUNK) asm volatile("s_waitcnt vmcnt(8)" ::: "memory"); else asm volatile("s_waitcnt vmcnt(0)" ::: "memory");
        if (c > 0) {
#pragma unroll
            for (int r = 0; r < 16; ++r) Yo[(size_t)(64 * (c - 1) + 32 * rb + crow(r, h)) * 512] = accY[r];
            asm volatile("" ::: "memory");
        }
#pragma unroll
        for (int g = 0; g < 4; ++g) *(u32x2*)(lds + swz(32 * cb + l31, 4 * rb + g) + 8 * h) = (u32x2){pk2(accS[4 * g], accS[4 * g + 1]), pk2(accS[4 * g + 2], accS[4 * g + 3])};
        asm volatile("s_waitcnt lgkmcnt(0)" ::: "memory"); __builtin_amdgcn_s_barrier(); asm volatile("" ::: "memory");
        const char* sl = lds + 8192 + slot * 32768;
        bf16x8 sb[4], gsf[4], gyf[4];
#pragma unroll
        for (int ks = 0; ks < 4; ++ks) { sb[ks] = frag(lds, 32 * cb + l31, ks, h); gyf[ks] = frag(sl, 32 * rb + l31, ks, h); gsf[ks] = frag(sl + 8192, 32 * rb + l31, ks, h); }
#pragma unroll
        for (int q = 0; q < 2; ++q) { const u32x4 ws = *(const u32x4*)(sl + 16384 + wid * 2048 + lane * 32 + q * 16), wy = *(const u32x4*)(sl + 24576 + wid * 2048 + lane * 32 + q * 16);
#pragma unroll
            for (int j = 0; j < 4; ++j) { accS[8 * q + 2 * j] = __uint_as_float(ws[j] << 16); accS[8 * q + 2 * j + 1] = __uint_as_float(ws[j] & 0xffff0000u);
                accY[8 * q + 2 * j] = __uint_as_float(wy[j] << 16); accY[8 * q + 2 * j + 1] = __uint_as_float(wy[j] & 0xffff0000u); } }
#pragma unroll
        for (int ks = 0; ks < 4; ++ks) { accS = __builtin_amdgcn_mfma_f32_32x32x16_bf16(gsf[ks], sb[ks], accS, 0, 0, 0); accY = __builtin_amdgcn_mfma_f32_32x32x16_bf16(gyf[ks], sb[ks], accY, 0, 0, 0); }
        asm volatile("s_waitcnt lgkmcnt(0)" ::: "memory"); __builtin_amdgcn_s_barrier(); asm volatile("" ::: "memory");
        if (c + 2 < NCHUNK) dma(c + 2, slot);
    }
#pragma unroll
    for (int r = 0; r < 16; ++r) Yo[(size_t)(64 * (NCHUNK - 1) + 32 * rb + crow(r, h)) * 512] = accY[r];
}

DEVI void phase4a(const P& p, int bid, int nb, char*) {
    const int tid = otid(), lane = tid & 63, wid = tid >> 6;
    for (int row = bid * 4 + wid; row < NP; row += nb * 4) {
        const bool pad = (row % LP) < PADL + NMETA;
#pragma unroll
        for (int j = 0; j < 2; ++j) {
            const int c = lane * 4 + 256 * j; const size_t o = (size_t)row * 512 + c;
            u32x2 outv = (u32x2){0u, 0u};
            if (!pad) {
                const bf16_t* zrow = WSP(bf16_t, WS_ZR) + (size_t)row * RWKV_COLS;
                const f32x4 y = *(const f32x4*)(WSP(float, WS_Y) + o), r = zs4(zrow, c, p.rwkv_mu), k2 = ld4bf(WSP(bf16_t, WS_RK2) + o), v = zs4(zrow, 1024 + c, p.rwkv_mu), g = ld4bf(WSP(bf16_t, WS_G) + o);
                const f32x4 rk = *(const f32x4*)(p.r_k + c), lg = *(const f32x4*)(p.lnx_g + c), lb = *(const f32x4*)(p.lnx_b + c);
                const float mu = sum16((y.x + y.y) + (y.z + y.w)) * (1.f / 64.f);
                const f32x4 dy = y - mu;
                const float var = sum16((dy.x * dy.x + dy.y * dy.y) + (dy.z * dy.z + dy.w * dy.w)) * (1.f / 64.f);
                const float rs = rsqrtf(var + GN_EPS);
                const float bonus = sum16((r.x * k2.x * rk.x + r.y * k2.y * rk.y) + (r.z * k2.z * rk.z + r.w * k2.w * rk.w));
                const f32x4 ov = (dy * rs * lg + lb + bonus * v) * g;
                outv = (u32x2){pk2(ov.x, ov.y), pk2(ov.z, ov.w)};
            }
            *(u32x2*)(WSP(bf16_t, WS_MIX) + (size_t)row * 1024 + 512 + c) = outv;
        }
    }
}

struct EpiOutProj {
    const P& p; int tm, tn;
    DEVI void operator()(f32x4 (&acc)[4][4], int wm, int wn, int l15, int lq) const {
#pragma unroll
        for (int mt = 0; mt < 4; ++mt) { const size_t row = (size_t)tm * 128 + wm * 64 + mt * 16 + l15;
#pragma unroll
            for (int nt = 0; nt < 4; ++nt) { const size_t o = row * 1024 + tn * 128 + wn * 64 + nt * 16 + 4 * lq;
                const u32x2 w = *(const u32x2*)(WSP(bf16_t, WS_H0B) + o);
                const f32x4 h0 = (f32x4){__uint_as_float(w.x << 16), __uint_as_float(w.x & 0xffff0000u), __uint_as_float(w.y << 16), __uint_as_float(w.y & 0xffff0000u)};
                *(f32x4*)(WSP(float, WS_PRE1) + o) = h0 * ALPHA + acc[mt][nt]; } }
    }
};
DEVI void phase4b(const P& p, const Sched& sc, char* lds) {
    const int tid = otid(), srow = 16 * (tid >> 6) + ((tid & 63) >> 2);
    for_xcd_items(sc, [&](int x, int rank, int nloc) __attribute__((always_inline)) {
        const int r0 = 16 * x;
        for (int i = rank; i < 16 * 8; i += nloc) {
            const int tr = r0 + (i >> 3), tn = i & 7, tm = (tr >> 6) * NQB + 1 + (tr & 63);
            const bf16_t *ap[4], *bp[2];
#pragma unroll
            for (int q = 0; q < 2; ++q) { ap[q] = WSP(bf16_t, WS_MIX) + (size_t)(tm * 128 + srow + 64 * q) * 1024; bp[q] = WSP(bf16_t, WS_WOUTT) + (size_t)(tn * 128 + srow + 64 * q) * 1024; }
            ap[2] = ap[3] = ap[0];
            gemm256<false, 4>(ap, bp, 1024, lds, EpiOutProj{p, tm, tn});
        }
    });
}

DEVI void phase4c(const P& p, int bid, int nb, char* lds) {
    const int tid = otid(), lane = tid & 63, wid = tid >> 6;
    const int e = tid & 31, ks = tid >> 5;
    float* hrow = (float*)lds;
    float* part = (float*)(lds + 16384);
    unsigned* cnt = WSP(unsigned, WS_CTL) + CW_CNT;
    float wreg[128];
#pragma unroll
    for (int k = 0; k < 128; ++k) wreg[k] = p.w_router[(size_t)(ks * 128 + k) * 32 + e];
    const float br = p.b_router[e];
    for (int base = bid * 4; base < NP; base += nb * 4) {
        const int row = base + wid;
        const bool pad = (row % LP) < PADL + NMETA;
        {
            u32x2* hb = (u32x2*)(WSP(bf16_t, WS_H1B) + (size_t)row * 1024) + lane;
            if (pad) {
#pragma unroll
                for (int j = 0; j < 4; ++j) { hb[64 * j] = (u32x2){0u, 0u}; *(f32x4*)(hrow + wid * 1024 + lane * 4 + 256 * j) = (f32x4){0.f, 0.f, 0.f, 0.f}; }
            } else {
                const f32x4* src = (const f32x4*)(WSP(float, WS_PRE1) + (size_t)row * 1024) + lane;
                f32x4 v[4]; float s = 0.f;
#pragma unroll
                for (int j = 0; j < 4; ++j) { v[j] = src[64 * j]; s += (v[j].x + v[j].y) + (v[j].z + v[j].w); }
                const float mean = wave_sum(s) * (1.f / 1024.f); float s2 = 0.f;
#pragma unroll
                for (int j = 0; j < 4; ++j) { v[j] = v[j] - mean; s2 += (v[j].x * v[j].x + v[j].y * v[j].y) + (v[j].z * v[j].z + v[j].w * v[j].w); }
                const float rstd = rsqrtf(wave_sum(s2) * (1.f / 1024.f) + LN_EPS);
                if (lane == 0) { WSP(float, WS_ST1)[(size_t)row * 2] = mean; WSP(float, WS_ST1)[(size_t)row * 2 + 1] = rstd; }
#pragma unroll
                for (int j = 0; j < 4; ++j) {
                    const f32x4 g = ((const f32x4*)p.ln1_g)[lane + 64 * j], bb = ((const f32x4*)p.ln1_b)[lane + 64 * j];
                    const f32x4 o = v[j] * rstd * g + bb;
                    hb[64 * j] = (u32x2){pk2(o.x, o.y), pk2(o.z, o.w)};
                    *(f32x4*)(hrow + wid * 1024 + lane * 4 + 256 * j) = o;
                }
            }
        }
        LBAR();
        {
            float a0 = 0.f, a1 = 0.f, a2 = 0.f, a3 = 0.f;
            const float* h0 = hrow + ks * 128;
#pragma unroll
            for (int k = 0; k < 128; k += 4) {
                const f32x4 x0 = *(const f32x4*)(h0 + k), x1 = *(const f32x4*)(h0 + 1024 + k), x2 = *(const f32x4*)(h0 + 2048 + k), x3 = *(const f32x4*)(h0 + 3072 + k);
#pragma unroll
                for (int q = 0; q < 4; ++q) { a0 += wreg[k + q] * x0[q]; a1 += wreg[k + q] * x1[q]; a2 += wreg[k + q] * x2[q]; a3 += wreg[k + q] * x3[q]; }
            }
            part[(0 * 8 + ks) * 32 + e] = a0; part[(1 * 8 + ks) * 32 + e] = a1; part[(2 * 8 + ks) * 32 + e] = a2; part[(3 * 8 + ks) * 32 + e] = a3;
        }
        LBAR();
        {
            const int ee = lane & 31;
            float logit = br;
#pragma unroll
            for (int q = 0; q < 8; ++q) logit += part[(wid * 8 + q) * 32 + ee];
            float cur = logit; float tv[4]; int ti[4];
#pragma unroll
            for (int k = 0; k < 4; ++k) {
                float bv = cur; int bi = ee;
#pragma unroll
                for (int o = 16; o > 0; o >>= 1) { const float ov = __shfl_xor(bv, o); const int oi = __shfl_xor(bi, o); if (ov > bv || (ov == bv && oi < bi)) { bv = ov; bi = oi; } }
                tv[k] = bv; ti[k] = bi; if (ee == bi) cur = -INFINITY;
            }
            const float e1 = __expf(tv[1] - tv[0]), e2 = __expf(tv[2] - tv[0]), e3 = __expf(tv[3] - tv[0]); const float inv = 1.f / (1.f + e1 + e2 + e3);
            if (lane < 4 && !pad) {
                const int ex = lane == 0 ? ti[0] : lane == 1 ? ti[1] : lane == 2 ? ti[2] : ti[3];
                const float gt = (lane == 0 ? 1.f : lane == 1 ? e1 : lane == 2 ? e2 : e3) * inv;
                const unsigned rank = atomicAdd(cnt + ex, 1u);
                WSP(int, WS_LTOK)[(size_t)ex * CAP + rank] = row; WSP(float, WS_LGATE)[(size_t)ex * CAP + rank] = gt;
                WSP(int, WS_RTE)[(size_t)row * 4 + lane] = ex; WSP(int, WS_RTR)[(size_t)row * 4 + lane] = (int)rank;
            }
        }
    }
}

struct MoeTab { int* rb; int* cn; int* nf; int* ng; };
DEVI MoeTab moe_prefix(const P& p, char* lds) {
    MoeTab t; t.rb = (int*)(lds + LX); t.cn = t.rb + 33; t.nf = t.cn + 32; t.ng = t.nf + 32;
    if (threadIdx.x == 0) { const unsigned* cnt = WSP(unsigned, WS_CTL) + CW_CNT; int acc = 0;
        for (int e = 0; e < NEXP; ++e) { const int c = (int)cnt[e]; int f = c >> 8, g = 0; const int rem = c & 255; if (rem > 128) ++f; else g = (rem + 63) >> 6;
            t.cn[e] = c; t.nf[e] = f; t.ng[e] = g; t.rb[e] = acc; acc += f * 256 + g * 64; }
        t.rb[NEXP] = acc; }
    __syncthreads();
    return t;
}

template <int MT> struct EpiGU {
    const P& p; int e, row0, tn;
    DEVI void operator()(f32x4 (&acc)[MT][4], int wm, int wn, int l15, int lq) const {
        const float* bg = p.b_gu + (size_t)e * 2048;
#pragma unroll
        for (int mt = 0; mt < MT; ++mt) { const size_t row = (size_t)row0 + wm * (16 * MT) + mt * 16 + l15;
#pragma unroll
            for (int np = 0; np < 2; ++np) { const int jc = tn * 64 + wn * 32 + np * 16 + 4 * lq;
                const f32x4 bgt = *(const f32x4*)(bg + jc), bup = *(const f32x4*)(bg + 1024 + jc); float ov[4];
#pragma unroll
                for (int r = 0; r < 4; ++r) { const float gate = fminf(acc[mt][2 * np][r] + bgt[r], 7.f); const float up = fminf(fmaxf(acc[mt][2 * np + 1][r] + bup[r], -7.f), 7.f);
                    ov[r] = (up + 1.f) * (gate * sigmoidf(gate * 1.702f)); }
                *(u32x2*)(WSP(bf16_t, WS_ACT) + row * 1024 + jc) = (u32x2){pk2(ov[0], ov[1]), pk2(ov[2], ov[3])}; } }
    }
};
template <int MT> struct EpiDown {
    const P& p; int e, row0, idx0, cnt_e, tn;
    DEVI void operator()(f32x4 (&acc)[MT][4], int wm, int wn, int l15, int lq) const {
        const float* bd = p.b_down + (size_t)e * 1024;
#pragma unroll
        for (int mt = 0; mt < MT; ++mt) { const int ml = wm * (16 * MT) + mt * 16 + l15; const int idx = idx0 + ml; const float gt = idx < cnt_e ? WSP(float, WS_LGATE)[(size_t)e * CAP + idx] : 0.f;
            const size_t row = (size_t)row0 + ml;
#pragma unroll
            for (int nt = 0; nt < 4; ++nt) { const int c = tn * 128 + wn * 64 + nt * 16 + 4 * lq; const f32x4 o = (acc[mt][nt] + *(const f32x4*)(bd + c)) * gt; *(u32x2*)(WSP(bf16_t, WS_YB) + row * 1024 + c) = (u32x2){pk2(o.x, o.y), pk2(o.z, o.w)}; } }
    }
};
template <int NT, class FullFn, class SmallFn>
DEVI void moe_items(const MoeTab& T, int x, int rank, int nloc, FullFn&& full, SmallFn&& small) {
    const int f0 = T.nf[x], f1 = f0 + T.nf[x + 8], f2 = f1 + T.nf[x + 16], f3 = f2 + T.nf[x + 24];
    const int g0 = T.ng[x], g1 = g0 + T.ng[x + 8], g2 = g1 + T.ng[x + 16], g3 = g2 + T.ng[x + 24];
    for (int i = rank; i < (f3 + g3) * NT; i += nloc) {
        if (i < f3 * NT) { const int rbk = i / NT, tn = i % NT; const int j = rbk < f0 ? 0 : rbk < f1 ? 1 : rbk < f2 ? 2 : 3; const int e = x + 8 * j, mb = rbk - (j == 0 ? 0 : j == 1 ? f0 : j == 2 ? f1 : f2);
            full(e, mb * 256, tn); }
        else { const int k = i - f3 * NT, gk = k / NT, tn = k % NT; const int j = gk < g0 ? 0 : gk < g1 ? 1 : gk < g2 ? 2 : 3; const int e = x + 8 * j, gi = gk - (j == 0 ? 0 : j == 1 ? g0 : j == 2 ? g1 : g2);
            small(e, T.nf[e] * 256 + gi * 64, tn); }
    }
}
DEVI void phase5(const P& p, const Sched& sc, char* lds) {
    const MoeTab T = moe_prefix(p, lds);
    const int tid = otid(), lane = tid & 63, wid = tid >> 6, srow = 16 * wid + (lane >> 2);
    for_xcd_items(sc, [&](int x, int rank, int nloc) __attribute__((always_inline)) {
        moe_items<16>(T, x, rank, nloc,
            [&](int e, int idx0, int tn) __attribute__((always_inline)) {
                const bf16_t *ap[4], *bp[2];
#pragma unroll
                for (int q = 0; q < 4; ++q) { const int idx = idx0 + srow + 64 * q; const int tok = idx < T.cn[e] ? WSP(int, WS_LTOK)[(size_t)e * CAP + idx] : 0; ap[q] = WSP(bf16_t, WS_H1B) + (size_t)tok * 1024; }
#pragma unroll
                for (int q = 0; q < 2; ++q) bp[q] = WSP(bf16_t, WS_WGUT) + ((size_t)e * 2048 + tn * 128 + srow + 64 * q) * 1024;
                gemm256<false, 8>(ap, bp, 1024, lds, EpiGU<8>{p, e, T.rb[e] + idx0, tn}); },
            [&](int e, int idx0, int tn) __attribute__((always_inline)) {
                const bf16_t *ap[4], *bp[2];
                { const int idx = idx0 + srow; const int tok = idx < T.cn[e] ? WSP(int, WS_LTOK)[(size_t)e * CAP + idx] : 0; ap[0] = WSP(bf16_t, WS_H1B) + (size_t)tok * 1024; ap[1] = ap[2] = ap[3] = ap[0]; }
#pragma unroll
                for (int q = 0; q < 2; ++q) bp[q] = WSP(bf16_t, WS_WGUT) + ((size_t)e * 2048 + tn * 128 + srow + 64 * q) * 1024;
                gemm256<false, 2>(ap, bp, 1024, lds, EpiGU<2>{p, e, T.rb[e] + idx0, tn}); });
    });
}
DEVI void phase6(const P& p, const Sched& sc, char* lds) {
    const MoeTab T = moe_prefix(p, lds);
    const int tid = otid(), lane = tid & 63, wid = tid >> 6, srow = 16 * wid + (lane >> 2);
    for_xcd_items(sc, [&](int x, int rank, int nloc) __attribute__((always_inline)) {
        moe_items<8>(T, x, rank, nloc,
            [&](int e, int idx0, int tn) __attribute__((always_inline)) {
                const bf16_t *ap[4], *bp[2];
#pragma unroll
                for (int q = 0; q < 4; ++q) ap[q] = WSP(bf16_t, WS_ACT) + ((size_t)T.rb[e] + idx0 + srow + 64 * q) * 1024;
#pragma unroll
                for (int q = 0; q < 2; ++q) bp[q] = WSP(bf16_t, WS_WDT) + ((size_t)e * 1024 + tn * 128 + srow + 64 * q) * 1024;
                gemm256<false, 8>(ap, bp, 1024, lds, EpiDown<8>{p, e, T.rb[e] + idx0, idx0, T.cn[e], tn}); },
            [&](int e, int idx0, int tn) __attribute__((always_inline)) {
                const bf16_t *ap[4], *bp[2];
                ap[0] = WSP(bf16_t, WS_ACT) + ((size_t)T.rb[e] + idx0 + srow) * 1024; ap[1] = ap[2] = ap[3] = ap[0];
#pragma unroll
                for (int q = 0; q < 2; ++q) bp[q] = WSP(bf16_t, WS_WDT) + ((size_t)e * 1024 + tn * 128 + srow + 64 * q) * 1024;
                gemm256<false, 2>(ap, bp, 1024, lds, EpiDown<2>{p, e, T.rb[e] + idx0, idx0, T.cn[e], tn}); });
    });
}
DEVI void phase7(const P& p, int bid, int nb, char* lds) {
    const MoeTab T = moe_prefix(p, lds);
    const int tid = otid(), lane = tid & 63, wid = tid >> 6;
    for (int row = bid * 4 + wid; row < NP; row += nb * 4) {
        const int b = row / LP, pp = row % LP; if (pp < PADL + NMETA) continue;
        const int t = pp - PADL - NMETA;
        const f32x4* pre = (const f32x4*)(WSP(float, WS_PRE1) + (size_t)row * 1024) + lane;
        const float mean1 = WSP(float, WS_ST1)[(size_t)row * 2], rstd1 = WSP(float, WS_ST1)[(size_t)row * 2 + 1];
        f32x4 v[4];
#pragma unroll
        for (int j = 0; j < 4; ++j) v[j] = ((pre[64 * j] - mean1) * rstd1 * ((const f32x4*)p.ln1_g)[lane + 64 * j] + ((const f32x4*)p.ln1_b)[lane + 64 * j]) * ALPHA;
#pragma unroll
        for (int k = 0; k < 4; ++k) { const int e = WSP(int, WS_RTE)[(size_t)row * 4 + k], rk = WSP(int, WS_RTR)[(size_t)row * 4 + k];
            const u32x2* yb = (const u32x2*)(WSP(bf16_t, WS_YB) + ((size_t)T.rb[e] + rk) * 1024) + lane;
#pragma unroll
            for (int j = 0; j < 4; ++j) { const u32x2 w = yb[64 * j]; v[j] += (f32x4){__uint_as_float(w.x << 16), __uint_as_float(w.x & 0xffff0000u), __uint_as_float(w.y << 16), __uint_as_float(w.y & 0xffff0000u)}; } }
        float s = 0.f;
#pragma unroll
        for (int j = 0; j < 4; ++j) s += (v[j].x + v[j].y) + (v[j].z + v[j].w);
        const float mean = wave_sum(s) * (1.f / 1024.f); float s2 = 0.f;
#pragma unroll
        for (int j = 0; j < 4; ++j) { v[j] = v[j] - mean; s2 += (v[j].x * v[j].x + v[j].y * v[j].y) + (v[j].z * v[j].z + v[j].w * v[j].w); }
        const float rstd = rsqrtf(wave_sum(s2) * (1.f / 1024.f) + LN_EPS);
        f32x4* o = (f32x4*)(p.out + ((size_t)b * SEQ + t) * 1024) + lane;
#pragma unroll
        for (int j = 0; j < 4; ++j) o[64 * j] = v[j] * rstd * ((const f32x4*)p.ln2_g)[lane + 64 * j] + ((const f32x4*)p.ln2_b)[lane + 64 * j];
    }
}

#define LAS __attribute__((address_space(3)))
#define XB_TMO      128
#define XB_XCNT(j)  (256  + 64 * (j))
#define XB_XSUB(j)  (1280 + 64 * (j))
#define XB_XGEN(j)  (2304 + 64 * (j))
#define XB_TOP      3328
#define XB_TOPGEN   3392
#define XCD_BAR_WORDS 3456
#define XB_SPIN_CAP (1u << 18)
__device__ __forceinline__ unsigned xb_ld(unsigned* p)              { return __hip_atomic_load(p, __ATOMIC_RELAXED, __HIP_MEMORY_SCOPE_AGENT); }
__device__ __forceinline__ unsigned xb_add(unsigned* p, unsigned v) { return __hip_atomic_fetch_add(p, v, __ATOMIC_RELAXED, __HIP_MEMORY_SCOPE_AGENT); }
__device__ __forceinline__ unsigned xb_xcc_id() { return (unsigned)__builtin_amdgcn_s_getreg((3 << 11) | 20) & 0xFu; }
#define XB_SPIN(cond, bar) do { unsigned _sp = 0; while (cond) { __builtin_amdgcn_s_sleep(1); \
    if ((++_sp & 255u) == 0u) { if (xb_ld(&(bar)[XB_TMO])) break; if (_sp > XB_SPIN_CAP) { atomicAdd(&(bar)[XB_TMO], 1u); break; } } } } while (0)
struct XcdBarrier { unsigned* bar; unsigned x; volatile LAS unsigned* st; };
__device__ __forceinline__ XcdBarrier xcd_barrier_post(unsigned* bar, volatile LAS unsigned* st) {
    XcdBarrier b; b.bar = bar; b.x = xb_xcc_id(); b.st = st;
    if (threadIdx.x == 0) (void)xb_add(&bar[XB_XCNT(b.x)], 1u);
    return b;
}
__device__ __forceinline__ void xcd_barrier_complete(unsigned* bar, unsigned x, unsigned& nloc, unsigned& nx) {
    const unsigned G = gridDim.x * gridDim.y * gridDim.z;
    unsigned sum, cnt, mine, sp = 0u;
    for (;;) {
        sum = 0u; cnt = 0u; mine = 0u;
#pragma unroll
        for (unsigned j = 0; j < 16; ++j) { const unsigned c = xb_ld(&bar[XB_XCNT(j)]); sum += c; cnt += (c > 0u) ? 1u : 0u; mine = (j == x) ? c : mine; }
        if (sum == G) break;
        __builtin_amdgcn_s_sleep(1);
        if ((++sp & 255u) == 0u) { if (xb_ld(&bar[XB_TMO])) break; if (sp > XB_SPIN_CAP) { atomicAdd(&bar[XB_TMO], 1u); break; } }
    }
    nloc = mine > 0u ? mine : 1u; nx = cnt > 0u ? cnt : 1u;
}
__device__ __forceinline__ void xcd_barrier(const XcdBarrier& b) {
    asm volatile("s_waitcnt vmcnt(0)" ::: "memory");
    __syncthreads();
    if (threadIdx.x == 0) {
        unsigned* bar = b.bar;
        __builtin_amdgcn_s_waitcnt(0);
        unsigned nloc = b.st[0], nx = b.st[1];
        if (nloc == 0u) { xcd_barrier_complete(bar, b.x, nloc, nx); b.st[0] = nloc; b.st[1] = nx; }
        const unsigned old = xb_add(&bar[XB_XSUB(b.x)], 1u);
        const unsigned gen = old / nloc;
        if (old + 1u == (gen + 1u) * nloc) {
            __builtin_amdgcn_fence(__ATOMIC_RELEASE, "agent");
            asm volatile("s_waitcnt vmcnt(0)" ::: "memory");
            const unsigned og = xb_add(&bar[XB_TOP], 1u);
            const unsigned tg = og / nx;
            if (og + 1u == (tg + 1u) * nx) xb_add(&bar[XB_TOPGEN], 1u);
            else XB_SPIN(xb_ld(&bar[XB_TOPGEN]) == tg, bar);
            __builtin_amdgcn_fence(__ATOMIC_ACQUIRE, "agent");
            xb_add(&bar[XB_XGEN(b.x)], 1u);
            asm volatile("s_waitcnt vmcnt(0)" ::: "memory");
        } else {
            XB_SPIN(xb_ld(&bar[XB_XGEN(b.x)]) == gen, bar);
            __builtin_amdgcn_fence(__ATOMIC_ACQUIRE, "agent");
            asm volatile("s_waitcnt vmcnt(0)" ::: "memory");
        }
    }
    __syncthreads();
}

namespace cg = cooperative_groups;
constexpr int CW_BAR = 4096;
constexpr size_t CTL_ZERO_BYTES = 65536;
constexpr int N_SCAN_JOBS = 16, N_ATT_ITEMS = 16 * (NQB - 1);
DEVI void phase3(const P& p, char* lds, int qoff) {
    int* s_item = (int*)(lds + LX + 992);
    unsigned* q = WSP(unsigned, WS_CTL) + CW_QATT + qoff;
    for (;;) {
        if (threadIdx.x == 0) *s_item = (int)atomicAdd(q, 1u);
        __syncthreads();
        const int it = __builtin_amdgcn_readfirstlane(*s_item);
        __syncthreads();
        if (it >= N_SCAN_JOBS + N_ATT_ITEMS + N_CONV_ITEMS) break;
        if (it < N_SCAN_JOBS) {
            chunk_job(p, it * NCHUNK, lds);
            __threadfence(); __syncthreads();
            __builtin_amdgcn_s_setprio(3); scanB_job(p, it, lds); __builtin_amdgcn_s_setprio(0); continue; }
        const int r = it - N_SCAN_JOBS; int a;
        if (r < 3 * N_CONV_ITEMS) { if (r % 3 == 2) { conv_moe_item(p, r / 3, lds); continue; } a = 2 * (r / 3) + (r % 3); }
        else a = r - N_CONV_ITEMS;
        { const int qb = NQB - 1 - a / 16, bh = a % 16; attn_item(p, bh >> 3, bh & 7, qb, lds); }
    }
}
__global__ void __launch_bounds__(256, 2) k_mega(P p) {
    __shared__ __attribute__((aligned(16))) char lds[LDS_BYTES];
    const int bid = blockIdx.x, nb = gridDim.x;
    volatile LAS unsigned* st = (volatile LAS unsigned*)(LAS char*)(lds + LX + 1008);
    if (threadIdx.x < 2) st[threadIdx.x] = 0u;
    __syncthreads();
    if (p.ws == nullptr) cg::this_grid().sync();
    const XcdBarrier bar = xcd_barrier_post(WSP(unsigned, WS_CTL) + CW_BAR, st);
    int* s_rank = (int*)(lds + LX + 976);
    if (threadIdx.x == 0) *s_rank = (int)atomicAdd(WSP(unsigned, WS_CTL) + CW_XRANK + 64 * (bar.x & 15), 1u);
#ifndef PROBE_MASK
#define PROBE_MASK 0
#endif
#define RUNP(k, call) do { call; if (PROBE_MASK & (1 << (k))) { xcd_barrier(bar); call; } } while (0)
    RUNP(0, phase0(p, bid, nb, lds));  xcd_barrier(bar);
    Sched sc;
    { const int nloc = __builtin_amdgcn_readfirstlane((int)st[0]), nx = __builtin_amdgcn_readfirstlane((int)st[1]), rk = __builtin_amdgcn_readfirstlane(*s_rank); const bool ok = nx == 8 && bar.x < 8 && rk < nloc;
      sc.x = ok ? (int)bar.x : 0; sc.rank = ok ? rk : bid; sc.nloc = ok ? nloc : nb; sc.nxcd = ok ? 8 : 0; }
    RUNP(1, phase1(p, sc, lds));  xcd_barrier(bar);
    RUNP(4, phase2c(p, bid, nb, lds)); xcd_barrier(bar);
    phase3(p, lds, 0); if (PROBE_MASK & (1 << 5)) { xcd_barrier(bar); phase3(p, lds, 64); } xcd_barrier(bar);
    RUNP(6, phase4a(p, bid, nb, lds)); xcd_barrier(bar);
    RUNP(7, phase4b(p, sc, lds)); xcd_barrier(bar);
    phase4c(p, bid, nb, lds); xcd_barrier(bar);
    RUNP(9, phase5(p, sc, lds));  xcd_barrier(bar);
    RUNP(10, phase6(p, sc, lds));  xcd_barrier(bar);
    RUNP(11, phase7(p, bid, nb, lds));
}

extern "C" void kernel_launch(void* const* d_in, const int* in_sizes, int n_in, void* d_out, int out_size, void* d_ws, size_t ws_size, hipStream_t stream) {
    if (n_in != 29 || ws_size < WS_NEED) { fprintf(stderr, "kernel_launch: unexpected n_in %d or ws_size %zu (need %zu)\n", n_in, ws_size, (size_t)WS_NEED); return; }
    static int grid_blocks = 0;
    if (!grid_blocks) {
        int dev = 0, cus = 0, per_cu = 0;
        (void)hipGetDevice(&dev);
        (void)hipDeviceGetAttribute(&cus, hipDeviceAttributeMultiprocessorCount, dev);
        (void)hipOccupancyMaxActiveBlocksPerMultiprocessor(&per_cu, k_mega, 256, 0);
        if (per_cu > 2) per_cu = 2;
        grid_blocks = cus * per_cu;
        if (grid_blocks <= 0) { fprintf(stderr, "kernel_launch: occupancy query gave %d x %d\n", cus, per_cu); grid_blocks = 0; return; }
    }
    (void)hipMemsetAsync((char*)d_ws + WS_CTL, 0, CTL_ZERO_BYTES, stream);
    P p{};
    const float** pf = (const float**)&p;
    for (int i = 0; i < 29; ++i) pf[i] = (const float*)d_in[i];
    p.out = (float*)d_out; p.ws = (unsigned char*)d_ws;
    void* args[] = {&p};
    hipError_t e = hipLaunchCooperativeKernel((void*)k_mega, dim3(grid_blocks), dim3(256), args, 0, stream);
    if (e != hipSuccess) fprintf(stderr, "cooperative launch failed: %s (grid %d)\n", hipGetErrorString(e), grid_blocks);
}
```

```cpp
#include <hip/hip_runtime.h>
#include <hip/hip_cooperative_groups.h>
#include <stdint.h>
#include <stdio.h>

#define DEVI __device__ __forceinline__
typedef unsigned short bf16_t;
typedef short bf16x8 __attribute__((ext_vector_type(8)));
typedef float f32x4 __attribute__((ext_vector_type(4)));
typedef float f32x16 __attribute__((ext_vector_type(16)));
typedef unsigned u32x4 __attribute__((ext_vector_type(4)));
typedef unsigned u32x2 __attribute__((ext_vector_type(2)));

constexpr int BATCH = 2, SEQ = 8192, DM = 1024, NMETA = 16;
constexpr int LTOK = SEQ + NMETA;
constexpr int PADL = 112;
constexpr int LP = LTOK + PADL;
constexpr int NP = BATCH * LP;
constexpr int NQB = LP / 128;
constexpr int NH = 8, HD = 64;
constexpr int FOXW = 512, RWW = 512;
constexpr int RWKV_COLS = 1792;
constexpr int IN_COLS = 3336;
constexpr int WIN_N = 3456;
constexpr int NEXP = 32, TOPK = 4;
constexpr int CAP = BATCH * LTOK;
constexpr int MAXBLK = (BATCH * LTOK * TOPK) / 256 + NEXP + 1;
constexpr float ALPHA = 1.189207115002721f;
constexpr float LN_EPS = 1e-5f, GN_EPS = 64e-5f, RMS_EPS = 1e-6f;
constexpr float LOG2E = 1.4426950408889634f;
constexpr float QSCALE = 0.125f * LOG2E;
constexpr float NEGBIG = -1e30f;

constexpr size_t MiB = 1u << 20;
constexpr size_t al256(size_t x) { return (x + 255) & ~(size_t)255; }
constexpr size_t WS_CTL = 0;
constexpr size_t WS_WINT = 1 * MiB;
constexpr size_t WS_WOUTT = WS_WINT + (size_t)WIN_N * 1024 * 2;
constexpr size_t WS_W2T = WS_WOUTT + (size_t)1024 * 1024 * 2;
constexpr size_t WS_A2T = WS_W2T + 512 * 64 * 2;
constexpr size_t WS_G2T = WS_A2T + 512 * 64 * 2;
constexpr size_t WS_WGUT = al256(WS_G2T + 512 * 128 * 2);
constexpr size_t WS_WDT = WS_WGUT + (size_t)32 * 2048 * 1024 * 2;
constexpr size_t WS_ST1 = WS_WDT + (size_t)32 * 1024 * 1024 * 2;
constexpr size_t WS_H1B = WS_ST1 + (size_t)NP * 2 * 4;
constexpr size_t WS_RTE = WS_H1B + (size_t)NP * 1024 * 2;
constexpr size_t WS_RTR = WS_RTE + (size_t)NP * 16;
constexpr size_t WS_LTOK = WS_RTR + (size_t)NP * 16;
constexpr size_t WS_LGATE = WS_LTOK + (size_t)32 * CAP * 4;
constexpr size_t WS_PRE1 = al256(WS_LGATE + (size_t)32 * CAP * 4);
constexpr size_t WS_EARLY = WS_PRE1 + (size_t)NP * 1024 * 4;
constexpr size_t WS_H0B = WS_EARLY;
constexpr size_t WS_QB = WS_H0B + (size_t)NP * 1024 * 2;
constexpr size_t WS_KB = WS_QB + (size_t)NP * 512 * 2;
constexpr size_t WS_VT = WS_KB + (size_t)NP * 512 * 2;
constexpr size_t WS_ZR = WS_VT + (size_t)NP * 512 * 2;
constexpr size_t WS_LF = WS_ZR + (size_t)NP * 1792 * 4;
constexpr size_t WS_CS = WS_LF + (size_t)NP * 8 * 4;
constexpr size_t WS_R = WS_CS + (size_t)NP * 8 * 4;
constexpr size_t WS_CHK = WS_R;
static_assert((size_t)16 * 129 * 32768 <= (size_t)4 * NP * 512 * 2, "chunk buffers fit");
constexpr size_t WS_KR = WS_R + (size_t)NP * 512 * 2;
constexpr size_t WS_VR = WS_KR + (size_t)NP * 512 * 2;
constexpr size_t WS_KK = WS_VR + (size_t)NP * 512 * 2;
constexpr size_t WS_TW = WS_KK + (size_t)NP * 512 * 2;
constexpr size_t WS_DA = WS_TW + (size_t)NP * 64 * 2;
constexpr size_t WS_SG = WS_DA + (size_t)NP * 64 * 2;
constexpr size_t WS_RW = WS_SG + (size_t)NP * 128 * 2;
constexpr size_t WS_RB = WS_RW + (size_t)NP * 512 * 4;
constexpr size_t WS_RK2 = WS_RB + (size_t)NP * 512 * 2;
constexpr size_t WS_G = WS_RK2 + (size_t)NP * 512 * 2;
constexpr size_t WS_Y = WS_G + (size_t)NP * 512 * 2;
constexpr size_t WS_MIX = WS_Y + (size_t)NP * 512 * 4;
constexpr size_t WS_LGS = WS_MIX + (size_t)NP * 1024 * 2;
constexpr size_t WS_EARLY_END = WS_LGS + (size_t)1024 * 32768;
constexpr size_t WS_ACT = WS_EARLY;
constexpr size_t WS_YB = WS_ACT + (size_t)MAXBLK * 256 * 1024 * 2;
constexpr size_t WS_LATE_END = WS_YB + (size_t)MAXBLK * 256 * 1024 * 2;
constexpr size_t WS_NEED = WS_EARLY_END > WS_LATE_END ? WS_EARLY_END : WS_LATE_END;
constexpr int CW_CNT = 0;
constexpr int CW_QATT = 64;
constexpr int CW_QK2 = 320;
constexpr int CW_XRANK = 1024;

struct P {
    const float *x, *meta, *ln0_g, *ln0_b, *w_in, *b_fgate, *fox_norm_g, *rwkv_mu, *w0, *w2, *a0, *a2, *g2, *k_k, *k_a, *r_k, *lnx_g,
        *lnx_b, *w_out, *ln1_g, *ln1_b, *w_router, *b_router, *w_gu, *b_gu, *w_down, *b_down, *ln2_g, *ln2_b;
    float* out;
    unsigned char* ws;
};
#define WSP(T, off) ((T*)(p.ws + (off)))

#define LBAR() do { asm volatile("s_waitcnt lgkmcnt(0)" ::: "memory"); __builtin_amdgcn_s_barrier(); asm volatile("" ::: "memory"); } while (0)
DEVI int otid() { int t = threadIdx.x; asm volatile("" : "+v"(t)); return t; }
DEVI unsigned f2bf(float f) { unsigned u = __float_as_uint(f); u += 0x7fffu + ((u >> 16) & 1u); return u >> 16; }
typedef float f32x2 __attribute__((ext_vector_type(2)));
typedef __bf16 bf16x2_t __attribute__((ext_vector_type(2)));
DEVI unsigned pk2(float lo, float hi) { const f32x2 v = {lo, hi}; const bf16x2_t b = __builtin_convertvector(v, bf16x2_t); return __builtin_bit_cast(unsigned, b); }
DEVI f32x4 ld4bf(const bf16_t* p) { const u32x2 w = *(const u32x2*)p; return (f32x4){__uint_as_float(w.x << 16), __uint_as_float(w.x & 0xffff0000u), __uint_as_float(w.y << 16), __uint_as_float(w.y & 0xffff0000u)}; }
DEVI void st4bf(bf16_t* p, f32x4 v) { *(u32x2*)p = (u32x2){pk2(v.x, v.y), pk2(v.z, v.w)}; }
DEVI float ld1bf(const bf16_t* p) { return __uint_as_float((unsigned)(*p) << 16); }
DEVI float wave_sum(float v) {
#pragma unroll
    for (int o = 32; o > 0; o >>= 1) v += __shfl_xor(v, o);
    return v;
}
DEVI float sum16(float v) {
#pragma unroll
    for (int o = 8; o > 0; o >>= 1) v += __shfl_xor(v, o);
    return v;
}
template <int CTRL> DEVI float dpp_mov(float v) { return __int_as_float(__builtin_amdgcn_update_dpp(0, __float_as_int(v), CTRL, 0xF, 0xF, false)); }
DEVI float rowsum16_dpp(float v) {
    v += dpp_mov<0xB1>(v);
    v += dpp_mov<0x4E>(v);
    v += dpp_mov<0x141>(v);
    v += dpp_mov<0x140>(v);
    return v;
}
DEVI float softplusf(float x) { return fmaxf(x, 0.f) + log1pf(__expf(-fabsf(x))); }
DEVI float sigmoidf(float x) { return __builtin_amdgcn_rcpf(1.f + __expf(-x)); }
DEVI float tanh_fast(float x) { return 1.f - 2.f * __builtin_amdgcn_rcpf(__expf(2.f * x) + 1.f); }
DEVI f32x4 zs4(const bf16_t* zrow, int col, const float* mu) { const f32x4 zc = ld4bf(zrow + col), zp = ld4bf(zrow - RWKV_COLS + col); return zc + (zp - zc) * *(const f32x4*)(mu + col); }
DEVI float softplus_fast(float x) { return fmaxf(x, 0.f) + __logf(1.f + __expf(-fabsf(x))); }

constexpr int G2_STAGE = 24576;
constexpr int LDS_BYTES = 73728 + 1024;
constexpr int LX = 73728;
DEVI int xf4(int r) { return (0x78 >> (2 * ((r >> 2) & 3))) & 3; }
template <bool SWAP, int MT, class Epi>
DEVI void gemm256(const bf16_t* (&ap)[4], const bf16_t* (&bp)[2], int K, char* lds, Epi&& epi) {
    typedef __attribute__((address_space(3))) unsigned lds_u32;
    constexpr int NA = MT / 2 < 1 ? 1 : MT / 2;
    const int tid = otid(), lane = tid & 63, wid = __builtin_amdgcn_readfirstlane(tid >> 6), wm = wid >> 1, wn = wid & 1;
    const int l15 = lane & 15, lq = lane >> 4;
    const int gko = ((lane & 3) ^ xf4(lane >> 2)) << 3;
    f32x4 acc[MT][4];
#pragma unroll
    for (int i = 0; i < MT; ++i)
#pragma unroll
        for (int j = 0; j < 4; ++j) acc[i][j] = (f32x4){0.f, 0.f, 0.f, 0.f};
    const int nk = K / 32;
#define G2_DMA_A(kt, s, i) __builtin_amdgcn_global_load_lds((const unsigned*)(ap[i] + (kt) * 32 + gko), (lds_u32*)(lds + (s) * G2_STAGE + wid * 1024 + (i) * 4096), 16, 0, 0)
#define G2_DMA_B(kt, s, i) __builtin_amdgcn_global_load_lds((const unsigned*)(bp[i] + (kt) * 32 + gko), (lds_u32*)(lds + (s) * G2_STAGE + wid * 1024 + 16384 + (i) * 4096), 16, 0, 0)
#define G2_MMA(mt) do { _Pragma("unroll") for (int nt = 0; nt < 4; ++nt) { \
        if (SWAP) acc[mt][nt] = __builtin_amdgcn_mfma_f32_16x16x32_bf16(af[mt], bfr[nt], acc[mt][nt], 0, 0, 0); \
        else acc[mt][nt] = __builtin_amdgcn_mfma_f32_16x16x32_bf16(bfr[nt], af[mt], acc[mt][nt], 0, 0, 0); } } while (0)
#pragma unroll
    for (int st = 0; st < 2; ++st) { if (st < nk) {
#pragma unroll
        for (int i = 0; i < NA; ++i) G2_DMA_A(st, st, i);
        G2_DMA_B(st, st, 0); G2_DMA_B(st, st, 1); } }
    const int co = (lq ^ xf4(l15)) << 4;
    const int aoff = (wm * (16 * MT) + l15) * 64 + co, boff = 16384 + (wn * 64 + l15) * 64 + co;
    int s = 0;
    for (int kt = 0; kt < nk; ++kt) {
        if (kt + 1 < nk) { if (MT == 8) asm volatile("s_waitcnt vmcnt(6)" ::: "memory"); else if (MT == 4) asm volatile("s_waitcnt vmcnt(4)" ::: "memory"); else asm volatile("s_waitcnt vmcnt(3)" ::: "memory"); }
        else asm volatile("s_waitcnt vmcnt(0)" ::: "memory");
        __builtin_amdgcn_s_barrier(); asm volatile("" ::: "memory");
        const char* base = lds + s * G2_STAGE;
        bf16x8 af[MT], bfr[4];
#pragma unroll
        for (int t = 0; t < 4; ++t) bfr[t] = *(const bf16x8*)(base + boff + t * 1024);
#pragma unroll
        for (int t = 0; t < (MT < 4 ? MT : 4); ++t) af[t] = *(const bf16x8*)(base + aoff + t * 1024);
        const bool pre = kt + 2 < nk; int s2 = s + 2; if (s2 >= 3) s2 -= 3;
        __builtin_amdgcn_sched_barrier(0); __builtin_amdgcn_s_setprio(1);
        G2_MMA(0); __builtin_amdgcn_sched_barrier(0);
        if constexpr (MT == 8) {
#pragma unroll
            for (int t = 4; t < MT; ++t) af[t] = *(const bf16x8*)(base + aoff + t * 1024);
            if (pre) G2_DMA_A(kt + 2, s2, 0); __builtin_amdgcn_sched_barrier(0);
            G2_MMA(1); if (pre) G2_DMA_A(kt + 2, s2, 1); __builtin_amdgcn_sched_barrier(0);
            G2_MMA(2); if (pre) G2_DMA_A(kt + 2, s2, 2); __builtin_amdgcn_sched_barrier(0);
            G2_MMA(3); if (pre) G2_DMA_A(kt + 2, s2, 3); __builtin_amdgcn_sched_barrier(0);
            G2_MMA(4); if (pre) G2_DMA_B(kt + 2, s2, 0); __builtin_amdgcn_sched_barrier(0);
            G2_MMA(5); if (pre) G2_DMA_B(kt + 2, s2, 1); __builtin_amdgcn_sched_barrier(0);
            G2_MMA(6); G2_MMA(7);
        } else if constexpr (MT == 4) {
            if (pre) G2_DMA_A(kt + 2, s2, 0); __builtin_amdgcn_sched_barrier(0);
            G2_MMA(1); if (pre) G2_DMA_A(kt + 2, s2, 1); __builtin_amdgcn_sched_barrier(0);
            G2_MMA(2); if (pre) { G2_DMA_B(kt + 2, s2, 0); G2_DMA_B(kt + 2, s2, 1); } __builtin_amdgcn_sched_barrier(0);
            G2_MMA(3);
        } else {
            if (pre) { G2_DMA_A(kt + 2, s2, 0); G2_DMA_B(kt + 2, s2, 0); G2_DMA_B(kt + 2, s2, 1); } __builtin_amdgcn_sched_barrier(0);
            G2_MMA(1);
        }
        __builtin_amdgcn_s_setprio(0);
        asm volatile("s_waitcnt lgkmcnt(0)" ::: "memory");
        s = s == 2 ? 0 : s + 1;
    }
#undef G2_DMA_A
#undef G2_DMA_B
#undef G2_MMA
    __builtin_amdgcn_s_barrier(); asm volatile("" ::: "memory");
    epi(acc, wm, wn, l15, lq);
}

DEVI int srccol(int kind, int n) {
    if (kind == 0) return n;
    if (kind == 1) { if (n < 1536) return n; if (n < 3328) return n + 8; if (n < 3336) return 1536 + (n - 3328); return -1; }
    const int T = n >> 5, w = n & 31;
    return w < 16 ? T * 16 + w : 1024 + T * 16 + (w - 16);
}
DEVI void conv_tile(const float* src, int K, int NS, bf16_t* dst, int kind, int kt, int nt, float* scr  ) {
    const int tid = otid();
    const int nl = tid & 63, n = nt * 64 + nl, sc = srccol(kind, n);
    float v[16];
#pragma unroll
    for (int i = 0; i < 16; ++i) { const int k = i * 4 + (tid >> 6); v[i] = sc >= 0 ? src[(size_t)(kt * 64 + k) * NS + sc] : 0.f; }
#pragma unroll
    for (int i = 0; i < 16; ++i) { const int k = i * 4 + (tid >> 6); scr[k * 65 + nl] = v[i]; }
    LBAR();
    const int on = tid >> 2, kc = (tid & 3) * 16;
    u32x4 o0, o1;
    const float* s = scr + kc * 65 + on;
    o0.x = pk2(s[0 * 65], s[1 * 65]); o0.y = pk2(s[2 * 65], s[3 * 65]); o0.z = pk2(s[4 * 65], s[5 * 65]); o0.w = pk2(s[6 * 65], s[7 * 65]);
    o1.x = pk2(s[8 * 65], s[9 * 65]); o1.y = pk2(s[10 * 65], s[11 * 65]); o1.z = pk2(s[12 * 65], s[13 * 65]); o1.w = pk2(s[14 * 65], s[15 * 65]);
    bf16_t* d = dst + (size_t)(nt * 64 + on) * K + kt * 64 + kc;
    *(u32x4*)d = o0; *(u32x4*)(d + 8) = o1;
    LBAR();
}
DEVI void phase0(const P& p, int bid, int nb, char* lds) {
    const int tid = otid(), lane = tid & 63, wid = tid >> 6;
    {
        bf16_t* H0B = WSP(bf16_t, WS_H0B);
        for (int row = bid * 4 + wid; row < NP; row += nb * 4) {
            const int b = row / LP, pp = row % LP;
            u32x2* hb = (u32x2*)(H0B + (size_t)row * 1024) + lane;
            if (pp < PADL) {
#pragma unroll
                for (int j = 0; j < 4; ++j) hb[64 * j] = (u32x2){0u, 0u};
                continue;
            }
            const int t = pp - PADL;
            const float* src = t < NMETA ? p.meta + (size_t)t * 1024 : p.x + ((size_t)b * SEQ + (t - NMETA)) * 1024;
            f32x4 v[4]; float s = 0.f;
#pragma unroll
            for (int j = 0; j < 4; ++j) { v[j] = ((const f32x4*)src)[lane + 64 * j]; s += (v[j].x + v[j].y) + (v[j].z + v[j].w); }
            const float mean = wave_sum(s) * (1.f / 1024.f); float s2 = 0.f;
#pragma unroll
            for (int j = 0; j < 4; ++j) { v[j] = v[j] - mean; s2 += (v[j].x * v[j].x + v[j].y * v[j].y) + (v[j].z * v[j].z + v[j].w * v[j].w); }
            const float rstd = rsqrtf(wave_sum(s2) * (1.f / 1024.f) + LN_EPS);
#pragma unroll
            for (int j = 0; j < 4; ++j) {
                const f32x4 g = ((const f32x4*)p.ln0_g)[lane + 64 * j], bb = ((const f32x4*)p.ln0_b)[lane + 64 * j];
                const f32x4 o = v[j] * rstd * g + bb;
                hb[64 * j] = (u32x2){pk2(o.x, o.y), pk2(o.z, o.w)};
            }
        }
    }
    {
        float* scr = (float*)lds;
        constexpr int T_IN = 16 * 54, T_OUT = 16 * 16, T_W2 = 8, T_A2 = 8, T_G2 = 16;
        constexpr int TOT = T_IN + T_OUT + T_W2 + T_A2 + T_G2;
        for (int it = bid; it < TOT; it += nb) {
            int r = it;
            if (r < T_IN) { conv_tile(p.w_in, 1024, IN_COLS, WSP(bf16_t, WS_WINT), 1, r / 54, r % 54, scr); continue; } r -= T_IN;
            if (r < T_OUT) { conv_tile(p.w_out, 1024, 1024, WSP(bf16_t, WS_WOUTT), 0, r / 16, r % 16, scr); continue; } r -= T_OUT;
            if (r < T_W2) { conv_tile(p.w2, 64, 512, WSP(bf16_t, WS_W2T), 0, 0, r, scr); continue; } r -= T_W2;
            if (r < T_A2) { conv_tile(p.a2, 64, 512, WSP(bf16_t, WS_A2T), 0, 0, r, scr); continue; } r -= T_A2;
            conv_tile(p.g2, 128, 512, WSP(bf16_t, WS_G2T), 0, r / 8, r % 8, scr);
        }
    }
}
DEVI void conv_wide(const float* src, int NS, bf16_t* dst, int kind, int kt, int nt, float* scr) {
    const int tid = otid(), kq = tid >> 6, n4 = tid & 63;
    const int sc = srccol(kind, nt * 256 + 4 * n4);
    const float* sp = src + (size_t)(kt * 64 + kq) * NS + sc;
    f32x4 v[16];
#pragma unroll
    for (int i = 0; i < 16; ++i) v[i] = *(const f32x4*)(sp + (size_t)(4 * i) * NS);
#pragma unroll
    for (int i = 0; i < 16; ++i) { const int k = 4 * i + kq; *(f32x4*)(scr + k * 260 + ((4 * n4 + 4 * (k >> 3)) & 255)) = v[i]; }
    LBAR();
    const int ch = tid & 7, r0 = tid >> 3;
#pragma unroll
    for (int j = 0; j < 8; ++j) { const int row = j * 32 + r0; const float* s = scr + (8 * ch) * 260 + ((row + 4 * ch) & 255);
        *(u32x4*)(dst + (size_t)(nt * 256 + row) * 1024 + kt * 64 + 8 * ch) = (u32x4){pk2(s[0], s[260]), pk2(s[2 * 260], s[3 * 260]), pk2(s[4 * 260], s[5 * 260]), pk2(s[6 * 260], s[7 * 260])}; }
    LBAR();
}
constexpr int CONV_TILES = 12, N_CONV_ITEMS = (32 * 16 * 8 + 32 * 16 * 4) / CONV_TILES;
static_assert(2 * N_CONV_ITEMS <= 16 * (NQB - 1), "interleave pattern needs 2 attention items per conversion item");
DEVI void conv_moe_item(const P& p, int item, char* lds) {
    float* scr = (float*)lds;
    for (int t = 0; t < CONV_TILES; ++t) {
        int r = item * CONV_TILES + t;
        if (r < 32 * 128) { const int e = r / 128, q = r % 128; conv_wide(p.w_gu + (size_t)e * 1024 * 2048, 2048, WSP(bf16_t, WS_WGUT) + (size_t)e * 2048 * 1024, 2, q / 8, q % 8, scr); }
        else { r -= 32 * 128; const int e = r / 64, q = r % 64; conv_wide(p.w_down + (size_t)e * 1024 * 1024, 1024, WSP(bf16_t, WS_WDT) + (size_t)e * 1024 * 1024, 0, q / 4, q % 4, scr); }
    }
}

struct Sched { int x, rank, nloc, nxcd; };
template <class F> DEVI void for_xcd_items(const Sched& sc, F&& f) {
    const int x0 = sc.nxcd == 8 ? sc.x : 0, x1 = sc.nxcd == 8 ? sc.x + 1 : 8;
    for (int x = x0; x < x1; ++x) f(x, sc.rank, sc.nloc);
}

struct EpiInProj {
    const P& p; int tm, tn;
    DEVI void operator()(f32x4 (&acc)[8][4], int wm, int wn, int l15, int lq) const {
        if (tn < 8) {
            bf16_t* dst = tn < 4 ? WSP(bf16_t, WS_QB) : WSP(bf16_t, WS_KB); const float sc = tn < 4 ? QSCALE : 1.f;
            const int cb = (tn & 3) * 128 + wn * 64 + 4 * lq;
            float mx = 0.f;
#pragma unroll
            for (int mt = 0; mt < 8; ++mt) { const size_t row = (size_t)tm * 256 + wm * 128 + mt * 16 + l15; float ssq = 0.f;
#pragma unroll
                for (int nt = 0; nt < 4; ++nt) { const f32x4 a = acc[mt][nt] * sc; ssq += (a.x * a.x + a.y * a.y) + (a.z * a.z + a.w * a.w); *(u32x2*)(dst + row * 512 + cb + nt * 16) = (u32x2){pk2(a.x, a.y), pk2(a.z, a.w)}; }
                ssq += __shfl_xor(ssq, 16); ssq += __shfl_xor(ssq, 32); mx = fmaxf(mx, ssq); }
#pragma unroll
            for (int o = 1; o < 16; o <<= 1) mx = fmaxf(mx, __shfl_xor(mx, o));
            if ((threadIdx.x & 63) == 0) atomicMax(WSP(unsigned, WS_CTL) + CW_QK2 + (tn < 4 ? 0 : 8) + 2 * (tn & 3) + wn, __float_as_uint(mx));
        } else if (tn < 12) {
            bf16_t* VT = WSP(bf16_t, WS_VT); const int row0 = tm * 256 + wm * 128;
#pragma unroll
            for (int mt = 0; mt < 8; ++mt) { const int row = row0 + mt * 16 + 4 * lq, b = row / LP, pp = row % LP;
#pragma unroll
                for (int nt = 0; nt < 4; ++nt) { const int n = (tn - 8) * 128 + wn * 64 + nt * 16 + l15; const f32x4 a = acc[mt][nt];
                    *(u32x2*)(VT + (size_t)(b * 512 + n) * LP + pp) = (u32x2){pk2(a.x, a.y), pk2(a.z, a.w)}; } }
        } else if (tn < 26) {
            bf16_t* ZR = WSP(bf16_t, WS_ZR); const int cb = (tn - 12) * 128 + wn * 64 + 4 * lq;
#pragma unroll
            for (int mt = 0; mt < 8; ++mt) { const size_t row = (size_t)tm * 256 + wm * 128 + mt * 16 + l15;
#pragma unroll
                for (int nt = 0; nt < 4; ++nt) st4bf(ZR + row * RWKV_COLS + cb + nt * 16, acc[mt][nt]); }
        } else {
            if (wn == 0 && lq < 2) { float* LF = WSP(float, WS_LF);
#pragma unroll
                for (int mt = 0; mt < 8; ++mt) { const int row = tm * 256 + wm * 128 + mt * 16 + l15; const bool pad = (row % LP) < PADL; f32x4 o;
#pragma unroll
                    for (int r = 0; r < 4; ++r) { const float xv = acc[mt][0][r] + p.b_fgate[4 * lq + r]; o[r] = pad ? 0.f : -softplusf(-xv); }
                    *(f32x4*)(LF + (size_t)row * 8 + 4 * lq) = o; } }
        }
    }
};
DEVI void phase1(const P& p, const Sched& sc, char* lds) {
    const int tid = otid(), lane = tid & 63, wid = tid >> 6, srow_ = 16 * wid + (lane >> 2);
    for_xcd_items(sc, [&](int x, int rank, int nloc) __attribute__((always_inline)) {
        const int xr = x >> 2, xc = x & 3, c0 = 7 * xc, cnt = xc == 3 ? 6 : 7, r0 = 33 * xr, nr = xr ? 32 : 33;
        for (int i = rank; i < nr * cnt; i += nloc) {
            const int tm = r0 + i / cnt, tn = c0 + i % cnt;
            const bf16_t *ap[4], *bp[2];
            int srow = srow_; asm volatile("" : "+v"(srow));
#pragma unroll
            for (int q = 0; q < 4; ++q) ap[q] = WSP(bf16_t, WS_H0B) + (size_t)(tm * 256 + srow + 64 * q) * 1024;
#pragma unroll
            for (int q = 0; q < 2; ++q) bp[q] = WSP(bf16_t, WS_WINT) + (size_t)(tn * 128 + srow + 64 * q) * 1024;
            if (tn >= 8 && tn < 12) gemm256<true, 8>(ap, bp, 1024, lds, EpiInProj{p, tm, tn});
            else gemm256<false, 8>(ap, bp, 1024, lds, EpiInProj{p, tm, tn});
        }
    });
}

DEVI int pi_swap(int i) { return (i & ~12) | ((i & 4) << 1) | ((i & 8) >> 1); }
DEVI void attn_item(const P& p, int b, int h, int qb, char* lds) {
    const int tid = otid(), lane = tid & 63, wid = tid >> 6, ql = lane & 31, hi = lane >> 5;
    const int q_pp = qb * 128 + wid * 32 + ql; const size_t qrow = (size_t)b * LP + q_pp;
    const bf16_t* QB = WSP(bf16_t, WS_QB); const bf16_t* KB = WSP(bf16_t, WS_KB); const bf16_t* VT = WSP(bf16_t, WS_VT); const float* CS = WSP(float, WS_CS);
    bf16x8 qf[4];
#pragma unroll
    for (int d0 = 0; d0 < 4; ++d0) qf[d0] = *(const bf16x8*)(QB + qrow * 512 + h * 64 + 16 * d0 + 8 * hi);
    const float cref = CS[((size_t)b * LP + qb * 128) * 8 + h];
    const int r0 = tid >> 3, kc = tid & 7;
    const int soff = r0 * 128 + ((kc ^ ((r0 >> 1) & 7)) << 4);
    const bf16_t* ksrc = KB + ((size_t)b * LP + r0) * 512 + h * 64 + kc * 8;
    const bf16_t* vsrc = VT + (size_t)(b * 512 + h * 64 + r0) * LP + kc * 8;
    const float* csrc = CS + ((size_t)b * LP + (tid & 63)) * 8 + h;
    const int nkt = 2 * qb + 1;
    int kstart = 1;
    {
        const unsigned* qk2 = WSP(unsigned, WS_CTL) + CW_QK2;
        const float bnd = 64.f + 2.04f * sqrtf(__uint_as_float(qk2[h]) * __uint_as_float(qk2[8 + h]));
        const int kt = tid + 1; bool skip = false;
        if (kt <= nkt) skip = CS[((size_t)b * LP + 64 * kt + 63) * 8 + h] - cref > bnd;
        int* s_cnt = (int*)(lds + LX + 944);
        if (tid == 0) *s_cnt = 0;
        __syncthreads();
        const int c = __popcll(__ballot(skip));
        if (lane == 0 && c) atomicAdd(s_cnt, c);
        __syncthreads();
        kstart = 1 + __builtin_amdgcn_readfirstlane(*s_cnt);
        if (kstart > 2 * qb) kstart = 2 * qb;
    }
    u32x4 rk[2], rv[2]; float rc = 0.f;
    auto gload = [&](int kt) {
#pragma unroll
        for (int i = 0; i < 2; ++i) { rk[i] = *(const u32x4*)(ksrc + (size_t)(64 * kt + 32 * i) * 512); rv[i] = *(const u32x4*)(vsrc + 64 * kt + (size_t)i * 32 * LP); }
        if (tid < 64) rc = csrc[(size_t)64 * kt * 8];
    };
    auto swrite = [&](int s) {
        char* bs = lds + s * 16640;
#pragma unroll
        for (int i = 0; i < 2; ++i) { *(u32x4*)(bs + soff + i * 4096) = rk[i]; *(u32x4*)(bs + 8192 + soff + i * 4096) = rv[i]; }
        if (tid < 64) *(float*)(bs + 16384 + tid * 4) = rc - cref;
    };
    float m = NEGBIG, l = 0.f; f32x16 o[2];
#pragma unroll
    for (int r = 0; r < 16; ++r) { o[0][r] = 0.f; o[1][r] = 0.f; }
    const int krow0 = pi_swap(ql);
    const int koff = krow0 * 128, ksw = (krow0 >> 1) & 7;
    const int voff = 8192 + ql * 128, vsw = (ql >> 1) & 7;
    gload(kstart); swrite(kstart & 1); __syncthreads();
    for (int kt = kstart; kt <= nkt; ++kt) {
        const int s = kt & 1;
        if (kt < nkt) gload(kt + 1);
        if (64 * kt <= qb * 128 + wid * 32 + 31) {
            const char* bs = lds + s * 16640;
            f32x16 sc[2];
#pragma unroll
            for (int kh = 0; kh < 2; ++kh) {
#pragma unroll
                for (int r = 0; r < 16; ++r) sc[kh][r] = 0.f;
#pragma unroll
                for (int d0 = 0; d0 < 4; ++d0) { const bf16x8 kf = *(const bf16x8*)(bs + kh * 4096 + koff + (((2 * d0 + hi) ^ ksw) << 4));
                    sc[kh] = __builtin_amdgcn_mfma_f32_32x32x16_bf16(kf, qf[d0], sc[kh], 0, 0, 0); }
            }
            const float* csl = (const float*)(bs + 16384);
            const bool needmask = (kt == 1) || (kt >= 2 * qb);
            f32x2 xv[2][8];
#pragma unroll
            for (int kh = 0; kh < 2; ++kh)
#pragma unroll
                for (int g = 0; g < 4; ++g) { const int key0 = 32 * kh + 16 * (g >> 1) + 8 * hi + 4 * (g & 1); const f32x4 cv = *(const f32x4*)(csl + key0);
                    xv[kh][2 * g] = (f32x2){sc[kh][4 * g], sc[kh][4 * g + 1]} - (f32x2){cv.x, cv.y};
                    xv[kh][2 * g + 1] = (f32x2){sc[kh][4 * g + 2], sc[kh][4 * g + 3]} - (f32x2){cv.z, cv.w}; }
            if (needmask) {
#pragma unroll
                for (int kh = 0; kh < 2; ++kh)
#pragma unroll
                    for (int g = 0; g < 4; ++g) { const int key0 = 32 * kh + 16 * (g >> 1) + 8 * hi + 4 * (g & 1);
#pragma unroll
                        for (int c = 0; c < 4; ++c) { const int kp = 64 * kt + key0 + c; if (kp > q_pp || kp < PADL) xv[kh][2 * g + (c >> 1)][c & 1] = NEGBIG; } }
            }
            float mloc;
            { float a = __builtin_fmaxf(__builtin_fmaxf(xv[0][0].x, xv[0][0].y), xv[1][0].x), bq = __builtin_fmaxf(__builtin_fmaxf(xv[0][1].x, xv[0][1].y), xv[1][0].y);
              a = __builtin_fmaxf(__builtin_fmaxf(a, xv[1][1].x), xv[1][1].y);
#pragma unroll
              for (int i = 2; i < 8; i += 2) { a = __builtin_fmaxf(__builtin_fmaxf(a, xv[0][i].x), xv[0][i].y); bq = __builtin_fmaxf(__builtin_fmaxf(bq, xv[0][i + 1].x), xv[0][i + 1].y);
                  a = __builtin_fmaxf(__builtin_fmaxf(a, xv[1][i].x), xv[1][i].y); bq = __builtin_fmaxf(__builtin_fmaxf(bq, xv[1][i + 1].x), xv[1][i + 1].y); }
              mloc = __builtin_fmaxf(a, bq); }
            { const auto rr = __builtin_amdgcn_permlane32_swap(__float_as_uint(mloc), __float_as_uint(mloc), false, false); mloc = fmaxf(__uint_as_float(rr[0]), __uint_as_float(rr[1])); }
            if (__any(mloc > m + 8.f)) {
                const float mnew = fmaxf(m, mloc); const float f = __builtin_amdgcn_exp2f(m - mnew); m = mnew; l *= f;
#pragma unroll
                for (int r = 0; r < 16; ++r) { o[0][r] *= f; o[1][r] *= f; }
            }
            bf16x8 pf[2][2]; f32x2 ls2 = (f32x2){0.f, 0.f}; const f32x2 m2 = (f32x2){m, m};
#pragma unroll
            for (int kh = 0; kh < 2; ++kh)
#pragma unroll
                for (int s2 = 0; s2 < 2; ++s2) { u32x4 w;
#pragma unroll
                    for (int j = 0; j < 4; ++j) { const f32x2 d = xv[kh][4 * s2 + j] - m2; f32x2 e; e.x = __builtin_amdgcn_exp2f(d.x); e.y = __builtin_amdgcn_exp2f(d.y); ls2 += e; w[j] = pk2(e.x, e.y); }
                    pf[kh][s2] = __builtin_bit_cast(bf16x8, w); }
            l += ls2.x + ls2.y;
#pragma unroll
            for (int dh = 0; dh < 2; ++dh)
#pragma unroll
                for (int kh = 0; kh < 2; ++kh)
#pragma unroll
                    for (int s2 = 0; s2 < 2; ++s2) { const bf16x8 vf = *(const bf16x8*)(bs + voff + dh * 4096 + (((4 * kh + 2 * s2 + hi) ^ vsw) << 4));
                        o[dh] = __builtin_amdgcn_mfma_f32_32x32x16_bf16(vf, pf[kh][s2], o[dh], 0, 0, 0); }
        }
        if (kt < nkt) swrite((kt + 1) & 1);
        __syncthreads();
    }
    l += __shfl_xor(l, 32);
    const float inv = 1.f / l; float ss = 0.f;
#pragma unroll
    for (int r = 0; r < 16; ++r) { o[0][r] *= inv; o[1][r] *= inv; ss += o[0][r] * o[0][r] + o[1][r] * o[1][r]; }
    ss += __shfl_xor(ss, 32);
    const float rs = rsqrtf(ss * (1.f / 64.f) + RMS_EPS);
    bf16_t* MIX = WSP(bf16_t, WS_MIX); const bool padq = q_pp < PADL;
#pragma unroll
    for (int dh = 0; dh < 2; ++dh)
#pragma unroll
        for (int g = 0; g < 4; ++g) { const int d = 32 * dh + 8 * g + 4 * hi; const f32x4 gn = *(const f32x4*)(p.fox_norm_g + h * 64 + d);
            float v0 = o[dh][4 * g] * rs * gn.x, v1 = o[dh][4 * g + 1] * rs * gn.y, v2 = o[dh][4 * g + 2] * rs * gn.z, v3 = o[dh][4 * g + 3] * rs * gn.w;
            if (padq) { v0 = v1 = v2 = v3 = 0.f; }
            *(u32x2*)(MIX + qrow * 1024 + h * 64 + d) = (u32x2){pk2(v0, v1), pk2(v2, v3)}; }
}

constexpr int NCHUNK = 129;
constexpr int CHUNK_BYTES = 32768;
constexpr int C_XL = 32768, C_LG = 50176, C_PART = 67584, C_END = 68608;
DEVI int swz(int row, int chunk) { return row * 128 + ((chunk ^ ((row >> 1) & 7)) << 4); }
DEVI int crow(int r, int h) { return (r & 3) + 8 * (r >> 2) + 4 * h; }
DEVI bf16x8 frag(const char* base, int row, int ks, int h) { return *(const bf16x8*)(base + swz(row, 2 * ks + h)); }
DEVI void chunk_job(const P& p, int job, char* lds) {
    int tid_ = threadIdx.x; asm volatile("" : "+v"(tid_));
    const int tid = tid_, lane = tid & 63, wid = tid >> 6, l31 = lane & 31, h = lane >> 5, rb = wid >> 1, cb = wid & 1;
    const int bh = job / NCHUNK, c = job % NCHUNK, b = bh >> 3, hh = bh & 7;
    const size_t row0 = (size_t)b * LP + 64 + 64 * c; const int col0 = hh * 64;
    const bf16_t* BB = WSP(bf16_t, WS_RB) + row0 * 512 + col0; const bf16_t* K2 = WSP(bf16_t, WS_RK2) + row0 * 512 + col0;
    const bf16_t* ZRb = WSP(bf16_t, WS_ZR) + row0 * RWKV_COLS;
    float* LgG = WSP(float, WS_LGS) + (size_t)blockIdx.x * 8192;
    char* chk = (char*)p.ws + WS_CHK + (size_t)job * CHUNK_BYTES;
    char* R1 = lds; float* XL = (float*)(lds + C_XL); float* Lg = (float*)(lds + C_LG); float* part = (float*)(lds + C_PART);
    {
        const int t = tid >> 2, q = tid & 3; const bf16_t* zrow = ZRb + (size_t)t * RWKV_COLS; char* dst = R1 + q * 8192;
#pragma unroll 4
        for (int i = 0; i < 16; ++i) { f32x4 z = zs4(zrow, 1536 + 64 * q + 4 * i, p.rwkv_mu);
            if (q == 0) z = (f32x4){tanh_fast(z.x), tanh_fast(z.y), tanh_fast(z.z), tanh_fast(z.w)};
            else if (q >= 2) z = (f32x4){sigmoidf(z.x), sigmoidf(z.y), sigmoidf(z.z), sigmoidf(z.w)};
            *(u32x2*)(dst + swz(t, i >> 1) + (i & 1) * 8) = (u32x2){pk2(z.x, z.y), pk2(z.z, z.w)}; }
    }
    LBAR();
    {
        const bf16_t* W2T = WSP(bf16_t, WS_W2T) + (size_t)(col0 + 32 * cb + l31) * 64 + 8 * h; const bf16_t* A2T = WSP(bf16_t, WS_A2T) + (size_t)(col0 + 32 * cb + l31) * 64 + 8 * h;
        const bf16_t* G2T = WSP(bf16_t, WS_G2T) + (size_t)(col0 + 32 * cb + l31) * 128 + 8 * h;
        f32x16 dw, da, dg;
#pragma unroll
        for (int r = 0; r < 16; ++r) { dw[r] = 0.f; da[r] = 0.f; dg[r] = 0.f; }
#pragma unroll
        for (int ks = 0; ks < 4; ++ks) {
            dw = __builtin_amdgcn_mfma_f32_32x32x16_bf16(frag(R1, 32 * rb + l31, ks, h), *(const bf16x8*)(W2T + 16 * ks), dw, 0, 0, 0);
            da = __builtin_amdgcn_mfma_f32_32x32x16_bf16(frag(R1 + 8192, 32 * rb + l31, ks, h), *(const bf16x8*)(A2T + 16 * ks), da, 0, 0, 0);
        }
#pragma unroll
        for (int ks = 0; ks < 8; ++ks) dg = __builtin_amdgcn_mfma_f32_32x32x16_bf16(frag(R1 + 16384 + (ks >> 2) * 8192, 32 * rb + l31, ks & 3, h), *(const bf16x8*)(G2T + 16 * ks), dg, 0, 0, 0);
        LBAR();
        const int j = 32 * cb + l31; const float w0v = p.w0[col0 + j], a0v = p.a0[col0 + j]; float* At = (float*)R1;
#pragma unroll
        for (int r = 0; r < 16; ++r) { const int t = 32 * rb + crow(r, h);
            const float wl = -softplus_fast(-(w0v + dw[r])) - 0.5f; Lg[t * 64 + j] = -__expf(wl);
            At[t * 64 + j] = sigmoidf(a0v + da[r]);
            (WSP(bf16_t, WS_G) + row0 * 512 + col0)[(size_t)t * 512 + j] = (bf16_t)f2bf(dg[r]); }
    }
    LBAR();
    {
        const int cq = tid >> 6, cj = tid & 63; float cs[16]; float run = 0.f;
#pragma unroll
        for (int u = 0; u < 16; ++u) { run += Lg[(16 * cq + u) * 64 + cj]; cs[u] = run; }
        part[cq * 64 + cj] = run; LBAR();
        float off = 0.f;
        for (int q = 0; q < cq; ++q) off += part[q * 64 + cj];
#pragma unroll
        for (int u = 0; u < 16; ++u) { Lg[(16 * cq + u) * 64 + cj] = cs[u] + off; LgG[(16 * cq + u) * 64 + cj] = cs[u] + off; }
        LBAR();
    }
    {
        const int t = tid >> 2, jr = (tid & 3) * 16;
        f32x4 av4[4];
#pragma unroll
        for (int e4 = 0; e4 < 4; ++e4) av4[e4] = *(const f32x4*)((const float*)R1 + t * 64 + jr + 4 * e4);
        LBAR();
        const bf16_t* zrow = ZRb + (size_t)t * RWKV_COLS;
        f32x4 kr4[4], kk4[4], rr4[4], ka4[4]; float ss = 0.f;
        const int tp = t > 0 ? t - 1 : 0; const float pm = t > 0 ? 1.f : 0.f;
#pragma unroll
        for (int e4 = 0; e4 < 4; ++e4) { const int j = jr + 4 * e4;
            kr4[e4] = zs4(zrow, 512 + col0 + j, p.rwkv_mu); rr4[e4] = zs4(zrow, col0 + j, p.rwkv_mu); ka4[e4] = *(const f32x4*)(p.k_a + col0 + j);
            kk4[e4] = kr4[e4] * *(const f32x4*)(p.k_k + col0 + j);
            ss += (kk4[e4].x * kk4[e4].x + kk4[e4].y * kk4[e4].y) + (kk4[e4].z * kk4[e4].z + kk4[e4].w * kk4[e4].w); }
        ss += dpp_mov<0xB1>(ss); ss += dpp_mov<0x4E>(ss);
        const float kinv = 1.f / fmaxf(sqrtf(ss), 1e-12f);
#pragma unroll
        for (int e4 = 0; e4 < 4; ++e4) {
            const int j = jr + 4 * e4;
            const f32x4 lg = *(const f32x4*)(Lg + t * 64 + j), lgp = *(const f32x4*)(Lg + tp * 64 + j) * pm;
            const f32x4 kk = kk4[e4] * kinv, kr = kr4[e4], rr = rr4[e4], ka = ka4[e4];
            const f32x4 bb = kk * av4[e4], k2 = kr * (1.f + (av4[e4] - 1.f) * ka);
            st4bf((bf16_t*)BB + (size_t)t * 512 + j, bb); st4bf((bf16_t*)K2 + (size_t)t * 512 + j, k2);
            float at[4], rt[4], bt[4], kt[4];
#pragma unroll
            for (int q = 0; q < 4; ++q) { const float en = __expf(-lg[q]); at[q] = -kk[q] * __expf(lgp[q]); rt[q] = rr[q] * __expf(lg[q]); bt[q] = bb[q] * en; kt[q] = k2[q] * en; }
            const int o = swz(t, j >> 3) + (j & 7) * 2;
            *(u32x2*)(R1 + 0 + o) = (u32x2){pk2(bt[0], bt[1]), pk2(bt[2], bt[3])};
            *(u32x2*)(R1 + 8192 + o) = (u32x2){pk2(kt[0], kt[1]), pk2(kt[2], kt[3])};
            *(u32x2*)(R1 + 16384 + o) = (u32x2){pk2(at[0], at[1]), pk2(at[2], at[3])};
            *(u32x2*)(R1 + 24576 + o) = (u32x2){pk2(rt[0], rt[1]), pk2(rt[2], rt[3])};
#pragma unroll
            for (int q = 0; q < 4; ++q) XL[(j + q) * 68 + t] = at[q];
        }
    }
    LBAR();
    {
        f32x16 tb, tk, qb, hy;
#pragma unroll
        for (int r = 0; r < 16; ++r) { tb[r] = 0.f; tk[r] = 0.f; qb[r] = 0.f; hy[r] = 0.f; }
#pragma unroll
        for (int ks = 0; ks < 4; ++ks) {
            const bf16x8 aB = frag(R1, 32 * rb + l31, ks, h), aK = frag(R1 + 8192, 32 * rb + l31, ks, h), bA = frag(R1 + 16384, 32 * cb + l31, ks, h), bR = frag(R1 + 24576, 32 * cb + l31, ks, h);
            tb = __builtin_amdgcn_mfma_f32_32x32x16_bf16(aB, bA, tb, 0, 0, 0); tk = __builtin_amdgcn_mfma_f32_32x32x16_bf16(aK, bA, tk, 0, 0, 0);
            qb = __builtin_amdgcn_mfma_f32_32x32x16_bf16(aB, bR, qb, 0, 0, 0); hy = __builtin_amdgcn_mfma_f32_32x32x16_bf16(aK, bR, hy, 0, 0, 0);
        }
        const int t = 32 * cb + l31;
#pragma unroll
        for (int r = 0; r < 16; ++r) { const int s = 32 * rb + crow(r, h); if (!(s < t)) { tb[r] = 0.f; tk[r] = 0.f; } if (!(s <= t)) { qb[r] = 0.f; hy[r] = 0.f; } }
        LBAR();
        float* TbT = (float*)R1;
#pragma unroll
        for (int g = 0; g < 4; ++g) { const int s0 = 32 * rb + 8 * g + 4 * h;
            *(f32x4*)(TbT + t * 68 + s0) = (f32x4){tb[4 * g], tb[4 * g + 1], tb[4 * g + 2], tb[4 * g + 3]};
#pragma unroll
            for (int q = 0; q < 4; ++q) XL[(64 + s0 + q) * 68 + t] = tk[4 * g + q];
            *(u32x2*)(R1 + 17408 + swz(t, 4 * rb + g) + 8 * h) = (u32x2){pk2(qb[4 * g], qb[4 * g + 1]), pk2(qb[4 * g + 2], qb[4 * g + 3])};
            *(f32x4*)(LgG + 4096 + ((wid * 4 + g) * 64 + lane) * 4) = (f32x4){hy[4 * g], hy[4 * g + 1], hy[4 * g + 2], hy[4 * g + 3]}; }
    }
    LBAR();
    {
        const int row = tid >> 1, hf = tid & 1; float* xr = XL + row * 68; const float* TbT = (const float*)R1;
        for (int bj = 0; bj < 4; ++bj) {
            float y[16];
#pragma unroll
            for (int q = 0; q < 4; ++q) { const f32x4 v = *(const f32x4*)(xr + 16 * bj + 4 * q); y[4 * q] = v.x; y[4 * q + 1] = v.y; y[4 * q + 2] = v.z; y[4 * q + 3] = v.w; }
            float acc[16];
#pragma unroll
            for (int t = 0; t < 16; ++t) acc[t] = 0.f;
            for (int bi = 0; bi < bj; ++bi) {
                float xp[8];
#pragma unroll
                for (int q = 0; q < 2; ++q) { const f32x4 v = *(const f32x4*)(xr + 16 * bi + 8 * hf + 4 * q); xp[4 * q] = v.x; xp[4 * q + 1] = v.y; xp[4 * q + 2] = v.z; xp[4 * q + 3] = v.w; }
                const float* tb0 = TbT + (16 * bj) * 68 + 16 * bi + 8 * hf;
#pragma unroll
                for (int t = 0; t < 16; ++t) { float a0 = 0.f, a1 = 0.f;
#pragma unroll
                    for (int u = 0; u < 8; u += 2) { a0 += xp[u] * tb0[t * 68 + u]; a1 += xp[u + 1] * tb0[t * 68 + u + 1]; }
                    acc[t] += a0 + a1; }
            }
#pragma unroll
            for (int t = 0; t < 16; ++t) y[t] += acc[t] + dpp_mov<0xB1>(acc[t]);
            const float* td = TbT + (16 * bj) * 68 + 16 * bj;
#pragma unroll
            for (int t = 1; t < 16; ++t) { float a0 = y[t];
#pragma unroll
                for (int u = 0; u < 16; ++u) if (u < t) a0 += y[u] * td[t * 68 + u];
                y[t] = a0; }
            if (hf == 0) {
#pragma unroll
                for (int q = 0; q < 4; ++q) *(f32x4*)(xr + 16 * bj + 4 * q) = (f32x4){y[4 * q], y[4 * q + 1], y[4 * q + 2], y[4 * q + 3]};
            }
            asm volatile("s_waitcnt lgkmcnt(0)" ::: "memory");
        }
    }
    LBAR();
    {
        const int row = tid >> 1, hf = tid & 1; const float* xr = XL + row * 68 + 32 * hf; char* dst = R1 + (row >> 6) * 8192;
#pragma unroll
        for (int c8 = 0; c8 < 4; ++c8) { const f32x4 a = *(const f32x4*)(xr + 8 * c8), bq = *(const f32x4*)(xr + 8 * c8 + 4);
            *(u32x4*)(dst + swz(row & 63, 4 * hf + c8)) = (u32x4){pk2(a.x, a.y), pk2(a.z, a.w), pk2(bq.x, bq.y), pk2(bq.z, bq.w)}; }
    }
    __syncthreads();
    {
        const int t = tid >> 2, jr = (tid & 3) * 16; char* BbT = lds + 32768; char* VT = lds + 40960;
        f32x4 lgA[4], lcA[4], bbA[4], vvA[4];
#pragma unroll
        for (int e4 = 0; e4 < 4; ++e4) { const int j = jr + 4 * e4;
            lgA[e4] = *(const f32x4*)(LgG + t * 64 + j); lcA[e4] = *(const f32x4*)(LgG + 63 * 64 + j); bbA[e4] = ld4bf(BB + (size_t)t * 512 + j); vvA[e4] = zs4(ZRb + (size_t)t * RWKV_COLS, 1024 + col0 + j, p.rwkv_mu); }
#pragma unroll
        for (int e4 = 0; e4 < 4; ++e4) {
            const int j = jr + 4 * e4;
            const f32x4 lg = lgA[e4], lc = lcA[e4], bb = bbA[e4], vv = vvA[e4];
#pragma unroll
            for (int q = 0; q < 4; ++q) { const int o2 = swz(j + q, t >> 3) + (t & 7) * 2; *(bf16_t*)(BbT + o2) = (bf16_t)f2bf(bb[q] * __expf(lc[q] - lg[q])); *(bf16_t*)(VT + o2) = (bf16_t)f2bf(vv[q]); }
        }
    }
    LBAR();
    {
        f32x16 gy, gs, hs, hy;
#pragma unroll
        for (int g = 0; g < 4; ++g) { const f32x4 q4 = *(const f32x4*)(LgG + 4096 + ((wid * 4 + g) * 64 + lane) * 4); hy[4 * g] = q4.x; hy[4 * g + 1] = q4.y; hy[4 * g + 2] = q4.z; hy[4 * g + 3] = q4.w; }
        {
            const int tq = 32 * cb + l31;
            const float lcq = LgG[63 * 64 + tq]; const float elc = __expf(lcq);
#pragma unroll
            for (int g = 0; g < 4; ++g) { const int j0 = 32 * rb + 8 * g + 4 * h; const f32x4 r4 = zs4(ZRb + (size_t)tq * RWKV_COLS, col0 + j0, p.rwkv_mu), l4 = *(const f32x4*)(LgG + tq * 64 + j0);
#pragma unroll
                for (int q = 0; q < 4; ++q) { gy[4 * g + q] = r4[q] * __expf(l4[q]); gs[4 * g + q] = (j0 + q == tq) ? elc : 0.f;
                    const int s = j0 + q; hs[4 * g + q] = ld1bf(K2 + (size_t)s * 512 + tq) * __expf(lcq - LgG[s * 64 + tq]); } }
        }
#pragma unroll
        for (int ks = 0; ks < 4; ++ks) {
            const bf16x8 aA = frag(R1, 32 * rb + l31, ks, h), aW = frag(R1 + 8192, 32 * rb + l31, ks, h), bQ = frag(R1 + 17408, 32 * cb + l31, ks, h), bB = frag(lds + 32768, 32 * cb + l31, ks, h);
            gy = __builtin_amdgcn_mfma_f32_32x32x16_bf16(aA, bQ, gy, 0, 0, 0); gs = __builtin_amdgcn_mfma_f32_32x32x16_bf16(aA, bB, gs, 0, 0, 0);
            hy = __builtin_amdgcn_mfma_f32_32x32x16_bf16(aW, bQ, hy, 0, 0, 0); hs = __builtin_amdgcn_mfma_f32_32x32x16_bf16(aW, bB, hs, 0, 0, 0);
        }
        const int cc = 32 * cb + l31;
#pragma unroll
        for (int g = 0; g < 4; ++g) { const int r0 = 32 * rb + 8 * g + 4 * h;
            *(u32x2*)(chk + swz(cc, 4 * rb + g) + 8 * h) = (u32x2){pk2(gy[4 * g], gy[4 * g + 1]), pk2(gy[4 * g + 2], gy[4 * g + 3])};
            *(u32x2*)(chk + 8192 + swz(cc, 4 * rb + g) + 8 * h) = (u32x2){pk2(gs[4 * g], gs[4 * g + 1]), pk2(gs[4 * g + 2], gs[4 * g + 3])};
            *(u32x2*)(lds + 49152 + swz(cc, 4 * rb + g) + 8 * h) = (u32x2){pk2(hs[4 * g], hs[4 * g + 1]), pk2(hs[4 * g + 2], hs[4 * g + 3])};
            *(u32x2*)(lds + 57344 + swz(cc, 4 * rb + g) + 8 * h) = (u32x2){pk2(hy[4 * g], hy[4 * g + 1]), pk2(hy[4 * g + 2], hy[4 * g + 3])}; }
    }
    LBAR();
    {
        f32x16 sl, yl;
#pragma unroll
        for (int r = 0; r < 16; ++r) { sl[r] = 0.f; yl[r] = 0.f; }
#pragma unroll
        for (int ks = 0; ks < 4; ++ks) {
            const bf16x8 aS = frag(lds + 49152, 32 * rb + l31, ks, h), aY = frag(lds + 57344, 32 * rb + l31, ks, h), bV = frag(lds + 40960, 32 * cb + l31, ks, h);
            sl = __builtin_amdgcn_mfma_f32_32x32x16_bf16(aS, bV, sl, 0, 0, 0); yl = __builtin_amdgcn_mfma_f32_32x32x16_bf16(aY, bV, yl, 0, 0, 0);
        }
#pragma unroll
        for (int q = 0; q < 2; ++q) {
            *(u32x4*)(chk + 16384 + wid * 2048 + lane * 32 + q * 16) = (u32x4){pk2(sl[8 * q], sl[8 * q + 1]), pk2(sl[8 * q + 2], sl[8 * q + 3]), pk2(sl[8 * q + 4], sl[8 * q + 5]), pk2(sl[8 * q + 6], sl[8 * q + 7])};
            *(u32x4*)(chk + 24576 + wid * 2048 + lane * 32 + q * 16) = (u32x4){pk2(yl[8 * q], yl[8 * q + 1]), pk2(yl[8 * q + 2], yl[8 * q + 3]), pk2(yl[8 * q + 4], yl[8 * q + 5]), pk2(yl[8 * q + 6], yl[8 * q + 7])}; }
    }
    LBAR();
}
DEVI void cumsum_job(const P& p, int bh, char* lds) {
    const int tid = otid(), lane = tid & 63, wid = tid >> 6, b = bh >> 3, h = bh & 7; float* part = (float*)lds;
    const float* LF = WSP(float, WS_LF) + (size_t)b * LP * 8 + h; float* CS = WSP(float, WS_CS) + (size_t)b * LP * 8 + h;
    const int r0 = tid * 33; float v[33]; float s = 0.f;
#pragma unroll
    for (int i = 0; i < 33; ++i) v[i] = (r0 + i < LP) ? LF[(size_t)(r0 + i) * 8] : 0.f;
#pragma unroll
    for (int i = 0; i < 33; ++i) s += v[i];
    part[tid] = s; LBAR();
    if (wid == 0) { const f32x4 a = *(const f32x4*)(part + 4 * lane); const float tot = (a.x + a.y) + (a.z + a.w); float inc = tot;
#pragma unroll
        for (int o = 1; o < 64; o <<= 1) { const float u = __shfl_up(inc, o); if (lane >= o) inc += u; }
        const float ex = inc - tot; *(f32x4*)(part + 4 * lane) = (f32x4){ex, ex + a.x, ex + a.x + a.y, ex + a.x + a.y + a.z}; }
    LBAR();
    float pre = part[tid];
#pragma unroll
    for (int i = 0; i < 33; ++i) { pre += v[i]; if (r0 + i < LP) CS[(size_t)(r0 + i) * 8] = pre * LOG2E; }
    LBAR();
}
DEVI void phase2c(const P& p, int bid, int nb, char* lds) {
    if (bid < 16) cumsum_job(p, bid, lds);
    for (int q = bid; q < 16 * (NCHUNK - 1); q += nb) chunk_job(p, (q >> 7) * NCHUNK + 1 + (q & 127), lds);
}

DEVI void scanB_job(const P& p, int bh, char* lds) {
    typedef __attribute__((address_space(3))) unsigned lds_u32;
    const int tid = otid(), lane = tid & 63, wid = __builtin_amdgcn_readfirstlane(tid >> 6), l31 = lane & 31, h = lane >> 5, rb = wid >> 1, cb = wid & 1;
    const int b = bh >> 3, hh = bh & 7; const int col0 = hh * 64;
    float* Yo = WSP(float, WS_Y) + ((size_t)b * LP + 64) * 512 + col0 + 32 * cb + l31;
    const char* chk = (const char*)p.ws + WS_CHK + (size_t)bh * NCHUNK * CHUNK_BYTES + wid * 8192 + lane * 16;
    f32x16 accS, accY;
#pragma unroll
    for (int r = 0; r < 16; ++r) { accS[r] = 0.f; accY[r] = 0.f; }
    auto dma = [&](int c, int slot) __attribute__((always_inline)) {
        const char* g = chk + (size_t)c * CHUNK_BYTES; char* d = lds + 8192 + slot * 32768 + wid * 8192;
#pragma unroll
        for (int i = 0; i < 8; ++i) __builtin_amdgcn_global_load_lds((const unsigned*)(g + i * 1024), (lds_u32*)(d + i * 1024), 16, 0, 0);
    };
    dma(0, 0); dma(1, 1);
    for (int c = 0; c < NCHUNK; ++c) {
        const int slot = c & 1;
        if (c + 1 < NCHUNK) asm volatile("s_waitcnt vmcnt(8)" ::: "memory"); else asm volatile("s_waitcnt vmcnt(0)" ::: "memory");
        if (c > 0) {
#pragma unroll
            for (int r = 0; r < 16; ++r) Yo[(size_t)(64 * (c - 1) + 32 * rb + crow(r, h)) * 512] = accY[r];
            asm volatile("" ::: "memory");
        }
#pragma unroll
        for (int g = 0; g < 4; ++g) *(u32x2*)(lds + swz(32 * cb + l31, 4 * rb + g) + 8 * h) = (u32x2){pk2(accS[4 * g], accS[4 * g + 1]), pk2(accS[4 * g + 2], accS[4 * g + 3])};
        asm volatile("s_waitcnt lgkmcnt(0)" ::: "memory"); __builtin_amdgcn_s_barrier(); asm volatile("" ::: "memory");
        const char* sl = lds + 8192 + slot * 32768;
        bf16x8 sb[4], gsf[4], gyf[4];
#pragma unroll
        for (int ks = 0; ks < 4; ++ks) { sb[ks] = frag(lds, 32 * cb + l31, ks, h); gyf[ks] = frag(sl, 32 * rb + l31, ks, h); gsf[ks] = frag(sl + 8192, 32 * rb + l31, ks, h); }
#pragma unroll
        for (int q = 0; q < 2; ++q) { const u32x4 ws = *(const u32x4*)(sl + 16384 + wid * 2048 + lane * 32 + q * 16), wy = *(const u32x4*)(sl + 24576 + wid * 2048 + lane * 32 + q * 16);
#pragma unroll
            for (int j = 0; j < 4; ++j) { accS[8 * q + 2 * j] = __uint_as_float(ws[j] << 16); accS[8 * q + 2 * j + 1] = __uint_as_float(ws[j] & 0xffff0000u);
                accY[8 * q + 2 * j] = __uint_as_float(wy[j] << 16); accY[8 * q + 2 * j + 1] = __uint_as_float(wy[j] & 0xffff0000u); } }
#pragma unroll
        for (int ks = 0; ks < 4; ++ks) { accS = __builtin_amdgcn_mfma_f32_32x32x16_bf16(gsf[ks], sb[ks], accS, 0, 0, 0); accY = __builtin_amdgcn_mfma_f32_32x32x16_bf16(gyf[ks], sb[ks], accY, 0, 0, 0); }
        asm volatile("s_waitcnt lgkmcnt(0)" ::: "memory"); __builtin_amdgcn_s_barrier(); asm volatile("" ::: "memory");
        if (c + 2 < NCHUNK) dma(c + 2, slot);
    }
#pragma unroll
    for (int r = 0; r < 16; ++r) Yo[(size_t)(64 * (NCHUNK - 1) + 32 * rb + crow(r, h)) * 512] = accY[r];
}

DEVI void phase4a(const P& p, int bid, int nb, char*) {
    const int tid = otid(), lane = tid & 63, wid = tid >> 6;
    for (int row = bid * 4 + wid; row < NP; row += nb * 4) {
        const bool pad = (row % LP) < PADL + NMETA;
#pragma unroll
        for (int j = 0; j < 2; ++j) {
            const int c = lane * 4 + 256 * j; const size_t o = (size_t)row * 512 + c;
            u32x2 outv = (u32x2){0u, 0u};
            if (!pad) {
                const bf16_t* zrow = WSP(bf16_t, WS_ZR) + (size_t)row * RWKV_COLS;
                const f32x4 y = *(const f32x4*)(WSP(float, WS_Y) + o), r = zs4(zrow, c, p.rwkv_mu), k2 = ld4bf(WSP(bf16_t, WS_RK2) + o), v = zs4(zrow, 1024 + c, p.rwkv_mu), g = ld4bf(WSP(bf16_t, WS_G) + o);
                const f32x4 rk = *(const f32x4*)(p.r_k + c), lg = *(const f32x4*)(p.lnx_g + c), lb = *(const f32x4*)(p.lnx_b + c);
                const float mu = sum16((y.x + y.y) + (y.z + y.w)) * (1.f / 64.f);
                const f32x4 dy = y - mu;
                const float var = sum16((dy.x * dy.x + dy.y * dy.y) + (dy.z * dy.z + dy.w * dy.w)) * (1.f / 64.f);
                const float rs = rsqrtf(var + GN_EPS);
                const float bonus = sum16((r.x * k2.x * rk.x + r.y * k2.y * rk.y) + (r.z * k2.z * rk.z + r.w * k2.w * rk.w));
                const f32x4 ov = (dy * rs * lg + lb + bonus * v) * g;
                outv = (u32x2){pk2(ov.x, ov.y), pk2(ov.z, ov.w)};
            }
            *(u32x2*)(WSP(bf16_t, WS_MIX) + (size_t)row * 1024 + 512 + c) = outv;
        }
    }
}

struct EpiOutProj {
    const P& p; int tm, tn;
    DEVI void operator()(f32x4 (&acc)[4][4], int wm, int wn, int l15, int lq) const {
#pragma unroll
        for (int mt = 0; mt < 4; ++mt) { const size_t row = (size_t)tm * 128 + wm * 64 + mt * 16 + l15;
#pragma unroll
            for (int nt = 0; nt < 4; ++nt) { const size_t o = row * 1024 + tn * 128 + wn * 64 + nt * 16 + 4 * lq;
                const u32x2 w = *(const u32x2*)(WSP(bf16_t, WS_H0B) + o);
                const f32x4 h0 = (f32x4){__uint_as_float(w.x << 16), __uint_as_float(w.x & 0xffff0000u), __uint_as_float(w.y << 16), __uint_as_float(w.y & 0xffff0000u)};
                *(f32x4*)(WSP(float, WS_PRE1) + o) = h0 * ALPHA + acc[mt][nt]; } }
    }
};
DEVI void phase4b(const P& p, const Sched& sc, char* lds) {
    const int tid = otid(), srow = 16 * (tid >> 6) + ((tid & 63) >> 2);
    for_xcd_items(sc, [&](int x, int rank, int nloc) __attribute__((always_inline)) {
        const int r0 = 16 * x;
        for (int i = rank; i < 16 * 8; i += nloc) {
            const int tr = r0 + (i >> 3), tn = i & 7, tm = (tr >> 6) * NQB + 1 + (tr & 63);
            const bf16_t *ap[4], *bp[2];
#pragma unroll
            for (int q = 0; q < 2; ++q) { ap[q] = WSP(bf16_t, WS_MIX) + (size_t)(tm * 128 + srow + 64 * q) * 1024; bp[q] = WSP(bf16_t, WS_WOUTT) + (size_t)(tn * 128 + srow + 64 * q) * 1024; }
            ap[2] = ap[3] = ap[0];
            gemm256<false, 4>(ap, bp, 1024, lds, EpiOutProj{p, tm, tn});
        }
    });
}

DEVI void phase4c(const P& p, int bid, int nb, char* lds) {
    const int tid = otid(), lane = tid & 63, wid = tid >> 6;
    const int e = tid & 31, ks = tid >> 5;
    float* hrow = (float*)lds;
    float* part = (float*)(lds + 16384);
    unsigned* cnt = WSP(unsigned, WS_CTL) + CW_CNT;
    float wreg[128];
#pragma unroll
    for (int k = 0; k < 128; ++k) wreg[k] = p.w_router[(size_t)(ks * 128 + k) * 32 + e];
    const float br = p.b_router[e];
    for (int base = bid * 4; base < NP; base += nb * 4) {
        const int row = base + wid;
        const bool pad = (row % LP) < PADL + NMETA;
        {
            u32x2* hb = (u32x2*)(WSP(bf16_t, WS_H1B) + (size_t)row * 1024) + lane;
            if (pad) {
#pragma unroll
                for (int j = 0; j < 4; ++j) { hb[64 * j] = (u32x2){0u, 0u}; *(f32x4*)(hrow + wid * 1024 + lane * 4 + 256 * j) = (f32x4){0.f, 0.f, 0.f, 0.f}; }
            } else {
                const f32x4* src = (const f32x4*)(WSP(float, WS_PRE1) + (size_t)row * 1024) + lane;
                f32x4 v[4]; float s = 0.f;
#pragma unroll
                for (int j = 0; j < 4; ++j) { v[j] = src[64 * j]; s += (v[j].x + v[j].y) + (v[j].z + v[j].w); }
                const float mean = wave_sum(s) * (1.f / 1024.f); float s2 = 0.f;
#pragma unroll
                for (int j = 0; j < 4; ++j) { v[j] = v[j] - mean; s2 += (v[j].x * v[j].x + v[j].y * v[j].y) + (v[j].z * v[j].z + v[j].w * v[j].w); }
                const float rstd = rsqrtf(wave_sum(s2) * (1.f / 1024.f) + LN_EPS);
                if (lane == 0) { WSP(float, WS_ST1)[(size_t)row * 2] = mean; WSP(float, WS_ST1)[(size_t)row * 2 + 1] = rstd; }
#pragma unroll
                for (int j = 0; j < 4; ++j) {
                    const f32x4 g = ((const f32x4*)p.ln1_g)[lane + 64 * j], bb = ((const f32x4*)p.ln1_b)[lane + 64 * j];
                    const f32x4 o = v[j] * rstd * g + bb;
                    hb[64 * j] = (u32x2){pk2(o.x, o.y), pk2(o.z, o.w)};
                    *(f32x4*)(hrow + wid * 1024 + lane * 4 + 256 * j) = o;
                }
            }
        }
        LBAR();
        {
            float a0 = 0.f, a1 = 0.f, a2 = 0.f, a3 = 0.f;
            const float* h0 = hrow + ks * 128;
#pragma unroll
            for (int k = 0; k < 128; k += 4) {
                const f32x4 x0 = *(const f32x4*)(h0 + k), x1 = *(const f32x4*)(h0 + 1024 + k), x2 = *(const f32x4*)(h0 + 2048 + k), x3 = *(const f32x4*)(h0 + 3072 + k);
#pragma unroll
                for (int q = 0; q < 4; ++q) { a0 += wreg[k + q] * x0[q]; a1 += wreg[k + q] * x1[q]; a2 += wreg[k + q] * x2[q]; a3 += wreg[k + q] * x3[q]; }
            }
            part[(0 * 8 + ks) * 32 + e] = a0; part[(1 * 8 + ks) * 32 + e] = a1; part[(2 * 8 + ks) * 32 + e] = a2; part[(3 * 8 + ks) * 32 + e] = a3;
        }
        LBAR();
        {
            const int ee = lane & 31;
            float logit = br;
#pragma unroll
            for (int q = 0; q < 8; ++q) logit += part[(wid * 8 + q) * 32 + ee];
            float cur = logit; float tv[4]; int ti[4];
#pragma unroll
            for (int k = 0; k < 4; ++k) {
                float bv = cur; int bi = ee;
#pragma unroll
                for (int o = 16; o > 0; o >>= 1) { const float ov = __shfl_xor(bv, o); const int oi = __shfl_xor(bi, o); if (ov > bv || (ov == bv && oi < bi)) { bv = ov; bi = oi; } }
                tv[k] = bv; ti[k] = bi; if (ee == bi) cur = -INFINITY;
            }
            const float e1 = __expf(tv[1] - tv[0]), e2 = __expf(tv[2] - tv[0]), e3 = __expf(tv[3] - tv[0]); const float inv = 1.f / (1.f + e1 + e2 + e3);
            if (lane < 4 && !pad) {
                const int ex = lane == 0 ? ti[0] : lane == 1 ? ti[1] : lane == 2 ? ti[2] : ti[3];
                const float gt = (lane == 0 ? 1.f : lane == 1 ? e1 : lane == 2 ? e2 : e3) * inv;
                const unsigned rank = atomicAdd(cnt + ex, 1u);
                WSP(int, WS_LTOK)[(size_t)ex * CAP + rank] = row; WSP(float, WS_LGATE)[(size_t)ex * CAP + rank] = gt;
                WSP(int, WS_RTE)[(size_t)row * 4 + lane] = ex; WSP(int, WS_RTR)[(size_t)row * 4 + lane] = (int)rank;
            }
        }
    }
}

struct MoeTab { int* rb; int* cn; int* nf; int* ng; };
DEVI MoeTab moe_prefix(const P& p, char* lds) {
    MoeTab t; t.rb = (int*)(lds + LX); t.cn = t.rb + 33; t.nf = t.cn + 32; t.ng = t.nf + 32;
    if (threadIdx.x == 0) { const unsigned* cnt = WSP(unsigned, WS_CTL) + CW_CNT; int acc = 0;
        for (int e = 0; e < NEXP; ++e) { const int c = (int)cnt[e]; int f = c >> 8, g = 0; const int rem = c & 255; if (rem > 128) ++f; else g = (rem + 63) >> 6;
            t.cn[e] = c; t.nf[e] = f; t.ng[e] = g; t.rb[e] = acc; acc += f * 256 + g * 64; }
        t.rb[NEXP] = acc; }
    __syncthreads();
    return t;
}

template <int MT> struct EpiGU {
    const P& p; int e, row0, tn;
    DEVI void operator()(f32x4 (&acc)[MT][4], int wm, int wn, int l15, int lq) const {
        const float* bg = p.b_gu + (size_t)e * 2048;
#pragma unroll
        for (int mt = 0; mt < MT; ++mt) { const size_t row = (size_t)row0 + wm * (16 * MT) + mt * 16 + l15;
#pragma unroll
            for (int np = 0; np < 2; ++np) { const int jc = tn * 64 + wn * 32 + np * 16 + 4 * lq;
                const f32x4 bgt = *(const f32x4*)(bg + jc), bup = *(const f32x4*)(bg + 1024 + jc); float ov[4];
#pragma unroll
                for (int r = 0; r < 4; ++r) { const float gate = fminf(acc[mt][2 * np][r] + bgt[r], 7.f); const float up = fminf(fmaxf(acc[mt][2 * np + 1][r] + bup[r], -7.f), 7.f);
                    ov[r] = (up + 1.f) * (gate * sigmoidf(gate * 1.702f)); }
                *(u32x2*)(WSP(bf16_t, WS_ACT) + row * 1024 + jc) = (u32x2){pk2(ov[0], ov[1]), pk2(ov[2], ov[3])}; } }
    }
};
template <int MT> struct EpiDown {
    const P& p; int e, row0, idx0, cnt_e, tn;
    DEVI void operator()(f32x4 (&acc)[MT][4], int wm, int wn, int l15, int lq) const {
        const float* bd = p.b_down + (size_t)e * 1024;
#pragma unroll
        for (int mt = 0; mt < MT; ++mt) { const int ml = wm * (16 * MT) + mt * 16 + l15; const int idx = idx0 + ml; const float gt = idx < cnt_e ? WSP(float, WS_LGATE)[(size_t)e * CAP + idx] : 0.f;
            const size_t row = (size_t)row0 + ml;
#pragma unroll
            for (int nt = 0; nt < 4; ++nt) { const int c = tn * 128 + wn * 64 + nt * 16 + 4 * lq; const f32x4 o = (acc[mt][nt] + *(const f32x4*)(bd + c)) * gt; *(u32x2*)(WSP(bf16_t, WS_YB) + row * 1024 + c) = (u32x2){pk2(o.x, o.y), pk2(o.z, o.w)}; } }
    }
};
template <int NT, class FullFn, class SmallFn>
DEVI void moe_items(const MoeTab& T, int x, int rank, int nloc, FullFn&& full, SmallFn&& small) {
    const int f0 = T.nf[x], f1 = f0 + T.nf[x + 8], f2 = f1 + T.nf[x + 16], f3 = f2 + T.nf[x + 24];
    const int g0 = T.ng[x], g1 = g0 + T.ng[x + 8], g2 = g1 + T.ng[x + 16], g3 = g2 + T.ng[x + 24];
    for (int i = rank; i < (f3 + g3) * NT; i += nloc) {
        if (i < f3 * NT) { const int rbk = i / NT, tn = i % NT; const int j = rbk < f0 ? 0 : rbk < f1 ? 1 : rbk < f2 ? 2 : 3; const int e = x + 8 * j, mb = rbk - (j == 0 ? 0 : j == 1 ? f0 : j == 2 ? f1 : f2);
            full(e, mb * 256, tn); }
        else { const int k = i - f3 * NT, gk = k / NT, tn = k % NT; const int j = gk < g0 ? 0 : gk < g1 ? 1 : gk < g2 ? 2 : 3; const int e = x + 8 * j, gi = gk - (j == 0 ? 0 : j == 1 ? g0 : j == 2 ? g1 : g2);
            small(e, T.nf[e] * 256 + gi * 64, tn); }
    }
}
DEVI void phase5(const P& p, const Sched& sc, char* lds) {
    const MoeTab T = moe_prefix(p, lds);
    const int tid = otid(), lane = tid & 63, wid = tid >> 6, srow = 16 * wid + (lane >> 2);
    for_xcd_items(sc, [&](int x, int rank, int nloc) __attribute__((always_inline)) {
        moe_items<16>(T, x, rank, nloc,
            [&](int e, int idx0, int tn) __attribute__((always_inline)) {
                const bf16_t *ap[4], *bp[2];
#pragma unroll
                for (int q = 0; q < 4; ++q) { const int idx = idx0 + srow + 64 * q; const int tok = idx < T.cn[e] ? WSP(int, WS_LTOK)[(size_t)e * CAP + idx] : 0; ap[q] = WSP(bf16_t, WS_H1B) + (size_t)tok * 1024; }
#pragma unroll
                for (int q = 0; q < 2; ++q) bp[q] = WSP(bf16_t, WS_WGUT) + ((size_t)e * 2048 + tn * 128 + srow + 64 * q) * 1024;
                gemm256<false, 8>(ap, bp, 1024, lds, EpiGU<8>{p, e, T.rb[e] + idx0, tn}); },
            [&](int e, int idx0, int tn) __attribute__((always_inline)) {
                const bf16_t *ap[4], *bp[2];
                { const int idx = idx0 + srow; const int tok = idx < T.cn[e] ? WSP(int, WS_LTOK)[(size_t)e * CAP + idx] : 0; ap[0] = WSP(bf16_t, WS_H1B) + (size_t)tok * 1024; ap[1] = ap[2] = ap[3] = ap[0]; }
#pragma unroll
                for (int q = 0; q < 2; ++q) bp[q] = WSP(bf16_t, WS_WGUT) + ((size_t)e * 2048 + tn * 128 + srow + 64 * q) * 1024;
                gemm256<false, 2>(ap, bp, 1024, lds, EpiGU<2>{p, e, T.rb[e] + idx0, tn}); });
    });
}
DEVI void phase6(const P& p, const Sched& sc, char* lds) {
    const MoeTab T = moe_prefix(p, lds);
    const int tid = otid(), lane = tid & 63, wid = tid >> 6, srow = 16 * wid + (lane >> 2);
    for_xcd_items(sc, [&](int x, int rank, int nloc) __attribute__((always_inline)) {
        moe_items<8>(T, x, rank, nloc,
            [&](int e, int idx0, int tn) __attribute__((always_inline)) {
                const bf16_t *ap[4], *bp[2];
#pragma unroll
                for (int q = 0; q < 4; ++q) ap[q] = WSP(bf16_t, WS_ACT) + ((size_t)T.rb[e] + idx0 + srow + 64 * q) * 1024;
#pragma unroll
                for (int q = 0; q < 2; ++q) bp[q] = WSP(bf16_t, WS_WDT) + ((size_t)e * 1024 + tn * 128 + srow + 64 * q) * 1024;
                gemm256<false, 8>(ap, bp, 1024, lds, EpiDown<8>{p, e, T.rb[e] + idx0, idx0, T.cn[e], tn}); },
            [&](int e, int idx0, int tn) __attribute__((always_inline)) {
                const bf16_t *ap[4], *bp[2];
                ap[0] = WSP(bf16_t, WS_ACT) + ((size_t)T.rb[e] + idx0 + srow) * 1024; ap[1] = ap[2] = ap[3] = ap[0];
#pragma unroll
                for (int q = 0; q < 2; ++q) bp[q] = WSP(bf16_t, WS_WDT) + ((size_t)e * 1024 + tn * 128 + srow + 64 * q) * 1024;
                gemm256<false, 2>(ap, bp, 1024, lds, EpiDown<2>{p, e, T.rb[e] + idx0, idx0, T.cn[e], tn}); });
    });
}
DEVI void phase7(const P& p, int bid, int nb, char* lds) {
    const MoeTab T = moe_prefix(p, lds);
    const int tid = otid(), lane = tid & 63, wid = tid >> 6;
    for (int row = bid * 4 + wid; row < NP; row += nb * 4) {
        const int b = row / LP, pp = row % LP; if (pp < PADL + NMETA) continue;
        const int t = pp - PADL - NMETA;
        const f32x4* pre = (const f32x4*)(WSP(float, WS_PRE1) + (size_t)row * 1024) + lane;
        const float mean1 = WSP(float, WS_ST1)[(size_t)row * 2], rstd1 = WSP(float, WS_ST1)[(size_t)row * 2 + 1];
        f32x4 v[4];
#pragma unroll
        for (int j = 0; j < 4; ++j) v[j] = ((pre[64 * j] - mean1) * rstd1 * ((const f32x4*)p.ln1_g)[lane + 64 * j] + ((const f32x4*)p.ln1_b)[lane + 64 * j]) * ALPHA;
#pragma unroll
        for (int k = 0; k < 4; ++k) { const int e = WSP(int, WS_RTE)[(size_t)row * 4 + k], rk = WSP(int, WS_RTR)[(size_t)row * 4 + k];
            const u32x2* yb = (const u32x2*)(WSP(bf16_t, WS_YB) + ((size_t)T.rb[e] + rk) * 1024) + lane;
#pragma unroll
            for (int j = 0; j < 4; ++j) { const u32x2 w = yb[64 * j]; v[j] += (f32x4){__uint_as_float(w.x << 16), __uint_as_float(w.x & 0xffff0000u), __uint_as_float(w.y << 16), __uint_as_float(w.y & 0xffff0000u)}; } }
        float s = 0.f;
#pragma unroll
        for (int j = 0; j < 4; ++j) s += (v[j].x + v[j].y) + (v[j].z + v[j].w);
        const float mean = wave_sum(s) * (1.f / 1024.f); float s2 = 0.f;
#pragma unroll
        for (int j = 0; j < 4; ++j) { v[j] = v[j] - mean; s2 += (v[j].x * v[j].x + v[j].y * v[j].y) + (v[j].z * v[j].z + v[j].w * v[j].w); }
        const float rstd = rsqrtf(wave_sum(s2) * (1.f / 1024.f) + LN_EPS);
        f32x4* o = (f32x4*)(p.out + ((size_t)b * SEQ + t) * 1024) + lane;
#pragma unroll
        for (int j = 0; j < 4; ++j) o[64 * j] = v[j] * rstd * ((const f32x4*)p.ln2_g)[lane + 64 * j] + ((const f32x4*)p.ln2_b)[lane + 64 * j];
    }
}

#define LAS __attribute__((address_space(3)))
#define XB_TMO      128
#define XB_XCNT(j)  (256  + 64 * (j))
#define XB_XSUB(j)  (1280 + 64 * (j))
#define XB_XGEN(j)  (2304 + 64 * (j))
#define XB_TOP      3328
#define XB_TOPGEN   3392
#define XCD_BAR_WORDS 3456
#define XB_SPIN_CAP (1u << 18)
__device__ __forceinline__ unsigned xb_ld(unsigned* p)              { return __hip_atomic_load(p, __ATOMIC_RELAXED, __HIP_MEMORY_SCOPE_AGENT); }
__device__ __forceinline__ unsigned xb_add(unsigned* p, unsigned v) { return __hip_atomic_fetch_add(p, v, __ATOMIC_RELAXED, __HIP_MEMORY_SCOPE_AGENT); }
__device__ __forceinline__ unsigned xb_xcc_id() { return (unsigned)__builtin_amdgcn_s_getreg((3 << 11) | 20) & 0xFu; }
#define XB_SPIN(cond, bar) do { unsigned _sp = 0; while (cond) { __builtin_amdgcn_s_sleep(1); \
    if ((++_sp & 255u) == 0u) { if (xb_ld(&(bar)[XB_TMO])) break; if (_sp > XB_SPIN_CAP) { atomicAdd(&(bar)[XB_TMO], 1u); break; } } } } while (0)
struct XcdBarrier { unsigned* bar; unsigned x; volatile LAS unsigned* st; };
__device__ __forceinline__ XcdBarrier xcd_barrier_post(unsigned* bar, volatile LAS unsigned* st) {
    XcdBarrier b; b.bar = bar; b.x = xb_xcc_id(); b.st = st;
    if (threadIdx.x == 0) (void)xb_add(&bar[XB_XCNT(b.x)], 1u);
    return b;
}
__device__ __forceinline__ void xcd_barrier_complete(unsigned* bar, unsigned x, unsigned& nloc, unsigned& nx) {
    const unsigned G = gridDim.x * gridDim.y * gridDim.z;
    unsigned sum, cnt, mine, sp = 0u;
    for (;;) {
        sum = 0u; cnt = 0u; mine = 0u;
#pragma unroll
        for (unsigned j = 0; j < 16; ++j) { const unsigned c = xb_ld(&bar[XB_XCNT(j)]); sum += c; cnt += (c > 0u) ? 1u : 0u; mine = (j == x) ? c : mine; }
        if (sum == G) break;
        __builtin_amdgcn_s_sleep(1);
        if ((++sp & 255u) == 0u) { if (xb_ld(&bar[XB_TMO])) break; if (sp > XB_SPIN_CAP) { atomicAdd(&bar[XB_TMO], 1u); break; } }
    }
    nloc = mine > 0u ? mine : 1u; nx = cnt > 0u ? cnt : 1u;
}
__device__ __forceinline__ void xcd_barrier(const XcdBarrier& b) {
    asm volatile("s_waitcnt vmcnt(0)" ::: "memory");
    __syncthreads();
    if (threadIdx.x == 0) {
        unsigned* bar = b.bar;
        __builtin_amdgcn_s_waitcnt(0);
        unsigned nloc = b.st[0], nx = b.st[1];
        if (nloc == 0u) { xcd_barrier_complete(bar, b.x, nloc, nx); b.st[0] = nloc; b.st[1] = nx; }
        const unsigned old = xb_add(&bar[XB_XSUB(b.x)], 1u);
        const unsigned gen = old / nloc;
        if (old + 1u == (gen + 1u) * nloc) {
            __builtin_amdgcn_fence(__ATOMIC_RELEASE, "agent");
            asm volatile("s_waitcnt vmcnt(0)" ::: "memory");
            const unsigned og = xb_add(&bar[XB_TOP], 1u);
            const unsigned tg = og / nx;
            if (og + 1u == (tg + 1u) * nx) xb_add(&bar[XB_TOPGEN], 1u);
            else XB_SPIN(xb_ld(&bar[XB_TOPGEN]) == tg, bar);
            __builtin_amdgcn_fence(__ATOMIC_ACQUIRE, "agent");
            xb_add(&bar[XB_XGEN(b.x)], 1u);
            asm volatile("s_waitcnt vmcnt(0)" ::: "memory");
        } else {
            XB_SPIN(xb_ld(&bar[XB_XGEN(b.x)]) == gen, bar);
            __builtin_amdgcn_fence(__ATOMIC_ACQUIRE, "agent");
            asm volatile("s_waitcnt vmcnt(0)" ::: "memory");
        }
    }
    __syncthreads();
}

namespace cg = cooperative_groups;
constexpr int CW_BAR = 4096;
constexpr size_t CTL_ZERO_BYTES = 65536;
constexpr int N_SCAN_JOBS = 16, N_ATT_ITEMS = 16 * (NQB - 1);
DEVI void phase3(const P& p, char* lds, int qoff) {
    int* s_item = (int*)(lds + LX + 992);
    unsigned* q = WSP(unsigned, WS_CTL) + CW_QATT + qoff;
    for (;;) {
        if (threadIdx.x == 0) *s_item = (int)atomicAdd(q, 1u);
        __syncthreads();
        const int it = __builtin_amdgcn_readfirstlane(*s_item);
        __syncthreads();
        if (it >= N_SCAN_JOBS + N_ATT_ITEMS + N_CONV_ITEMS) break;
        if (it < N_SCAN_JOBS) {
            chunk_job(p, it * NCHUNK, lds);
            __threadfence(); __syncthreads();
            __builtin_amdgcn_s_setprio(3); scanB_job(p, it, lds); __builtin_amdgcn_s_setprio(0); continue; }
        const int r = it - N_SCAN_JOBS; int a;
        if (r < 3 * N_CONV_ITEMS) { if (r % 3 == 2) { conv_moe_item(p, r / 3, lds); continue; } a = 2 * (r / 3) + (r % 3); }
        else a = r - N_CONV_ITEMS;
        { const int qb = NQB - 1 - a / 16, bh = a % 16; attn_item(p, bh >> 3, bh & 7, qb, lds); }
    }
}
__global__ void __launch_bounds__(256, 2) k_mega(P p) {
    __shared__ __attribute__((aligned(16))) char lds[LDS_BYTES];
    const int bid = blockIdx.x, nb = gridDim.x;
    volatile LAS unsigned* st = (volatile LAS unsigned*)(LAS char*)(lds + LX + 1008);
    if (threadIdx.x < 2) st[threadIdx.x] = 0u;
    __syncthreads();
    if (p.ws == nullptr) cg::this_grid().sync();
    const XcdBarrier bar = xcd_barrier_post(WSP(unsigned, WS_CTL) + CW_BAR, st);
    int* s_rank = (int*)(lds + LX + 976);
    if (threadIdx.x == 0) *s_rank = (int)atomicAdd(WSP(unsigned, WS_CTL) + CW_XRANK + 64 * (bar.x & 15), 1u);
#ifndef PROBE_MASK
#define PROBE_MASK 0
#endif
#define RUNP(k, call) do { call; if (PROBE_MASK & (1 << (k))) { xcd_barrier(bar); call; } } while (0)
    RUNP(0, phase0(p, bid, nb, lds));  xcd_barrier(bar);
    Sched sc;
    { const int nloc = __builtin_amdgcn_readfirstlane((int)st[0]), nx = __builtin_amdgcn_readfirstlane((int)st[1]), rk = __builtin_amdgcn_readfirstlane(*s_rank); const bool ok = nx == 8 && bar.x < 8 && rk < nloc;
      sc.x = ok ? (int)bar.x : 0; sc.rank = ok ? rk : bid; sc.nloc = ok ? nloc : nb; sc.nxcd = ok ? 8 : 0; }
    RUNP(1, phase1(p, sc, lds));  xcd_barrier(bar);
    RUNP(4, phase2c(p, bid, nb, lds)); xcd_barrier(bar);
    phase3(p, lds, 0); if (PROBE_MASK & (1 << 5)) { xcd_barrier(bar); phase3(p, lds, 64); } xcd_barrier(bar);
    RUNP(6, phase4a(p, bid, nb, lds)); xcd_barrier(bar);
    RUNP(7, phase4b(p, sc, lds)); xcd_barrier(bar);
    phase4c(p, bid, nb, lds); xcd_barrier(bar);
    RUNP(9, phase5(p, sc, lds));  xcd_barrier(bar);
    RUNP(10, phase6(p, sc, lds));  xcd_barrier(bar);
    RUNP(11, phase7(p, bid, nb, lds));
}

extern "C" void kernel_launch(void* const* d_in, const int* in_sizes, int n_in, void* d_out, int out_size, void* d_ws, size_t ws_size, hipStream_t stream) {
    if (n_in != 29 || ws_size < WS_NEED) { fprintf(stderr, "kernel_launch: unexpected n_in %d or ws_size %zu (need %zu)\n", n_in, ws_size, (size_t)WS_NEED); return; }
    static int grid_blocks = 0;
    if (!grid_blocks) {
        int dev = 0, cus = 0, per_cu = 0;
        (void)hipGetDevice(&dev);
        (void)hipDeviceGetAttribute(&cus, hipDeviceAttributeMultiprocessorCount, dev);
        (void)hipOccupancyMaxActiveBlocksPerMultiprocessor(&per_cu, k_mega, 256, 0);
        if (per_cu > 2) per_cu = 2;
        grid_blocks = cus * per_cu;
        if (grid_blocks <= 0) { fprintf(stderr, "kernel_launch: occupancy query gave %d x %d\n", cus, per_cu); grid_blocks = 0; return; }
    }
    (void)hipMemsetAsync((char*)d_ws + WS_CTL, 0, CTL_ZERO_BYTES, stream);
    P p{};
    const float** pf = (const float**)&p;
    for (int i = 0; i < 29; ++i) pf[i] = (const float*)d_in[i];
    p.out = (float*)d_out; p.ws = (unsigned char*)d_ws;
    void* args[] = {&p};
    hipError_t e = hipLaunchCooperativeKernel((void*)k_mega, dim3(grid_blocks), dim3(256), args, 0, stream);
    if (e != hipSuccess) fprintf(stderr, "cooperative launch failed: %s (grid %d)\n", hipGetErrorString(e), grid_blocks);
}
```

```cpp
#include <hip/hip_runtime.h>
#include <hip/hip_cooperative_groups.h>
#include <stdint.h>
#include <stdio.h>

#define DEVI __device__ __forceinline__
typedef unsigned short bf16_t;
typedef short bf16x8 __attribute__((ext_vector_type(8)));
typedef float f32x4 __attribute__((ext_vector_type(4)));
typedef float f32x16 __attribute__((ext_vector_type(16)));
typedef unsigned u32x4 __attribute__((ext_vector_type(4)));
typedef unsigned u32x2 __attribute__((ext_vector_type(2)));

constexpr int BATCH = 2, SEQ = 8192, DM = 1024, NMETA = 16;
constexpr int LTOK = SEQ + NMETA;
constexpr int PADL = 112;
constexpr int LP = LTOK + PADL;
constexpr int NP = BATCH * LP;
constexpr int NQB = LP / 128;
constexpr int NH = 8, HD = 64;
constexpr int FOXW = 512, RWW = 512;
constexpr int RWKV_COLS = 1792;
constexpr int IN_COLS = 3336;
constexpr int WIN_N = 3456;
constexpr int NEXP = 32, TOPK = 4;
constexpr int CAP = BATCH * LTOK;
constexpr int MAXBLK = (BATCH * LTOK * TOPK) / 256 + NEXP + 1;
constexpr float ALPHA = 1.189207115002721f;
constexpr float LN_EPS = 1e-5f, GN_EPS = 64e-5f, RMS_EPS = 1e-6f;
constexpr float LOG2E = 1.4426950408889634f;
constexpr float QSCALE = 0.125f * LOG2E;
constexpr float NEGBIG = -1e30f;

constexpr size_t MiB = 1u << 20;
constexpr size_t al256(size_t x) { return (x + 255) & ~(size_t)255; }
constexpr size_t WS_CTL = 0;
constexpr size_t WS_WINT = 1 * MiB;
constexpr size_t WS_WOUTT = WS_WINT + (size_t)WIN_N * 1024 * 2;
constexpr size_t WS_W2T = WS_WOUTT + (size_t)1024 * 1024 * 2;
constexpr size_t WS_A2T = WS_W2T + 512 * 64 * 2;
constexpr size_t WS_G2T = WS_A2T + 512 * 64 * 2;
constexpr size_t WS_WGUT = al256(WS_G2T + 512 * 128 * 2);
constexpr size_t WS_WDT = WS_WGUT + (size_t)32 * 2048 * 1024 * 2;
constexpr size_t WS_ST1 = WS_WDT + (size_t)32 * 1024 * 1024 * 2;
constexpr size_t WS_H1B = WS_ST1 + (size_t)NP * 2 * 4;
constexpr size_t WS_RTE = WS_H1B + (size_t)NP * 1024 * 2;
constexpr size_t WS_RTR = WS_RTE + (size_t)NP * 16;
constexpr size_t WS_LTOK = WS_RTR + (size_t)NP * 16;
constexpr size_t WS_LGATE = WS_LTOK + (size_t)32 * CAP * 4;
constexpr size_t WS_PRE1 = al256(WS_LGATE + (size_t)32 * CAP * 4);
constexpr size_t WS_EARLY = WS_PRE1 + (size_t)NP * 1024 * 4;
constexpr size_t WS_H0B = WS_EARLY;
constexpr size_t WS_QB = WS_H0B + (size_t)NP * 1024 * 2;
constexpr size_t WS_KB = WS_QB + (size_t)NP * 512 * 2;
constexpr size_t WS_VT = WS_KB + (size_t)NP * 512 * 2;
constexpr size_t WS_ZR = WS_VT + (size_t)NP * 512 * 2;
constexpr size_t WS_LF = WS_ZR + (size_t)NP * 1792 * 4;
constexpr size_t WS_CS = WS_LF + (size_t)NP * 8 * 4;
constexpr size_t WS_R = WS_CS + (size_t)NP * 8 * 4;
constexpr size_t WS_CHK = WS_R;
static_assert((size_t)16 * 129 * 32768 <= (size_t)4 * NP * 512 * 2, "chunk buffers fit");
constexpr size_t WS_KR = WS_R + (size_t)NP * 512 * 2;
constexpr size_t WS_VR = WS_KR + (size_t)NP * 512 * 2;
constexpr size_t WS_KK = WS_VR + (size_t)NP * 512 * 2;
constexpr size_t WS_TW = WS_KK + (size_t)NP * 512 * 2;
constexpr size_t WS_DA = WS_TW + (size_t)NP * 64 * 2;
constexpr size_t WS_SG = WS_DA + (size_t)NP * 64 * 2;
constexpr size_t WS_RW = WS_SG + (size_t)NP * 128 * 2;
constexpr size_t WS_RB = WS_RW + (size_t)NP * 512 * 4;
constexpr size_t WS_RK2 = WS_RB + (size_t)NP * 512 * 2;
constexpr size_t WS_G = WS_RK2 + (size_t)NP * 512 * 2;
constexpr size_t WS_Y = WS_G + (size_t)NP * 512 * 2;
constexpr size_t WS_MIX = WS_Y + (size_t)NP * 512 * 4;
constexpr size_t WS_LGS = WS_MIX + (size_t)NP * 1024 * 2;
constexpr size_t WS_EARLY_END = WS_LGS + (size_t)1024 * 49152;
constexpr size_t WS_ACT = WS_EARLY;
constexpr size_t WS_YB = WS_ACT + (size_t)MAXBLK * 256 * 1024 * 2;
constexpr size_t WS_LATE_END = WS_YB + (size_t)MAXBLK * 256 * 1024 * 2;
constexpr size_t WS_NEED = WS_EARLY_END > WS_LATE_END ? WS_EARLY_END : WS_LATE_END;
constexpr int CW_CNT = 0;
constexpr int CW_QATT = 64;
constexpr int CW_QK2 = 320;
constexpr int CW_XRANK = 1024;

struct P {
    const float *x, *meta, *ln0_g, *ln0_b, *w_in, *b_fgate, *fox_norm_g, *rwkv_mu, *w0, *w2, *a0, *a2, *g2, *k_k, *k_a, *r_k, *lnx_g,
        *lnx_b, *w_out, *ln1_g, *ln1_b, *w_router, *b_router, *w_gu, *b_gu, *w_down, *b_down, *ln2_g, *ln2_b;
    float* out;
    unsigned char* ws;
};
#define WSP(T, off) ((T*)(p.ws + (off)))

#define LBAR() do { asm volatile("s_waitcnt lgkmcnt(0)" ::: "memory"); __builtin_amdgcn_s_barrier(); asm volatile("" ::: "memory"); } while (0)
DEVI int otid() { int t = threadIdx.x; asm volatile("" : "+v"(t)); return t; }
DEVI unsigned f2bf(float f) { unsigned u = __float_as_uint(f); u += 0x7fffu + ((u >> 16) & 1u); return u >> 16; }
typedef float f32x2 __attribute__((ext_vector_type(2)));
typedef __bf16 bf16x2_t __attribute__((ext_vector_type(2)));
DEVI unsigned pk2(float lo, float hi) { const f32x2 v = {lo, hi}; const bf16x2_t b = __builtin_convertvector(v, bf16x2_t); return __builtin_bit_cast(unsigned, b); }
DEVI f32x4 ld4bf(const bf16_t* p) { const u32x2 w = *(const u32x2*)p; return (f32x4){__uint_as_float(w.x << 16), __uint_as_float(w.x & 0xffff0000u), __uint_as_float(w.y << 16), __uint_as_float(w.y & 0xffff0000u)}; }
DEVI void st4bf(bf16_t* p, f32x4 v) { *(u32x2*)p = (u32x2){pk2(v.x, v.y), pk2(v.z, v.w)}; }
DEVI float ld1bf(const bf16_t* p) { return __uint_as_float((unsigned)(*p) << 16); }
DEVI float wave_sum(float v) {
#pragma unroll
    for (int o = 32; o > 0; o >>= 1) v += __shfl_xor(v, o);
    return v;
}
DEVI float sum16(float v) {
#pragma unroll
    for (int o = 8; o > 0; o >>= 1) v += __shfl_xor(v, o);
    return v;
}
template <int CTRL> DEVI float dpp_mov(float v) { return __int_as_float(__builtin_amdgcn_update_dpp(0, __float_as_int(v), CTRL, 0xF, 0xF, false)); }
DEVI float rowsum16_dpp(float v) {
    v += dpp_mov<0xB1>(v);
    v += dpp_mov<0x4E>(v);
    v += dpp_mov<0x141>(v);
    v += dpp_mov<0x140>(v);
    return v;
}
DEVI float softplusf(float x) { return fmaxf(x, 0.f) + log1pf(__expf(-fabsf(x))); }
DEVI float sigmoidf(float x) { return __builtin_amdgcn_rcpf(1.f + __expf(-x)); }
DEVI float tanh_fast(float x) { return 1.f - 2.f * __builtin_amdgcn_rcpf(__expf(2.f * x) + 1.f); }
DEVI f32x4 zs4(const bf16_t* zrow, int col, const float* mu) { const f32x4 zc = ld4bf(zrow + col), zp = ld4bf(zrow - RWKV_COLS + col); return zc + (zp - zc) * *(const f32x4*)(mu + col); }
DEVI float softplus_fast(float x) { return fmaxf(x, 0.f) + __logf(1.f + __expf(-fabsf(x))); }

constexpr int G2_STAGE = 24576;
constexpr int LDS_BYTES = 73728 + 1024;
constexpr int LX = 73728;
DEVI int xf4(int r) { return (0x78 >> (2 * ((r >> 2) & 3))) & 3; }
template <bool SWAP, int MT, class Epi>
DEVI void gemm256(const bf16_t* (&ap)[4], const bf16_t* (&bp)[2], int K, char* lds, Epi&& epi) {
    typedef __attribute__((address_space(3))) unsigned lds_u32;
    constexpr int NA = MT / 2 < 1 ? 1 : MT / 2;
    const int tid = otid(), lane = tid & 63, wid = __builtin_amdgcn_readfirstlane(tid >> 6), wm = wid >> 1, wn = wid & 1;
    const int l15 = lane & 15, lq = lane >> 4;
    const int gko = ((lane & 3) ^ xf4(lane >> 2)) << 3;
    f32x4 acc[MT][4];
#pragma unroll
    for (int i = 0; i < MT; ++i)
#pragma unroll
        for (int j = 0; j < 4; ++j) acc[i][j] = (f32x4){0.f, 0.f, 0.f, 0.f};
    const int nk = K / 32;
#define G2_DMA_A(kt, s, i) __builtin_amdgcn_global_load_lds((const unsigned*)(ap[i] + (kt) * 32 + gko), (lds_u32*)(lds + (s) * G2_STAGE + wid * 1024 + (i) * 4096), 16, 0, 0)
#define G2_DMA_B(kt, s, i) __builtin_amdgcn_global_load_lds((const unsigned*)(bp[i] + (kt) * 32 + gko), (lds_u32*)(lds + (s) * G2_STAGE + wid * 1024 + 16384 + (i) * 4096), 16, 0, 0)
#define G2_MMA(mt) do { _Pragma("unroll") for (int nt = 0; nt < 4; ++nt) { \
        if (SWAP) acc[mt][nt] = __builtin_amdgcn_mfma_f32_16x16x32_bf16(af[mt], bfr[nt], acc[mt][nt], 0, 0, 0); \
        else acc[mt][nt] = __builtin_amdgcn_mfma_f32_16x16x32_bf16(bfr[nt], af[mt], acc[mt][nt], 0, 0, 0); } } while (0)
#pragma unroll
    for (int st = 0; st < 2; ++st) { if (st < nk) {
#pragma unroll
        for (int i = 0; i < NA; ++i) G2_DMA_A(st, st, i);
        G2_DMA_B(st, st, 0); G2_DMA_B(st, st, 1); } }
    const int co = (lq ^ xf4(l15)) << 4;
    const int aoff = (wm * (16 * MT) + l15) * 64 + co, boff = 16384 + (wn * 64 + l15) * 64 + co;
    int s = 0;
    for (int kt = 0; kt < nk; ++kt) {
        if (kt + 1 < nk) { if (MT == 8) asm volatile("s_waitcnt vmcnt(6)" ::: "memory"); else if (MT == 4) asm volatile("s_waitcnt vmcnt(4)" ::: "memory"); else asm volatile("s_waitcnt vmcnt(3)" ::: "memory"); }
        else asm volatile("s_waitcnt vmcnt(0)" ::: "memory");
        __builtin_amdgcn_s_barrier(); asm volatile("" ::: "memory");
        const char* base = lds + s * G2_STAGE;
        bf16x8 af[MT], bfr[4];
#pragma unroll
        for (int t = 0; t < 4; ++t) bfr[t] = *(const bf16x8*)(base + boff + t * 1024);
#pragma unroll
        for (int t = 0; t < (MT < 4 ? MT : 4); ++t) af[t] = *(const bf16x8*)(base + aoff + t * 1024);
        const bool pre = kt + 2 < nk; int s2 = s + 2; if (s2 >= 3) s2 -= 3;
        __builtin_amdgcn_sched_barrier(0); __builtin_amdgcn_s_setprio(1);
        G2_MMA(0); __builtin_amdgcn_sched_barrier(0);
        if constexpr (MT == 8) {
#pragma unroll
            for (int t = 4; t < MT; ++t) af[t] = *(const bf16x8*)(base + aoff + t * 1024);
            if (pre) G2_DMA_A(kt + 2, s2, 0); __builtin_amdgcn_sched_barrier(0);
            G2_MMA(1); if (pre) G2_DMA_A(kt + 2, s2, 1); __builtin_amdgcn_sched_barrier(0);
            G2_MMA(2); if (pre) G2_DMA_A(kt + 2, s2, 2); __builtin_amdgcn_sched_barrier(0);
            G2_MMA(3); if (pre) G2_DMA_A(kt + 2, s2, 3); __builtin_amdgcn_sched_barrier(0);
            G2_MMA(4); if (pre) G2_DMA_B(kt + 2, s2, 0); __builtin_amdgcn_sched_barrier(0);
            G2_MMA(5); if (pre) G2_DMA_B(kt + 2, s2, 1); __builtin_amdgcn_sched_barrier(0);
            G2_MMA(6); G2_MMA(7);
        } else if constexpr (MT == 4) {
            if (pre) G2_DMA_A(kt + 2, s2, 0); __builtin_amdgcn_sched_barrier(0);
            G2_MMA(1); if (pre) G2_DMA_A(kt + 2, s2, 1); __builtin_amdgcn_sched_barrier(0);
            G2_MMA(2); if (pre) { G2_DMA_B(kt + 2, s2, 0); G2_DMA_B(kt + 2, s2, 1); } __builtin_amdgcn_sched_barrier(0);
            G2_MMA(3);
        } else {
            if (pre) { G2_DMA_A(kt + 2, s2, 0); G2_DMA_B(kt + 2, s2, 0); G2_DMA_B(kt + 2, s2, 1); } __builtin_amdgcn_sched_barrier(0);
            G2_MMA(1);
        }
        __builtin_amdgcn_s_setprio(0);
        asm volatile("s_waitcnt lgkmcnt(0)" ::: "memory");
        s = s == 2 ? 0 : s + 1;
    }
#undef G2_DMA_A
#undef G2_DMA_B
#undef G2_MMA
    __builtin_amdgcn_s_barrier(); asm volatile("" ::: "memory");
    epi(acc, wm, wn, l15, lq);
}

DEVI int srccol(int kind, int n) {
    if (kind == 0) return n;
    if (kind == 1) { if (n < 1536) return n; if (n < 3328) return n + 8; if (n < 3336) return 1536 + (n - 3328); return -1; }
    const int T = n >> 5, w = n & 31;
    return w < 16 ? T * 16 + w : 1024 + T * 16 + (w - 16);
}
DEVI void conv_tile(const float* src, int K, int NS, bf16_t* dst, int kind, int kt, int nt, float* scr  ) {
    const int tid = otid();
    const int nl = tid & 63, n = nt * 64 + nl, sc = srccol(kind, n);
    float v[16];
#pragma unroll
    for (int i = 0; i < 16; ++i) { const int k = i * 4 + (tid >> 6); v[i] = sc >= 0 ? src[(size_t)(kt * 64 + k) * NS + sc] : 0.f; }
#pragma unroll
    for (int i = 0; i < 16; ++i) { const int k = i * 4 + (tid >> 6); scr[k * 65 + nl] = v[i]; }
    LBAR();
    const int on = tid >> 2, kc = (tid & 3) * 16;
    u32x4 o0, o1;
    const float* s = scr + kc * 65 + on;
    o0.x = pk2(s[0 * 65], s[1 * 65]); o0.y = pk2(s[2 * 65], s[3 * 65]); o0.z = pk2(s[4 * 65], s[5 * 65]); o0.w = pk2(s[6 * 65], s[7 * 65]);
    o1.x = pk2(s[8 * 65], s[9 * 65]); o1.y = pk2(s[10 * 65], s[11 * 65]); o1.z = pk2(s[12 * 65], s[13 * 65]); o1.w = pk2(s[14 * 65], s[15 * 65]);
    bf16_t* d = dst + (size_t)(nt * 64 + on) * K + kt * 64 + kc;
    *(u32x4*)d = o0; *(u32x4*)(d + 8) = o1;
    LBAR();
}
DEVI void phase0(const P& p, int bid, int nb, char* lds) {
    const int tid = otid(), lane = tid & 63, wid = tid >> 6;
    {
        bf16_t* H0B = WSP(bf16_t, WS_H0B);
        for (int row = bid * 4 + wid; row < NP; row += nb * 4) {
            const int b = row / LP, pp = row % LP;
            u32x2* hb = (u32x2*)(H0B + (size_t)row * 1024) + lane;
            if (pp < PADL) {
#pragma unroll
                for (int j = 0; j < 4; ++j) hb[64 * j] = (u32x2){0u, 0u};
                continue;
            }
            const int t = pp - PADL;
            const float* src = t < NMETA ? p.meta + (size_t)t * 1024 : p.x + ((size_t)b * SEQ + (t - NMETA)) * 1024;
            f32x4 v[4]; float s = 0.f;
#pragma unroll
            for (int j = 0; j < 4; ++j) { v[j] = ((const f32x4*)src)[lane + 64 * j]; s += (v[j].x + v[j].y) + (v[j].z + v[j].w); }
            const float mean = wave_sum(s) * (1.f / 1024.f); float s2 = 0.f;
#pragma unroll
            for (int j = 0; j < 4; ++j) { v[j] = v[j] - mean; s2 += (v[j].x * v[j].x + v[j].y * v[j].y) + (v[j].z * v[j].z + v[j].w * v[j].w); }
            const float rstd = rsqrtf(wave_sum(s2) * (1.f / 1024.f) + LN_EPS);
#pragma unroll
            for (int j = 0; j < 4; ++j) {
                const f32x4 g = ((const f32x4*)p.ln0_g)[lane + 64 * j], bb = ((const f32x4*)p.ln0_b)[lane + 64 * j];
                const f32x4 o = v[j] * rstd * g + bb;
                hb[64 * j] = (u32x2){pk2(o.x, o.y), pk2(o.z, o.w)};
            }
        }
    }
    {
        float* scr = (float*)lds;
        constexpr int T_IN = 16 * 54, T_OUT = 16 * 16, T_W2 = 8, T_A2 = 8, T_G2 = 16;
        constexpr int TOT = T_IN + T_OUT + T_W2 + T_A2 + T_G2;
        for (int it = bid; it < TOT; it += nb) {
            int r = it;
            if (r < T_IN) { conv_tile(p.w_in, 1024, IN_COLS, WSP(bf16_t, WS_WINT), 1, r / 54, r % 54, scr); continue; } r -= T_IN;
            if (r < T_OUT) { conv_tile(p.w_out, 1024, 1024, WSP(bf16_t, WS_WOUTT), 0, r / 16, r % 16, scr); continue; } r -= T_OUT;
            if (r < T_W2) { conv_tile(p.w2, 64, 512, WSP(bf16_t, WS_W2T), 0, 0, r, scr); continue; } r -= T_W2;
            if (r < T_A2) { conv_tile(p.a2, 64, 512, WSP(bf16_t, WS_A2T), 0, 0, r, scr); continue; } r -= T_A2;
            conv_tile(p.g2, 128, 512, WSP(bf16_t, WS_G2T), 0, r / 8, r % 8, scr);
        }
    }
}
DEVI void conv_wide(const float* src, int NS, bf16_t* dst, int kind, int kt, int nt, float* scr) {
    const int tid = otid(), kq = tid >> 6, n4 = tid & 63;
    const int sc = srccol(kind, nt * 256 + 4 * n4);
    const float* sp = src + (size_t)(kt * 64 + kq) * NS + sc;
    f32x4 v[16];
#pragma unroll
    for (int i = 0; i < 16; ++i) v[i] = *(const f32x4*)(sp + (size_t)(4 * i) * NS);
#pragma unroll
    for (int i = 0; i < 16; ++i) { const int k = 4 * i + kq; *(f32x4*)(scr + k * 260 + ((4 * n4 + 4 * (k >> 3)) & 255)) = v[i]; }
    LBAR();
    const int ch = tid & 7, r0 = tid >> 3;
#pragma unroll
    for (int j = 0; j < 8; ++j) { const int row = j * 32 + r0; const float* s = scr + (8 * ch) * 260 + ((row + 4 * ch) & 255);
        *(u32x4*)(dst + (size_t)(nt * 256 + row) * 1024 + kt * 64 + 8 * ch) = (u32x4){pk2(s[0], s[260]), pk2(s[2 * 260], s[3 * 260]), pk2(s[4 * 260], s[5 * 260]), pk2(s[6 * 260], s[7 * 260])}; }
    LBAR();
}
constexpr int CONV_TILES = 12, N_CONV_ITEMS = (32 * 16 * 8 + 32 * 16 * 4) / CONV_TILES;
static_assert(2 * N_CONV_ITEMS <= 16 * (NQB - 1), "interleave pattern needs 2 attention items per conversion item");
DEVI void conv_moe_item(const P& p, int item, char* lds) {
    float* scr = (float*)lds;
    for (int t = 0; t < CONV_TILES; ++t) {
        int r = item * CONV_TILES + t;
        if (r < 32 * 128) { const int e = r / 128, q = r % 128; conv_wide(p.w_gu + (size_t)e * 1024 * 2048, 2048, WSP(bf16_t, WS_WGUT) + (size_t)e * 2048 * 1024, 2, q / 8, q % 8, scr); }
        else { r -= 32 * 128; const int e = r / 64, q = r % 64; conv_wide(p.w_down + (size_t)e * 1024 * 1024, 1024, WSP(bf16_t, WS_WDT) + (size_t)e * 1024 * 1024, 0, q / 4, q % 4, scr); }
    }
}

struct Sched { int x, rank, nloc, nxcd; };
template <class F> DEVI void for_xcd_items(const Sched& sc, F&& f) {
    const int x0 = sc.nxcd == 8 ? sc.x : 0, x1 = sc.nxcd == 8 ? sc.x + 1 : 8;
    for (int x = x0; x < x1; ++x) f(x, sc.rank, sc.nloc);
}

DEVI void stage_out64(char* lds, int wid, int lane, bf16_t* dst  , size_t ld) {
    const char* st = lds + wid * 18432;
    asm volatile("s_waitcnt lgkmcnt(0)" ::: "memory");
#pragma unroll
    for (int i = 0; i < 16; ++i) { const int r = 8 * i + (lane >> 3), ch = lane & 7; *(u32x4*)(dst + (size_t)r * ld + ch * 8) = *(const u32x4*)(st + r * 144 + ch * 16); }
    LBAR();
}
struct EpiInProj {
    const P& p; int tm, tn; char* lds;
    DEVI void operator()(f32x4 (&acc)[8][4], int wm, int wn, int l15, int lq) const {
        if (tn < 8) {
            bf16_t* dst = tn < 4 ? WSP(bf16_t, WS_QB) : WSP(bf16_t, WS_KB); const float sc = tn < 4 ? QSCALE : 1.f;
            const int wid = wm * 2 + wn; char* st = lds + wid * 18432;
            float mx = 0.f;
#pragma unroll
            for (int mt = 0; mt < 8; ++mt) { float ssq = 0.f;
#pragma unroll
                for (int nt = 0; nt < 4; ++nt) { const f32x4 a = acc[mt][nt] * sc; ssq += (a.x * a.x + a.y * a.y) + (a.z * a.z + a.w * a.w); *(u32x2*)(st + (mt * 16 + l15) * 144 + (nt * 16 + 4 * lq) * 2) = (u32x2){pk2(a.x, a.y), pk2(a.z, a.w)}; }
                ssq += __shfl_xor(ssq, 16); ssq += __shfl_xor(ssq, 32); mx = fmaxf(mx, ssq); }
            stage_out64(lds, wid, l15 + 16 * lq, dst + ((size_t)tm * 256 + wm * 128) * 512 + (tn & 3) * 128 + wn * 64, 512);
#pragma unroll
            for (int o = 1; o < 16; o <<= 1) mx = fmaxf(mx, __shfl_xor(mx, o));
            if ((threadIdx.x & 63) == 0) atomicMax(WSP(unsigned, WS_CTL) + CW_QK2 + (tn < 4 ? 0 : 8) + 2 * (tn & 3) + wn, __float_as_uint(mx));
        } else if (tn < 12) {
            bf16_t* VT = WSP(bf16_t, WS_VT); const int row0 = tm * 256 + wm * 128;
#pragma unroll
            for (int mt = 0; mt < 8; ++mt) { const int row = row0 + mt * 16 + 4 * lq, b = row / LP, pp = row % LP;
#pragma unroll
                for (int nt = 0; nt < 4; ++nt) { const int n = (tn - 8) * 128 + wn * 64 + nt * 16 + l15; const f32x4 a = acc[mt][nt];
                    *(u32x2*)(VT + (size_t)(b * 512 + n) * LP + pp) = (u32x2){pk2(a.x, a.y), pk2(a.z, a.w)}; } }
        } else if (tn < 26) {
            bf16_t* ZR = WSP(bf16_t, WS_ZR); const int wid = wm * 2 + wn; char* st = lds + wid * 18432;
#pragma unroll
            for (int mt = 0; mt < 8; ++mt)
#pragma unroll
                for (int nt = 0; nt < 4; ++nt) { const f32x4 a = acc[mt][nt]; *(u32x2*)(st + (mt * 16 + l15) * 144 + (nt * 16 + 4 * lq) * 2) = (u32x2){pk2(a.x, a.y), pk2(a.z, a.w)}; }
            stage_out64(lds, wid, l15 + 16 * lq, ZR + ((size_t)tm * 256 + wm * 128) * RWKV_COLS + (tn - 12) * 128 + wn * 64, RWKV_COLS);
        } else {
            if (wn == 0 && lq < 2) { float* LF = WSP(float, WS_LF);
#pragma unroll
                for (int mt = 0; mt < 8; ++mt) { const int row = tm * 256 + wm * 128 + mt * 16 + l15; const bool pad = (row % LP) < PADL; f32x4 o;
#pragma unroll
                    for (int r = 0; r < 4; ++r) { const float xv = acc[mt][0][r] + p.b_fgate[4 * lq + r]; o[r] = pad ? 0.f : -softplusf(-xv); }
                    *(f32x4*)(LF + (size_t)row * 8 + 4 * lq) = o; } }
        }
    }
};
DEVI void phase1(const P& p, const Sched& sc, char* lds) {
    const int tid = otid(), lane = tid & 63, wid = tid >> 6, srow_ = 16 * wid + (lane >> 2);
    for_xcd_items(sc, [&](int x, int rank, int nloc) __attribute__((always_inline)) {
        const int xr = x >> 2, xc = x & 3, c0 = 7 * xc, cnt = xc == 3 ? 6 : 7, r0 = 33 * xr, nr = xr ? 32 : 33;
        for (int i = rank; i < nr * cnt; i += nloc) {
            const int tm = r0 + i / cnt, tn = c0 + i % cnt;
            const bf16_t *ap[4], *bp[2];
            int srow = srow_; asm volatile("" : "+v"(srow));
#pragma unroll
            for (int q = 0; q < 4; ++q) ap[q] = WSP(bf16_t, WS_H0B) + (size_t)(tm * 256 + srow + 64 * q) * 1024;
#pragma unroll
            for (int q = 0; q < 2; ++q) bp[q] = WSP(bf16_t, WS_WINT) + (size_t)(tn * 128 + srow + 64 * q) * 1024;
            if (tn >= 8 && tn < 12) gemm256<true, 8>(ap, bp, 1024, lds, EpiInProj{p, tm, tn, lds});
            else gemm256<false, 8>(ap, bp, 1024, lds, EpiInProj{p, tm, tn, lds});
        }
    });
}

DEVI int pi_swap(int i) { return (i & ~12) | ((i & 4) << 1) | ((i & 8) >> 1); }
DEVI void attn_item(const P& p, int b, int h, int qb, char* lds) {
    const int tid = otid(), lane = tid & 63, wid = tid >> 6, ql = lane & 31, hi = lane >> 5;
    const int q_pp = qb * 128 + wid * 32 + ql; const size_t qrow = (size_t)b * LP + q_pp;
    const bf16_t* QB = WSP(bf16_t, WS_QB); const bf16_t* KB = WSP(bf16_t, WS_KB); const bf16_t* VT = WSP(bf16_t, WS_VT); const float* CS = WSP(float, WS_CS);
    bf16x8 qf[4];
#pragma unroll
    for (int d0 = 0; d0 < 4; ++d0) qf[d0] = *(const bf16x8*)(QB + qrow * 512 + h * 64 + 16 * d0 + 8 * hi);
    const float cref = CS[((size_t)b * LP + qb * 128) * 8 + h];
    const int r0 = tid >> 3, kc = tid & 7;
    const int soff = r0 * 128 + ((kc ^ ((r0 >> 1) & 7)) << 4);
    const bf16_t* ksrc = KB + ((size_t)b * LP + r0) * 512 + h * 64 + kc * 8;
    const bf16_t* vsrc = VT + (size_t)(b * 512 + h * 64 + r0) * LP + kc * 8;
    const float* csrc = CS + ((size_t)b * LP + (tid & 63)) * 8 + h;
    const int nkt = 2 * qb + 1;
    int kstart = 1;
    {
        const unsigned* qk2 = WSP(unsigned, WS_CTL) + CW_QK2;
        const float bnd = 64.f + 2.04f * sqrtf(__uint_as_float(qk2[h]) * __uint_as_float(qk2[8 + h]));
        const int kt = tid + 1; bool skip = false;
        if (kt <= nkt) skip = CS[((size_t)b * LP + 64 * kt + 63) * 8 + h] - cref > bnd;
        int* s_cnt = (int*)(lds + LX + 944);
        if (tid == 0) *s_cnt = 0;
        __syncthreads();
        const int c = __popcll(__ballot(skip));
        if (lane == 0 && c) atomicAdd(s_cnt, c);
        __syncthreads();
        kstart = 1 + __builtin_amdgcn_readfirstlane(*s_cnt);
        if (kstart > 2 * qb) kstart = 2 * qb;
    }
    u32x4 rk[2], rv[2]; float rc = 0.f;
    auto gload = [&](int kt) {
#pragma unroll
        for (int i = 0; i < 2; ++i) { rk[i] = *(const u32x4*)(ksrc + (size_t)(64 * kt + 32 * i) * 512); rv[i] = *(const u32x4*)(vsrc + 64 * kt + (size_t)i * 32 * LP); }
        if (tid < 64) rc = csrc[(size_t)64 * kt * 8];
    };
    auto swrite = [&](int s) {
        char* bs = lds + s * 16640;
#pragma unroll
        for (int i = 0; i < 2; ++i) { *(u32x4*)(bs + soff + i * 4096) = rk[i]; *(u32x4*)(bs + 8192 + soff + i * 4096) = rv[i]; }
        if (tid < 64) *(float*)(bs + 16384 + tid * 4) = rc - cref;
    };
    float m = NEGBIG, l = 0.f; f32x16 o[2];
#pragma unroll
    for (int r = 0; r < 16; ++r) { o[0][r] = 0.f; o[1][r] = 0.f; }
    const int krow0 = pi_swap(ql);
    const int koff = krow0 * 128, ksw = (krow0 >> 1) & 7;
    const int voff = 8192 + ql * 128, vsw = (ql >> 1) & 7;
    gload(kstart); swrite(kstart & 1); __syncthreads();
    for (int kt = kstart; kt <= nkt; ++kt) {
        const int s = kt & 1;
        if (kt < nkt) gload(kt + 1);
        if (64 * kt <= qb * 128 + wid * 32 + 31) {
            const char* bs = lds + s * 16640;
            f32x16 sc[2];
#pragma unroll
            for (int kh = 0; kh < 2; ++kh) {
#pragma unroll
                for (int r = 0; r < 16; ++r) sc[kh][r] = 0.f;
#pragma unroll
                for (int d0 = 0; d0 < 4; ++d0) { const bf16x8 kf = *(const bf16x8*)(bs + kh * 4096 + koff + (((2 * d0 + hi) ^ ksw) << 4));
                    sc[kh] = __builtin_amdgcn_mfma_f32_32x32x16_bf16(kf, qf[d0], sc[kh], 0, 0, 0); }
            }
            const float* csl = (const float*)(bs + 16384);
            const bool needmask = (kt == 1) || (kt >= 2 * qb);
            f32x2 xv[2][8];
#pragma unroll
            for (int kh = 0; kh < 2; ++kh)
#pragma unroll
                for (int g = 0; g < 4; ++g) { const int key0 = 32 * kh + 16 * (g >> 1) + 8 * hi + 4 * (g & 1); const f32x4 cv = *(const f32x4*)(csl + key0);
                    xv[kh][2 * g] = (f32x2){sc[kh][4 * g], sc[kh][4 * g + 1]} - (f32x2){cv.x, cv.y};
                    xv[kh][2 * g + 1] = (f32x2){sc[kh][4 * g + 2], sc[kh][4 * g + 3]} - (f32x2){cv.z, cv.w}; }
            if (needmask) {
#pragma unroll
                for (int kh = 0; kh < 2; ++kh)
#pragma unroll
                    for (int g = 0; g < 4; ++g) { const int key0 = 32 * kh + 16 * (g >> 1) + 8 * hi + 4 * (g & 1);
#pragma unroll
                        for (int c = 0; c < 4; ++c) { const int kp = 64 * kt + key0 + c; if (kp > q_pp || kp < PADL) xv[kh][2 * g + (c >> 1)][c & 1] = NEGBIG; } }
            }
            float mloc;
            { float a = __builtin_fmaxf(__builtin_fmaxf(xv[0][0].x, xv[0][0].y), xv[1][0].x), bq = __builtin_fmaxf(__builtin_fmaxf(xv[0][1].x, xv[0][1].y), xv[1][0].y);
              a = __builtin_fmaxf(__builtin_fmaxf(a, xv[1][1].x), xv[1][1].y);
#pragma unroll
              for (int i = 2; i < 8; i += 2) { a = __builtin_fmaxf(__builtin_fmaxf(a, xv[0][i].x), xv[0][i].y); bq = __builtin_fmaxf(__builtin_fmaxf(bq, xv[0][i + 1].x), xv[0][i + 1].y);
                  a = __builtin_fmaxf(__builtin_fmaxf(a, xv[1][i].x), xv[1][i].y); bq = __builtin_fmaxf(__builtin_fmaxf(bq, xv[1][i + 1].x), xv[1][i + 1].y); }
              mloc = __builtin_fmaxf(a, bq); }
            { const auto rr = __builtin_amdgcn_permlane32_swap(__float_as_uint(mloc), __float_as_uint(mloc), false, false); mloc = fmaxf(__uint_as_float(rr[0]), __uint_as_float(rr[1])); }
            if (__any(mloc > m + 8.f)) {
                const float mnew = fmaxf(m, mloc); const float f = __builtin_amdgcn_exp2f(m - mnew); m = mnew; l *= f;
#pragma unroll
                for (int r = 0; r < 16; ++r) { o[0][r] *= f; o[1][r] *= f; }
            }
            bf16x8 pf[2][2]; f32x2 ls2 = (f32x2){0.f, 0.f}; const f32x2 m2 = (f32x2){m, m};
#pragma unroll
            for (int kh = 0; kh < 2; ++kh)
#pragma unroll
                for (int s2 = 0; s2 < 2; ++s2) { u32x4 w;
#pragma unroll
                    for (int j = 0; j < 4; ++j) { const f32x2 d = xv[kh][4 * s2 + j] - m2; f32x2 e; e.x = __builtin_amdgcn_exp2f(d.x); e.y = __builtin_amdgcn_exp2f(d.y); ls2 += e; w[j] = pk2(e.x, e.y); }
                    pf[kh][s2] = __builtin_bit_cast(bf16x8, w); }
            l += ls2.x + ls2.y;
#pragma unroll
            for (int dh = 0; dh < 2; ++dh)
#pragma unroll
                for (int kh = 0; kh < 2; ++kh)
#pragma unroll
                    for (int s2 = 0; s2 < 2; ++s2) { const bf16x8 vf = *(const bf16x8*)(bs + voff + dh * 4096 + (((4 * kh + 2 * s2 + hi) ^ vsw) << 4));
                        o[dh] = __builtin_amdgcn_mfma_f32_32x32x16_bf16(vf, pf[kh][s2], o[dh], 0, 0, 0); }
        }
        if (kt < nkt) swrite((kt + 1) & 1);
        __syncthreads();
    }
    l += __shfl_xor(l, 32);
    const float inv = 1.f / l; float ss = 0.f;
#pragma unroll
    for (int r = 0; r < 16; ++r) { o[0][r] *= inv; o[1][r] *= inv; ss += o[0][r] * o[0][r] + o[1][r] * o[1][r]; }
    ss += __shfl_xor(ss, 32);
    const float rs = rsqrtf(ss * (1.f / 64.f) + RMS_EPS);
    bf16_t* MIX = WSP(bf16_t, WS_MIX); const bool padq = q_pp < PADL;
#pragma unroll
    for (int dh = 0; dh < 2; ++dh)
#pragma unroll
        for (int g = 0; g < 4; ++g) { const int d = 32 * dh + 8 * g + 4 * hi; const f32x4 gn = *(const f32x4*)(p.fox_norm_g + h * 64 + d);
            float v0 = o[dh][4 * g] * rs * gn.x, v1 = o[dh][4 * g + 1] * rs * gn.y, v2 = o[dh][4 * g + 2] * rs * gn.z, v3 = o[dh][4 * g + 3] * rs * gn.w;
            if (padq) { v0 = v1 = v2 = v3 = 0.f; }
            *(u32x2*)(MIX + qrow * 1024 + h * 64 + d) = (u32x2){pk2(v0, v1), pk2(v2, v3)}; }
}

constexpr int NCHUNK = 129;
constexpr int CHUNK_BYTES = 32768;
constexpr int C_XL = 32768, C_LG = 50176, C_PART = 67584, C_END = 68608;
DEVI int swz(int row, int chunk) { return row * 128 + ((chunk ^ ((row >> 1) & 7)) << 4); }
DEVI int crow(int r, int h) { return (r & 3) + 8 * (r >> 2) + 4 * h; }
DEVI bf16x8 frag(const char* base, int row, int ks, int h) { return *(const bf16x8*)(base + swz(row, 2 * ks + h)); }
DEVI void chunk_job(const P& p, int job, char* lds) {
    int tid_ = threadIdx.x; asm volatile("" : "+v"(tid_));
    const int tid = tid_, lane = tid & 63, wid = tid >> 6, l31 = lane & 31, h = lane >> 5, rb = wid >> 1, cb = wid & 1;
    const int bh = job / NCHUNK, c = job % NCHUNK, b = bh >> 3, hh = bh & 7;
    const size_t row0 = (size_t)b * LP + 64 + 64 * c; const int col0 = hh * 64;
    const bf16_t* BB = WSP(bf16_t, WS_RB) + row0 * 512 + col0; const bf16_t* K2 = WSP(bf16_t, WS_RK2) + row0 * 512 + col0;
    const bf16_t* ZRb = WSP(bf16_t, WS_ZR) + row0 * RWKV_COLS;
    float* LgG = WSP(float, WS_LGS) + (size_t)blockIdx.x * 12288;
    char* chk = (char*)p.ws + WS_CHK + (size_t)job * CHUNK_BYTES;
    char* R1 = lds; float* XL = (float*)(lds + C_XL); float* Lg = (float*)(lds + C_LG); float* part = (float*)(lds + C_PART);
    {
        const int t = tid >> 2, q = tid & 3; const bf16_t* zrow = ZRb + (size_t)t * RWKV_COLS;
#pragma unroll 4
        for (int i = 0; i < 16; ++i) { const int c = 16 * i + 4 * q;
            f32x4 z = zs4(zrow, 1536 + c, p.rwkv_mu);
            if (i < 4) z = (f32x4){tanh_fast(z.x), tanh_fast(z.y), tanh_fast(z.z), tanh_fast(z.w)};
            else if (i >= 8) z = (f32x4){sigmoidf(z.x), sigmoidf(z.y), sigmoidf(z.z), sigmoidf(z.w)};
            *(u32x2*)(R1 + (i >> 2) * 8192 + swz(t, (c & 63) >> 3) + (c & 7) * 2) = (u32x2){pk2(z.x, z.y), pk2(z.z, z.w)}; }
    }
    LBAR();
    {
        const bf16_t* W2T = WSP(bf16_t, WS_W2T) + (size_t)(col0 + 32 * cb + l31) * 64 + 8 * h; const bf16_t* A2T = WSP(bf16_t, WS_A2T) + (size_t)(col0 + 32 * cb + l31) * 64 + 8 * h;
        const bf16_t* G2T = WSP(bf16_t, WS_G2T) + (size_t)(col0 + 32 * cb + l31) * 128 + 8 * h;
        f32x16 dw, da, dg;
#pragma unroll
        for (int r = 0; r < 16; ++r) { dw[r] = 0.f; da[r] = 0.f; dg[r] = 0.f; }
#pragma unroll
        for (int ks = 0; ks < 4; ++ks) {
            dw = __builtin_amdgcn_mfma_f32_32x32x16_bf16(frag(R1, 32 * rb + l31, ks, h), *(const bf16x8*)(W2T + 16 * ks), dw, 0, 0, 0);
            da = __builtin_amdgcn_mfma_f32_32x32x16_bf16(frag(R1 + 8192, 32 * rb + l31, ks, h), *(const bf16x8*)(A2T + 16 * ks), da, 0, 0, 0);
        }
#pragma unroll
        for (int ks = 0; ks < 8; ++ks) dg = __builtin_amdgcn_mfma_f32_32x32x16_bf16(frag(R1 + 16384 + (ks >> 2) * 8192, 32 * rb + l31, ks & 3, h), *(const bf16x8*)(G2T + 16 * ks), dg, 0, 0, 0);
        LBAR();
        const int j = 32 * cb + l31; const float w0v = p.w0[col0 + j], a0v = p.a0[col0 + j]; float* At = (float*)R1;
#pragma unroll
        for (int r = 0; r < 16; ++r) { const int t = 32 * rb + crow(r, h);
            const float wl = -softplus_fast(-(w0v + dw[r])) - 0.5f; Lg[t * 64 + j] = -__expf(wl);
            At[t * 64 + j] = sigmoidf(a0v + da[r]);
            (WSP(bf16_t, WS_G) + row0 * 512 + col0)[(size_t)t * 512 + j] = (bf16_t)f2bf(dg[r]); }
    }
    LBAR();
    {
        const int cq = tid >> 6, cj = tid & 63; float cs[16]; float run = 0.f;
#pragma unroll
        for (int u = 0; u < 16; ++u) { run += Lg[(16 * cq + u) * 64 + cj]; cs[u] = run; }
        part[cq * 64 + cj] = run; LBAR();
        float off = 0.f;
        for (int q = 0; q < cq; ++q) off += part[q * 64 + cj];
#pragma unroll
        for (int u = 0; u < 16; ++u) { Lg[(16 * cq + u) * 64 + cj] = cs[u] + off; LgG[(16 * cq + u) * 64 + cj] = cs[u] + off; }
        LBAR();
    }
    {
        const int t = tid >> 2, jq = (tid & 3) * 4;
        f32x4 av4[4];
#pragma unroll
        for (int e4 = 0; e4 < 4; ++e4) av4[e4] = *(const f32x4*)((const float*)R1 + t * 64 + 16 * e4 + jq);
        LBAR();
        const bf16_t* zrow = ZRb + (size_t)t * RWKV_COLS;
        f32x4 kr4[4], kk4[4], rr4[4], ka4[4]; float ss = 0.f;
        const int tp = t > 0 ? t - 1 : 0; const float pm = t > 0 ? 1.f : 0.f;
#pragma unroll
        for (int e4 = 0; e4 < 4; ++e4) { const int j = 16 * e4 + jq;
            kr4[e4] = zs4(zrow, 512 + col0 + j, p.rwkv_mu); rr4[e4] = zs4(zrow, col0 + j, p.rwkv_mu); ka4[e4] = *(const f32x4*)(p.k_a + col0 + j);
            kk4[e4] = kr4[e4] * *(const f32x4*)(p.k_k + col0 + j);
            ss += (kk4[e4].x * kk4[e4].x + kk4[e4].y * kk4[e4].y) + (kk4[e4].z * kk4[e4].z + kk4[e4].w * kk4[e4].w); }
        ss += dpp_mov<0xB1>(ss); ss += dpp_mov<0x4E>(ss);
        const float kinv = 1.f / fmaxf(sqrtf(ss), 1e-12f);
#pragma unroll
        for (int e4 = 0; e4 < 4; ++e4) {
            const int j = 16 * e4 + jq;
            const f32x4 lg = *(const f32x4*)(Lg + t * 64 + j), lgp = *(const f32x4*)(Lg + tp * 64 + j) * pm;
            const f32x4 kk = kk4[e4] * kinv, kr = kr4[e4], rr = rr4[e4], ka = ka4[e4];
            const f32x4 bb = kk * av4[e4], k2 = kr * (1.f + (av4[e4] - 1.f) * ka);
            st4bf((bf16_t*)BB + (size_t)t * 512 + j, bb); st4bf((bf16_t*)K2 + (size_t)t * 512 + j, k2);
            float at[4], rt[4], bt[4], kt[4];
#pragma unroll
            for (int q = 0; q < 4; ++q) { const float en = __expf(-lg[q]); at[q] = -kk[q] * __expf(lgp[q]); rt[q] = rr[q] * __expf(lg[q]); bt[q] = bb[q] * en; kt[q] = k2[q] * en; }
            const int o = swz(t, j >> 3) + (j & 7) * 2;
            *(u32x2*)(R1 + 0 + o) = (u32x2){pk2(bt[0], bt[1]), pk2(bt[2], bt[3])};
            *(u32x2*)(R1 + 8192 + o) = (u32x2){pk2(kt[0], kt[1]), pk2(kt[2], kt[3])};
            *(u32x2*)(R1 + 16384 + o) = (u32x2){pk2(at[0], at[1]), pk2(at[2], at[3])};
            *(u32x2*)(R1 + 24576 + o) = (u32x2){pk2(rt[0], rt[1]), pk2(rt[2], rt[3])};
#pragma unroll
            for (int q = 0; q < 4; ++q) { XL[(j + q) * 68 + t] = at[q]; LgG[8192 + (j + q) * 64 + t] = rt[q]; }
        }
    }
    LBAR();
    {
        f32x16 tb, tk, qb, hy;
#pragma unroll
        for (int r = 0; r < 16; ++r) { tb[r] = 0.f; tk[r] = 0.f; qb[r] = 0.f; hy[r] = 0.f; }
#pragma unroll
        for (int ks = 0; ks < 4; ++ks) {
            const bf16x8 aB = frag(R1, 32 * rb + l31, ks, h), aK = frag(R1 + 8192, 32 * rb + l31, ks, h), bA = frag(R1 + 16384, 32 * cb + l31, ks, h), bR = frag(R1 + 24576, 32 * cb + l31, ks, h);
            tb = __builtin_amdgcn_mfma_f32_32x32x16_bf16(aB, bA, tb, 0, 0, 0); tk = __builtin_amdgcn_mfma_f32_32x32x16_bf16(aK, bA, tk, 0, 0, 0);
            qb = __builtin_amdgcn_mfma_f32_32x32x16_bf16(aB, bR, qb, 0, 0, 0); hy = __builtin_amdgcn_mfma_f32_32x32x16_bf16(aK, bR, hy, 0, 0, 0);
        }
        const int t = 32 * cb + l31;
#pragma unroll
        for (int r = 0; r < 16; ++r) { const int s = 32 * rb + crow(r, h); if (!(s < t)) { tb[r] = 0.f; tk[r] = 0.f; } if (!(s <= t)) { qb[r] = 0.f; hy[r] = 0.f; } }
        LBAR();
        float* TbT = (float*)R1;
#pragma unroll
        for (int g = 0; g < 4; ++g) { const int s0 = 32 * rb + 8 * g + 4 * h;
            *(f32x4*)(TbT + t * 68 + s0) = (f32x4){tb[4 * g], tb[4 * g + 1], tb[4 * g + 2], tb[4 * g + 3]};
#pragma unroll
            for (int q = 0; q < 4; ++q) XL[(64 + s0 + q) * 68 + t] = tk[4 * g + q];
            *(u32x2*)(R1 + 17408 + swz(t, 4 * rb + g) + 8 * h) = (u32x2){pk2(qb[4 * g], qb[4 * g + 1]), pk2(qb[4 * g + 2], qb[4 * g + 3])};
            *(f32x4*)(LgG + 4096 + ((wid * 4 + g) * 64 + lane) * 4) = (f32x4){hy[4 * g], hy[4 * g + 1], hy[4 * g + 2], hy[4 * g + 3]}; }
    }
    LBAR();
    {
        const int row = tid >> 1, hf = tid & 1; float* xr = XL + row * 68; const float* TbT = (const float*)R1;
        for (int bj = 0; bj < 4; ++bj) {
            float y[16];
#pragma unroll
            for (int q = 0; q < 4; ++q) { const f32x4 v = *(const f32x4*)(xr + 16 * bj + 4 * q); y[4 * q] = v.x; y[4 * q + 1] = v.y; y[4 * q + 2] = v.z; y[4 * q + 3] = v.w; }
            float acc[16];
#pragma unroll
            for (int t = 0; t < 16; ++t) acc[t] = 0.f;
            for (int bi = 0; bi < bj; ++bi) {
                float xp[8];
#pragma unroll
                for (int q = 0; q < 2; ++q) { const f32x4 v = *(const f32x4*)(xr + 16 * bi + 8 * hf + 4 * q); xp[4 * q] = v.x; xp[4 * q + 1] = v.y; xp[4 * q + 2] = v.z; xp[4 * q + 3] = v.w; }
                const float* tb0 = TbT + (16 * bj) * 68 + 16 * bi + 8 * hf;
#pragma unroll
                for (int t = 0; t < 16; ++t) { float a0 = 0.f, a1 = 0.f;
#pragma unroll
                    for (int u = 0; u < 8; u += 2) { a0 += xp[u] * tb0[t * 68 + u]; a1 += xp[u + 1] * tb0[t * 68 + u + 1]; }
                    acc[t] += a0 + a1; }
            }
#pragma unroll
            for (int t = 0; t < 16; ++t) y[t] += acc[t] + dpp_mov<0xB1>(acc[t]);
            const float* td = TbT + (16 * bj) * 68 + 16 * bj;
#pragma unroll
            for (int t = 1; t < 16; ++t) { float a0 = y[t];
#pragma unroll
                for (int u = 0; u < 16; ++u) if (u < t) a0 += y[u] * td[t * 68 + u];
                y[t] = a0; }
            if (hf == 0) {
#pragma unroll
                for (int q = 0; q < 4; ++q) *(f32x4*)(xr + 16 * bj + 4 * q) = (f32x4){y[4 * q], y[4 * q + 1], y[4 * q + 2], y[4 * q + 3]};
            }
            asm volatile("s_waitcnt lgkmcnt(0)" ::: "memory");
        }
    }
    LBAR();
    {
        const int row = tid >> 1, hf = tid & 1; const float* xr = XL + row * 68 + 32 * hf; char* dst = R1 + (row >> 6) * 8192;
#pragma unroll
        for (int c8 = 0; c8 < 4; ++c8) { const f32x4 a = *(const f32x4*)(xr + 8 * c8), bq = *(const f32x4*)(xr + 8 * c8 + 4);
            *(u32x4*)(dst + swz(row & 63, 4 * hf + c8)) = (u32x4){pk2(a.x, a.y), pk2(a.z, a.w), pk2(bq.x, bq.y), pk2(bq.z, bq.w)}; }
    }
    __syncthreads();
    {
        const int t = tid >> 2, jq = (tid & 3) * 4; char* BbT = lds + 32768; char* VT = lds + 40960;
        f32x4 lgA[4], lcA[4], bbA[4], vvA[4];
#pragma unroll
        for (int e4 = 0; e4 < 4; ++e4) { const int j = 16 * e4 + jq;
            lgA[e4] = *(const f32x4*)(LgG + t * 64 + j); lcA[e4] = *(const f32x4*)(LgG + 63 * 64 + j); bbA[e4] = ld4bf(BB + (size_t)t * 512 + j); vvA[e4] = zs4(ZRb + (size_t)t * RWKV_COLS, 1024 + col0 + j, p.rwkv_mu); }
#pragma unroll
        for (int e4 = 0; e4 < 4; ++e4) {
            const int j = 16 * e4 + jq;
            const f32x4 lg = lgA[e4], lc = lcA[e4], bb = bbA[e4], vv = vvA[e4];
#pragma unroll
            for (int q = 0; q < 4; ++q) { const int o2 = swz(j + q, t >> 3) + (t & 7) * 2; *(bf16_t*)(BbT + o2) = (bf16_t)f2bf(bb[q] * __expf(lc[q] - lg[q])); *(bf16_t*)(VT + o2) = (bf16_t)f2bf(vv[q]); }
        }
    }
    LBAR();
    {
        f32x16 gy, gs, hs, hy;
#pragma unroll
        for (int g = 0; g < 4; ++g) { const f32x4 q4 = *(const f32x4*)(LgG + 4096 + ((wid * 4 + g) * 64 + lane) * 4); hy[4 * g] = q4.x; hy[4 * g + 1] = q4.y; hy[4 * g + 2] = q4.z; hy[4 * g + 3] = q4.w; }
        {
            const int tq = 32 * cb + l31;
            const float lcq = LgG[63 * 64 + tq]; const float elc = __expf(lcq);
#pragma unroll
            for (int g = 0; g < 4; ++g) { const int j0 = 32 * rb + 8 * g + 4 * h;
#pragma unroll
                for (int q = 0; q < 4; ++q) { gy[4 * g + q] = LgG[8192 + (j0 + q) * 64 + tq]; gs[4 * g + q] = (j0 + q == tq) ? elc : 0.f;
                    const int s = j0 + q; hs[4 * g + q] = ld1bf(K2 + (size_t)s * 512 + tq) * __expf(lcq - LgG[s * 64 + tq]); } }
        }
#pragma unroll
        for (int ks = 0; ks < 4; ++ks) {
            const bf16x8 aA = frag(R1, 32 * rb + l31, ks, h), aW = frag(R1 + 8192, 32 * rb + l31, ks, h), bQ = frag(R1 + 17408, 32 * cb + l31, ks, h), bB = frag(lds + 32768, 32 * cb + l31, ks, h);
            gy = __builtin_amdgcn_mfma_f32_32x32x16_bf16(aA, bQ, gy, 0, 0, 0); gs = __builtin_amdgcn_mfma_f32_32x32x16_bf16(aA, bB, gs, 0, 0, 0);
            hy = __builtin_amdgcn_mfma_f32_32x32x16_bf16(aW, bQ, hy, 0, 0, 0); hs = __builtin_amdgcn_mfma_f32_32x32x16_bf16(aW, bB, hs, 0, 0, 0);
        }
        const int cc = 32 * cb + l31;
#pragma unroll
        for (int g = 0; g < 4; ++g) { const int r0 = 32 * rb + 8 * g + 4 * h;
            *(u32x2*)(chk + swz(cc, 4 * rb + g) + 8 * h) = (u32x2){pk2(gy[4 * g], gy[4 * g + 1]), pk2(gy[4 * g + 2], gy[4 * g + 3])};
            *(u32x2*)(chk + 8192 + swz(cc, 4 * rb + g) + 8 * h) = (u32x2){pk2(gs[4 * g], gs[4 * g + 1]), pk2(gs[4 * g + 2], gs[4 * g + 3])};
            *(u32x2*)(lds + 49152 + swz(cc, 4 * rb + g) + 8 * h) = (u32x2){pk2(hs[4 * g], hs[4 * g + 1]), pk2(hs[4 * g + 2], hs[4 * g + 3])};
            *(u32x2*)(lds + 57344 + swz(cc, 4 * rb + g) + 8 * h) = (u32x2){pk2(hy[4 * g], hy[4 * g + 1]), pk2(hy[4 * g + 2], hy[4 * g + 3])}; }
    }
    LBAR();
    {
        f32x16 sl, yl;
#pragma unroll
        for (int r = 0; r < 16; ++r) { sl[r] = 0.f; yl[r] = 0.f; }
#pragma unroll
        for (int ks = 0; ks < 4; ++ks) {
            const bf16x8 aS = frag(lds + 49152, 32 * rb + l31, ks, h), aY = frag(lds + 57344, 32 * rb + l31, ks, h), bV = frag(lds + 40960, 32 * cb + l31, ks, h);
            sl = __builtin_amdgcn_mfma_f32_32x32x16_bf16(aS, bV, sl, 0, 0, 0); yl = __builtin_amdgcn_mfma_f32_32x32x16_bf16(aY, bV, yl, 0, 0, 0);
        }
#pragma unroll
        for (int q = 0; q < 2; ++q) {
            *(u32x4*)(chk + 16384 + wid * 2048 + lane * 32 + q * 16) = (u32x4){pk2(sl[8 * q], sl[8 * q + 1]), pk2(sl[8 * q + 2], sl[8 * q + 3]), pk2(sl[8 * q + 4], sl[8 * q + 5]), pk2(sl[8 * q + 6], sl[8 * q + 7])};
            *(u32x4*)(chk + 24576 + wid * 2048 + lane * 32 + q * 16) = (u32x4){pk2(yl[8 * q], yl[8 * q + 1]), pk2(yl[8 * q + 2], yl[8 * q + 3]), pk2(yl[8 * q + 4], yl[8 * q + 5]), pk2(yl[8 * q + 6], yl[8 * q + 7])}; }
    }
    LBAR();
}
DEVI void cumsum_job(const P& p, int bh, char* lds) {
    const int tid = otid(), lane = tid & 63, wid = tid >> 6, b = bh >> 3, h = bh & 7; float* part = (float*)lds;
    const float* LF = WSP(float, WS_LF) + (size_t)b * LP * 8 + h; float* CS = WSP(float, WS_CS) + (size_t)b * LP * 8 + h;
    const int r0 = tid * 33; float v[33]; float s = 0.f;
#pragma unroll
    for (int i = 0; i < 33; ++i) v[i] = (r0 + i < LP) ? LF[(size_t)(r0 + i) * 8] : 0.f;
#pragma unroll
    for (int i = 0; i < 33; ++i) s += v[i];
    part[tid] = s; LBAR();
    if (wid == 0) { const f32x4 a = *(const f32x4*)(part + 4 * lane); const float tot = (a.x + a.y) + (a.z + a.w); float inc = tot;
#pragma unroll
        for (int o = 1; o < 64; o <<= 1) { const float u = __shfl_up(inc, o); if (lane >= o) inc += u; }
        const float ex = inc - tot; *(f32x4*)(part + 4 * lane) = (f32x4){ex, ex + a.x, ex + a.x + a.y, ex + a.x + a.y + a.z}; }
    LBAR();
    float pre = part[tid];
#pragma unroll
    for (int i = 0; i < 33; ++i) { pre += v[i]; if (r0 + i < LP) CS[(size_t)(r0 + i) * 8] = pre * LOG2E; }
    LBAR();
}
DEVI void phase2c(const P& p, int bid, int nb, char* lds) {
    if (bid < 16) cumsum_job(p, bid, lds);
    for (int q = bid; q < 16 * (NCHUNK - 1); q += nb) chunk_job(p, (q >> 7) * NCHUNK + 1 + (q & 127), lds);
}

DEVI void scanB_job(const P& p, int bh, char* lds) {
    typedef __attribute__((address_space(3))) unsigned lds_u32;
    const int tid = otid(), lane = tid & 63, wid = __builtin_amdgcn_readfirstlane(tid >> 6), l31 = lane & 31, h = lane >> 5, rb = wid >> 1, cb = wid & 1;
    const int b = bh >> 3, hh = bh & 7; const int col0 = hh * 64;
    float* Yo = WSP(float, WS_Y) + ((size_t)b * LP + 64) * 512 + col0 + 32 * cb + l31;
    const char* chk = (const char*)p.ws + WS_CHK + (size_t)bh * NCHUNK * CHUNK_BYTES + wid * 8192 + lane * 16;
    f32x16 accS, accY;
#pragma unroll
    for (int r = 0; r < 16; ++r) { accS[r] = 0.f; accY[r] = 0.f; }
    auto dma = [&](int c, int slot) __attribute__((always_inline)) {
        const char* g = chk + (size_t)c * CHUNK_BYTES; char* d = lds + 8192 + slot * 32768 + wid * 8192;
#pragma unroll
        for (int i = 0; i < 8; ++i) __builtin_amdgcn_global_load_lds((const unsigned*)(g + i * 1024), (lds_u32*)(d + i * 1024), 16, 0, 0);
    };
    dma(0, 0); dma(1, 1);
    for (int c = 0; c < NCHUNK; ++c) {
        const int slot = c & 1;
        if (c + 1 < NCHUNK) asm volatile("s_waitcnt vmcnt(8)" ::: "memory"); else asm volatile("s_waitcnt vmcnt(0)" ::: "memory");
        if (c > 0) {
#pragma unroll
            for (int r = 0; r < 16; ++r) Yo[(size_t)(64 * (c - 1) + 32 * rb + crow(r, h)) * 512] = accY[r];
            asm volatile("" ::: "memory");
        }
#pragma unroll
        for (int g = 0; g < 4; ++g) *(u32x2*)(lds + swz(32 * cb + l31, 4 * rb + g) + 8 * h) = (u32x2){pk2(accS[4 * g], accS[4 * g + 1]), pk2(accS[4 * g + 2], accS[4 * g + 3])};
        asm volatile("s_waitcnt lgkmcnt(0)" ::: "memory"); __builtin_amdgcn_s_barrier(); asm volatile("" ::: "memory");
        const char* sl = lds + 8192 + slot * 32768;
        bf16x8 sb[4], gsf[4], gyf[4];
#pragma unroll
        for (int ks = 0; ks < 4; ++ks) { sb[ks] = frag(lds, 32 * cb + l31, ks, h); gyf[ks] = frag(sl, 32 * rb + l31, ks, h); gsf[ks] = frag(sl + 8192, 32 * rb + l31, ks, h); }
#pragma unroll
        for (int q = 0; q < 2; ++q) { const u32x4 ws = *(const u32x4*)(sl + 16384 + wid * 2048 + lane * 32 + q * 16), wy = *(const u32x4*)(sl + 24576 + wid * 2048 + lane * 32 + q * 16);
#pragma unroll
            for (int j = 0; j < 4; ++j) { accS[8 * q + 2 * j] = __uint_as_float(ws[j] << 16); accS[8 * q + 2 * j + 1] = __uint_as_float(ws[j] & 0xffff0000u);
                accY[8 * q + 2 * j] = __uint_as_float(wy[j] << 16); accY[8 * q + 2 * j + 1] = __uint_as_float(wy[j] & 0xffff0000u); } }
#pragma unroll
        for (int ks = 0; ks < 4; ++ks) { accS = __builtin_amdgcn_mfma_f32_32x32x16_bf16(gsf[ks], sb[ks], accS, 0, 0, 0); accY = __builtin_amdgcn_mfma_f32_32x32x16_bf16(gyf[ks], sb[ks], accY, 0, 0, 0); }
        asm volatile("s_waitcnt lgkmcnt(0)" ::: "memory"); __builtin_amdgcn_s_barrier(); asm volatile("" ::: "memory");
        if (c + 2 < NCHUNK) dma(c + 2, slot);
    }
#pragma unroll
    for (int r = 0; r < 16; ++r) Yo[(size_t)(64 * (NCHUNK - 1) + 32 * rb + crow(r, h)) * 512] = accY[r];
}

DEVI void phase4a(const P& p, int bid, int nb, char*) {
    const int tid = otid(), lane = tid & 63, wid = tid >> 6;
    for (int row = bid * 4 + wid; row < NP; row += nb * 4) {
        const bool pad = (row % LP) < PADL + NMETA;
#pragma unroll
        for (int j = 0; j < 2; ++j) {
            const int c = lane * 4 + 256 * j; const size_t o = (size_t)row * 512 + c;
            u32x2 outv = (u32x2){0u, 0u};
            if (!pad) {
                const bf16_t* zrow = WSP(bf16_t, WS_ZR) + (size_t)row * RWKV_COLS;
                const f32x4 y = *(const f32x4*)(WSP(float, WS_Y) + o), r = zs4(zrow, c, p.rwkv_mu), k2 = ld4bf(WSP(bf16_t, WS_RK2) + o), v = zs4(zrow, 1024 + c, p.rwkv_mu), g = ld4bf(WSP(bf16_t, WS_G) + o);
                const f32x4 rk = *(const f32x4*)(p.r_k + c), lg = *(const f32x4*)(p.lnx_g + c), lb = *(const f32x4*)(p.lnx_b + c);
                const float mu = sum16((y.x + y.y) + (y.z + y.w)) * (1.f / 64.f);
                const f32x4 dy = y - mu;
                const float var = sum16((dy.x * dy.x + dy.y * dy.y) + (dy.z * dy.z + dy.w * dy.w)) * (1.f / 64.f);
                const float rs = rsqrtf(var + GN_EPS);
                const float bonus = sum16((r.x * k2.x * rk.x + r.y * k2.y * rk.y) + (r.z * k2.z * rk.z + r.w * k2.w * rk.w));
                const f32x4 ov = (dy * rs * lg + lb + bonus * v) * g;
                outv = (u32x2){pk2(ov.x, ov.y), pk2(ov.z, ov.w)};
            }
            *(u32x2*)(WSP(bf16_t, WS_MIX) + (size_t)row * 1024 + 512 + c) = outv;
        }
    }
}

struct EpiOutProj {
    const P& p; int tm, tn;
    DEVI void operator()(f32x4 (&acc)[4][4], int wm, int wn, int l15, int lq) const {
#pragma unroll
        for (int mt = 0; mt < 4; ++mt) { const size_t row = (size_t)tm * 128 + wm * 64 + mt * 16 + l15;
#pragma unroll
            for (int nt = 0; nt < 4; ++nt) { const size_t o = row * 1024 + tn * 128 + wn * 64 + nt * 16 + 4 * lq;
                const u32x2 w = *(const u32x2*)(WSP(bf16_t, WS_H0B) + o);
                const f32x4 h0 = (f32x4){__uint_as_float(w.x << 16), __uint_as_float(w.x & 0xffff0000u), __uint_as_float(w.y << 16), __uint_as_float(w.y & 0xffff0000u)};
                *(f32x4*)(WSP(float, WS_PRE1) + o) = h0 * ALPHA + acc[mt][nt]; } }
    }
};
DEVI void phase4b(const P& p, const Sched& sc, char* lds) {
    const int tid = otid(), srow = 16 * (tid >> 6) + ((tid & 63) >> 2);
    for_xcd_items(sc, [&](int x, int rank, int nloc) __attribute__((always_inline)) {
        const int r0 = 16 * x;
        for (int i = rank; i < 16 * 8; i += nloc) {
            const int tr = r0 + (i >> 3), tn = i & 7, tm = (tr >> 6) * NQB + 1 + (tr & 63);
            const bf16_t *ap[4], *bp[2];
#pragma unroll
            for (int q = 0; q < 2; ++q) { ap[q] = WSP(bf16_t, WS_MIX) + (size_t)(tm * 128 + srow + 64 * q) * 1024; bp[q] = WSP(bf16_t, WS_WOUTT) + (size_t)(tn * 128 + srow + 64 * q) * 1024; }
            ap[2] = ap[3] = ap[0];
            gemm256<false, 4>(ap, bp, 1024, lds, EpiOutProj{p, tm, tn});
        }
    });
}

DEVI void phase4c(const P& p, int bid, int nb, char* lds) {
    const int tid = otid(), lane = tid & 63, wid = tid >> 6;
    const int e = tid & 31, ks = tid >> 5;
    float* hrow = (float*)lds;
    float* part = (float*)(lds + 16384);
    unsigned* cnt = WSP(unsigned, WS_CTL) + CW_CNT;
    float wreg[128];
#pragma unroll
    for (int k = 0; k < 128; ++k) wreg[k] = p.w_router[(size_t)(ks * 128 + k) * 32 + e];
    const float br = p.b_router[e];
    for (int base = bid * 4; base < NP; base += nb * 4) {
        const int row = base + wid;
        const bool pad = (row % LP) < PADL + NMETA;
        {
            u32x2* hb = (u32x2*)(WSP(bf16_t, WS_H1B) + (size_t)row * 1024) + lane;
            if (pad) {
#pragma unroll
                for (int j = 0; j < 4; ++j) { hb[64 * j] = (u32x2){0u, 0u}; *(f32x4*)(hrow + wid * 1024 + lane * 4 + 256 * j) = (f32x4){0.f, 0.f, 0.f, 0.f}; }
            } else {
                const f32x4* src = (const f32x4*)(WSP(float, WS_PRE1) + (size_t)row * 1024) + lane;
                f32x4 v[4]; float s = 0.f;
#pragma unroll
                for (int j = 0; j < 4; ++j) { v[j] = src[64 * j]; s += (v[j].x + v[j].y) + (v[j].z + v[j].w); }
                const float mean = wave_sum(s) * (1.f / 1024.f); float s2 = 0.f;
#pragma unroll
                for (int j = 0; j < 4; ++j) { v[j] = v[j] - mean; s2 += (v[j].x * v[j].x + v[j].y * v[j].y) + (v[j].z * v[j].z + v[j].w * v[j].w); }
                const float rstd = rsqrtf(wave_sum(s2) * (1.f / 1024.f) + LN_EPS);
                if (lane == 0) { WSP(float, WS_ST1)[(size_t)row * 2] = mean; WSP(float, WS_ST1)[(size_t)row * 2 + 1] = rstd; }
#pragma unroll
                for (int j = 0; j < 4; ++j) {
                    const f32x4 g = ((const f32x4*)p.ln1_g)[lane + 64 * j], bb = ((const f32x4*)p.ln1_b)[lane + 64 * j];
                    const f32x4 o = v[j] * rstd * g + bb;
                    hb[64 * j] = (u32x2){pk2(o.x, o.y), pk2(o.z, o.w)};
                    *(f32x4*)(hrow + wid * 1024 + lane * 4 + 256 * j) = o;
                }
            }
        }
        LBAR();
        {
            float a0 = 0.f, a1 = 0.f, a2 = 0.f, a3 = 0.f;
            const float* h0 = hrow + ks * 128;
#pragma unroll
            for (int k = 0; k < 128; k += 4) {
                const f32x4 x0 = *(const f32x4*)(h0 + k), x1 = *(const f32x4*)(h0 + 1024 + k), x2 = *(const f32x4*)(h0 + 2048 + k), x3 = *(const f32x4*)(h0 + 3072 + k);
#pragma unroll
                for (int q = 0; q < 4; ++q) { a0 += wreg[k + q] * x0[q]; a1 += wreg[k + q] * x1[q]; a2 += wreg[k + q] * x2[q]; a3 += wreg[k + q] * x3[q]; }
            }
            part[(0 * 8 + ks) * 32 + e] = a0; part[(1 * 8 + ks) * 32 + e] = a1; part[(2 * 8 + ks) * 32 + e] = a2; part[(3 * 8 + ks) * 32 + e] = a3;
        }
        LBAR();
        {
            const int ee = lane & 31;
            float logit = br;
#pragma unroll
            for (int q = 0; q < 8; ++q) logit += part[(wid * 8 + q) * 32 + ee];
            float cur = logit; float tv[4]; int ti[4];
#pragma unroll
            for (int k = 0; k < 4; ++k) {
                float bv = cur; int bi = ee;
#pragma unroll
                for (int o = 16; o > 0; o >>= 1) { const float ov = __shfl_xor(bv, o); const int oi = __shfl_xor(bi, o); if (ov > bv || (ov == bv && oi < bi)) { bv = ov; bi = oi; } }
                tv[k] = bv; ti[k] = bi; if (ee == bi) cur = -INFINITY;
            }
            const float e1 = __expf(tv[1] - tv[0]), e2 = __expf(tv[2] - tv[0]), e3 = __expf(tv[3] - tv[0]); const float inv = 1.f / (1.f + e1 + e2 + e3);
            if (lane < 4 && !pad) {
                const int ex = lane == 0 ? ti[0] : lane == 1 ? ti[1] : lane == 2 ? ti[2] : ti[3];
                const float gt = (lane == 0 ? 1.f : lane == 1 ? e1 : lane == 2 ? e2 : e3) * inv;
                const unsigned rank = atomicAdd(cnt + ex, 1u);
                WSP(int, WS_LTOK)[(size_t)ex * CAP + rank] = row; WSP(float, WS_LGATE)[(size_t)ex * CAP + rank] = gt;
                WSP(int, WS_RTE)[(size_t)row * 4 + lane] = ex; WSP(int, WS_RTR)[(size_t)row * 4 + lane] = (int)rank;
            }
        }
    }
}

struct MoeTab { int* rb; int* cn; int* nf; int* ng; };
DEVI MoeTab moe_prefix(const P& p, char* lds) {
    MoeTab t; t.rb = (int*)(lds + LX); t.cn = t.rb + 33; t.nf = t.cn + 32; t.ng = t.nf + 32;
    if (threadIdx.x == 0) { const unsigned* cnt = WSP(unsigned, WS_CTL) + CW_CNT; int acc = 0;
        for (int e = 0; e < NEXP; ++e) { const int c = (int)cnt[e]; int f = c >> 8, g = 0; const int rem = c & 255; if (rem > 128) ++f; else g = (rem + 63) >> 6;
            t.cn[e] = c; t.nf[e] = f; t.ng[e] = g; t.rb[e] = acc; acc += f * 256 + g * 64; }
        t.rb[NEXP] = acc; }
    __syncthreads();
    return t;
}

template <int MT> struct EpiGU {
    const P& p; int e, row0, tn; char* lds;
    DEVI void operator()(f32x4 (&acc)[MT][4], int wm, int wn, int l15, int lq) const {
        const float* bg = p.b_gu + (size_t)e * 2048;
        const int lane = l15 + 16 * lq, wid = wm * 2 + wn; char* st = lds + wid * 18432;
#pragma unroll
        for (int mt = 0; mt < MT; ++mt) { const size_t row = (size_t)row0 + wm * (16 * MT) + mt * 16 + l15;
#pragma unroll
            for (int np = 0; np < 2; ++np) { const int jc = tn * 64 + wn * 32 + np * 16 + 4 * lq;
                const f32x4 bgt = *(const f32x4*)(bg + jc), bup = *(const f32x4*)(bg + 1024 + jc); float ov[4];
#pragma unroll
                for (int r = 0; r < 4; ++r) { const float gate = fminf(acc[mt][2 * np][r] + bgt[r], 7.f); const float up = fminf(fmaxf(acc[mt][2 * np + 1][r] + bup[r], -7.f), 7.f);
                    ov[r] = (up + 1.f) * (gate * sigmoidf(gate * 1.702f)); }
                const u32x2 w = (u32x2){pk2(ov[0], ov[1]), pk2(ov[2], ov[3])};
                if constexpr (MT == 8) *(u32x2*)(st + (mt * 16 + l15) * 80 + (np * 16 + 4 * lq) * 2) = w;
                else *(u32x2*)(WSP(bf16_t, WS_ACT) + row * 1024 + jc) = w; } }
        if constexpr (MT == 8) {
            asm volatile("s_waitcnt lgkmcnt(0)" ::: "memory");
            bf16_t* dst = WSP(bf16_t, WS_ACT) + ((size_t)row0 + wm * 128) * 1024 + tn * 64 + wn * 32;
#pragma unroll
            for (int i = 0; i < 8; ++i) { const int r = 16 * i + (lane >> 2), ch = lane & 3; *(u32x4*)(dst + (size_t)r * 1024 + ch * 8) = *(const u32x4*)(st + r * 80 + ch * 16); }
            LBAR();
        }
    }
};
template <int MT> struct EpiDown {
    const P& p; int e, row0, idx0, cnt_e, tn; char* lds;
    DEVI void operator()(f32x4 (&acc)[MT][4], int wm, int wn, int l15, int lq) const {
        const float* bd = p.b_down + (size_t)e * 1024;
        if constexpr (MT == 8) {
            const int lane = l15 + 16 * lq, wid = wm * 2 + wn; char* st = lds + wid * 18432;
#pragma unroll
            for (int mt = 0; mt < MT; ++mt) { const int ml = wm * 128 + mt * 16 + l15; const int idx = idx0 + ml; const float gt = idx < cnt_e ? WSP(float, WS_LGATE)[(size_t)e * CAP + idx] : 0.f;
#pragma unroll
                for (int nt = 0; nt < 4; ++nt) { const int c = tn * 128 + wn * 64 + nt * 16 + 4 * lq; const f32x4 o = (acc[mt][nt] + *(const f32x4*)(bd + c)) * gt;
                    *(u32x2*)(st + (mt * 16 + l15) * 144 + (nt * 16 + 4 * lq) * 2) = (u32x2){pk2(o.x, o.y), pk2(o.z, o.w)}; } }
            asm volatile("s_waitcnt lgkmcnt(0)" ::: "memory");
            bf16_t* dst = WSP(bf16_t, WS_YB) + ((size_t)row0 + wm * 128) * 1024 + tn * 128 + wn * 64;
#pragma unroll
            for (int i = 0; i < 16; ++i) { const int r = 8 * i + (lane >> 3), ch = lane & 7; *(u32x4*)(dst + (size_t)r * 1024 + ch * 8) = *(const u32x4*)(st + r * 144 + ch * 16); }
            LBAR();
        } else {
#pragma unroll
            for (int mt = 0; mt < MT; ++mt) { const int ml = wm * (16 * MT) + mt * 16 + l15; const int idx = idx0 + ml; const float gt = idx < cnt_e ? WSP(float, WS_LGATE)[(size_t)e * CAP + idx] : 0.f;
                const size_t row = (size_t)row0 + ml;
#pragma unroll
                for (int nt = 0; nt < 4; ++nt) { const int c = tn * 128 + wn * 64 + nt * 16 + 4 * lq; const f32x4 o = (acc[mt][nt] + *(const f32x4*)(bd + c)) * gt; *(u32x2*)(WSP(bf16_t, WS_YB) + row * 1024 + c) = (u32x2){pk2(o.x, o.y), pk2(o.z, o.w)}; } }
        }
    }
};
template <int NT, class FullFn, class SmallFn>
DEVI void moe_items(const MoeTab& T, int x, int rank, int nloc, FullFn&& full, SmallFn&& small) {
    const int f0 = T.nf[x], f1 = f0 + T.nf[x + 8], f2 = f1 + T.nf[x + 16], f3 = f2 + T.nf[x + 24];
    const int g0 = T.ng[x], g1 = g0 + T.ng[x + 8], g2 = g1 + T.ng[x + 16], g3 = g2 + T.ng[x + 24];
    for (int i = rank; i < (f3 + g3) * NT; i += nloc) {
        if (i < f3 * NT) { const int rbk = i / NT, tn = i % NT; const int j = rbk < f0 ? 0 : rbk < f1 ? 1 : rbk < f2 ? 2 : 3; const int e = x + 8 * j, mb = rbk - (j == 0 ? 0 : j == 1 ? f0 : j == 2 ? f1 : f2);
            full(e, mb * 256, tn); }
        else { const int k = i - f3 * NT, gk = k / NT, tn = k % NT; const int j = gk < g0 ? 0 : gk < g1 ? 1 : gk < g2 ? 2 : 3; const int e = x + 8 * j, gi = gk - (j == 0 ? 0 : j == 1 ? g0 : j == 2 ? g1 : g2);
            small(e, T.nf[e] * 256 + gi * 64, tn); }
    }
}
DEVI void phase5(const P& p, const Sched& sc, char* lds) {
    const MoeTab T = moe_prefix(p, lds);
    const int tid = otid(), lane = tid & 63, wid = tid >> 6, srow = 16 * wid + (lane >> 2);
    for_xcd_items(sc, [&](int x, int rank, int nloc) __attribute__((always_inline)) {
        moe_items<16>(T, x, rank, nloc,
            [&](int e, int idx0, int tn) __attribute__((always_inline)) {
                const bf16_t *ap[4], *bp[2];
#pragma unroll
                for (int q = 0; q < 4; ++q) { const int idx = idx0 + srow + 64 * q; const int tok = idx < T.cn[e] ? WSP(int, WS_LTOK)[(size_t)e * CAP + idx] : 0; ap[q] = WSP(bf16_t, WS_H1B) + (size_t)tok * 1024; }
#pragma unroll
                for (int q = 0; q < 2; ++q) bp[q] = WSP(bf16_t, WS_WGUT) + ((size_t)e * 2048 + tn * 128 + srow + 64 * q) * 1024;
                gemm256<false, 8>(ap, bp, 1024, lds, EpiGU<8>{p, e, T.rb[e] + idx0, tn, lds}); },
            [&](int e, int idx0, int tn) __attribute__((always_inline)) {
                const bf16_t *ap[4], *bp[2];
                { const int idx = idx0 + srow; const int tok = idx < T.cn[e] ? WSP(int, WS_LTOK)[(size_t)e * CAP + idx] : 0; ap[0] = WSP(bf16_t, WS_H1B) + (size_t)tok * 1024; ap[1] = ap[2] = ap[3] = ap[0]; }
#pragma unroll
                for (int q = 0; q < 2; ++q) bp[q] = WSP(bf16_t, WS_WGUT) + ((size_t)e * 2048 + tn * 128 + srow + 64 * q) * 1024;
                gemm256<false, 2>(ap, bp, 1024, lds, EpiGU<2>{p, e, T.rb[e] + idx0, tn, lds}); });
    });
}
DEVI void phase6(const P& p, const Sched& sc, char* lds) {
    const MoeTab T = moe_prefix(p, lds);
    const int tid = otid(), lane = tid & 63, wid = tid >> 6, srow = 16 * wid + (lane >> 2);
    for_xcd_items(sc, [&](int x, int rank, int nloc) __attribute__((always_inline)) {
        moe_items<8>(T, x, rank, nloc,
            [&](int e, int idx0, int tn) __attribute__((always_inline)) {
                const bf16_t *ap[4], *bp[2];
#pragma unroll
                for (int q = 0; q < 4; ++q) ap[q] = WSP(bf16_t, WS_ACT) + ((size_t)T.rb[e] + idx0 + srow + 64 * q) * 1024;
#pragma unroll
                for (int q = 0; q < 2; ++q) bp[q] = WSP(bf16_t, WS_WDT) + ((size_t)e * 1024 + tn * 128 + srow + 64 * q) * 1024;
                gemm256<false, 8>(ap, bp, 1024, lds, EpiDown<8>{p, e, T.rb[e] + idx0, idx0, T.cn[e], tn, lds}); },
            [&](int e, int idx0, int tn) __attribute__((always_inline)) {
                const bf16_t *ap[4], *bp[2];
                ap[0] = WSP(bf16_t, WS_ACT) + ((size_t)T.rb[e] + idx0 + srow) * 1024; ap[1] = ap[2] = ap[3] = ap[0];
#pragma unroll
                for (int q = 0; q < 2; ++q) bp[q] = WSP(bf16_t, WS_WDT) + ((size_t)e * 1024 + tn * 128 + srow + 64 * q) * 1024;
                gemm256<false, 2>(ap, bp, 1024, lds, EpiDown<2>{p, e, T.rb[e] + idx0, idx0, T.cn[e], tn, lds}); });
    });
}
DEVI void phase7(const P& p, int bid, int nb, char* lds) {
    const MoeTab T = moe_prefix(p, lds);
    const int tid = otid(), lane = tid & 63, wid = tid >> 6;
    for (int row = bid * 4 + wid; row < NP; row += nb * 4) {
        const int b = row / LP, pp = row % LP; if (pp < PADL + NMETA) continue;
        const int t = pp - PADL - NMETA;
        const f32x4* pre = (const f32x4*)(WSP(float, WS_PRE1) + (size_t)row * 1024) + lane;
        const float mean1 = WSP(float, WS_ST1)[(size_t)row * 2], rstd1 = WSP(float, WS_ST1)[(size_t)row * 2 + 1];
        f32x4 v[4];
#pragma unroll
        for (int j = 0; j < 4; ++j) v[j] = ((pre[64 * j] - mean1) * rstd1 * ((const f32x4*)p.ln1_g)[lane + 64 * j] + ((const f32x4*)p.ln1_b)[lane + 64 * j]) * ALPHA;
#pragma unroll
        for (int k = 0; k < 4; ++k) { const int e = WSP(int, WS_RTE)[(size_t)row * 4 + k], rk = WSP(int, WS_RTR)[(size_t)row * 4 + k];
            const u32x2* yb = (const u32x2*)(WSP(bf16_t, WS_YB) + ((size_t)T.rb[e] + rk) * 1024) + lane;
#pragma unroll
            for (int j = 0; j < 4; ++j) { const u32x2 w = yb[64 * j]; v[j] += (f32x4){__uint_as_float(w.x << 16), __uint_as_float(w.x & 0xffff0000u), __uint_as_float(w.y << 16), __uint_as_float(w.y & 0xffff0000u)}; } }
        float s = 0.f;
#pragma unroll
        for (int j = 0; j < 4; ++j) s += (v[j].x + v[j].y) + (v[j].z + v[j].w);
        const float mean = wave_sum(s) * (1.f / 1024.f); float s2 = 0.f;
#pragma unroll
        for (int j = 0; j < 4; ++j) { v[j] = v[j] - mean; s2 += (v[j].x * v[j].x + v[j].y * v[j].y) + (v[j].z * v[j].z + v[j].w * v[j].w); }
        const float rstd = rsqrtf(wave_sum(s2) * (1.f / 1024.f) + LN_EPS);
        f32x4* o = (f32x4*)(p.out + ((size_t)b * SEQ + t) * 1024) + lane;
#pragma unroll
        for (int j = 0; j < 4; ++j) o[64 * j] = v[j] * rstd * ((const f32x4*)p.ln2_g)[lane + 64 * j] + ((const f32x4*)p.ln2_b)[lane + 64 * j];
    }
}

#define LAS __attribute__((address_space(3)))
#define XB_TMO      128
#define XB_XCNT(j)  (256  + 64 * (j))
#define XB_XSUB(j)  (1280 + 64 * (j))
#define XB_XGEN(j)  (2304 + 64 * (j))
#define XB_TOP      3328
#define XB_TOPGEN   3392
#define XCD_BAR_WORDS 3456
#define XB_SPIN_CAP (1u << 18)
__device__ __forceinline__ unsigned xb_ld(unsigned* p)              { return __hip_atomic_load(p, __ATOMIC_RELAXED, __HIP_MEMORY_SCOPE_AGENT); }
__device__ __forceinline__ unsigned xb_add(unsigned* p, unsigned v) { return __hip_atomic_fetch_add(p, v, __ATOMIC_RELAXED, __HIP_MEMORY_SCOPE_AGENT); }
__device__ __forceinline__ unsigned xb_xcc_id() { return (unsigned)__builtin_amdgcn_s_getreg((3 << 11) | 20) & 0xFu; }
#define XB_SPIN(cond, bar) do { unsigned _sp = 0; while (cond) { __builtin_amdgcn_s_sleep(1); \
    if ((++_sp & 255u) == 0u) { if (xb_ld(&(bar)[XB_TMO])) break; if (_sp > XB_SPIN_CAP) { atomicAdd(&(bar)[XB_TMO], 1u); break; } } } } while (0)
struct XcdBarrier { unsigned* bar; unsigned x; volatile LAS unsigned* st; };
__device__ __forceinline__ XcdBarrier xcd_barrier_post(unsigned* bar, volatile LAS unsigned* st) {
    XcdBarrier b; b.bar = bar; b.x = xb_xcc_id(); b.st = st;
    if (threadIdx.x == 0) (void)xb_add(&bar[XB_XCNT(b.x)], 1u);
    return b;
}
__device__ __forceinline__ void xcd_barrier_complete(unsigned* bar, unsigned x, unsigned& nloc, unsigned& nx) {
    const unsigned G = gridDim.x * gridDim.y * gridDim.z;
    unsigned sum, cnt, mine, sp = 0u;
    for (;;) {
        sum = 0u; cnt = 0u; mine = 0u;
#pragma unroll
        for (unsigned j = 0; j < 16; ++j) { const unsigned c = xb_ld(&bar[XB_XCNT(j)]); sum += c; cnt += (c > 0u) ? 1u : 0u; mine = (j == x) ? c : mine; }
        if (sum == G) break;
        __builtin_amdgcn_s_sleep(1);
        if ((++sp & 255u) == 0u) { if (xb_ld(&bar[XB_TMO])) break; if (sp > XB_SPIN_CAP) { atomicAdd(&bar[XB_TMO], 1u); break; } }
    }
    nloc = mine > 0u ? mine : 1u; nx = cnt > 0u ? cnt : 1u;
}
__device__ __forceinline__ void xcd_barrier(const XcdBarrier& b) {
    asm volatile("s_waitcnt vmcnt(0)" ::: "memory");
    __syncthreads();
    if (threadIdx.x == 0) {
        unsigned* bar = b.bar;
        __builtin_amdgcn_s_waitcnt(0);
        unsigned nloc = b.st[0], nx = b.st[1];
        if (nloc == 0u) { xcd_barrier_complete(bar, b.x, nloc, nx); b.st[0] = nloc; b.st[1] = nx; }
        const unsigned old = xb_add(&bar[XB_XSUB(b.x)], 1u);
        const unsigned gen = old / nloc;
        if (old + 1u == (gen + 1u) * nloc) {
            __builtin_amdgcn_fence(__ATOMIC_RELEASE, "agent");
            asm volatile("s_waitcnt vmcnt(0)" ::: "memory");
            const unsigned og = xb_add(&bar[XB_TOP], 1u);
            const unsigned tg = og / nx;
            if (og + 1u == (tg + 1u) * nx) xb_add(&bar[XB_TOPGEN], 1u);
            else XB_SPIN(xb_ld(&bar[XB_TOPGEN]) == tg, bar);
            __builtin_amdgcn_fence(__ATOMIC_ACQUIRE, "agent");
            xb_add(&bar[XB_XGEN(b.x)], 1u);
            asm volatile("s_waitcnt vmcnt(0)" ::: "memory");
        } else {
            XB_SPIN(xb_ld(&bar[XB_XGEN(b.x)]) == gen, bar);
            __builtin_amdgcn_fence(__ATOMIC_ACQUIRE, "agent");
            asm volatile("s_waitcnt vmcnt(0)" ::: "memory");
        }
    }
    __syncthreads();
}

namespace cg = cooperative_groups;
constexpr int CW_BAR = 4096;
constexpr size_t CTL_ZERO_BYTES = 65536;
constexpr int N_SCAN_JOBS = 16, N_ATT_ITEMS = 16 * (NQB - 1);
DEVI void phase3(const P& p, char* lds, int qoff) {
    int* s_item = (int*)(lds + LX + 992);
    unsigned* q = WSP(unsigned, WS_CTL) + CW_QATT + qoff;
    for (;;) {
        if (threadIdx.x == 0) *s_item = (int)atomicAdd(q, 1u);
        __syncthreads();
        const int it = __builtin_amdgcn_readfirstlane(*s_item);
        __syncthreads();
        if (it >= N_SCAN_JOBS + N_ATT_ITEMS + N_CONV_ITEMS) break;
        if (it < N_SCAN_JOBS) {
            chunk_job(p, it * NCHUNK, lds);
            __threadfence(); __syncthreads();
            __builtin_amdgcn_s_setprio(3); scanB_job(p, it, lds); __builtin_amdgcn_s_setprio(0); continue; }
        const int r = it - N_SCAN_JOBS; int a;
        if (r < 3 * N_CONV_ITEMS) { if (r % 3 == 2) { conv_moe_item(p, r / 3, lds); continue; } a = 2 * (r / 3) + (r % 3); }
        else a = r - N_CONV_ITEMS;
        { const int qb = NQB - 1 - a / 16, bh = a % 16; attn_item(p, bh >> 3, bh & 7, qb, lds); }
    }
}
__global__ void __launch_bounds__(256, 2) k_mega(P p) {
    __shared__ __attribute__((aligned(16))) char lds[LDS_BYTES];
    const int bid = blockIdx.x, nb = gridDim.x;
    volatile LAS unsigned* st = (volatile LAS unsigned*)(LAS char*)(lds + LX + 1008);
    if (threadIdx.x < 2) st[threadIdx.x] = 0u;
    __syncthreads();
    if (p.ws == nullptr) cg::this_grid().sync();
    const XcdBarrier bar = xcd_barrier_post(WSP(unsigned, WS_CTL) + CW_BAR, st);
    int* s_rank = (int*)(lds + LX + 976);
    if (threadIdx.x == 0) *s_rank = (int)atomicAdd(WSP(unsigned, WS_CTL) + CW_XRANK + 64 * (bar.x & 15), 1u);
#ifndef PROBE_MASK
#define PROBE_MASK 0
#endif
#define RUNP(k, call) do { call; if (PROBE_MASK & (1 << (k))) { xcd_barrier(bar); call; } } while (0)
    RUNP(0, phase0(p, bid, nb, lds));  xcd_barrier(bar);
    Sched sc;
    { const int nloc = __builtin_amdgcn_readfirstlane((int)st[0]), nx = __builtin_amdgcn_readfirstlane((int)st[1]), rk = __builtin_amdgcn_readfirstlane(*s_rank); const bool ok = nx == 8 && bar.x < 8 && rk < nloc;
      sc.x = ok ? (int)bar.x : 0; sc.rank = ok ? rk : bid; sc.nloc = ok ? nloc : nb; sc.nxcd = ok ? 8 : 0; }
    RUNP(1, phase1(p, sc, lds));  xcd_barrier(bar);
    RUNP(4, phase2c(p, bid, nb, lds)); xcd_barrier(bar);
    phase3(p, lds, 0); if (PROBE_MASK & (1 << 5)) { xcd_barrier(bar); phase3(p, lds, 64); } xcd_barrier(bar);
    RUNP(6, phase4a(p, bid, nb, lds)); xcd_barrier(bar);
    RUNP(7, phase4b(p, sc, lds)); xcd_barrier(bar);
    phase4c(p, bid, nb, lds); xcd_barrier(bar);
    RUNP(9, phase5(p, sc, lds));  xcd_barrier(bar);
    RUNP(10, phase6(p, sc, lds));  xcd_barrier(bar);
    RUNP(11, phase7(p, bid, nb, lds));
}

extern "C" void kernel_launch(void* const* d_in, const int* in_sizes, int n_in, void* d_out, int out_size, void* d_ws, size_t ws_size, hipStream_t stream) {
    if (n_in != 29 || ws_size < WS_NEED) { fprintf(stderr, "kernel_launch: unexpected n_in %d or ws_size %zu (need %zu)\n", n_in, ws_size, (size_t)WS_NEED); return; }
    static int grid_blocks = 0;
    if (!grid_blocks) {
        int dev = 0, cus = 0, per_cu = 0;
        (void)hipGetDevice(&dev);
        (void)hipDeviceGetAttribute(&cus, hipDeviceAttributeMultiprocessorCount, dev);
        (void)hipOccupancyMaxActiveBlocksPerMultiprocessor(&per_cu, k_mega, 256, 0);
        if (per_cu > 2) per_cu = 2;
        grid_blocks = cus * per_cu;
        if (grid_blocks <= 0) { fprintf(stderr, "kernel_launch: occupancy query gave %d x %d\n", cus, per_cu); grid_blocks = 0; return; }
    }
    (void)hipMemsetAsync((char*)d_ws + WS_CTL, 0, CTL_ZERO_BYTES, stream);
    P p{};
    const float** pf = (const float**)&p;
    for (int i = 0; i < 29; ++i) pf[i] = (const float*)d_in[i];
    p.out = (float*)d_out; p.ws = (unsigned char*)d_ws;
    void* args[] = {&p};
    hipError_t e = hipLaunchCooperativeKernel((void*)k_mega, dim3(grid_blocks), dim3(256), args, 0, stream);
    if (e != hipSuccess) fprintf(stderr, "cooperative launch failed: %s (grid %d)\n", hipGetErrorString(e), grid_blocks);
}
```

```cpp
#include <hip/hip_runtime.h>
#include <hip/hip_cooperative_groups.h>
#include <stdint.h>
#include <stdio.h>

#define DEVI __device__ __forceinline__
typedef unsigned short bf16_t;
typedef short bf16x8 __attribute__((ext_vector_type(8)));
typedef float f32x4 __attribute__((ext_vector_type(4)));
typedef float f32x16 __attribute__((ext_vector_type(16)));
typedef unsigned u32x4 __attribute__((ext_vector_type(4)));
typedef unsigned u32x2 __attribute__((ext_vector_type(2)));

constexpr int BATCH = 2, SEQ = 8192, DM = 1024, NMETA = 16;
constexpr int LTOK = SEQ + NMETA;
constexpr int PADL = 112;
constexpr int LP = LTOK + PADL;
constexpr int NP = BATCH * LP;
constexpr int NQB = LP / 128;
constexpr int NH = 8, HD = 64;
constexpr int FOXW = 512, RWW = 512;
constexpr int RWKV_COLS = 1792;
constexpr int IN_COLS = 3336;
constexpr int WIN_N = 3456;
constexpr int NEXP = 32, TOPK = 4;
constexpr int CAP = BATCH * LTOK;
constexpr int MAXBLK = (BATCH * LTOK * TOPK) / 256 + NEXP + 1;
constexpr float ALPHA = 1.189207115002721f;
constexpr float LN_EPS = 1e-5f, GN_EPS = 64e-5f, RMS_EPS = 1e-6f;
constexpr float LOG2E = 1.4426950408889634f;
constexpr float QSCALE = 0.125f * LOG2E;
constexpr float NEGBIG = -1e30f;

constexpr size_t MiB = 1u << 20;
constexpr size_t al256(size_t x) { return (x + 255) & ~(size_t)255; }
constexpr size_t WS_CTL = 0;
constexpr size_t WS_WINT = 1 * MiB;
constexpr size_t WS_WOUTT = WS_WINT + (size_t)WIN_N * 1024 * 2;
constexpr size_t WS_W2T = WS_WOUTT + (size_t)1024 * 1024 * 2;
constexpr size_t WS_A2T = WS_W2T + 512 * 64 * 2;
constexpr size_t WS_G2T = WS_A2T + 512 * 64 * 2;
constexpr size_t WS_WGUT = al256(WS_G2T + 512 * 128 * 2);
constexpr size_t WS_WDT = WS_WGUT + (size_t)32 * 2048 * 1024 * 2;
constexpr size_t WS_ST1 = WS_WDT + (size_t)32 * 1024 * 1024 * 2;
constexpr size_t WS_H1B = WS_ST1 + (size_t)NP * 2 * 4;
constexpr size_t WS_RTE = WS_H1B + (size_t)NP * 1024 * 2;
constexpr size_t WS_RTR = WS_RTE + (size_t)NP * 16;
constexpr size_t WS_LTOK = WS_RTR + (size_t)NP * 16;
constexpr size_t WS_LGATE = WS_LTOK + (size_t)32 * CAP * 4;
constexpr size_t WS_PRE1 = al256(WS_LGATE + (size_t)32 * CAP * 4);
constexpr size_t WS_EARLY = WS_PRE1 + (size_t)NP * 1024 * 4;
constexpr size_t WS_H0B = WS_EARLY;
constexpr size_t WS_QB = WS_H0B + (size_t)NP * 1024 * 2;
constexpr size_t WS_KB = WS_QB + (size_t)NP * 512 * 2;
constexpr size_t WS_VT = WS_KB + (size_t)NP * 512 * 2;
constexpr size_t WS_ZR = WS_VT + (size_t)NP * 512 * 2;
constexpr size_t WS_LF = WS_ZR + (size_t)NP * 1792 * 4;
constexpr size_t WS_CS = WS_LF + (size_t)NP * 8 * 4;
constexpr size_t WS_R = WS_CS + (size_t)NP * 8 * 4;
constexpr size_t WS_CHK = WS_R;
static_assert((size_t)16 * 129 * 32768 <= (size_t)4 * NP * 512 * 2, "chunk buffers fit");
constexpr size_t WS_KR = WS_R + (size_t)NP * 512 * 2;
constexpr size_t WS_VR = WS_KR + (size_t)NP * 512 * 2;
constexpr size_t WS_KK = WS_VR + (size_t)NP * 512 * 2;
constexpr size_t WS_TW = WS_KK + (size_t)NP * 512 * 2;
constexpr size_t WS_DA = WS_TW + (size_t)NP * 64 * 2;
constexpr size_t WS_SG = WS_DA + (size_t)NP * 64 * 2;
constexpr size_t WS_RW = WS_SG + (size_t)NP * 128 * 2;
constexpr size_t WS_RB = WS_RW + (size_t)NP * 512 * 4;
constexpr size_t WS_RK2 = WS_RB + (size_t)NP * 512 * 2;
constexpr size_t WS_G = WS_RK2 + (size_t)NP * 512 * 2;
constexpr size_t WS_Y = WS_G + (size_t)NP * 512 * 2;
constexpr size_t WS_MIX = WS_Y + (size_t)NP * 512 * 4;
constexpr size_t WS_LGS = WS_MIX + (size_t)NP * 1024 * 2;
constexpr size_t WS_EARLY_END = WS_LGS + (size_t)1024 * 49152;
constexpr size_t WS_ACT = WS_EARLY;
constexpr size_t WS_YB = WS_ACT + (size_t)MAXBLK * 256 * 1024 * 2;
constexpr size_t WS_LATE_END = WS_YB + (size_t)MAXBLK * 256 * 1024 * 2;
constexpr size_t WS_NEED = WS_EARLY_END > WS_LATE_END ? WS_EARLY_END : WS_LATE_END;
constexpr int CW_CNT = 0;
constexpr int CW_QATT = 64;
constexpr int CW_QK2 = 320;
constexpr int CW_XRANK = 1024;

struct P {
    const float *x, *meta, *ln0_g, *ln0_b, *w_in, *b_fgate, *fox_norm_g, *rwkv_mu, *w0, *w2, *a0, *a2, *g2, *k_k, *k_a, *r_k, *lnx_g,
        *lnx_b, *w_out, *ln1_g, *ln1_b, *w_router, *b_router, *w_gu, *b_gu, *w_down, *b_down, *ln2_g, *ln2_b;
    float* out;
    unsigned char* ws;
};
#define WSP(T, off) ((T*)(p.ws + (off)))

#define LBAR() do { asm volatile("s_waitcnt lgkmcnt(0)" ::: "memory"); __builtin_amdgcn_s_barrier(); asm volatile("" ::: "memory"); } while (0)
DEVI int otid() { int t = threadIdx.x; asm volatile("" : "+v"(t)); return t; }
DEVI unsigned f2bf(float f) { unsigned u = __float_as_uint(f); u += 0x7fffu + ((u >> 16) & 1u); return u >> 16; }
typedef float f32x2 __attribute__((ext_vector_type(2)));
typedef __bf16 bf16x2_t __attribute__((ext_vector_type(2)));
DEVI unsigned pk2(float lo, float hi) { const f32x2 v = {lo, hi}; const bf16x2_t b = __builtin_convertvector(v, bf16x2_t); return __builtin_bit_cast(unsigned, b); }
DEVI f32x4 ld4bf(const bf16_t* p) { const u32x2 w = *(const u32x2*)p; return (f32x4){__uint_as_float(w.x << 16), __uint_as_float(w.x & 0xffff0000u), __uint_as_float(w.y << 16), __uint_as_float(w.y & 0xffff0000u)}; }
DEVI void st4bf(bf16_t* p, f32x4 v) { *(u32x2*)p = (u32x2){pk2(v.x, v.y), pk2(v.z, v.w)}; }
DEVI float ld1bf(const bf16_t* p) { return __uint_as_float((unsigned)(*p) << 16); }
DEVI float wave_sum(float v) {
#pragma unroll
    for (int o = 32; o > 0; o >>= 1) v += __shfl_xor(v, o);
    return v;
}
DEVI float sum16(float v) {
#pragma unroll
    for (int o = 8; o > 0; o >>= 1) v += __shfl_xor(v, o);
    return v;
}
template <int CTRL> DEVI float dpp_mov(float v) { return __int_as_float(__builtin_amdgcn_update_dpp(0, __float_as_int(v), CTRL, 0xF, 0xF, false)); }
DEVI float rowsum16_dpp(float v) {
    v += dpp_mov<0xB1>(v);
    v += dpp_mov<0x4E>(v);
    v += dpp_mov<0x141>(v);
    v += dpp_mov<0x140>(v);
    return v;
}
DEVI float softplusf(float x) { return fmaxf(x, 0.f) + log1pf(__expf(-fabsf(x))); }
DEVI float sigmoidf(float x) { return __builtin_amdgcn_rcpf(1.f + __expf(-x)); }
DEVI float tanh_fast(float x) { return 1.f - 2.f * __builtin_amdgcn_rcpf(__expf(2.f * x) + 1.f); }
DEVI f32x4 zs4(const bf16_t* zrow, int col, const float* mu) { const f32x4 zc = ld4bf(zrow + col), zp = ld4bf(zrow - RWKV_COLS + col); return zc + (zp - zc) * *(const f32x4*)(mu + col); }
DEVI float softplus_fast(float x) { return fmaxf(x, 0.f) + __logf(1.f + __expf(-fabsf(x))); }

constexpr int G2_STAGE = 24576;
constexpr int LDS_BYTES = 73728 + 1024;
constexpr int LX = 73728;
DEVI int xf4(int r) { return (0x78 >> (2 * ((r >> 2) & 3))) & 3; }
template <bool SWAP, int MT, class Epi>
DEVI void gemm256(const bf16_t* (&ap)[4], const bf16_t* (&bp)[2], int K, char* lds, Epi&& epi) {
    typedef __attribute__((address_space(3))) unsigned lds_u32;
    constexpr int NA = MT / 2 < 1 ? 1 : MT / 2;
    const int tid = otid(), lane = tid & 63, wid = __builtin_amdgcn_readfirstlane(tid >> 6), wm = wid >> 1, wn = wid & 1;
    const int l15 = lane & 15, lq = lane >> 4;
    const int gko = ((lane & 3) ^ xf4(lane >> 2)) << 3;
    f32x4 acc[MT][4];
#pragma unroll
    for (int i = 0; i < MT; ++i)
#pragma unroll
        for (int j = 0; j < 4; ++j) acc[i][j] = (f32x4){0.f, 0.f, 0.f, 0.f};
    const int nk = K / 32;
#define G2_DMA_A(kt, s, i) __builtin_amdgcn_global_load_lds((const unsigned*)(ap[i] + (kt) * 32 + gko), (lds_u32*)(lds + (s) * G2_STAGE + wid * 1024 + (i) * 4096), 16, 0, 0)
#define G2_DMA_B(kt, s, i) __builtin_amdgcn_global_load_lds((const unsigned*)(bp[i] + (kt) * 32 + gko), (lds_u32*)(lds + (s) * G2_STAGE + wid * 1024 + 16384 + (i) * 4096), 16, 0, 0)
#define G2_MMA(mt) do { _Pragma("unroll") for (int nt = 0; nt < 4; ++nt) { \
        if (SWAP) acc[mt][nt] = __builtin_amdgcn_mfma_f32_16x16x32_bf16(af[mt], bfr[nt], acc[mt][nt], 0, 0, 0); \
        else acc[mt][nt] = __builtin_amdgcn_mfma_f32_16x16x32_bf16(bfr[nt], af[mt], acc[mt][nt], 0, 0, 0); } } while (0)
#pragma unroll
    for (int st = 0; st < 2; ++st) { if (st < nk) {
#pragma unroll
        for (int i = 0; i < NA; ++i) G2_DMA_A(st, st, i);
        G2_DMA_B(st, st, 0); G2_DMA_B(st, st, 1); } }
    const int co = (lq ^ xf4(l15)) << 4;
    const int aoff = (wm * (16 * MT) + l15) * 64 + co, boff = 16384 + (wn * 64 + l15) * 64 + co;
    int s = 0;
    for (int kt = 0; kt < nk; ++kt) {
        if (kt + 1 < nk) { if (MT == 8) asm volatile("s_waitcnt vmcnt(6)" ::: "memory"); else if (MT == 4) asm volatile("s_waitcnt vmcnt(4)" ::: "memory"); else asm volatile("s_waitcnt vmcnt(3)" ::: "memory"); }
        else asm volatile("s_waitcnt vmcnt(0)" ::: "memory");
        __builtin_amdgcn_s_barrier(); asm volatile("" ::: "memory");
        const char* base = lds + s * G2_STAGE;
        bf16x8 af[MT], bfr[4];
#pragma unroll
        for (int t = 0; t < 4; ++t) bfr[t] = *(const bf16x8*)(base + boff + t * 1024);
#pragma unroll
        for (int t = 0; t < (MT < 4 ? MT : 4); ++t) af[t] = *(const bf16x8*)(base + aoff + t * 1024);
        const bool pre = kt + 2 < nk; int s2 = s + 2; if (s2 >= 3) s2 -= 3;
        __builtin_amdgcn_sched_barrier(0); __builtin_amdgcn_s_setprio(1);
        G2_MMA(0); __builtin_amdgcn_sched_barrier(0);
        if constexpr (MT == 8) {
#pragma unroll
            for (int t = 4; t < MT; ++t) af[t] = *(const bf16x8*)(base + aoff + t * 1024);
            if (pre) G2_DMA_A(kt + 2, s2, 0); __builtin_amdgcn_sched_barrier(0);
            G2_MMA(1); if (pre) G2_DMA_A(kt + 2, s2, 1); __builtin_amdgcn_sched_barrier(0);
            G2_MMA(2); if (pre) G2_DMA_A(kt + 2, s2, 2); __builtin_amdgcn_sched_barrier(0);
            G2_MMA(3); if (pre) G2_DMA_A(kt + 2, s2, 3); __builtin_amdgcn_sched_barrier(0);
            G2_MMA(4); if (pre) G2_DMA_B(kt + 2, s2, 0); __builtin_amdgcn_sched_barrier(0);
            G2_MMA(5); if (pre) G2_DMA_B(kt + 2, s2, 1); __builtin_amdgcn_sched_barrier(0);
            G2_MMA(6); G2_MMA(7);
        } else if constexpr (MT == 4) {
            if (pre) G2_DMA_A(kt + 2, s2, 0); __builtin_amdgcn_sched_barrier(0);
            G2_MMA(1); if (pre) G2_DMA_A(kt + 2, s2, 1); __builtin_amdgcn_sched_barrier(0);
            G2_MMA(2); if (pre) { G2_DMA_B(kt + 2, s2, 0); G2_DMA_B(kt + 2, s2, 1); } __builtin_amdgcn_sched_barrier(0);
            G2_MMA(3);
        } else {
            if (pre) { G2_DMA_A(kt + 2, s2, 0); G2_DMA_B(kt + 2, s2, 0); G2_DMA_B(kt + 2, s2, 1); } __builtin_amdgcn_sched_barrier(0);
            G2_MMA(1);
        }
        __builtin_amdgcn_s_setprio(0);
        asm volatile("s_waitcnt lgkmcnt(0)" ::: "memory");
        s = s == 2 ? 0 : s + 1;
    }
#undef G2_DMA_A
#undef G2_DMA_B
#undef G2_MMA
    __builtin_amdgcn_s_barrier(); asm volatile("" ::: "memory");
    epi(acc, wm, wn, l15, lq);
}

DEVI int srccol(int kind, int n) {
    if (kind == 0) return n;
    if (kind == 1) { if (n < 1536) return n; if (n < 3328) return n + 8; if (n < 3336) return 1536 + (n - 3328); return -1; }
    const int T = n >> 5, w = n & 31;
    return w < 16 ? T * 16 + w : 1024 + T * 16 + (w - 16);
}
DEVI void conv_tile(const float* src, int K, int NS, bf16_t* dst, int kind, int kt, int nt, float* scr  ) {
    const int tid = otid();
    const int nl = tid & 63, n = nt * 64 + nl, sc = srccol(kind, n);
    float v[16];
#pragma unroll
    for (int i = 0; i < 16; ++i) { const int k = i * 4 + (tid >> 6); v[i] = sc >= 0 ? src[(size_t)(kt * 64 + k) * NS + sc] : 0.f; }
#pragma unroll
    for (int i = 0; i < 16; ++i) { const int k = i * 4 + (tid >> 6); scr[k * 65 + nl] = v[i]; }
    LBAR();
    const int on = tid >> 2, kc = (tid & 3) * 16;
    u32x4 o0, o1;
    const float* s = scr + kc * 65 + on;
    o0.x = pk2(s[0 * 65], s[1 * 65]); o0.y = pk2(s[2 * 65], s[3 * 65]); o0.z = pk2(s[4 * 65], s[5 * 65]); o0.w = pk2(s[6 * 65], s[7 * 65]);
    o1.x = pk2(s[8 * 65], s[9 * 65]); o1.y = pk2(s[10 * 65], s[11 * 65]); o1.z = pk2(s[12 * 65], s[13 * 65]); o1.w = pk2(s[14 * 65], s[15 * 65]);
    bf16_t* d = dst + (size_t)(nt * 64 + on) * K + kt * 64 + kc;
    *(u32x4*)d = o0; *(u32x4*)(d + 8) = o1;
    LBAR();
}
DEVI void phase0(const P& p, int bid, int nb, char* lds) {
    const int tid = otid(), lane = tid & 63, wid = tid >> 6;
    {
        bf16_t* H0B = WSP(bf16_t, WS_H0B);
        for (int row = bid * 4 + wid; row < NP; row += nb * 4) {
            const int b = row / LP, pp = row % LP;
            u32x2* hb = (u32x2*)(H0B + (size_t)row * 1024) + lane;
            if (pp < PADL) {
#pragma unroll
                for (int j = 0; j < 4; ++j) hb[64 * j] = (u32x2){0u, 0u};
                continue;
            }
            const int t = pp - PADL;
            const float* src = t < NMETA ? p.meta + (size_t)t * 1024 : p.x + ((size_t)b * SEQ + (t - NMETA)) * 1024;
            f32x4 v[4]; float s = 0.f;
#pragma unroll
            for (int j = 0; j < 4; ++j) { v[j] = ((const f32x4*)src)[lane + 64 * j]; s += (v[j].x + v[j].y) + (v[j].z + v[j].w); }
            const float mean = wave_sum(s) * (1.f / 1024.f); float s2 = 0.f;
#pragma unroll
            for (int j = 0; j < 4; ++j) { v[j] = v[j] - mean; s2 += (v[j].x * v[j].x + v[j].y * v[j].y) + (v[j].z * v[j].z + v[j].w * v[j].w); }
            const float rstd = rsqrtf(wave_sum(s2) * (1.f / 1024.f) + LN_EPS);
#pragma unroll
            for (int j = 0; j < 4; ++j) {
                const f32x4 g = ((const f32x4*)p.ln0_g)[lane + 64 * j], bb = ((const f32x4*)p.ln0_b)[lane + 64 * j];
                const f32x4 o = v[j] * rstd * g + bb;
                hb[64 * j] = (u32x2){pk2(o.x, o.y), pk2(o.z, o.w)};
            }
        }
    }
    {
        float* scr = (float*)lds;
        constexpr int T_IN = 16 * 54, T_OUT = 16 * 16, T_W2 = 8, T_A2 = 8, T_G2 = 16;
        constexpr int TOT = T_IN + T_OUT + T_W2 + T_A2 + T_G2;
        for (int it = bid; it < TOT; it += nb) {
            int r = it;
            if (r < T_IN) { conv_tile(p.w_in, 1024, IN_COLS, WSP(bf16_t, WS_WINT), 1, r / 54, r % 54, scr); continue; } r -= T_IN;
            if (r < T_OUT) { conv_tile(p.w_out, 1024, 1024, WSP(bf16_t, WS_WOUTT), 0, r / 16, r % 16, scr); continue; } r -= T_OUT;
            if (r < T_W2) { conv_tile(p.w2, 64, 512, WSP(bf16_t, WS_W2T), 0, 0, r, scr); continue; } r -= T_W2;
            if (r < T_A2) { conv_tile(p.a2, 64, 512, WSP(bf16_t, WS_A2T), 0, 0, r, scr); continue; } r -= T_A2;
            conv_tile(p.g2, 128, 512, WSP(bf16_t, WS_G2T), 0, r / 8, r % 8, scr);
        }
    }
}
DEVI void conv_wide(const float* src, int NS, bf16_t* dst, int kind, int kt, int nt, float* scr) {
    const int tid = otid(), kq = tid >> 6, n4 = tid & 63;
    const int sc = srccol(kind, nt * 256 + 4 * n4);
    const float* sp = src + (size_t)(kt * 64 + kq) * NS + sc;
    f32x4 v[16];
#pragma unroll
    for (int i = 0; i < 16; ++i) v[i] = *(const f32x4*)(sp + (size_t)(4 * i) * NS);
#pragma unroll
    for (int i = 0; i < 16; ++i) { const int k = 4 * i + kq; *(f32x4*)(scr + k * 260 + ((4 * n4 + 4 * (k >> 3)) & 255)) = v[i]; }
    LBAR();
    const int ch = tid & 7, r0 = tid >> 3;
#pragma unroll
    for (int j = 0; j < 8; ++j) { const int row = j * 32 + r0; const float* s = scr + (8 * ch) * 260 + ((row + 4 * ch) & 255);
        *(u32x4*)(dst + (size_t)(nt * 256 + row) * 1024 + kt * 64 + 8 * ch) = (u32x4){pk2(s[0], s[260]), pk2(s[2 * 260], s[3 * 260]), pk2(s[4 * 260], s[5 * 260]), pk2(s[6 * 260], s[7 * 260])}; }
    LBAR();
}
constexpr int CONV_TILES = 12, N_CONV_ITEMS = (32 * 16 * 8 + 32 * 16 * 4) / CONV_TILES;
static_assert(2 * N_CONV_ITEMS <= 16 * (NQB - 1), "interleave pattern needs 2 attention items per conversion item");
DEVI void conv_moe_item(const P& p, int item, char* lds) {
    float* scr = (float*)lds;
    for (int t = 0; t < CONV_TILES; ++t) {
        int r = item * CONV_TILES + t;
        if (r < 32 * 128) { const int e = r / 128, q = r % 128; conv_wide(p.w_gu + (size_t)e * 1024 * 2048, 2048, WSP(bf16_t, WS_WGUT) + (size_t)e * 2048 * 1024, 2, q / 8, q % 8, scr); }
        else { r -= 32 * 128; const int e = r / 64, q = r % 64; conv_wide(p.w_down + (size_t)e * 1024 * 1024, 1024, WSP(bf16_t, WS_WDT) + (size_t)e * 1024 * 1024, 0, q / 4, q % 4, scr); }
    }
}

struct Sched { int x, rank, nloc, nxcd; };
template <class F> DEVI void for_xcd_items(const Sched& sc, F&& f) {
    const int x0 = sc.nxcd == 8 ? sc.x : 0, x1 = sc.nxcd == 8 ? sc.x + 1 : 8;
    for (int x = x0; x < x1; ++x) f(x, sc.rank, sc.nloc);
}

DEVI void stage_out64(char* lds, int wid, int lane, bf16_t* dst  , size_t ld) {
    const char* st = lds + wid * 18432;
    asm volatile("s_waitcnt lgkmcnt(0)" ::: "memory");
#pragma unroll
    for (int i = 0; i < 16; ++i) { const int r = 8 * i + (lane >> 3), ch = lane & 7; *(u32x4*)(dst + (size_t)r * ld + ch * 8) = *(const u32x4*)(st + r * 144 + ch * 16); }
    LBAR();
}
struct EpiInProj {
    const P& p; int tm, tn; char* lds;
    DEVI void operator()(f32x4 (&acc)[8][4], int wm, int wn, int l15, int lq) const {
        if (tn < 8) {
            bf16_t* dst = tn < 4 ? WSP(bf16_t, WS_QB) : WSP(bf16_t, WS_KB); const float sc = tn < 4 ? QSCALE : 1.f;
            const int wid = wm * 2 + wn; char* st = lds + wid * 18432;
            float mx = 0.f;
#pragma unroll
            for (int mt = 0; mt < 8; ++mt) { float ssq = 0.f;
#pragma unroll
                for (int nt = 0; nt < 4; ++nt) { const f32x4 a = acc[mt][nt] * sc; ssq += (a.x * a.x + a.y * a.y) + (a.z * a.z + a.w * a.w); *(u32x2*)(st + (mt * 16 + l15) * 144 + (nt * 16 + 4 * lq) * 2) = (u32x2){pk2(a.x, a.y), pk2(a.z, a.w)}; }
                ssq += __shfl_xor(ssq, 16); ssq += __shfl_xor(ssq, 32); mx = fmaxf(mx, ssq); }
            stage_out64(lds, wid, l15 + 16 * lq, dst + ((size_t)tm * 256 + wm * 128) * 512 + (tn & 3) * 128 + wn * 64, 512);
#pragma unroll
            for (int o = 1; o < 16; o <<= 1) mx = fmaxf(mx, __shfl_xor(mx, o));
            if ((threadIdx.x & 63) == 0) atomicMax(WSP(unsigned, WS_CTL) + CW_QK2 + (tn < 4 ? 0 : 8) + 2 * (tn & 3) + wn, __float_as_uint(mx));
        } else if (tn < 12) {
            bf16_t* VT = WSP(bf16_t, WS_VT); const int row0 = tm * 256 + wm * 128;
#pragma unroll
            for (int mt = 0; mt < 8; ++mt) { const int row = row0 + mt * 16 + 4 * lq, b = row / LP, pp = row % LP;
#pragma unroll
                for (int nt = 0; nt < 4; ++nt) { const int n = (tn - 8) * 128 + wn * 64 + nt * 16 + l15; const f32x4 a = acc[mt][nt];
                    *(u32x2*)(VT + (size_t)(b * 512 + n) * LP + pp) = (u32x2){pk2(a.x, a.y), pk2(a.z, a.w)}; } }
        } else if (tn < 26) {
            bf16_t* ZR = WSP(bf16_t, WS_ZR); const int wid = wm * 2 + wn; char* st = lds + wid * 18432;
#pragma unroll
            for (int mt = 0; mt < 8; ++mt)
#pragma unroll
                for (int nt = 0; nt < 4; ++nt) { const f32x4 a = acc[mt][nt]; *(u32x2*)(st + (mt * 16 + l15) * 144 + (nt * 16 + 4 * lq) * 2) = (u32x2){pk2(a.x, a.y), pk2(a.z, a.w)}; }
            stage_out64(lds, wid, l15 + 16 * lq, ZR + ((size_t)tm * 256 + wm * 128) * RWKV_COLS + (tn - 12) * 128 + wn * 64, RWKV_COLS);
        } else {
            if (wn == 0 && lq < 2) { float* LF = WSP(float, WS_LF);
#pragma unroll
                for (int mt = 0; mt < 8; ++mt) { const int row = tm * 256 + wm * 128 + mt * 16 + l15; const bool pad = (row % LP) < PADL; f32x4 o;
#pragma unroll
                    for (int r = 0; r < 4; ++r) { const float xv = acc[mt][0][r] + p.b_fgate[4 * lq + r]; o[r] = pad ? 0.f : -softplusf(-xv); }
                    *(f32x4*)(LF + (size_t)row * 8 + 4 * lq) = o; } }
        }
    }
};
DEVI void phase1(const P& p, const Sched& sc, char* lds) {
    const int tid = otid(), lane = tid & 63, wid = tid >> 6, srow_ = 16 * wid + (lane >> 2);
    for_xcd_items(sc, [&](int x, int rank, int nloc) __attribute__((always_inline)) {
        const int xr = x >> 2, xc = x & 3, c0 = 7 * xc, cnt = xc == 3 ? 6 : 7, r0 = 33 * xr, nr = xr ? 32 : 33;
        for (int i = rank; i < nr * cnt; i += nloc) {
            const int tm = r0 + i / cnt, tn = c0 + i % cnt;
            const bf16_t *ap[4], *bp[2];
            int srow = srow_; asm volatile("" : "+v"(srow));
#pragma unroll
            for (int q = 0; q < 4; ++q) ap[q] = WSP(bf16_t, WS_H0B) + (size_t)(tm * 256 + srow + 64 * q) * 1024;
#pragma unroll
            for (int q = 0; q < 2; ++q) bp[q] = WSP(bf16_t, WS_WINT) + (size_t)(tn * 128 + srow + 64 * q) * 1024;
            if (tn >= 8 && tn < 12) gemm256<true, 8>(ap, bp, 1024, lds, EpiInProj{p, tm, tn, lds});
            else gemm256<false, 8>(ap, bp, 1024, lds, EpiInProj{p, tm, tn, lds});
        }
    });
}

DEVI int pi_swap(int i) { return (i & ~12) | ((i & 4) << 1) | ((i & 8) >> 1); }
DEVI void attn_item(const P& p, int b, int h, int qb, char* lds) {
    const int tid = otid(), lane = tid & 63, wid = tid >> 6, ql = lane & 31, hi = lane >> 5;
    const int wu = __builtin_amdgcn_readfirstlane(wid);
    const int q_pp = qb * 128 + wu * 32 + ql; const size_t qrow = (size_t)b * LP + q_pp;
    const bf16_t* QB = WSP(bf16_t, WS_QB); const bf16_t* KB = WSP(bf16_t, WS_KB); const bf16_t* VT = WSP(bf16_t, WS_VT); const float* CS = WSP(float, WS_CS);
    bf16x8 qf[4];
#pragma unroll
    for (int d0 = 0; d0 < 4; ++d0) qf[d0] = *(const bf16x8*)(QB + qrow * 512 + h * 64 + 16 * d0 + 8 * hi);
    const float* CSh = CS + (size_t)(b * 8 + h) * LP;
    const float cref = CSh[qb * 128];
    const int nkt = 2 * qb + 1;
    int kstart = 1;
    {
        const unsigned* qk2 = WSP(unsigned, WS_CTL) + CW_QK2;
        const float bnd = 64.f + 2.04f * sqrtf(__uint_as_float(qk2[h]) * __uint_as_float(qk2[8 + h]));
        const int kt = tid + 1; bool skip = false;
        if (kt <= nkt) skip = CSh[64 * kt + 63] - cref > bnd;
        int* s_cnt = (int*)(lds + LX + 944);
        if (tid == 0) *s_cnt = 0;
        __syncthreads();
        const int c = __popcll(__ballot(skip));
        if (lane == 0 && c) atomicAdd(s_cnt, c);
        __syncthreads();
        kstart = 1 + __builtin_amdgcn_readfirstlane(*s_cnt);
        if (kstart > 2 * qb) kstart = 2 * qb;
    }
    typedef __attribute__((address_space(3))) unsigned lds_u32;
    constexpr int ABUF = 16640;
    auto dma = [&](int kt, int bsel) __attribute__((always_inline)) {
        char* bs = lds + bsel * ABUF;
#pragma unroll
        for (int i = 0; i < 2; ++i) { const int pi = wu + 4 * i; const int R = 8 * pi + (lane >> 3), pc = lane & 7, sc8 = (pc ^ ((R >> 1) & 7)) << 3;
            __builtin_amdgcn_global_load_lds((const unsigned*)(KB + ((size_t)b * LP + 64 * kt + R) * 512 + h * 64 + sc8), (lds_u32*)(bs + pi * 1024), 16, 0, 0);
            __builtin_amdgcn_global_load_lds((const unsigned*)(VT + (size_t)(b * 512 + h * 64 + R) * LP + 64 * kt + sc8), (lds_u32*)(bs + 8192 + pi * 1024), 16, 0, 0); }
        __builtin_amdgcn_global_load_lds((const unsigned*)(CSh + 64 * kt + lane), (lds_u32*)(bs + 16384), 4, 0, 0);
    };
    float m = NEGBIG, l = 0.f; f32x16 o[2];
#pragma unroll
    for (int r = 0; r < 16; ++r) { o[0][r] = 0.f; o[1][r] = 0.f; }
    const int krow0 = pi_swap(ql);
    const int koff = krow0 * 128, ksw = (krow0 >> 1) & 7;
    const int voff = 8192 + ql * 128, vsw = (ql >> 1) & 7;
    const int lim = qb * 128 + wu * 32 + 31;
#pragma unroll
    for (int j = 0; j < 3; ++j) if (kstart + j <= nkt) dma(kstart + j, j);
#define SB() __builtin_amdgcn_sched_barrier(0)
    for (int kt = kstart; kt <= nkt; ++kt) {
        const int bi = (kt - kstart) & 3; const char* bs0 = lds + bi * ABUF;
        { const int rem = nkt - kt;
          if (rem >= 2) asm volatile("s_waitcnt vmcnt(10)" ::: "memory"); else if (rem == 1) asm volatile("s_waitcnt vmcnt(5)" ::: "memory"); else asm volatile("s_waitcnt vmcnt(0)" ::: "memory"); }
        asm volatile("s_waitcnt lgkmcnt(0)" ::: "memory"); __builtin_amdgcn_s_barrier(); asm volatile("" ::: "memory");
        if (kt + 3 <= nkt) dma(kt + 3, (bi + 3) & 3);
        if (64 * kt <= lim) {
            bf16x8 kf[2][4], vf[2][2][2]; f32x4 cv[2][4]; f32x16 sc[2];
#pragma unroll
            for (int d0 = 0; d0 < 4; ++d0)
#pragma unroll
                for (int kh = 0; kh < 2; ++kh) kf[kh][d0] = *(const bf16x8*)(bs0 + kh * 4096 + koff + (((2 * d0 + hi) ^ ksw) << 4));
            { const float* csl = (const float*)(bs0 + 16384);
#pragma unroll
              for (int kh = 0; kh < 2; ++kh)
#pragma unroll
                for (int g = 0; g < 4; ++g) cv[kh][g] = *(const f32x4*)(csl + 32 * kh + 16 * (g >> 1) + 8 * hi + 4 * (g & 1)); }
            SB();
#pragma unroll
            for (int r = 0; r < 16; ++r) { sc[0][r] = 0.f; sc[1][r] = 0.f; }
#pragma unroll
            for (int d0 = 0; d0 < 4; ++d0)
#pragma unroll
                for (int kh = 0; kh < 2; ++kh) sc[kh] = __builtin_amdgcn_mfma_f32_32x32x16_bf16(kf[kh][d0], qf[d0], sc[kh], 0, 0, 0);
#pragma unroll
            for (int kh = 0; kh < 2; ++kh)
#pragma unroll
                for (int s2 = 0; s2 < 2; ++s2)
#pragma unroll
                    for (int dh = 0; dh < 2; ++dh) vf[dh][kh][s2] = *(const bf16x8*)(bs0 + voff + dh * 4096 + (((4 * kh + 2 * s2 + hi) ^ vsw) << 4));
            SB();
            f32x2 xv[2][8];
#pragma unroll
            for (int kh = 0; kh < 2; ++kh)
#pragma unroll
                for (int g = 0; g < 4; ++g) {
                    xv[kh][2 * g] = (f32x2){sc[kh][4 * g], sc[kh][4 * g + 1]} - (f32x2){cv[kh][g].x, cv[kh][g].y};
                    xv[kh][2 * g + 1] = (f32x2){sc[kh][4 * g + 2], sc[kh][4 * g + 3]} - (f32x2){cv[kh][g].z, cv[kh][g].w}; }
            if (kt == 1 || kt >= 2 * qb) {
#pragma unroll
                for (int kh = 0; kh < 2; ++kh)
#pragma unroll
                    for (int g = 0; g < 4; ++g) { const int key0 = 32 * kh + 16 * (g >> 1) + 8 * hi + 4 * (g & 1);
#pragma unroll
                        for (int c = 0; c < 4; ++c) { const int kp = 64 * kt + key0 + c; if (kp > q_pp || kp < PADL) xv[kh][2 * g + (c >> 1)][c & 1] = NEGBIG; } }
            }
            float mloc;
            { float a = __builtin_fmaxf(__builtin_fmaxf(xv[0][0].x, xv[0][0].y), xv[1][0].x), bq = __builtin_fmaxf(__builtin_fmaxf(xv[0][1].x, xv[0][1].y), xv[1][0].y);
              a = __builtin_fmaxf(__builtin_fmaxf(a, xv[1][1].x), xv[1][1].y);
#pragma unroll
              for (int i = 2; i < 8; i += 2) { a = __builtin_fmaxf(__builtin_fmaxf(a, xv[0][i].x), xv[0][i].y); bq = __builtin_fmaxf(__builtin_fmaxf(bq, xv[0][i + 1].x), xv[0][i + 1].y);
                  a = __builtin_fmaxf(__builtin_fmaxf(a, xv[1][i].x), xv[1][i].y); bq = __builtin_fmaxf(__builtin_fmaxf(bq, xv[1][i + 1].x), xv[1][i + 1].y); }
              mloc = __builtin_fmaxf(a, bq); }
            { const auto rr = __builtin_amdgcn_permlane32_swap(__float_as_uint(mloc), __float_as_uint(mloc), false, false); mloc = fmaxf(__uint_as_float(rr[0]), __uint_as_float(rr[1])); }
            if (__any(mloc > m + 8.f)) {
                const float mnew = fmaxf(m, mloc); const float f = __builtin_amdgcn_exp2f(m - mnew); m = mnew; l *= f;
#pragma unroll
                for (int r = 0; r < 16; ++r) { o[0][r] *= f; o[1][r] *= f; }
            }
            bf16x8 pf[2][2]; f32x2 ls2 = (f32x2){0.f, 0.f}; const f32x2 m2 = (f32x2){m, m};
#pragma unroll
            for (int kh = 0; kh < 2; ++kh)
#pragma unroll
                for (int s2 = 0; s2 < 2; ++s2) { u32x4 w;
#pragma unroll
                    for (int j = 0; j < 4; ++j) { const f32x2 d = xv[kh][4 * s2 + j] - m2; f32x2 e; e.x = __builtin_amdgcn_exp2f(d.x); e.y = __builtin_amdgcn_exp2f(d.y); ls2 += e; w[j] = pk2(e.x, e.y); }
                    pf[kh][s2] = __builtin_bit_cast(bf16x8, w); }
            l += ls2.x + ls2.y;
            SB();
#pragma unroll
            for (int kh = 0; kh < 2; ++kh)
#pragma unroll
                for (int s2 = 0; s2 < 2; ++s2)
#pragma unroll
                    for (int dh = 0; dh < 2; ++dh) o[dh] = __builtin_amdgcn_mfma_f32_32x32x16_bf16(vf[dh][kh][s2], pf[kh][s2], o[dh], 0, 0, 0);
        }
    }
#undef SB
    asm volatile("s_waitcnt lgkmcnt(0)" ::: "memory"); __builtin_amdgcn_s_barrier(); asm volatile("" ::: "memory");
    l += __shfl_xor(l, 32);
    const float inv = 1.f / l; float ss = 0.f;
#pragma unroll
    for (int r = 0; r < 16; ++r) { o[0][r] *= inv; o[1][r] *= inv; ss += o[0][r] * o[0][r] + o[1][r] * o[1][r]; }
    ss += __shfl_xor(ss, 32);
    const float rs = rsqrtf(ss * (1.f / 64.f) + RMS_EPS);
    bf16_t* MIX = WSP(bf16_t, WS_MIX); const bool padq = q_pp < PADL;
    char* sg = lds + wu * 4608;
#pragma unroll
    for (int dh = 0; dh < 2; ++dh)
#pragma unroll
        for (int g = 0; g < 4; ++g) { const int d = 32 * dh + 8 * g + 4 * hi; const f32x4 gn = *(const f32x4*)(p.fox_norm_g + h * 64 + d);
            float v0 = o[dh][4 * g] * rs * gn.x, v1 = o[dh][4 * g + 1] * rs * gn.y, v2 = o[dh][4 * g + 2] * rs * gn.z, v3 = o[dh][4 * g + 3] * rs * gn.w;
            if (padq) { v0 = v1 = v2 = v3 = 0.f; }
            *(u32x2*)(sg + ql * 144 + d * 2) = (u32x2){pk2(v0, v1), pk2(v2, v3)}; }
    asm volatile("s_waitcnt lgkmcnt(0)" ::: "memory");
    { bf16_t* dst = MIX + ((size_t)b * LP + qb * 128 + wu * 32) * 1024 + h * 64;
#pragma unroll
      for (int i = 0; i < 4; ++i) { const int r = 8 * i + (lane >> 3), ch = lane & 7; *(u32x4*)(dst + (size_t)r * 1024 + ch * 8) = *(const u32x4*)(sg + r * 144 + ch * 16); } }
    __syncthreads();
}

constexpr int NCHUNK = 129;
constexpr int CHUNK_BYTES = 32768;
constexpr int C_XL = 32768, C_LG = 50176, C_PART = 67584, C_END = 68608;
DEVI int swz(int row, int chunk) { return row * 128 + ((chunk ^ ((row >> 1) & 7)) << 4); }
DEVI int crow(int r, int h) { return (r & 3) + 8 * (r >> 2) + 4 * h; }
DEVI bf16x8 frag(const char* base, int row, int ks, int h) { return *(const bf16x8*)(base + swz(row, 2 * ks + h)); }
DEVI void chunk_job(const P& p, int job, char* lds) {
    int tid_ = threadIdx.x; asm volatile("" : "+v"(tid_));
    const int tid = tid_, lane = tid & 63, wid = tid >> 6, l31 = lane & 31, h = lane >> 5, rb = wid >> 1, cb = wid & 1;
    const int bh = job / NCHUNK, c = job % NCHUNK, b = bh >> 3, hh = bh & 7;
    const size_t row0 = (size_t)b * LP + 64 + 64 * c; const int col0 = hh * 64;
    const bf16_t* BB = WSP(bf16_t, WS_RB) + row0 * 512 + col0; const bf16_t* K2 = WSP(bf16_t, WS_RK2) + row0 * 512 + col0;
    const bf16_t* ZRb = WSP(bf16_t, WS_ZR) + row0 * RWKV_COLS;
    float* LgG = WSP(float, WS_LGS) + (size_t)blockIdx.x * 12288;
    char* chk = (char*)p.ws + WS_CHK + (size_t)job * CHUNK_BYTES;
    char* R1 = lds; float* XL = (float*)(lds + C_XL); float* Lg = (float*)(lds + C_LG); float* part = (float*)(lds + C_PART);
    {
        const int t = tid >> 2, q = tid & 3; const bf16_t* zrow = ZRb + (size_t)t * RWKV_COLS;
#pragma unroll 4
        for (int i = 0; i < 16; ++i) { const int c = 16 * i + 4 * q;
            f32x4 z = zs4(zrow, 1536 + c, p.rwkv_mu);
            if (i < 4) z = (f32x4){tanh_fast(z.x), tanh_fast(z.y), tanh_fast(z.z), tanh_fast(z.w)};
            else if (i >= 8) z = (f32x4){sigmoidf(z.x), sigmoidf(z.y), sigmoidf(z.z), sigmoidf(z.w)};
            *(u32x2*)(R1 + (i >> 2) * 8192 + swz(t, (c & 63) >> 3) + (c & 7) * 2) = (u32x2){pk2(z.x, z.y), pk2(z.z, z.w)}; }
    }
    LBAR();
    {
        const bf16_t* W2T = WSP(bf16_t, WS_W2T) + (size_t)(col0 + 32 * cb + l31) * 64 + 8 * h; const bf16_t* A2T = WSP(bf16_t, WS_A2T) + (size_t)(col0 + 32 * cb + l31) * 64 + 8 * h;
        const bf16_t* G2T = WSP(bf16_t, WS_G2T) + (size_t)(col0 + 32 * cb + l31) * 128 + 8 * h;
        f32x16 dw, da, dg;
#pragma unroll
        for (int r = 0; r < 16; ++r) { dw[r] = 0.f; da[r] = 0.f; dg[r] = 0.f; }
#pragma unroll
        for (int ks = 0; ks < 4; ++ks) {
            dw = __builtin_amdgcn_mfma_f32_32x32x16_bf16(frag(R1, 32 * rb + l31, ks, h), *(const bf16x8*)(W2T + 16 * ks), dw, 0, 0, 0);
            da = __builtin_amdgcn_mfma_f32_32x32x16_bf16(frag(R1 + 8192, 32 * rb + l31, ks, h), *(const bf16x8*)(A2T + 16 * ks), da, 0, 0, 0);
        }
#pragma unroll
        for (int ks = 0; ks < 8; ++ks) dg = __builtin_amdgcn_mfma_f32_32x32x16_bf16(frag(R1 + 16384 + (ks >> 2) * 8192, 32 * rb + l31, ks & 3, h), *(const bf16x8*)(G2T + 16 * ks), dg, 0, 0, 0);
        LBAR();
        const int j = 32 * cb + l31; const float w0v = p.w0[col0 + j], a0v = p.a0[col0 + j]; float* At = (float*)R1;
#pragma unroll
        for (int r = 0; r < 16; ++r) { const int t = 32 * rb + crow(r, h);
            const float wl = -softplus_fast(-(w0v + dw[r])) - 0.5f; Lg[t * 64 + j] = -__expf(wl);
            At[t * 64 + j] = sigmoidf(a0v + da[r]);
            (WSP(bf16_t, WS_G) + row0 * 512 + col0)[(size_t)t * 512 + j] = (bf16_t)f2bf(dg[r]); }
    }
    LBAR();
    {
        const int cq = tid >> 6, cj = tid & 63; float cs[16]; float run = 0.f;
#pragma unroll
        for (int u = 0; u < 16; ++u) { run += Lg[(16 * cq + u) * 64 + cj]; cs[u] = run; }
        part[cq * 64 + cj] = run; LBAR();
        float off = 0.f;
        for (int q = 0; q < cq; ++q) off += part[q * 64 + cj];
#pragma unroll
        for (int u = 0; u < 16; ++u) { Lg[(16 * cq + u) * 64 + cj] = cs[u] + off; LgG[(16 * cq + u) * 64 + cj] = cs[u] + off; }
        LBAR();
    }
    {
        const int t = tid >> 2, jq = (tid & 3) * 4;
        f32x4 av4[4];
#pragma unroll
        for (int e4 = 0; e4 < 4; ++e4) av4[e4] = *(const f32x4*)((const float*)R1 + t * 64 + 16 * e4 + jq);
        LBAR();
        const bf16_t* zrow = ZRb + (size_t)t * RWKV_COLS;
        f32x4 kr4[4], kk4[4], rr4[4], ka4[4]; float ss = 0.f;
        const int tp = t > 0 ? t - 1 : 0; const float pm = t > 0 ? 1.f : 0.f;
#pragma unroll
        for (int e4 = 0; e4 < 4; ++e4) { const int j = 16 * e4 + jq;
            kr4[e4] = zs4(zrow, 512 + col0 + j, p.rwkv_mu); rr4[e4] = zs4(zrow, col0 + j, p.rwkv_mu); ka4[e4] = *(const f32x4*)(p.k_a + col0 + j);
            kk4[e4] = kr4[e4] * *(const f32x4*)(p.k_k + col0 + j);
            ss += (kk4[e4].x * kk4[e4].x + kk4[e4].y * kk4[e4].y) + (kk4[e4].z * kk4[e4].z + kk4[e4].w * kk4[e4].w); }
        ss += dpp_mov<0xB1>(ss); ss += dpp_mov<0x4E>(ss);
        const float kinv = 1.f / fmaxf(sqrtf(ss), 1e-12f);
#pragma unroll
        for (int e4 = 0; e4 < 4; ++e4) {
            const int j = 16 * e4 + jq;
            const f32x4 lg = *(const f32x4*)(Lg + t * 64 + j), lgp = *(const f32x4*)(Lg + tp * 64 + j) * pm;
            const f32x4 kk = kk4[e4] * kinv, kr = kr4[e4], rr = rr4[e4], ka = ka4[e4];
            const f32x4 bb = kk * av4[e4], k2 = kr * (1.f + (av4[e4] - 1.f) * ka);
            st4bf((bf16_t*)BB + (size_t)t * 512 + j, bb); st4bf((bf16_t*)K2 + (size_t)t * 512 + j, k2);
            float at[4], rt[4], bt[4], kt[4];
#pragma unroll
            for (int q = 0; q < 4; ++q) { const float en = __expf(-lg[q]); at[q] = -kk[q] * __expf(lgp[q]); rt[q] = rr[q] * __expf(lg[q]); bt[q] = bb[q] * en; kt[q] = k2[q] * en; }
            const int o = swz(t, j >> 3) + (j & 7) * 2;
            *(u32x2*)(R1 + 0 + o) = (u32x2){pk2(bt[0], bt[1]), pk2(bt[2], bt[3])};
            *(u32x2*)(R1 + 8192 + o) = (u32x2){pk2(kt[0], kt[1]), pk2(kt[2], kt[3])};
            *(u32x2*)(R1 + 16384 + o) = (u32x2){pk2(at[0], at[1]), pk2(at[2], at[3])};
            *(u32x2*)(R1 + 24576 + o) = (u32x2){pk2(rt[0], rt[1]), pk2(rt[2], rt[3])};
#pragma unroll
            for (int q = 0; q < 4; ++q) { XL[(j + q) * 68 + t] = at[q]; LgG[8192 + (j + q) * 64 + t] = rt[q]; }
        }
    }
    LBAR();
    {
        f32x16 tb, tk, qb, hy;
#pragma unroll
        for (int r = 0; r < 16; ++r) { tb[r] = 0.f; tk[r] = 0.f; qb[r] = 0.f; hy[r] = 0.f; }
#pragma unroll
        for (int ks = 0; ks < 4; ++ks) {
            const bf16x8 aB = frag(R1, 32 * rb + l31, ks, h), aK = frag(R1 + 8192, 32 * rb + l31, ks, h), bA = frag(R1 + 16384, 32 * cb + l31, ks, h), bR = frag(R1 + 24576, 32 * cb + l31, ks, h);
            tb = __builtin_amdgcn_mfma_f32_32x32x16_bf16(aB, bA, tb, 0, 0, 0); tk = __builtin_amdgcn_mfma_f32_32x32x16_bf16(aK, bA, tk, 0, 0, 0);
            qb = __builtin_amdgcn_mfma_f32_32x32x16_bf16(aB, bR, qb, 0, 0, 0); hy = __builtin_amdgcn_mfma_f32_32x32x16_bf16(aK, bR, hy, 0, 0, 0);
        }
        const int t = 32 * cb + l31;
#pragma unroll
        for (int r = 0; r < 16; ++r) { const int s = 32 * rb + crow(r, h); if (!(s < t)) { tb[r] = 0.f; tk[r] = 0.f; } if (!(s <= t)) { qb[r] = 0.f; hy[r] = 0.f; } }
        LBAR();
        float* TbT = (float*)R1;
#pragma unroll
        for (int g = 0; g < 4; ++g) { const int s0 = 32 * rb + 8 * g + 4 * h;
            *(f32x4*)(TbT + t * 68 + s0) = (f32x4){tb[4 * g], tb[4 * g + 1], tb[4 * g + 2], tb[4 * g + 3]};
#pragma unroll
            for (int q = 0; q < 4; ++q) XL[(64 + s0 + q) * 68 + t] = tk[4 * g + q];
            *(u32x2*)(R1 + 17408 + swz(t, 4 * rb + g) + 8 * h) = (u32x2){pk2(qb[4 * g], qb[4 * g + 1]), pk2(qb[4 * g + 2], qb[4 * g + 3])};
            *(f32x4*)(LgG + 4096 + ((wid * 4 + g) * 64 + lane) * 4) = (f32x4){hy[4 * g], hy[4 * g + 1], hy[4 * g + 2], hy[4 * g + 3]}; }
    }
    LBAR();
    {
        const int row = tid >> 1, hf = tid & 1; float* xr = XL + row * 68; const float* TbT = (const float*)R1;
        for (int bj = 0; bj < 4; ++bj) {
            float y[16];
#pragma unroll
            for (int q = 0; q < 4; ++q) { const f32x4 v = *(const f32x4*)(xr + 16 * bj + 4 * q); y[4 * q] = v.x; y[4 * q + 1] = v.y; y[4 * q + 2] = v.z; y[4 * q + 3] = v.w; }
            float acc[16];
#pragma unroll
            for (int t = 0; t < 16; ++t) acc[t] = 0.f;
            for (int bi = 0; bi < bj; ++bi) {
                float xp[8];
#pragma unroll
                for (int q = 0; q < 2; ++q) { const f32x4 v = *(const f32x4*)(xr + 16 * bi + 8 * hf + 4 * q); xp[4 * q] = v.x; xp[4 * q + 1] = v.y; xp[4 * q + 2] = v.z; xp[4 * q + 3] = v.w; }
                const float* tb0 = TbT + (16 * bj) * 68 + 16 * bi + 8 * hf;
#pragma unroll
                for (int t = 0; t < 16; ++t) { float a0 = 0.f, a1 = 0.f;
#pragma unroll
                    for (int u = 0; u < 8; u += 2) { a0 += xp[u] * tb0[t * 68 + u]; a1 += xp[u + 1] * tb0[t * 68 + u + 1]; }
                    acc[t] += a0 + a1; }
            }
#pragma unroll
            for (int t = 0; t < 16; ++t) y[t] += acc[t] + dpp_mov<0xB1>(acc[t]);
            const float* td = TbT + (16 * bj) * 68 + 16 * bj;
#pragma unroll
            for (int t = 1; t < 16; ++t) { float a0 = y[t];
#pragma unroll
                for (int u = 0; u < 16; ++u) if (u < t) a0 += y[u] * td[t * 68 + u];
                y[t] = a0; }
            if (hf == 0) {
#pragma unroll
                for (int q = 0; q < 4; ++q) *(f32x4*)(xr + 16 * bj + 4 * q) = (f32x4){y[4 * q], y[4 * q + 1], y[4 * q + 2], y[4 * q + 3]};
            }
            asm volatile("s_waitcnt lgkmcnt(0)" ::: "memory");
        }
    }
    LBAR();
    {
        const int row = tid >> 1, hf = tid & 1; const float* xr = XL + row * 68 + 32 * hf; char* dst = R1 + (row >> 6) * 8192;
#pragma unroll
        for (int c8 = 0; c8 < 4; ++c8) { const f32x4 a = *(const f32x4*)(xr + 8 * c8), bq = *(const f32x4*)(xr + 8 * c8 + 4);
            *(u32x4*)(dst + swz(row & 63, 4 * hf + c8)) = (u32x4){pk2(a.x, a.y), pk2(a.z, a.w), pk2(bq.x, bq.y), pk2(bq.z, bq.w)}; }
    }
    __syncthreads();
    {
        const int t = tid >> 2, jq = (tid & 3) * 4; char* BbT = lds + 32768; char* VT = lds + 40960;
        f32x4 lgA[4], lcA[4], bbA[4], vvA[4];
#pragma unroll
        for (int e4 = 0; e4 < 4; ++e4) { const int j = 16 * e4 + jq;
            lgA[e4] = *(const f32x4*)(LgG + t * 64 + j); lcA[e4] = *(const f32x4*)(LgG + 63 * 64 + j); bbA[e4] = ld4bf(BB + (size_t)t * 512 + j); vvA[e4] = zs4(ZRb + (size_t)t * RWKV_COLS, 1024 + col0 + j, p.rwkv_mu); }
#pragma unroll
        for (int e4 = 0; e4 < 4; ++e4) {
            const int j = 16 * e4 + jq;
            const f32x4 lg = lgA[e4], lc = lcA[e4], bb = bbA[e4], vv = vvA[e4];
#pragma unroll
            for (int q = 0; q < 4; ++q) { const int o2 = swz(j + q, t >> 3) + (t & 7) * 2; *(bf16_t*)(BbT + o2) = (bf16_t)f2bf(bb[q] * __expf(lc[q] - lg[q])); *(bf16_t*)(VT + o2) = (bf16_t)f2bf(vv[q]); }
        }
    }
    LBAR();
    {
        f32x16 gy, gs, hs, hy;
#pragma unroll
        for (int g = 0; g < 4; ++g) { const f32x4 q4 = *(const f32x4*)(LgG + 4096 + ((wid * 4 + g) * 64 + lane) * 4); hy[4 * g] = q4.x; hy[4 * g + 1] = q4.y; hy[4 * g + 2] = q4.z; hy[4 * g + 3] = q4.w; }
        {
            const int tq = 32 * cb + l31;
            const float lcq = LgG[63 * 64 + tq]; const float elc = __expf(lcq);
#pragma unroll
            for (int g = 0; g < 4; ++g) { const int j0 = 32 * rb + 8 * g + 4 * h;
#pragma unroll
                for (int q = 0; q < 4; ++q) { gy[4 * g + q] = LgG[8192 + (j0 + q) * 64 + tq]; gs[4 * g + q] = (j0 + q == tq) ? elc : 0.f;
                    const int s = j0 + q; hs[4 * g + q] = ld1bf(K2 + (size_t)s * 512 + tq) * __expf(lcq - LgG[s * 64 + tq]); } }
        }
#pragma unroll
        for (int ks = 0; ks < 4; ++ks) {
            const bf16x8 aA = frag(R1, 32 * rb + l31, ks, h), aW = frag(R1 + 8192, 32 * rb + l31, ks, h), bQ = frag(R1 + 17408, 32 * cb + l31, ks, h), bB = frag(lds + 32768, 32 * cb + l31, ks, h);
            gy = __builtin_amdgcn_mfma_f32_32x32x16_bf16(aA, bQ, gy, 0, 0, 0); gs = __builtin_amdgcn_mfma_f32_32x32x16_bf16(aA, bB, gs, 0, 0, 0);
            hy = __builtin_amdgcn_mfma_f32_32x32x16_bf16(aW, bQ, hy, 0, 0, 0); hs = __builtin_amdgcn_mfma_f32_32x32x16_bf16(aW, bB, hs, 0, 0, 0);
        }
        const int cc = 32 * cb + l31;
#pragma unroll
        for (int g = 0; g < 4; ++g) { const int r0 = 32 * rb + 8 * g + 4 * h;
            *(u32x2*)(chk + swz(cc, 4 * rb + g) + 8 * h) = (u32x2){pk2(gy[4 * g], gy[4 * g + 1]), pk2(gy[4 * g + 2], gy[4 * g + 3])};
            *(u32x2*)(chk + 8192 + swz(cc, 4 * rb + g) + 8 * h) = (u32x2){pk2(gs[4 * g], gs[4 * g + 1]), pk2(gs[4 * g + 2], gs[4 * g + 3])};
            *(u32x2*)(lds + 49152 + swz(cc, 4 * rb + g) + 8 * h) = (u32x2){pk2(hs[4 * g], hs[4 * g + 1]), pk2(hs[4 * g + 2], hs[4 * g + 3])};
            *(u32x2*)(lds + 57344 + swz(cc, 4 * rb + g) + 8 * h) = (u32x2){pk2(hy[4 * g], hy[4 * g + 1]), pk2(hy[4 * g + 2], hy[4 * g + 3])}; }
    }
    LBAR();
    {
        f32x16 sl, yl;
#pragma unroll
        for (int r = 0; r < 16; ++r) { sl[r] = 0.f; yl[r] = 0.f; }
#pragma unroll
        for (int ks = 0; ks < 4; ++ks) {
            const bf16x8 aS = frag(lds + 49152, 32 * rb + l31, ks, h), aY = frag(lds + 57344, 32 * rb + l31, ks, h), bV = frag(lds + 40960, 32 * cb + l31, ks, h);
            sl = __builtin_amdgcn_mfma_f32_32x32x16_bf16(aS, bV, sl, 0, 0, 0); yl = __builtin_amdgcn_mfma_f32_32x32x16_bf16(aY, bV, yl, 0, 0, 0);
        }
#pragma unroll
        for (int q = 0; q < 2; ++q) {
            *(u32x4*)(chk + 16384 + wid * 2048 + lane * 32 + q * 16) = (u32x4){pk2(sl[8 * q], sl[8 * q + 1]), pk2(sl[8 * q + 2], sl[8 * q + 3]), pk2(sl[8 * q + 4], sl[8 * q + 5]), pk2(sl[8 * q + 6], sl[8 * q + 7])};
            *(u32x4*)(chk + 24576 + wid * 2048 + lane * 32 + q * 16) = (u32x4){pk2(yl[8 * q], yl[8 * q + 1]), pk2(yl[8 * q + 2], yl[8 * q + 3]), pk2(yl[8 * q + 4], yl[8 * q + 5]), pk2(yl[8 * q + 6], yl[8 * q + 7])}; }
    }
    LBAR();
}
DEVI void cumsum_job(const P& p, int bh, char* lds) {
    const int tid = otid(), lane = tid & 63, wid = tid >> 6, b = bh >> 3, h = bh & 7; float* part = (float*)lds;
    const float* LF = WSP(float, WS_LF) + (size_t)b * LP * 8 + h; float* CS = WSP(float, WS_CS) + (size_t)bh * LP;
    const int r0 = tid * 33; float v[33]; float s = 0.f;
#pragma unroll
    for (int i = 0; i < 33; ++i) v[i] = (r0 + i < LP) ? LF[(size_t)(r0 + i) * 8] : 0.f;
#pragma unroll
    for (int i = 0; i < 33; ++i) s += v[i];
    part[tid] = s; LBAR();
    if (wid == 0) { const f32x4 a = *(const f32x4*)(part + 4 * lane); const float tot = (a.x + a.y) + (a.z + a.w); float inc = tot;
#pragma unroll
        for (int o = 1; o < 64; o <<= 1) { const float u = __shfl_up(inc, o); if (lane >= o) inc += u; }
        const float ex = inc - tot; *(f32x4*)(part + 4 * lane) = (f32x4){ex, ex + a.x, ex + a.x + a.y, ex + a.x + a.y + a.z}; }
    LBAR();
    float pre = part[tid];
#pragma unroll
    for (int i = 0; i < 33; ++i) { pre += v[i]; if (r0 + i < LP) CS[r0 + i] = pre * LOG2E; }
    LBAR();
}
DEVI void phase2c(const P& p, int bid, int nb, char* lds) {
    if (bid < 16) cumsum_job(p, bid, lds);
    for (int q = bid; q < 16 * (NCHUNK - 1); q += nb) chunk_job(p, (q >> 7) * NCHUNK + 1 + (q & 127), lds);
}

constexpr size_t WS_SPREV = WS_Y;
DEVI void scanB_job(const P& p, int bh, char* lds) {
    typedef __attribute__((address_space(3))) unsigned lds_u32;
    const int tid = otid(), lane = tid & 63, wid = __builtin_amdgcn_readfirstlane(tid >> 6), l31 = lane & 31, h = lane >> 5, rb = wid >> 1, cb = wid & 1;
    const char* chk = (const char*)p.ws + WS_CHK + (size_t)bh * NCHUNK * CHUNK_BYTES + 8192 + wid * 8192 + lane * 16;
    char* sprev = (char*)p.ws + WS_SPREV + (size_t)bh * NCHUNK * 8192 + (wid & 1) * 4096 + lane * 16;
    f32x16 accS;
#pragma unroll
    for (int r = 0; r < 16; ++r) accS[r] = 0.f;
    auto dma = [&](int c, int slot) __attribute__((always_inline)) {
        if (wid < 2) {
            const char* g = chk + (size_t)c * CHUNK_BYTES; char* d = lds + 8192 + slot * 16384 + wid * 8192;
#pragma unroll
            for (int i = 0; i < 8; ++i) __builtin_amdgcn_global_load_lds((const unsigned*)(g + i * 1024), (lds_u32*)(d + i * 1024), 16, 0, 0);
        }
    };
    dma(0, 0); dma(1, 1); dma(2, 2); dma(3, 3);
    for (int c = 0; c < NCHUNK; ++c) {
        const int slot = c & 3;
#pragma unroll
        for (int g = 0; g < 4; ++g) *(u32x2*)(lds + swz(32 * cb + l31, 4 * rb + g) + 8 * h) = (u32x2){pk2(accS[4 * g], accS[4 * g + 1]), pk2(accS[4 * g + 2], accS[4 * g + 3])};
        if (wid < 2) { if (c + 3 < NCHUNK) asm volatile("s_waitcnt vmcnt(24)" ::: "memory"); else asm volatile("s_waitcnt vmcnt(0)" ::: "memory"); }
        asm volatile("s_waitcnt lgkmcnt(0)" ::: "memory"); __builtin_amdgcn_s_barrier(); asm volatile("" ::: "memory");
        const char* sl = lds + 8192 + slot * 16384;
        bf16x8 sb[4], gsf[4];
#pragma unroll
        for (int ks = 0; ks < 4; ++ks) { sb[ks] = frag(lds, 32 * cb + l31, ks, h); gsf[ks] = frag(sl, 32 * rb + l31, ks, h); }
#pragma unroll
        for (int q = 0; q < 2; ++q) { const u32x4 ws = *(const u32x4*)(sl + 8192 + wid * 2048 + lane * 32 + q * 16);
#pragma unroll
            for (int j = 0; j < 4; ++j) { accS[8 * q + 2 * j] = __uint_as_float(ws[j] << 16); accS[8 * q + 2 * j + 1] = __uint_as_float(ws[j] & 0xffff0000u); } }
        if (wid >= 2) {
            char* d = sprev + (size_t)c * 8192; const char* s = lds + (wid & 1) * 4096 + lane * 16;
#pragma unroll
            for (int i = 0; i < 4; ++i) *(u32x4*)(d + i * 1024) = *(const u32x4*)(s + i * 1024);
        }
#pragma unroll
        for (int ks = 0; ks < 4; ++ks) accS = __builtin_amdgcn_mfma_f32_32x32x16_bf16(gsf[ks], sb[ks], accS, 0, 0, 0);
        asm volatile("s_waitcnt lgkmcnt(0)" ::: "memory"); __builtin_amdgcn_s_barrier(); asm volatile("" ::: "memory");
        if (c + 4 < NCHUNK) dma(c + 4, slot);
    }
}

DEVI void phase4a(const P& p, int bid, int nb, char* lds) {
    typedef __attribute__((address_space(3))) unsigned lds_u32;
    const int tid = otid(), lane = tid & 63, wid = __builtin_amdgcn_readfirstlane(tid >> 6), l31 = lane & 31, h = lane >> 5, rb = wid >> 1, cb = wid & 1;
    for (int item = bid; item < 16 * (NCHUNK - 1); item += nb) {
        const int bh = item >> 7, c = 1 + (item & 127), b = bh >> 3, hh = bh & 7;
        const char* img = (const char*)p.ws + WS_CHK + ((size_t)bh * NCHUNK + c) * CHUNK_BYTES;
        const char* spv = (const char*)p.ws + WS_SPREV + ((size_t)bh * NCHUNK + c) * 8192;
#pragma unroll
        for (int i = 0; i < 2; ++i) { const int off = (wid * 2 + i) * 1024;
            __builtin_amdgcn_global_load_lds((const unsigned*)(img + off + lane * 16), (lds_u32*)(lds + off), 16, 0, 0);
            __builtin_amdgcn_global_load_lds((const unsigned*)(spv + off + lane * 16), (lds_u32*)(lds + 8192 + off), 16, 0, 0);
            __builtin_amdgcn_global_load_lds((const unsigned*)(img + 24576 + off + lane * 16), (lds_u32*)(lds + 16384 + off), 16, 0, 0); }
        asm volatile("s_waitcnt vmcnt(0)" ::: "memory"); __builtin_amdgcn_s_barrier(); asm volatile("" ::: "memory");
        f32x16 accY; bf16x8 sb[4], gyf[4];
#pragma unroll
        for (int ks = 0; ks < 4; ++ks) { sb[ks] = frag(lds + 8192, 32 * cb + l31, ks, h); gyf[ks] = frag(lds, 32 * rb + l31, ks, h); }
#pragma unroll
        for (int q = 0; q < 2; ++q) { const u32x4 wy = *(const u32x4*)(lds + 16384 + wid * 2048 + lane * 32 + q * 16);
#pragma unroll
            for (int j = 0; j < 4; ++j) { accY[8 * q + 2 * j] = __uint_as_float(wy[j] << 16); accY[8 * q + 2 * j + 1] = __uint_as_float(wy[j] & 0xffff0000u); } }
#pragma unroll
        for (int ks = 0; ks < 4; ++ks) accY = __builtin_amdgcn_mfma_f32_32x32x16_bf16(gyf[ks], sb[ks], accY, 0, 0, 0);
        float* YT = (float*)(lds + 24576);
#pragma unroll
        for (int r = 0; r < 16; ++r) YT[(32 * rb + crow(r, h)) * 68 + 32 * cb + l31] = accY[r];
        LBAR();
#pragma unroll
        for (int ps = 0; ps < 4; ++ps) {
            const int t = 16 * ps + (tid >> 4), c4 = (tid & 15) * 4, gc = hh * 64 + c4;
            const size_t row = (size_t)b * LP + 64 + 64 * c + t, o = row * 512 + gc;
            const bf16_t* zrow = WSP(bf16_t, WS_ZR) + row * RWKV_COLS;
            const f32x4 y = *(const f32x4*)(YT + t * 68 + c4), r = zs4(zrow, gc, p.rwkv_mu), k2 = ld4bf(WSP(bf16_t, WS_RK2) + o), v = zs4(zrow, 1024 + gc, p.rwkv_mu), g = ld4bf(WSP(bf16_t, WS_G) + o);
            const f32x4 rk = *(const f32x4*)(p.r_k + gc), lg = *(const f32x4*)(p.lnx_g + gc), lb = *(const f32x4*)(p.lnx_b + gc);
            const float mu = sum16((y.x + y.y) + (y.z + y.w)) * (1.f / 64.f);
            const f32x4 dy = y - mu;
            const float var = sum16((dy.x * dy.x + dy.y * dy.y) + (dy.z * dy.z + dy.w * dy.w)) * (1.f / 64.f);
            const float rs = rsqrtf(var + GN_EPS);
            const float bonus = sum16((r.x * k2.x * rk.x + r.y * k2.y * rk.y) + (r.z * k2.z * rk.z + r.w * k2.w * rk.w));
            const f32x4 ov = (dy * rs * lg + lb + bonus * v) * g;
            *(u32x2*)(WSP(bf16_t, WS_MIX) + row * 1024 + 512 + gc) = (u32x2){pk2(ov.x, ov.y), pk2(ov.z, ov.w)};
        }
        LBAR();
    }
}

struct EpiOutProj {
    const P& p; int tm, tn;
    DEVI void operator()(f32x4 (&acc)[4][4], int wm, int wn, int l15, int lq) const {
#pragma unroll
        for (int mt = 0; mt < 4; ++mt) { const size_t row = (size_t)tm * 128 + wm * 64 + mt * 16 + l15;
#pragma unroll
            for (int nt = 0; nt < 4; ++nt) { const size_t o = row * 1024 + tn * 128 + wn * 64 + nt * 16 + 4 * lq;
                const u32x2 w = *(const u32x2*)(WSP(bf16_t, WS_H0B) + o);
                const f32x4 h0 = (f32x4){__uint_as_float(w.x << 16), __uint_as_float(w.x & 0xffff0000u), __uint_as_float(w.y << 16), __uint_as_float(w.y & 0xffff0000u)};
                *(f32x4*)(WSP(float, WS_PRE1) + o) = h0 * ALPHA + acc[mt][nt]; } }
    }
};
DEVI void phase4b(const P& p, const Sched& sc, char* lds) {
    const int tid = otid(), srow = 16 * (tid >> 6) + ((tid & 63) >> 2);
    for_xcd_items(sc, [&](int x, int rank, int nloc) __attribute__((always_inline)) {
        const int r0 = 16 * x;
        for (int i = rank; i < 16 * 8; i += nloc) {
            const int tr = r0 + (i >> 3), tn = i & 7, tm = (tr >> 6) * NQB + 1 + (tr & 63);
            const bf16_t *ap[4], *bp[2];
#pragma unroll
            for (int q = 0; q < 2; ++q) { ap[q] = WSP(bf16_t, WS_MIX) + (size_t)(tm * 128 + srow + 64 * q) * 1024; bp[q] = WSP(bf16_t, WS_WOUTT) + (size_t)(tn * 128 + srow + 64 * q) * 1024; }
            ap[2] = ap[3] = ap[0];
            gemm256<false, 4>(ap, bp, 1024, lds, EpiOutProj{p, tm, tn});
        }
    });
}

DEVI void phase4c(const P& p, int bid, int nb, char* lds) {
    const int tid = otid(), lane = tid & 63, wid = tid >> 6;
    const int e = tid & 31, ks = tid >> 5;
    float* hrow = (float*)lds;
    float* part = (float*)(lds + 16384);
    unsigned* cnt = WSP(unsigned, WS_CTL) + CW_CNT;
    float wreg[128];
#pragma unroll
    for (int k = 0; k < 128; ++k) wreg[k] = p.w_router[(size_t)(ks * 128 + k) * 32 + e];
    const float br = p.b_router[e];
    for (int base = bid * 4; base < NP; base += nb * 4) {
        const int row = base + wid;
        const bool pad = (row % LP) < PADL + NMETA;
        {
            u32x2* hb = (u32x2*)(WSP(bf16_t, WS_H1B) + (size_t)row * 1024) + lane;
            if (pad) {
#pragma unroll
                for (int j = 0; j < 4; ++j) { hb[64 * j] = (u32x2){0u, 0u}; *(f32x4*)(hrow + wid * 1024 + lane * 4 + 256 * j) = (f32x4){0.f, 0.f, 0.f, 0.f}; }
            } else {
                const f32x4* src = (const f32x4*)(WSP(float, WS_PRE1) + (size_t)row * 1024) + lane;
                f32x4 v[4]; float s = 0.f;
#pragma unroll
                for (int j = 0; j < 4; ++j) { v[j] = src[64 * j]; s += (v[j].x + v[j].y) + (v[j].z + v[j].w); }
                const float mean = wave_sum(s) * (1.f / 1024.f); float s2 = 0.f;
#pragma unroll
                for (int j = 0; j < 4; ++j) { v[j] = v[j] - mean; s2 += (v[j].x * v[j].x + v[j].y * v[j].y) + (v[j].z * v[j].z + v[j].w * v[j].w); }
                const float rstd = rsqrtf(wave_sum(s2) * (1.f / 1024.f) + LN_EPS);
                if (lane == 0) { WSP(float, WS_ST1)[(size_t)row * 2] = mean; WSP(float, WS_ST1)[(size_t)row * 2 + 1] = rstd; }
#pragma unroll
                for (int j = 0; j < 4; ++j) {
                    const f32x4 g = ((const f32x4*)p.ln1_g)[lane + 64 * j], bb = ((const f32x4*)p.ln1_b)[lane + 64 * j];
                    const f32x4 o = v[j] * rstd * g + bb;
                    hb[64 * j] = (u32x2){pk2(o.x, o.y), pk2(o.z, o.w)};
                    *(f32x4*)(hrow + wid * 1024 + lane * 4 + 256 * j) = o;
                }
            }
        }
        LBAR();
        {
            float a0 = 0.f, a1 = 0.f, a2 = 0.f, a3 = 0.f;
            const float* h0 = hrow + ks * 128;
#pragma unroll
            for (int k = 0; k < 128; k += 4) {
                const f32x4 x0 = *(const f32x4*)(h0 + k), x1 = *(const f32x4*)(h0 + 1024 + k), x2 = *(const f32x4*)(h0 + 2048 + k), x3 = *(const f32x4*)(h0 + 3072 + k);
#pragma unroll
                for (int q = 0; q < 4; ++q) { a0 += wreg[k + q] * x0[q]; a1 += wreg[k + q] * x1[q]; a2 += wreg[k + q] * x2[q]; a3 += wreg[k + q] * x3[q]; }
            }
            part[(0 * 8 + ks) * 32 + e] = a0; part[(1 * 8 + ks) * 32 + e] = a1; part[(2 * 8 + ks) * 32 + e] = a2; part[(3 * 8 + ks) * 32 + e] = a3;
        }
        LBAR();
        {
            const int ee = lane & 31;
            float logit = br;
#pragma unroll
            for (int q = 0; q < 8; ++q) logit += part[(wid * 8 + q) * 32 + ee];
            float cur = logit; float tv[4]; int ti[4];
#pragma unroll
            for (int k = 0; k < 4; ++k) {
                float bv = cur; int bi = ee;
#pragma unroll
                for (int o = 16; o > 0; o >>= 1) { const float ov = __shfl_xor(bv, o); const int oi = __shfl_xor(bi, o); if (ov > bv || (ov == bv && oi < bi)) { bv = ov; bi = oi; } }
                tv[k] = bv; ti[k] = bi; if (ee == bi) cur = -INFINITY;
            }
            const float e1 = __expf(tv[1] - tv[0]), e2 = __expf(tv[2] - tv[0]), e3 = __expf(tv[3] - tv[0]); const float inv = 1.f / (1.f + e1 + e2 + e3);
            if (lane < 4 && !pad) {
                const int ex = lane == 0 ? ti[0] : lane == 1 ? ti[1] : lane == 2 ? ti[2] : ti[3];
                const float gt = (lane == 0 ? 1.f : lane == 1 ? e1 : lane == 2 ? e2 : e3) * inv;
                const unsigned rank = atomicAdd(cnt + ex, 1u);
                WSP(int, WS_LTOK)[(size_t)ex * CAP + rank] = row; WSP(float, WS_LGATE)[(size_t)ex * CAP + rank] = gt;
                WSP(int, WS_RTE)[(size_t)row * 4 + lane] = ex; WSP(int, WS_RTR)[(size_t)row * 4 + lane] = (int)rank;
            }
        }
    }
}

struct MoeTab { int* rb; int* cn; int* nf; int* ng; };
DEVI MoeTab moe_prefix(const P& p, char* lds) {
    MoeTab t; t.rb = (int*)(lds + LX); t.cn = t.rb + 33; t.nf = t.cn + 32; t.ng = t.nf + 32;
    if (threadIdx.x == 0) { const unsigned* cnt = WSP(unsigned, WS_CTL) + CW_CNT; int acc = 0;
        for (int e = 0; e < NEXP; ++e) { const int c = (int)cnt[e]; int f = c >> 8, g = 0; const int rem = c & 255; if (rem > 128) ++f; else g = (rem + 63) >> 6;
            t.cn[e] = c; t.nf[e] = f; t.ng[e] = g; t.rb[e] = acc; acc += f * 256 + g * 64; }
        t.rb[NEXP] = acc; }
    __syncthreads();
    return t;
}

template <int MT> struct EpiGU {
    const P& p; int e, row0, tn; char* lds;
    DEVI void operator()(f32x4 (&acc)[MT][4], int wm, int wn, int l15, int lq) const {
        const float* bg = p.b_gu + (size_t)e * 2048;
        const int lane = l15 + 16 * lq, wid = wm * 2 + wn; char* st = lds + wid * 18432;
#pragma unroll
        for (int mt = 0; mt < MT; ++mt) { const size_t row = (size_t)row0 + wm * (16 * MT) + mt * 16 + l15;
#pragma unroll
            for (int np = 0; np < 2; ++np) { const int jc = tn * 64 + wn * 32 + np * 16 + 4 * lq;
                const f32x4 bgt = *(const f32x4*)(bg + jc), bup = *(const f32x4*)(bg + 1024 + jc); float ov[4];
#pragma unroll
                for (int r = 0; r < 4; ++r) { const float gate = fminf(acc[mt][2 * np][r] + bgt[r], 7.f); const float up = fminf(fmaxf(acc[mt][2 * np + 1][r] + bup[r], -7.f), 7.f);
                    ov[r] = (up + 1.f) * (gate * sigmoidf(gate * 1.702f)); }
                const u32x2 w = (u32x2){pk2(ov[0], ov[1]), pk2(ov[2], ov[3])};
                if constexpr (MT == 8) *(u32x2*)(st + (mt * 16 + l15) * 80 + (np * 16 + 4 * lq) * 2) = w;
                else *(u32x2*)(WSP(bf16_t, WS_ACT) + row * 1024 + jc) = w; } }
        if constexpr (MT == 8) {
            asm volatile("s_waitcnt lgkmcnt(0)" ::: "memory");
            bf16_t* dst = WSP(bf16_t, WS_ACT) + ((size_t)row0 + wm * 128) * 1024 + tn * 64 + wn * 32;
#pragma unroll
            for (int i = 0; i < 8; ++i) { const int r = 16 * i + (lane >> 2), ch = lane & 3; *(u32x4*)(dst + (size_t)r * 1024 + ch * 8) = *(const u32x4*)(st + r * 80 + ch * 16); }
            LBAR();
        }
    }
};
template <int MT> struct EpiDown {
    const P& p; int e, row0, idx0, cnt_e, tn; char* lds;
    DEVI void operator()(f32x4 (&acc)[MT][4], int wm, int wn, int l15, int lq) const {
        const float* bd = p.b_down + (size_t)e * 1024;
        if constexpr (MT == 8) {
            const int lane = l15 + 16 * lq, wid = wm * 2 + wn; char* st = lds + wid * 18432;
#pragma unroll
            for (int mt = 0; mt < MT; ++mt) { const int ml = wm * 128 + mt * 16 + l15; const int idx = idx0 + ml; const float gt = idx < cnt_e ? WSP(float, WS_LGATE)[(size_t)e * CAP + idx] : 0.f;
#pragma unroll
                for (int nt = 0; nt < 4; ++nt) { const int c = tn * 128 + wn * 64 + nt * 16 + 4 * lq; const f32x4 o = (acc[mt][nt] + *(const f32x4*)(bd + c)) * gt;
                    *(u32x2*)(st + (mt * 16 + l15) * 144 + (nt * 16 + 4 * lq) * 2) = (u32x2){pk2(o.x, o.y), pk2(o.z, o.w)}; } }
            asm volatile("s_waitcnt lgkmcnt(0)" ::: "memory");
            bf16_t* dst = WSP(bf16_t, WS_YB) + ((size_t)row0 + wm * 128) * 1024 + tn * 128 + wn * 64;
#pragma unroll
            for (int i = 0; i < 16; ++i) { const int r = 8 * i + (lane >> 3), ch = lane & 7; *(u32x4*)(dst + (size_t)r * 1024 + ch * 8) = *(const u32x4*)(st + r * 144 + ch * 16); }
            LBAR();
        } else {
#pragma unroll
            for (int mt = 0; mt < MT; ++mt) { const int ml = wm * (16 * MT) + mt * 16 + l15; const int idx = idx0 + ml; const float gt = idx < cnt_e ? WSP(float, WS_LGATE)[(size_t)e * CAP + idx] : 0.f;
                const size_t row = (size_t)row0 + ml;
#pragma unroll
                for (int nt = 0; nt < 4; ++nt) { const int c = tn * 128 + wn * 64 + nt * 16 + 4 * lq; const f32x4 o = (acc[mt][nt] + *(const f32x4*)(bd + c)) * gt; *(u32x2*)(WSP(bf16_t, WS_YB) + row * 1024 + c) = (u32x2){pk2(o.x, o.y), pk2(o.z, o.w)}; } }
        }
    }
};
template <int NT, class FullFn, class SmallFn>
DEVI void moe_items(const MoeTab& T, int x, int rank, int nloc, FullFn&& full, SmallFn&& small) {
    const int f0 = T.nf[x], f1 = f0 + T.nf[x + 8], f2 = f1 + T.nf[x + 16], f3 = f2 + T.nf[x + 24];
    const int g0 = T.ng[x], g1 = g0 + T.ng[x + 8], g2 = g1 + T.ng[x + 16], g3 = g2 + T.ng[x + 24];
    for (int i = rank; i < (f3 + g3) * NT; i += nloc) {
        if (i < f3 * NT) { const int rbk = i / NT, tn = i % NT; const int j = rbk < f0 ? 0 : rbk < f1 ? 1 : rbk < f2 ? 2 : 3; const int e = x + 8 * j, mb = rbk - (j == 0 ? 0 : j == 1 ? f0 : j == 2 ? f1 : f2);
            full(e, mb * 256, tn); }
        else { const int k = i - f3 * NT, gk = k / NT, tn = k % NT; const int j = gk < g0 ? 0 : gk < g1 ? 1 : gk < g2 ? 2 : 3; const int e = x + 8 * j, gi = gk - (j == 0 ? 0 : j == 1 ? g0 : j == 2 ? g1 : g2);
            small(e, T.nf[e] * 256 + gi * 64, tn); }
    }
}
DEVI void phase5(const P& p, const Sched& sc, char* lds) {
    const MoeTab T = moe_prefix(p, lds);
    const int tid = otid(), lane = tid & 63, wid = tid >> 6, srow = 16 * wid + (lane >> 2);
    for_xcd_items(sc, [&](int x, int rank, int nloc) __attribute__((always_inline)) {
        moe_items<16>(T, x, rank, nloc,
            [&](int e, int idx0, int tn) __attribute__((always_inline)) {
                const bf16_t *ap[4], *bp[2];
#pragma unroll
                for (int q = 0; q < 4; ++q) { const int idx = idx0 + srow + 64 * q; const int tok = idx < T.cn[e] ? WSP(int, WS_LTOK)[(size_t)e * CAP + idx] : 0; ap[q] = WSP(bf16_t, WS_H1B) + (size_t)tok * 1024; }
#pragma unroll
                for (int q = 0; q < 2; ++q) bp[q] = WSP(bf16_t, WS_WGUT) + ((size_t)e * 2048 + tn * 128 + srow + 64 * q) * 1024;
                gemm256<false, 8>(ap, bp, 1024, lds, EpiGU<8>{p, e, T.rb[e] + idx0, tn, lds}); },
            [&](int e, int idx0, int tn) __attribute__((always_inline)) {
                const bf16_t *ap[4], *bp[2];
                { const int idx = idx0 + srow; const int tok = idx < T.cn[e] ? WSP(int, WS_LTOK)[(size_t)e * CAP + idx] : 0; ap[0] = WSP(bf16_t, WS_H1B) + (size_t)tok * 1024; ap[1] = ap[2] = ap[3] = ap[0]; }
#pragma unroll
                for (int q = 0; q < 2; ++q) bp[q] = WSP(bf16_t, WS_WGUT) + ((size_t)e * 2048 + tn * 128 + srow + 64 * q) * 1024;
                gemm256<false, 2>(ap, bp, 1024, lds, EpiGU<2>{p, e, T.rb[e] + idx0, tn, lds}); });
    });
}
DEVI void phase6(const P& p, const Sched& sc, char* lds) {
    const MoeTab T = moe_prefix(p, lds);
    const int tid = otid(), lane = tid & 63, wid = tid >> 6, srow = 16 * wid + (lane >> 2);
    for_xcd_items(sc, [&](int x, int rank, int nloc) __attribute__((always_inline)) {
        moe_items<8>(T, x, rank, nloc,
            [&](int e, int idx0, int tn) __attribute__((always_inline)) {
                const bf16_t *ap[4], *bp[2];
#pragma unroll
                for (int q = 0; q < 4; ++q) ap[q] = WSP(bf16_t, WS_ACT) + ((size_t)T.rb[e] + idx0 + srow + 64 * q) * 1024;
#pragma unroll
                for (int q = 0; q < 2; ++q) bp[q] = WSP(bf16_t, WS_WDT) + ((size_t)e * 1024 + tn * 128 + srow + 64 * q) * 1024;
                gemm256<false, 8>(ap, bp, 1024, lds, EpiDown<8>{p, e, T.rb[e] + idx0, idx0, T.cn[e], tn, lds}); },
            [&](int e, int idx0, int tn) __attribute__((always_inline)) {
                const bf16_t *ap[4], *bp[2];
                ap[0] = WSP(bf16_t, WS_ACT) + ((size_t)T.rb[e] + idx0 + srow) * 1024; ap[1] = ap[2] = ap[3] = ap[0];
#pragma unroll
                for (int q = 0; q < 2; ++q) bp[q] = WSP(bf16_t, WS_WDT) + ((size_t)e * 1024 + tn * 128 + srow + 64 * q) * 1024;
                gemm256<false, 2>(ap, bp, 1024, lds, EpiDown<2>{p, e, T.rb[e] + idx0, idx0, T.cn[e], tn, lds}); });
    });
}
DEVI void phase7(const P& p, int bid, int nb, char* lds) {
    const MoeTab T = moe_prefix(p, lds);
    const int tid = otid(), lane = tid & 63, wid = tid >> 6;
    for (int row = bid * 4 + wid; row < NP; row += nb * 4) {
        const int b = row / LP, pp = row % LP; if (pp < PADL + NMETA) continue;
        const int t = pp - PADL - NMETA;
        const f32x4* pre = (const f32x4*)(WSP(float, WS_PRE1) + (size_t)row * 1024) + lane;
        const float mean1 = WSP(float, WS_ST1)[(size_t)row * 2], rstd1 = WSP(float, WS_ST1)[(size_t)row * 2 + 1];
        f32x4 v[4];
#pragma unroll
        for (int j = 0; j < 4; ++j) v[j] = ((pre[64 * j] - mean1) * rstd1 * ((const f32x4*)p.ln1_g)[lane + 64 * j] + ((const f32x4*)p.ln1_b)[lane + 64 * j]) * ALPHA;
#pragma unroll
        for (int k = 0; k < 4; ++k) { const int e = WSP(int, WS_RTE)[(size_t)row * 4 + k], rk = WSP(int, WS_RTR)[(size_t)row * 4 + k];
            const u32x2* yb = (const u32x2*)(WSP(bf16_t, WS_YB) + ((size_t)T.rb[e] + rk) * 1024) + lane;
#pragma unroll
            for (int j = 0; j < 4; ++j) { const u32x2 w = yb[64 * j]; v[j] += (f32x4){__uint_as_float(w.x << 16), __uint_as_float(w.x & 0xffff0000u), __uint_as_float(w.y << 16), __uint_as_float(w.y & 0xffff0000u)}; } }
        float s = 0.f;
#pragma unroll
        for (int j = 0; j < 4; ++j) s += (v[j].x + v[j].y) + (v[j].z + v[j].w);
        const float mean = wave_sum(s) * (1.f / 1024.f); float s2 = 0.f;
#pragma unroll
        for (int j = 0; j < 4; ++j) { v[j] = v[j] - mean; s2 += (v[j].x * v[j].x + v[j].y * v[j].y) + (v[j].z * v[j].z + v[j].w * v[j].w); }
        const float rstd = rsqrtf(wave_sum(s2) * (1.f / 1024.f) + LN_EPS);
        f32x4* o = (f32x4*)(p.out + ((size_t)b * SEQ + t) * 1024) + lane;
#pragma unroll
        for (int j = 0; j < 4; ++j) o[64 * j] = v[j] * rstd * ((const f32x4*)p.ln2_g)[lane + 64 * j] + ((const f32x4*)p.ln2_b)[lane + 64 * j];
    }
}

#define LAS __attribute__((address_space(3)))
#define XB_TMO      128
#define XB_XCNT(j)  (256  + 64 * (j))
#define XB_XSUB(j)  (1280 + 64 * (j))
#define XB_XGEN(j)  (2304 + 64 * (j))
#define XB_TOP      3328
#define XB_TOPGEN   3392
#define XCD_BAR_WORDS 3456
#define XB_SPIN_CAP (1u << 18)
__device__ __forceinline__ unsigned xb_ld(unsigned* p)              { return __hip_atomic_load(p, __ATOMIC_RELAXED, __HIP_MEMORY_SCOPE_AGENT); }
__device__ __forceinline__ unsigned xb_add(unsigned* p, unsigned v) { return __hip_atomic_fetch_add(p, v, __ATOMIC_RELAXED, __HIP_MEMORY_SCOPE_AGENT); }
__device__ __forceinline__ unsigned xb_xcc_id() { return (unsigned)__builtin_amdgcn_s_getreg((3 << 11) | 20) & 0xFu; }
#define XB_SPIN(cond, bar) do { unsigned _sp = 0; while (cond) { __builtin_amdgcn_s_sleep(1); \
    if ((++_sp & 255u) == 0u) { if (xb_ld(&(bar)[XB_TMO])) break; if (_sp > XB_SPIN_CAP) { atomicAdd(&(bar)[XB_TMO], 1u); break; } } } } while (0)
struct XcdBarrier { unsigned* bar; unsigned x; volatile LAS unsigned* st; };
__device__ __forceinline__ XcdBarrier xcd_barrier_post(unsigned* bar, volatile LAS unsigned* st) {
    XcdBarrier b; b.bar = bar; b.x = xb_xcc_id(); b.st = st;
    if (threadIdx.x == 0) (void)xb_add(&bar[XB_XCNT(b.x)], 1u);
    return b;
}
__device__ __forceinline__ void xcd_barrier_complete(unsigned* bar, unsigned x, unsigned& nloc, unsigned& nx) {
    const unsigned G = gridDim.x * gridDim.y * gridDim.z;
    unsigned sum, cnt, mine, sp = 0u;
    for (;;) {
        sum = 0u; cnt = 0u; mine = 0u;
#pragma unroll
        for (unsigned j = 0; j < 16; ++j) { const unsigned c = xb_ld(&bar[XB_XCNT(j)]); sum += c; cnt += (c > 0u) ? 1u : 0u; mine = (j == x) ? c : mine; }
        if (sum == G) break;
        __builtin_amdgcn_s_sleep(1);
        if ((++sp & 255u) == 0u) { if (xb_ld(&bar[XB_TMO])) break; if (sp > XB_SPIN_CAP) { atomicAdd(&bar[XB_TMO], 1u); break; } }
    }
    nloc = mine > 0u ? mine : 1u; nx = cnt > 0u ? cnt : 1u;
}
__device__ __forceinline__ void xcd_barrier(const XcdBarrier& b) {
    asm volatile("s_waitcnt vmcnt(0)" ::: "memory");
    __syncthreads();
    if (threadIdx.x == 0) {
        unsigned* bar = b.bar;
        __builtin_amdgcn_s_waitcnt(0);
        unsigned nloc = b.st[0], nx = b.st[1];
        if (nloc == 0u) { xcd_barrier_complete(bar, b.x, nloc, nx); b.st[0] = nloc; b.st[1] = nx; }
        const unsigned old = xb_add(&bar[XB_XSUB(b.x)], 1u);
        const unsigned gen = old / nloc;
        if (old + 1u == (gen + 1u) * nloc) {
            __builtin_amdgcn_fence(__ATOMIC_RELEASE, "agent");
            asm volatile("s_waitcnt vmcnt(0)" ::: "memory");
            const unsigned og = xb_add(&bar[XB_TOP], 1u);
            const unsigned tg = og / nx;
            if (og + 1u == (tg + 1u) * nx) xb_add(&bar[XB_TOPGEN], 1u);
            else XB_SPIN(xb_ld(&bar[XB_TOPGEN]) == tg, bar);
            __builtin_amdgcn_fence(__ATOMIC_ACQUIRE, "agent");
            xb_add(&bar[XB_XGEN(b.x)], 1u);
            asm volatile("s_waitcnt vmcnt(0)" ::: "memory");
        } else {
            XB_SPIN(xb_ld(&bar[XB_XGEN(b.x)]) == gen, bar);
            __builtin_amdgcn_fence(__ATOMIC_ACQUIRE, "agent");
            asm volatile("s_waitcnt vmcnt(0)" ::: "memory");
        }
    }
    __syncthreads();
}

namespace cg = cooperative_groups;
constexpr int CW_BAR = 4096;
constexpr size_t CTL_ZERO_BYTES = 65536;
constexpr int N_SCAN_JOBS = 16, N_ATT_ITEMS = 16 * (NQB - 1);
DEVI void phase3(const P& p, char* lds, int qoff) {
    int* s_item = (int*)(lds + LX + 992);
    unsigned* q = WSP(unsigned, WS_CTL) + CW_QATT + qoff;
    for (;;) {
        if (threadIdx.x == 0) *s_item = (int)atomicAdd(q, 1u);
        __syncthreads();
        const int it = __builtin_amdgcn_readfirstlane(*s_item);
        __syncthreads();
        if (it >= N_SCAN_JOBS + N_ATT_ITEMS + N_CONV_ITEMS) break;
        if (it < N_SCAN_JOBS) {
            chunk_job(p, it * NCHUNK, lds);
            __threadfence(); __syncthreads();
            __builtin_amdgcn_s_setprio(3); scanB_job(p, it, lds); __builtin_amdgcn_s_setprio(0); continue; }
        const int r = it - N_SCAN_JOBS; int a;
        if (r < 3 * N_CONV_ITEMS) { if (r % 3 == 2) { conv_moe_item(p, r / 3, lds); continue; } a = 2 * (r / 3) + (r % 3); }
        else a = r - N_CONV_ITEMS;
        { const int qb = NQB - 1 - a / 16, bh = a % 16; attn_item(p, bh >> 3, bh & 7, qb, lds); }
    }
}
__global__ void __launch_bounds__(256, 2) k_mega(P p) {
    __shared__ __attribute__((aligned(16))) char lds[LDS_BYTES];
    const int bid = blockIdx.x, nb = gridDim.x;
    volatile LAS unsigned* st = (volatile LAS unsigned*)(LAS char*)(lds + LX + 1008);
    if (threadIdx.x < 2) st[threadIdx.x] = 0u;
    __syncthreads();
    if (p.ws == nullptr) cg::this_grid().sync();
    const XcdBarrier bar = xcd_barrier_post(WSP(unsigned, WS_CTL) + CW_BAR, st);
    int* s_rank = (int*)(lds + LX + 976);
    if (threadIdx.x == 0) *s_rank = (int)atomicAdd(WSP(unsigned, WS_CTL) + CW_XRANK + 64 * (bar.x & 15), 1u);
#ifndef PROBE_MASK
#define PROBE_MASK 0
#endif
#define RUNP(k, call) do { call; if (PROBE_MASK & (1 << (k))) { xcd_barrier(bar); call; } } while (0)
    RUNP(0, phase0(p, bid, nb, lds));  xcd_barrier(bar);
    Sched sc;
    { const int nloc = __builtin_amdgcn_readfirstlane((int)st[0]), nx = __builtin_amdgcn_readfirstlane((int)st[1]), rk = __builtin_amdgcn_readfirstlane(*s_rank); const bool ok = nx == 8 && bar.x < 8 && rk < nloc;
      sc.x = ok ? (int)bar.x : 0; sc.rank = ok ? rk : bid; sc.nloc = ok ? nloc : nb; sc.nxcd = ok ? 8 : 0; }
    RUNP(1, phase1(p, sc, lds));  xcd_barrier(bar);
    RUNP(4, phase2c(p, bid, nb, lds)); xcd_barrier(bar);
    phase3(p, lds, 0); if (PROBE_MASK & (1 << 5)) { xcd_barrier(bar); phase3(p, lds, 64); } xcd_barrier(bar);
    RUNP(6, phase4a(p, bid, nb, lds)); xcd_barrier(bar);
    RUNP(7, phase4b(p, sc, lds)); xcd_barrier(bar);
    phase4c(p, bid, nb, lds); xcd_barrier(bar);
    RUNP(9, phase5(p, sc, lds));  xcd_barrier(bar);
    RUNP(10, phase6(p, sc, lds));  xcd_barrier(bar);
    RUNP(11, phase7(p, bid, nb, lds));
}

extern "C" void kernel_launch(void* const* d_in, const int* in_sizes, int n_in, void* d_out, int out_size, void* d_ws, size_t ws_size, hipStream_t stream) {
    if (n_in != 29 || ws_size < WS_NEED) { fprintf(stderr, "kernel_launch: unexpected n_in %d or ws_size %zu (need %zu)\n", n_in, ws_size, (size_t)WS_NEED); return; }
    static int grid_blocks = 0;
    if (!grid_blocks) {
        int dev = 0, cus = 0, per_cu = 0;
        (void)hipGetDevice(&dev);
        (void)hipDeviceGetAttribute(&cus, hipDeviceAttributeMultiprocessorCount, dev);
        (void)hipOccupancyMaxActiveBlocksPerMultiprocessor(&per_cu, k_mega, 256, 0);
        if (per_cu > 2) per_cu = 2;
        grid_blocks = cus * per_cu;
        if (grid_blocks <= 0) { fprintf(stderr, "kernel_launch: occupancy query gave %d x %d\n", cus, per_cu); grid_blocks = 0; return; }
    }
    (void)hipMemsetAsync((char*)d_ws + WS_CTL, 0, CTL_ZERO_BYTES, stream);
    P p{};
    const float** pf = (const float**)&p;
    for (int i = 0; i < 29; ++i) pf[i] = (const float*)d_in[i];
    p.out = (float*)d_out; p.ws = (unsigned char*)d_ws;
    void* args[] = {&p};
    hipError_t e = hipLaunchCooperativeKernel((void*)k_mega, dim3(grid_blocks), dim3(256), args, 0, stream);
    if (e != hipSuccess) fprintf(stderr, "cooperative launch failed: %s (grid %d)\n", hipGetErrorString(e), grid_blocks);
}
```

```cpp
#include <hip/hip_runtime.h>
#include <hip/hip_cooperative_groups.h>
#include <stdint.h>
#include <stdio.h>

#define DEVI __device__ __forceinline__
typedef unsigned short bf16_t;
typedef short bf16x8 __attribute__((ext_vector_type(8)));
typedef float f32x4 __attribute__((ext_vector_type(4)));
typedef float f32x16 __attribute__((ext_vector_type(16)));
typedef unsigned u32x4 __attribute__((ext_vector_type(4)));
typedef unsigned u32x2 __attribute__((ext_vector_type(2)));

constexpr int BATCH = 2, SEQ = 8192, DM = 1024, NMETA = 16;
constexpr int LTOK = SEQ + NMETA;
constexpr int PADL = 112;
constexpr int LP = LTOK + PADL;
constexpr int NP = BATCH * LP;
constexpr int NQB = LP / 128;
constexpr int NH = 8, HD = 64;
constexpr int FOXW = 512, RWW = 512;
constexpr int RWKV_COLS = 1792;
constexpr int IN_COLS = 3336;
constexpr int WIN_N = 3456;
constexpr int NEXP = 32, TOPK = 4;
constexpr int CAP = BATCH * LTOK;
constexpr int MAXBLK = (BATCH * LTOK * TOPK) / 256 + NEXP + 1;
constexpr float ALPHA = 1.189207115002721f;
constexpr float LN_EPS = 1e-5f, GN_EPS = 64e-5f, RMS_EPS = 1e-6f;
constexpr float LOG2E = 1.4426950408889634f;
constexpr float QSCALE = 0.125f * LOG2E;
constexpr float NEGBIG = -1e30f;

constexpr size_t MiB = 1u << 20;
constexpr size_t al256(size_t x) { return (x + 255) & ~(size_t)255; }
constexpr size_t WS_CTL = 0;
constexpr size_t WS_WINT = 1 * MiB;
constexpr size_t WS_WOUTT = WS_WINT + (size_t)WIN_N * 1024 * 2;
constexpr size_t WS_W2T = WS_WOUTT + (size_t)1024 * 1024 * 2;
constexpr size_t WS_A2T = WS_W2T + 512 * 64 * 2;
constexpr size_t WS_G2T = WS_A2T + 512 * 64 * 2;
constexpr size_t WS_WGUT = al256(WS_G2T + 512 * 128 * 2);
constexpr size_t WS_WDT = WS_WGUT + (size_t)32 * 2048 * 1024 * 2;
constexpr size_t WS_ST1 = WS_WDT + (size_t)32 * 1024 * 1024 * 2;
constexpr size_t WS_H1B = WS_ST1 + (size_t)NP * 2 * 4;
constexpr size_t WS_RTE = WS_H1B + (size_t)NP * 1024 * 2;
constexpr size_t WS_RTR = WS_RTE + (size_t)NP * 16;
constexpr size_t WS_LTOK = WS_RTR + (size_t)NP * 16;
constexpr size_t WS_LGATE = WS_LTOK + (size_t)32 * CAP * 4;
constexpr size_t WS_PRE1 = al256(WS_LGATE + (size_t)32 * CAP * 4);
constexpr size_t WS_EARLY = WS_PRE1 + (size_t)NP * 1024 * 4;
constexpr size_t WS_H0B = WS_EARLY;
constexpr size_t WS_QB = WS_H0B + (size_t)NP * 1024 * 2;
constexpr size_t WS_KB = WS_QB + (size_t)NP * 512 * 2;
constexpr size_t WS_VT = WS_KB + (size_t)NP * 512 * 2;
constexpr size_t WS_ZR = WS_VT + (size_t)NP * 512 * 2;
constexpr size_t WS_LF = WS_ZR + (size_t)NP * 1792 * 4;
constexpr size_t WS_CS = WS_LF + (size_t)NP * 8 * 4;
constexpr size_t WS_R = WS_CS + (size_t)NP * 8 * 4;
constexpr size_t WS_CHK = WS_R;
static_assert((size_t)16 * 129 * 32768 <= (size_t)4 * NP * 512 * 2, "chunk buffers fit");
constexpr size_t WS_KR = WS_R + (size_t)NP * 512 * 2;
constexpr size_t WS_VR = WS_KR + (size_t)NP * 512 * 2;
constexpr size_t WS_KK = WS_VR + (size_t)NP * 512 * 2;
constexpr size_t WS_TW = WS_KK + (size_t)NP * 512 * 2;
constexpr size_t WS_DA = WS_TW + (size_t)NP * 64 * 2;
constexpr size_t WS_SG = WS_DA + (size_t)NP * 64 * 2;
constexpr size_t WS_RW = WS_SG + (size_t)NP * 128 * 2;
constexpr size_t WS_RB = WS_RW + (size_t)NP * 512 * 4;
constexpr size_t WS_RK2 = WS_RB + (size_t)NP * 512 * 2;
constexpr size_t WS_G = WS_RK2 + (size_t)NP * 512 * 2;
constexpr size_t WS_Y = WS_G + (size_t)NP * 512 * 2;
constexpr size_t WS_MIX = WS_Y + (size_t)NP * 512 * 4;
constexpr size_t WS_LGS = WS_MIX + (size_t)NP * 1024 * 2;
constexpr size_t WS_EARLY_END = WS_LGS + (size_t)1024 * 49152;
constexpr size_t WS_ACT = WS_EARLY;
constexpr size_t WS_YB = WS_ACT + (size_t)MAXBLK * 256 * 1024 * 2;
constexpr size_t WS_LATE_END = WS_YB + (size_t)MAXBLK * 256 * 1024 * 2;
constexpr size_t WS_NEED = WS_EARLY_END > WS_LATE_END ? WS_EARLY_END : WS_LATE_END;
constexpr int CW_CNT = 0;
constexpr int CW_QATT = 64;
constexpr int CW_QK2 = 320;
constexpr int CW_XRANK = 1024;

struct P {
    const float *x, *meta, *ln0_g, *ln0_b, *w_in, *b_fgate, *fox_norm_g, *rwkv_mu, *w0, *w2, *a0, *a2, *g2, *k_k, *k_a, *r_k, *lnx_g,
        *lnx_b, *w_out, *ln1_g, *ln1_b, *w_router, *b_router, *w_gu, *b_gu, *w_down, *b_down, *ln2_g, *ln2_b;
    float* out;
    unsigned char* ws;
};
#define WSP(T, off) ((T*)(p.ws + (off)))

#define LBAR() do { asm volatile("s_waitcnt lgkmcnt(0)" ::: "memory"); __builtin_amdgcn_s_barrier(); asm volatile("" ::: "memory"); } while (0)
DEVI int otid() { int t = threadIdx.x; asm volatile("" : "+v"(t)); return t; }
DEVI unsigned f2bf(float f) { unsigned u = __float_as_uint(f); u += 0x7fffu + ((u >> 16) & 1u); return u >> 16; }
typedef float f32x2 __attribute__((ext_vector_type(2)));
typedef __bf16 bf16x2_t __attribute__((ext_vector_type(2)));
DEVI unsigned pk2(float lo, float hi) { const f32x2 v = {lo, hi}; const bf16x2_t b = __builtin_convertvector(v, bf16x2_t); return __builtin_bit_cast(unsigned, b); }
DEVI f32x4 ld4bf(const bf16_t* p) { const u32x2 w = *(const u32x2*)p; return (f32x4){__uint_as_float(w.x << 16), __uint_as_float(w.x & 0xffff0000u), __uint_as_float(w.y << 16), __uint_as_float(w.y & 0xffff0000u)}; }
DEVI void st4bf(bf16_t* p, f32x4 v) { *(u32x2*)p = (u32x2){pk2(v.x, v.y), pk2(v.z, v.w)}; }
DEVI float ld1bf(const bf16_t* p) { return __uint_as_float((unsigned)(*p) << 16); }
DEVI float wave_sum(float v) {
#pragma unroll
    for (int o = 32; o > 0; o >>= 1) v += __shfl_xor(v, o);
    return v;
}
DEVI float sum16(float v) {
#pragma unroll
    for (int o = 8; o > 0; o >>= 1) v += __shfl_xor(v, o);
    return v;
}
template <int CTRL> DEVI float dpp_mov(float v) { return __int_as_float(__builtin_amdgcn_update_dpp(0, __float_as_int(v), CTRL, 0xF, 0xF, false)); }
DEVI float rowsum16_dpp(float v) {
    v += dpp_mov<0xB1>(v);
    v += dpp_mov<0x4E>(v);
    v += dpp_mov<0x141>(v);
    v += dpp_mov<0x140>(v);
    return v;
}
DEVI float softplusf(float x) { return fmaxf(x, 0.f) + log1pf(__expf(-fabsf(x))); }
DEVI float sigmoidf(float x) { return __builtin_amdgcn_rcpf(1.f + __expf(-x)); }
DEVI float tanh_fast(float x) { return 1.f - 2.f * __builtin_amdgcn_rcpf(__expf(2.f * x) + 1.f); }
DEVI f32x4 zs4(const bf16_t* zrow, int col, const float* mu) { const f32x4 zc = ld4bf(zrow + col), zp = ld4bf(zrow - RWKV_COLS + col); return zc + (zp - zc) * *(const f32x4*)(mu + col); }
DEVI float softplus_fast(float x) { return fmaxf(x, 0.f) + __logf(1.f + __expf(-fabsf(x))); }

constexpr int G2_STAGE = 24576;
constexpr int LDS_BYTES = 73728 + 1024;
constexpr int LX = 73728;
DEVI int xf4(int r) { return (0x78 >> (2 * ((r >> 2) & 3))) & 3; }
template <bool SWAP, int MT, class Epi>
DEVI void gemm256(const bf16_t* (&ap)[4], const bf16_t* (&bp)[2], int K, char* lds, Epi&& epi) {
    typedef __attribute__((address_space(3))) unsigned lds_u32;
    constexpr int NA = MT / 2 < 1 ? 1 : MT / 2;
    const int tid = otid(), lane = tid & 63, wid = __builtin_amdgcn_readfirstlane(tid >> 6), wm = wid >> 1, wn = wid & 1;
    const int l15 = lane & 15, lq = lane >> 4;
    const int gko = ((lane & 3) ^ xf4(lane >> 2)) << 3;
    f32x4 acc[MT][4];
#pragma unroll
    for (int i = 0; i < MT; ++i)
#pragma unroll
        for (int j = 0; j < 4; ++j) acc[i][j] = (f32x4){0.f, 0.f, 0.f, 0.f};
    const int nk = K / 32;
#define G2_DMA_A(kt, s, i) __builtin_amdgcn_global_load_lds((const unsigned*)(ap[i] + (kt) * 32 + gko), (lds_u32*)(lds + (s) * G2_STAGE + wid * 1024 + (i) * 4096), 16, 0, 0)
#define G2_DMA_B(kt, s, i) __builtin_amdgcn_global_load_lds((const unsigned*)(bp[i] + (kt) * 32 + gko), (lds_u32*)(lds + (s) * G2_STAGE + wid * 1024 + 16384 + (i) * 4096), 16, 0, 0)
#define G2_MMA(mt) do { _Pragma("unroll") for (int nt = 0; nt < 4; ++nt) { \
        if (SWAP) acc[mt][nt] = __builtin_amdgcn_mfma_f32_16x16x32_bf16(af[mt], bfr[nt], acc[mt][nt], 0, 0, 0); \
        else acc[mt][nt] = __builtin_amdgcn_mfma_f32_16x16x32_bf16(bfr[nt], af[mt], acc[mt][nt], 0, 0, 0); } } while (0)
#pragma unroll
    for (int st = 0; st < 2; ++st) { if (st < nk) {
#pragma unroll
        for (int i = 0; i < NA; ++i) G2_DMA_A(st, st, i);
        G2_DMA_B(st, st, 0); G2_DMA_B(st, st, 1); } }
    const int co = (lq ^ xf4(l15)) << 4;
    const int aoff = (wm * (16 * MT) + l15) * 64 + co, boff = 16384 + (wn * 64 + l15) * 64 + co;
    int s = 0;
    for (int kt = 0; kt < nk; ++kt) {
        if (kt + 1 < nk) { if (MT == 8) asm volatile("s_waitcnt vmcnt(6)" ::: "memory"); else if (MT == 4) asm volatile("s_waitcnt vmcnt(4)" ::: "memory"); else asm volatile("s_waitcnt vmcnt(3)" ::: "memory"); }
        else asm volatile("s_waitcnt vmcnt(0)" ::: "memory");
        __builtin_amdgcn_s_barrier(); asm volatile("" ::: "memory");
        const char* base = lds + s * G2_STAGE;
        bf16x8 af[MT], bfr[4];
#pragma unroll
        for (int t = 0; t < 4; ++t) bfr[t] = *(const bf16x8*)(base + boff + t * 1024);
#pragma unroll
        for (int t = 0; t < (MT < 4 ? MT : 4); ++t) af[t] = *(const bf16x8*)(base + aoff + t * 1024);
        const bool pre = kt + 2 < nk; int s2 = s + 2; if (s2 >= 3) s2 -= 3;
        __builtin_amdgcn_sched_barrier(0); __builtin_amdgcn_s_setprio(1);
        G2_MMA(0); __builtin_amdgcn_sched_barrier(0);
        if constexpr (MT == 8) {
#pragma unroll
            for (int t = 4; t < MT; ++t) af[t] = *(const bf16x8*)(base + aoff + t * 1024);
            if (pre) G2_DMA_A(kt + 2, s2, 0); __builtin_amdgcn_sched_barrier(0);
            G2_MMA(1); if (pre) G2_DMA_A(kt + 2, s2, 1); __builtin_amdgcn_sched_barrier(0);
            G2_MMA(2); if (pre) G2_DMA_A(kt + 2, s2, 2); __builtin_amdgcn_sched_barrier(0);
            G2_MMA(3); if (pre) G2_DMA_A(kt + 2, s2, 3); __builtin_amdgcn_sched_barrier(0);
            G2_MMA(4); if (pre) G2_DMA_B(kt + 2, s2, 0); __builtin_amdgcn_sched_barrier(0);
            G2_MMA(5); if (pre) G2_DMA_B(kt + 2, s2, 1); __builtin_amdgcn_sched_barrier(0);
            G2_MMA(6); G2_MMA(7);
        } else if constexpr (MT == 4) {
            if (pre) G2_DMA_A(kt + 2, s2, 0); __builtin_amdgcn_sched_barrier(0);
            G2_MMA(1); if (pre) G2_DMA_A(kt + 2, s2, 1); __builtin_amdgcn_sched_barrier(0);
            G2_MMA(2); if (pre) { G2_DMA_B(kt + 2, s2, 0); G2_DMA_B(kt + 2, s2, 1); } __builtin_amdgcn_sched_barrier(0);
            G2_MMA(3);
        } else {
            if (pre) { G2_DMA_A(kt + 2, s2, 0); G2_DMA_B(kt + 2, s2, 0); G2_DMA_B(kt + 2, s2, 1); } __builtin_amdgcn_sched_barrier(0);
            G2_MMA(1);
        }
        __builtin_amdgcn_s_setprio(0);
        asm volatile("s_waitcnt lgkmcnt(0)" ::: "memory");
        s = s == 2 ? 0 : s + 1;
    }
#undef G2_DMA_A
#undef G2_DMA_B
#undef G2_MMA
    __builtin_amdgcn_s_barrier(); asm volatile("" ::: "memory");
    epi(acc, wm, wn, l15, lq);
}

DEVI int srccol(int kind, int n) {
    if (kind == 0) return n;
    if (kind == 1) { if (n < 1536) return n; if (n < 3328) return n + 8; if (n < 3336) return 1536 + (n - 3328); return -1; }
    const int T = n >> 5, w = n & 31;
    return w < 16 ? T * 16 + w : 1024 + T * 16 + (w - 16);
}
DEVI void conv_tile(const float* src, int K, int NS, bf16_t* dst, int kind, int kt, int nt, float* scr  ) {
    const int tid = otid();
    const int nl = tid & 63, n = nt * 64 + nl, sc = srccol(kind, n);
    float v[16];
#pragma unroll
    for (int i = 0; i < 16; ++i) { const int k = i * 4 + (tid >> 6); v[i] = sc >= 0 ? src[(size_t)(kt * 64 + k) * NS + sc] : 0.f; }
#pragma unroll
    for (int i = 0; i < 16; ++i) { const int k = i * 4 + (tid >> 6); scr[k * 65 + nl] = v[i]; }
    LBAR();
    const int on = tid >> 2, kc = (tid & 3) * 16;
    u32x4 o0, o1;
    const float* s = scr + kc * 65 + on;
    o0.x = pk2(s[0 * 65], s[1 * 65]); o0.y = pk2(s[2 * 65], s[3 * 65]); o0.z = pk2(s[4 * 65], s[5 * 65]); o0.w = pk2(s[6 * 65], s[7 * 65]);
    o1.x = pk2(s[8 * 65], s[9 * 65]); o1.y = pk2(s[10 * 65], s[11 * 65]); o1.z = pk2(s[12 * 65], s[13 * 65]); o1.w = pk2(s[14 * 65], s[15 * 65]);
    bf16_t* d = dst + (size_t)(nt * 64 + on) * K + kt * 64 + kc;
    *(u32x4*)d = o0; *(u32x4*)(d + 8) = o1;
    LBAR();
}
DEVI void phase0(const P& p, int bid, int nb, char* lds) {
    const int tid = otid(), lane = tid & 63, wid = tid >> 6;
    {
        bf16_t* H0B = WSP(bf16_t, WS_H0B);
        for (int row = bid * 4 + wid; row < NP; row += nb * 4) {
            const int b = row / LP, pp = row % LP;
            u32x2* hb = (u32x2*)(H0B + (size_t)row * 1024) + lane;
            if (pp < PADL) {
#pragma unroll
                for (int j = 0; j < 4; ++j) hb[64 * j] = (u32x2){0u, 0u};
                continue;
            }
            const int t = pp - PADL;
            const float* src = t < NMETA ? p.meta + (size_t)t * 1024 : p.x + ((size_t)b * SEQ + (t - NMETA)) * 1024;
            f32x4 v[4]; float s = 0.f;
#pragma unroll
            for (int j = 0; j < 4; ++j) { v[j] = ((const f32x4*)src)[lane + 64 * j]; s += (v[j].x + v[j].y) + (v[j].z + v[j].w); }
            const float mean = wave_sum(s) * (1.f / 1024.f); float s2 = 0.f;
#pragma unroll
            for (int j = 0; j < 4; ++j) { v[j] = v[j] - mean; s2 += (v[j].x * v[j].x + v[j].y * v[j].y) + (v[j].z * v[j].z + v[j].w * v[j].w); }
            const float rstd = rsqrtf(wave_sum(s2) * (1.f / 1024.f) + LN_EPS);
#pragma unroll
            for (int j = 0; j < 4; ++j) {
                const f32x4 g = ((const f32x4*)p.ln0_g)[lane + 64 * j], bb = ((const f32x4*)p.ln0_b)[lane + 64 * j];
                const f32x4 o = v[j] * rstd * g + bb;
                hb[64 * j] = (u32x2){pk2(o.x, o.y), pk2(o.z, o.w)};
            }
        }
    }
    {
        float* scr = (float*)lds;
        constexpr int T_IN = 16 * 54, T_OUT = 16 * 16, T_W2 = 8, T_A2 = 8, T_G2 = 16;
        constexpr int TOT = T_IN + T_OUT + T_W2 + T_A2 + T_G2;
        for (int it = bid; it < TOT; it += nb) {
            int r = it;
            if (r < T_IN) { conv_tile(p.w_in, 1024, IN_COLS, WSP(bf16_t, WS_WINT), 1, r / 54, r % 54, scr); continue; } r -= T_IN;
            if (r < T_OUT) { conv_tile(p.w_out, 1024, 1024, WSP(bf16_t, WS_WOUTT), 0, r / 16, r % 16, scr); continue; } r -= T_OUT;
            if (r < T_W2) { conv_tile(p.w2, 64, 512, WSP(bf16_t, WS_W2T), 0, 0, r, scr); continue; } r -= T_W2;
            if (r < T_A2) { conv_tile(p.a2, 64, 512, WSP(bf16_t, WS_A2T), 0, 0, r, scr); continue; } r -= T_A2;
            conv_tile(p.g2, 128, 512, WSP(bf16_t, WS_G2T), 0, r / 8, r % 8, scr);
        }
    }
}
DEVI void conv_wide(const float* src, int NS, bf16_t* dst, int kind, int kt, int nt, float* scr) {
    const int tid = otid(), kq = tid >> 6, n4 = tid & 63;
    const int sc = srccol(kind, nt * 256 + 4 * n4);
    const float* sp = src + (size_t)(kt * 64 + kq) * NS + sc;
    f32x4 v[16];
#pragma unroll
    for (int i = 0; i < 16; ++i) v[i] = *(const f32x4*)(sp + (size_t)(4 * i) * NS);
#pragma unroll
    for (int i = 0; i < 16; ++i) { const int k = 4 * i + kq; *(f32x4*)(scr + k * 260 + ((4 * n4 + 4 * (k >> 3)) & 255)) = v[i]; }
    LBAR();
    const int ch = tid & 7, r0 = tid >> 3;
#pragma unroll
    for (int j = 0; j < 8; ++j) { const int row = j * 32 + r0; const float* s = scr + (8 * ch) * 260 + ((row + 4 * ch) & 255);
        *(u32x4*)(dst + (size_t)(nt * 256 + row) * 1024 + kt * 64 + 8 * ch) = (u32x4){pk2(s[0], s[260]), pk2(s[2 * 260], s[3 * 260]), pk2(s[4 * 260], s[5 * 260]), pk2(s[6 * 260], s[7 * 260])}; }
    LBAR();
}
constexpr int CONV_TILES = 12, N_CONV_ITEMS = (32 * 16 * 8 + 32 * 16 * 4) / CONV_TILES;
static_assert(2 * N_CONV_ITEMS <= 16 * (NQB - 1), "interleave pattern needs 2 attention items per conversion item");
DEVI void conv_moe_item(const P& p, int item, char* lds) {
    float* scr = (float*)lds;
    for (int t = 0; t < CONV_TILES; ++t) {
        int r = item * CONV_TILES + t;
        if (r < 32 * 128) { const int e = r / 128, q = r % 128; conv_wide(p.w_gu + (size_t)e * 1024 * 2048, 2048, WSP(bf16_t, WS_WGUT) + (size_t)e * 2048 * 1024, 2, q / 8, q % 8, scr); }
        else { r -= 32 * 128; const int e = r / 64, q = r % 64; conv_wide(p.w_down + (size_t)e * 1024 * 1024, 1024, WSP(bf16_t, WS_WDT) + (size_t)e * 1024 * 1024, 0, q / 4, q % 4, scr); }
    }
}

struct Sched { int x, rank, nloc, nxcd; };
template <class F> DEVI void for_xcd_items(const Sched& sc, F&& f) {
    const int x0 = sc.nxcd == 8 ? sc.x : 0, x1 = sc.nxcd == 8 ? sc.x + 1 : 8;
    for (int x = x0; x < x1; ++x) f(x, sc.rank, sc.nloc);
}

DEVI void stage_out64(char* lds, int wid, int lane, bf16_t* dst  , size_t ld) {
    const char* st = lds + wid * 18432;
    asm volatile("s_waitcnt lgkmcnt(0)" ::: "memory");
#pragma unroll
    for (int i = 0; i < 16; ++i) { const int r = 8 * i + (lane >> 3), ch = lane & 7; *(u32x4*)(dst + (size_t)r * ld + ch * 8) = *(const u32x4*)(st + r * 144 + ch * 16); }
    LBAR();
}
struct EpiInProj {
    const P& p; int tm, tn; char* lds;
    DEVI void operator()(f32x4 (&acc)[8][4], int wm, int wn, int l15, int lq) const {
        if (tn < 8) {
            bf16_t* dst = tn < 4 ? WSP(bf16_t, WS_QB) : WSP(bf16_t, WS_KB); const float sc = tn < 4 ? QSCALE : 1.f;
            const int wid = wm * 2 + wn; char* st = lds + wid * 18432;
            float mx = 0.f;
#pragma unroll
            for (int mt = 0; mt < 8; ++mt) { float ssq = 0.f;
#pragma unroll
                for (int nt = 0; nt < 4; ++nt) { const f32x4 a = acc[mt][nt] * sc; ssq += (a.x * a.x + a.y * a.y) + (a.z * a.z + a.w * a.w); *(u32x2*)(st + (mt * 16 + l15) * 144 + (nt * 16 + 4 * lq) * 2) = (u32x2){pk2(a.x, a.y), pk2(a.z, a.w)}; }
                ssq += __shfl_xor(ssq, 16); ssq += __shfl_xor(ssq, 32); mx = fmaxf(mx, ssq); }
            stage_out64(lds, wid, l15 + 16 * lq, dst + ((size_t)tm * 256 + wm * 128) * 512 + (tn & 3) * 128 + wn * 64, 512);
#pragma unroll
            for (int o = 1; o < 16; o <<= 1) mx = fmaxf(mx, __shfl_xor(mx, o));
            if ((threadIdx.x & 63) == 0) atomicMax(WSP(unsigned, WS_CTL) + CW_QK2 + (tn < 4 ? 0 : 8) + 2 * (tn & 3) + wn, __float_as_uint(mx));
        } else if (tn < 12) {
            bf16_t* VT = WSP(bf16_t, WS_VT); const int row0 = tm * 256 + wm * 128;
#pragma unroll
            for (int mt = 0; mt < 8; ++mt) { const int row = row0 + mt * 16 + 4 * lq, b = row / LP, pp = row % LP;
#pragma unroll
                for (int nt = 0; nt < 4; ++nt) { const int n = (tn - 8) * 128 + wn * 64 + nt * 16 + l15; const f32x4 a = acc[mt][nt];
                    *(u32x2*)(VT + (size_t)(b * 512 + n) * LP + pp) = (u32x2){pk2(a.x, a.y), pk2(a.z, a.w)}; } }
        } else if (tn < 26) {
            bf16_t* ZR = WSP(bf16_t, WS_ZR); const int wid = wm * 2 + wn; char* st = lds + wid * 18432;
#pragma unroll
            for (int mt = 0; mt < 8; ++mt)
#pragma unroll
                for (int nt = 0; nt < 4; ++nt) { const f32x4 a = acc[mt][nt]; *(u32x2*)(st + (mt * 16 + l15) * 144 + (nt * 16 + 4 * lq) * 2) = (u32x2){pk2(a.x, a.y), pk2(a.z, a.w)}; }
            stage_out64(lds, wid, l15 + 16 * lq, ZR + ((size_t)tm * 256 + wm * 128) * RWKV_COLS + (tn - 12) * 128 + wn * 64, RWKV_COLS);
        } else {
            if (wn == 0 && lq < 2) { float* LF = WSP(float, WS_LF);
#pragma unroll
                for (int mt = 0; mt < 8; ++mt) { const int row = tm * 256 + wm * 128 + mt * 16 + l15; const bool pad = (row % LP) < PADL; f32x4 o;
#pragma unroll
                    for (int r = 0; r < 4; ++r) { const float xv = acc[mt][0][r] + p.b_fgate[4 * lq + r]; o[r] = pad ? 0.f : -softplusf(-xv); }
                    *(f32x4*)(LF + (size_t)row * 8 + 4 * lq) = o; } }
        }
    }
};
DEVI void phase1(const P& p, const Sched& sc, char* lds) {
    const int tid = otid(), lane = tid & 63, wid = tid >> 6, srow_ = 16 * wid + (lane >> 2);
    for_xcd_items(sc, [&](int x, int rank, int nloc) __attribute__((always_inline)) {
        const int xr = x >> 2, xc = x & 3, c0 = 7 * xc, cnt = xc == 3 ? 6 : 7, r0 = 33 * xr, nr = xr ? 32 : 33;
        for (int i = rank; i < nr * cnt; i += nloc) {
            const int tm = r0 + i / cnt, tn = c0 + i % cnt;
            const bf16_t *ap[4], *bp[2];
            int srow = srow_; asm volatile("" : "+v"(srow));
#pragma unroll
            for (int q = 0; q < 4; ++q) ap[q] = WSP(bf16_t, WS_H0B) + (size_t)(tm * 256 + srow + 64 * q) * 1024;
#pragma unroll
            for (int q = 0; q < 2; ++q) bp[q] = WSP(bf16_t, WS_WINT) + (size_t)(tn * 128 + srow + 64 * q) * 1024;
            if (tn >= 8 && tn < 12) gemm256<true, 8>(ap, bp, 1024, lds, EpiInProj{p, tm, tn, lds});
            else gemm256<false, 8>(ap, bp, 1024, lds, EpiInProj{p, tm, tn, lds});
        }
    });
}

DEVI int pi_swap(int i) { return (i & ~12) | ((i & 4) << 1) | ((i & 8) >> 1); }
DEVI void attn_item(const P& p, int b, int h, int qb, char* lds) {
    const int tid = otid(), lane = tid & 63, wid = tid >> 6, ql = lane & 31, hi = lane >> 5;
    const int wu = __builtin_amdgcn_readfirstlane(wid);
    const int q_pp = qb * 128 + wu * 32 + ql; const size_t qrow = (size_t)b * LP + q_pp;
    const bf16_t* QB = WSP(bf16_t, WS_QB); const bf16_t* KB = WSP(bf16_t, WS_KB); const bf16_t* VT = WSP(bf16_t, WS_VT); const float* CS = WSP(float, WS_CS);
    bf16x8 qf[4];
#pragma unroll
    for (int d0 = 0; d0 < 4; ++d0) qf[d0] = *(const bf16x8*)(QB + qrow * 512 + h * 64 + 16 * d0 + 8 * hi);
    const float* CSh = CS + (size_t)(b * 8 + h) * LP;
    const float cref = CSh[qb * 128];
    const int nkt = 2 * qb + 1;
    int kstart = 1; float qkmax;
    {
        const unsigned* qk2 = WSP(unsigned, WS_CTL) + CW_QK2;
        qkmax = 1.02f * sqrtf(__uint_as_float(qk2[h]) * __uint_as_float(qk2[8 + h]));
        const float bnd = 64.f + 2.f * qkmax;
        const int kt = tid + 1; bool skip = false;
        if (kt <= nkt) skip = CSh[64 * kt + 63] - cref > bnd;
        int* s_cnt = (int*)(lds + LX + 944);
        if (tid == 0) *s_cnt = 0;
        __syncthreads();
        const int c = __popcll(__ballot(skip));
        if (lane == 0 && c) atomicAdd(s_cnt, c);
        __syncthreads();
        kstart = 1 + __builtin_amdgcn_readfirstlane(*s_cnt);
        if (kstart > 2 * qb) kstart = 2 * qb;
    }
    typedef __attribute__((address_space(3))) unsigned lds_u32;
    constexpr int ABUF = 16640;
    auto dma = [&](int kt, int bsel) __attribute__((always_inline)) {
        char* bs = lds + bsel * ABUF;
#pragma unroll
        for (int i = 0; i < 2; ++i) { const int pi = wu + 4 * i; const int R = 8 * pi + (lane >> 3), pc = lane & 7, sc8 = (pc ^ ((R >> 1) & 7)) << 3;
            __builtin_amdgcn_global_load_lds((const unsigned*)(KB + ((size_t)b * LP + 64 * kt + R) * 512 + h * 64 + sc8), (lds_u32*)(bs + pi * 1024), 16, 0, 0);
            __builtin_amdgcn_global_load_lds((const unsigned*)(VT + (size_t)(b * 512 + h * 64 + R) * LP + 64 * kt + sc8), (lds_u32*)(bs + 8192 + pi * 1024), 16, 0, 0); }
        __builtin_amdgcn_global_load_lds((const unsigned*)(CSh + 64 * kt + lane), (lds_u32*)(bs + 16384), 4, 0, 0);
    };
    const float negm = CSh[q_pp] - fminf(qkmax, 60.f);
    float l = 0.f; f32x16 o[2];
#pragma unroll
    for (int r = 0; r < 16; ++r) { o[0][r] = 0.f; o[1][r] = 0.f; }
    const int krow0 = pi_swap(ql);
    const int koff = krow0 * 128, ksw = (krow0 >> 1) & 7;
    const int voff = 8192 + ql * 128, vsw = (ql >> 1) & 7;
    const int lim = qb * 128 + wu * 32 + 31;
#pragma unroll
    for (int j = 0; j < 3; ++j) if (kstart + j <= nkt) dma(kstart + j, j);
#define SB() __builtin_amdgcn_sched_barrier(0)
    for (int kt = kstart; kt <= nkt; ++kt) {
        const int bi = (kt - kstart) & 3; const char* bs0 = lds + bi * ABUF;
        { const int rem = nkt - kt;
          if (rem >= 2) asm volatile("s_waitcnt vmcnt(10)" ::: "memory"); else if (rem == 1) asm volatile("s_waitcnt vmcnt(5)" ::: "memory"); else asm volatile("s_waitcnt vmcnt(0)" ::: "memory"); }
        asm volatile("s_waitcnt lgkmcnt(0)" ::: "memory"); __builtin_amdgcn_s_barrier(); asm volatile("" ::: "memory");
        if (kt + 3 <= nkt) dma(kt + 3, (bi + 3) & 3);
        if (64 * kt <= lim) {
            bf16x8 kf[2][4], vf[2][2][2]; f32x4 cv[2][4]; f32x16 sc[2];
#pragma unroll
            for (int d0 = 0; d0 < 4; ++d0)
#pragma unroll
                for (int kh = 0; kh < 2; ++kh) kf[kh][d0] = *(const bf16x8*)(bs0 + kh * 4096 + koff + (((2 * d0 + hi) ^ ksw) << 4));
            { const float* csl = (const float*)(bs0 + 16384);
#pragma unroll
              for (int kh = 0; kh < 2; ++kh)
#pragma unroll
                for (int g = 0; g < 4; ++g) cv[kh][g] = *(const f32x4*)(csl + 32 * kh + 16 * (g >> 1) + 8 * hi + 4 * (g & 1)); }
            SB();
#pragma unroll
            for (int r = 0; r < 16; ++r) { sc[0][r] = negm; sc[1][r] = negm; }
#pragma unroll
            for (int d0 = 0; d0 < 4; ++d0)
#pragma unroll
                for (int kh = 0; kh < 2; ++kh) sc[kh] = __builtin_amdgcn_mfma_f32_32x32x16_bf16(kf[kh][d0], qf[d0], sc[kh], 0, 0, 0);
#pragma unroll
            for (int kh = 0; kh < 2; ++kh)
#pragma unroll
                for (int s2 = 0; s2 < 2; ++s2)
#pragma unroll
                    for (int dh = 0; dh < 2; ++dh) vf[dh][kh][s2] = *(const bf16x8*)(bs0 + voff + dh * 4096 + (((4 * kh + 2 * s2 + hi) ^ vsw) << 4));
            SB();
            f32x2 xv[2][8];
#pragma unroll
            for (int kh = 0; kh < 2; ++kh)
#pragma unroll
                for (int g = 0; g < 4; ++g) {
                    xv[kh][2 * g] = (f32x2){sc[kh][4 * g], sc[kh][4 * g + 1]} - (f32x2){cv[kh][g].x, cv[kh][g].y};
                    xv[kh][2 * g + 1] = (f32x2){sc[kh][4 * g + 2], sc[kh][4 * g + 3]} - (f32x2){cv[kh][g].z, cv[kh][g].w}; }
            if (kt == 1 || kt >= 2 * qb) {
#pragma unroll
                for (int kh = 0; kh < 2; ++kh)
#pragma unroll
                    for (int g = 0; g < 4; ++g) { const int key0 = 32 * kh + 16 * (g >> 1) + 8 * hi + 4 * (g & 1);
#pragma unroll
                        for (int c = 0; c < 4; ++c) { const int kp = 64 * kt + key0 + c; if (kp > q_pp || kp < PADL) xv[kh][2 * g + (c >> 1)][c & 1] = NEGBIG; } }
            }
            bf16x8 pf[2][2]; f32x2 ls2 = (f32x2){0.f, 0.f};
#pragma unroll
            for (int kh = 0; kh < 2; ++kh)
#pragma unroll
                for (int s2 = 0; s2 < 2; ++s2) { u32x4 w;
#pragma unroll
                    for (int j = 0; j < 4; ++j) { const f32x2 d = xv[kh][4 * s2 + j]; f32x2 e; e.x = __builtin_amdgcn_exp2f(d.x); e.y = __builtin_amdgcn_exp2f(d.y); ls2 += e; w[j] = pk2(e.x, e.y); }
                    pf[kh][s2] = __builtin_bit_cast(bf16x8, w); }
            l += ls2.x + ls2.y;
            SB();
#pragma unroll
            for (int kh = 0; kh < 2; ++kh)
#pragma unroll
                for (int s2 = 0; s2 < 2; ++s2)
#pragma unroll
                    for (int dh = 0; dh < 2; ++dh) o[dh] = __builtin_amdgcn_mfma_f32_32x32x16_bf16(vf[dh][kh][s2], pf[kh][s2], o[dh], 0, 0, 0);
        }
    }
#undef SB
    asm volatile("s_waitcnt lgkmcnt(0)" ::: "memory"); __builtin_amdgcn_s_barrier(); asm volatile("" ::: "memory");
    l += __shfl_xor(l, 32);
    const float inv = 1.f / l; float ss = 0.f;
#pragma unroll
    for (int r = 0; r < 16; ++r) { o[0][r] *= inv; o[1][r] *= inv; ss += o[0][r] * o[0][r] + o[1][r] * o[1][r]; }
    ss += __shfl_xor(ss, 32);
    const float rs = rsqrtf(ss * (1.f / 64.f) + RMS_EPS);
    bf16_t* MIX = WSP(bf16_t, WS_MIX); const bool padq = q_pp < PADL;
    char* sg = lds + wu * 4608;
#pragma unroll
    for (int dh = 0; dh < 2; ++dh)
#pragma unroll
        for (int g = 0; g < 4; ++g) { const int d = 32 * dh + 8 * g + 4 * hi; const f32x4 gn = *(const f32x4*)(p.fox_norm_g + h * 64 + d);
            float v0 = o[dh][4 * g] * rs * gn.x, v1 = o[dh][4 * g + 1] * rs * gn.y, v2 = o[dh][4 * g + 2] * rs * gn.z, v3 = o[dh][4 * g + 3] * rs * gn.w;
            if (padq) { v0 = v1 = v2 = v3 = 0.f; }
            *(u32x2*)(sg + ql * 144 + d * 2) = (u32x2){pk2(v0, v1), pk2(v2, v3)}; }
    asm volatile("s_waitcnt lgkmcnt(0)" ::: "memory");
    { bf16_t* dst = MIX + ((size_t)b * LP + qb * 128 + wu * 32) * 1024 + h * 64;
#pragma unroll
      for (int i = 0; i < 4; ++i) { const int r = 8 * i + (lane >> 3), ch = lane & 7; *(u32x4*)(dst + (size_t)r * 1024 + ch * 8) = *(const u32x4*)(sg + r * 144 + ch * 16); } }
    __syncthreads();
}

constexpr int NCHUNK = 129;
constexpr int CHUNK_BYTES = 32768;
constexpr int C_XL = 32768, C_LG = 50176, C_PART = 67584, C_END = 68608;
DEVI int swz(int row, int chunk) { return row * 128 + ((chunk ^ ((row >> 1) & 7)) << 4); }
DEVI int crow(int r, int h) { return (r & 3) + 8 * (r >> 2) + 4 * h; }
DEVI bf16x8 frag(const char* base, int row, int ks, int h) { return *(const bf16x8*)(base + swz(row, 2 * ks + h)); }
DEVI void chunk_job(const P& p, int job, char* lds) {
    int tid_ = threadIdx.x; asm volatile("" : "+v"(tid_));
    const int tid = tid_, lane = tid & 63, wid = tid >> 6, l31 = lane & 31, h = lane >> 5, rb = wid >> 1, cb = wid & 1;
    const int bh = job / NCHUNK, c = job % NCHUNK, b = bh >> 3, hh = bh & 7;
    const size_t row0 = (size_t)b * LP + 64 + 64 * c; const int col0 = hh * 64;
    const bf16_t* BB = WSP(bf16_t, WS_RB) + row0 * 512 + col0; const bf16_t* K2 = WSP(bf16_t, WS_RK2) + row0 * 512 + col0;
    const bf16_t* ZRb = WSP(bf16_t, WS_ZR) + row0 * RWKV_COLS;
    float* LgG = WSP(float, WS_LGS) + (size_t)blockIdx.x * 12288;
    char* chk = (char*)p.ws + WS_CHK + (size_t)job * CHUNK_BYTES;
    char* R1 = lds; float* XL = (float*)(lds + C_XL); float* Lg = (float*)(lds + C_LG); float* part = (float*)(lds + C_PART);
    {
        const int t = tid >> 2, q = tid & 3; const bf16_t* zrow = ZRb + (size_t)t * RWKV_COLS;
#pragma unroll 4
        for (int i = 0; i < 16; ++i) { const int c = 16 * i + 4 * q;
            f32x4 z = zs4(zrow, 1536 + c, p.rwkv_mu);
            if (i < 4) z = (f32x4){tanh_fast(z.x), tanh_fast(z.y), tanh_fast(z.z), tanh_fast(z.w)};
            else if (i >= 8) z = (f32x4){sigmoidf(z.x), sigmoidf(z.y), sigmoidf(z.z), sigmoidf(z.w)};
            *(u32x2*)(R1 + (i >> 2) * 8192 + swz(t, (c & 63) >> 3) + (c & 7) * 2) = (u32x2){pk2(z.x, z.y), pk2(z.z, z.w)}; }
    }
    LBAR();
    {
        const bf16_t* W2T = WSP(bf16_t, WS_W2T) + (size_t)(col0 + 32 * cb + l31) * 64 + 8 * h; const bf16_t* A2T = WSP(bf16_t, WS_A2T) + (size_t)(col0 + 32 * cb + l31) * 64 + 8 * h;
        const bf16_t* G2T = WSP(bf16_t, WS_G2T) + (size_t)(col0 + 32 * cb + l31) * 128 + 8 * h;
        f32x16 dw, da, dg;
#pragma unroll
        for (int r = 0; r < 16; ++r) { dw[r] = 0.f; da[r] = 0.f; dg[r] = 0.f; }
#pragma unroll
        for (int ks = 0; ks < 4; ++ks) {
            dw = __builtin_amdgcn_mfma_f32_32x32x16_bf16(frag(R1, 32 * rb + l31, ks, h), *(const bf16x8*)(W2T + 16 * ks), dw, 0, 0, 0);
            da = __builtin_amdgcn_mfma_f32_32x32x16_bf16(frag(R1 + 8192, 32 * rb + l31, ks, h), *(const bf16x8*)(A2T + 16 * ks), da, 0, 0, 0);
        }
#pragma unroll
        for (int ks = 0; ks < 8; ++ks) dg = __builtin_amdgcn_mfma_f32_32x32x16_bf16(frag(R1 + 16384 + (ks >> 2) * 8192, 32 * rb + l31, ks & 3, h), *(const bf16x8*)(G2T + 16 * ks), dg, 0, 0, 0);
        LBAR();
        const int j = 32 * cb + l31; const float w0v = p.w0[col0 + j], a0v = p.a0[col0 + j]; float* At = (float*)R1;
#pragma unroll
        for (int r = 0; r < 16; ++r) { const int t = 32 * rb + crow(r, h);
            const float wl = -softplus_fast(-(w0v + dw[r])) - 0.5f; Lg[t * 64 + j] = -__expf(wl);
            At[t * 64 + j] = sigmoidf(a0v + da[r]);
            (WSP(bf16_t, WS_G) + row0 * 512 + col0)[(size_t)t * 512 + j] = (bf16_t)f2bf(dg[r]); }
    }
    LBAR();
    {
        const int cq = tid >> 6, cj = tid & 63; float cs[16]; float run = 0.f;
#pragma unroll
        for (int u = 0; u < 16; ++u) { run += Lg[(16 * cq + u) * 64 + cj]; cs[u] = run; }
        part[cq * 64 + cj] = run; LBAR();
        float off = 0.f;
        for (int q = 0; q < cq; ++q) off += part[q * 64 + cj];
#pragma unroll
        for (int u = 0; u < 16; ++u) { Lg[(16 * cq + u) * 64 + cj] = cs[u] + off; LgG[(16 * cq + u) * 64 + cj] = cs[u] + off; }
        LBAR();
    }
    {
        const int t = tid >> 2, jq = (tid & 3) * 4;
        f32x4 av4[4];
#pragma unroll
        for (int e4 = 0; e4 < 4; ++e4) av4[e4] = *(const f32x4*)((const float*)R1 + t * 64 + 16 * e4 + jq);
        LBAR();
        const bf16_t* zrow = ZRb + (size_t)t * RWKV_COLS;
        f32x4 kr4[4], kk4[4], rr4[4], ka4[4]; float ss = 0.f;
        const int tp = t > 0 ? t - 1 : 0; const float pm = t > 0 ? 1.f : 0.f;
#pragma unroll
        for (int e4 = 0; e4 < 4; ++e4) { const int j = 16 * e4 + jq;
            kr4[e4] = zs4(zrow, 512 + col0 + j, p.rwkv_mu); rr4[e4] = zs4(zrow, col0 + j, p.rwkv_mu); ka4[e4] = *(const f32x4*)(p.k_a + col0 + j);
            kk4[e4] = kr4[e4] * *(const f32x4*)(p.k_k + col0 + j);
            ss += (kk4[e4].x * kk4[e4].x + kk4[e4].y * kk4[e4].y) + (kk4[e4].z * kk4[e4].z + kk4[e4].w * kk4[e4].w); }
        ss += dpp_mov<0xB1>(ss); ss += dpp_mov<0x4E>(ss);
        const float kinv = 1.f / fmaxf(sqrtf(ss), 1e-12f);
#pragma unroll
        for (int e4 = 0; e4 < 4; ++e4) {
            const int j = 16 * e4 + jq;
            const f32x4 lg = *(const f32x4*)(Lg + t * 64 + j), lgp = *(const f32x4*)(Lg + tp * 64 + j) * pm;
            const f32x4 kk = kk4[e4] * kinv, kr = kr4[e4], rr = rr4[e4], ka = ka4[e4];
            const f32x4 bb = kk * av4[e4], k2 = kr * (1.f + (av4[e4] - 1.f) * ka);
            st4bf((bf16_t*)BB + (size_t)t * 512 + j, bb); st4bf((bf16_t*)K2 + (size_t)t * 512 + j, k2);
            float at[4], rt[4], bt[4], kt[4];
#pragma unroll
            for (int q = 0; q < 4; ++q) { const float en = __expf(-lg[q]); at[q] = -kk[q] * __expf(lgp[q]); rt[q] = rr[q] * __expf(lg[q]); bt[q] = bb[q] * en; kt[q] = k2[q] * en; }
            const int o = swz(t, j >> 3) + (j & 7) * 2;
            *(u32x2*)(R1 + 0 + o) = (u32x2){pk2(bt[0], bt[1]), pk2(bt[2], bt[3])};
            *(u32x2*)(R1 + 8192 + o) = (u32x2){pk2(kt[0], kt[1]), pk2(kt[2], kt[3])};
            *(u32x2*)(R1 + 16384 + o) = (u32x2){pk2(at[0], at[1]), pk2(at[2], at[3])};
            *(u32x2*)(R1 + 24576 + o) = (u32x2){pk2(rt[0], rt[1]), pk2(rt[2], rt[3])};
#pragma unroll
            for (int q = 0; q < 4; ++q) { XL[(j + q) * 68 + t] = at[q]; LgG[8192 + (j + q) * 64 + t] = rt[q]; }
        }
    }
    LBAR();
    {
        f32x16 tb, tk, qb, hy;
#pragma unroll
        for (int r = 0; r < 16; ++r) { tb[r] = 0.f; tk[r] = 0.f; qb[r] = 0.f; hy[r] = 0.f; }
#pragma unroll
        for (int ks = 0; ks < 4; ++ks) {
            const bf16x8 aB = frag(R1, 32 * rb + l31, ks, h), aK = frag(R1 + 8192, 32 * rb + l31, ks, h), bA = frag(R1 + 16384, 32 * cb + l31, ks, h), bR = frag(R1 + 24576, 32 * cb + l31, ks, h);
            tb = __builtin_amdgcn_mfma_f32_32x32x16_bf16(aB, bA, tb, 0, 0, 0); tk = __builtin_amdgcn_mfma_f32_32x32x16_bf16(aK, bA, tk, 0, 0, 0);
            qb = __builtin_amdgcn_mfma_f32_32x32x16_bf16(aB, bR, qb, 0, 0, 0); hy = __builtin_amdgcn_mfma_f32_32x32x16_bf16(aK, bR, hy, 0, 0, 0);
        }
        const int t = 32 * cb + l31;
#pragma unroll
        for (int r = 0; r < 16; ++r) { const int s = 32 * rb + crow(r, h); if (!(s < t)) { tb[r] = 0.f; tk[r] = 0.f; } if (!(s <= t)) { qb[r] = 0.f; hy[r] = 0.f; } }
        LBAR();
        float* TbT = (float*)R1;
#pragma unroll
        for (int g = 0; g < 4; ++g) { const int s0 = 32 * rb + 8 * g + 4 * h;
            *(f32x4*)(TbT + t * 68 + s0) = (f32x4){tb[4 * g], tb[4 * g + 1], tb[4 * g + 2], tb[4 * g + 3]};
#pragma unroll
            for (int q = 0; q < 4; ++q) XL[(64 + s0 + q) * 68 + t] = tk[4 * g + q];
            *(u32x2*)(R1 + 17408 + swz(t, 4 * rb + g) + 8 * h) = (u32x2){pk2(qb[4 * g], qb[4 * g + 1]), pk2(qb[4 * g + 2], qb[4 * g + 3])};
            *(f32x4*)(LgG + 4096 + ((wid * 4 + g) * 64 + lane) * 4) = (f32x4){hy[4 * g], hy[4 * g + 1], hy[4 * g + 2], hy[4 * g + 3]}; }
    }
    LBAR();
    {
        const int row = tid >> 1, hf = tid & 1; float* xr = XL + row * 68; const float* TbT = (const float*)R1;
        for (int bj = 0; bj < 4; ++bj) {
            float y[16];
#pragma unroll
            for (int q = 0; q < 4; ++q) { const f32x4 v = *(const f32x4*)(xr + 16 * bj + 4 * q); y[4 * q] = v.x; y[4 * q + 1] = v.y; y[4 * q + 2] = v.z; y[4 * q + 3] = v.w; }
            float acc[16];
#pragma unroll
            for (int t = 0; t < 16; ++t) acc[t] = 0.f;
            for (int bi = 0; bi < bj; ++bi) {
                float xp[8];
#pragma unroll
                for (int q = 0; q < 2; ++q) { const f32x4 v = *(const f32x4*)(xr + 16 * bi + 8 * hf + 4 * q); xp[4 * q] = v.x; xp[4 * q + 1] = v.y; xp[4 * q + 2] = v.z; xp[4 * q + 3] = v.w; }
                const float* tb0 = TbT + (16 * bj) * 68 + 16 * bi + 8 * hf;
#pragma unroll
                for (int t = 0; t < 16; ++t) { float a0 = 0.f, a1 = 0.f;
#pragma unroll
                    for (int u = 0; u < 8; u += 2) { a0 += xp[u] * tb0[t * 68 + u]; a1 += xp[u + 1] * tb0[t * 68 + u + 1]; }
                    acc[t] += a0 + a1; }
            }
#pragma unroll
            for (int t = 0; t < 16; ++t) y[t] += acc[t] + dpp_mov<0xB1>(acc[t]);
            const float* td = TbT + (16 * bj) * 68 + 16 * bj;
#pragma unroll
            for (int t = 1; t < 16; ++t) { float a0 = y[t];
#pragma unroll
                for (int u = 0; u < 16; ++u) if (u < t) a0 += y[u] * td[t * 68 + u];
                y[t] = a0; }
            if (hf == 0) {
#pragma unroll
                for (int q = 0; q < 4; ++q) *(f32x4*)(xr + 16 * bj + 4 * q) = (f32x4){y[4 * q], y[4 * q + 1], y[4 * q + 2], y[4 * q + 3]};
            }
            asm volatile("s_waitcnt lgkmcnt(0)" ::: "memory");
        }
    }
    LBAR();
    {
        const int row = tid >> 1, hf = tid & 1; const float* xr = XL + row * 68 + 32 * hf; char* dst = R1 + (row >> 6) * 8192;
#pragma unroll
        for (int c8 = 0; c8 < 4; ++c8) { const f32x4 a = *(const f32x4*)(xr + 8 * c8), bq = *(const f32x4*)(xr + 8 * c8 + 4);
            *(u32x4*)(dst + swz(row & 63, 4 * hf + c8)) = (u32x4){pk2(a.x, a.y), pk2(a.z, a.w), pk2(bq.x, bq.y), pk2(bq.z, bq.w)}; }
    }
    __syncthreads();
    {
        const int t = tid >> 2, jq = (tid & 3) * 4; char* BbT = lds + 32768; char* VT = lds + 40960;
        f32x4 lgA[4], lcA[4], bbA[4], vvA[4];
#pragma unroll
        for (int e4 = 0; e4 < 4; ++e4) { const int j = 16 * e4 + jq;
            lgA[e4] = *(const f32x4*)(LgG + t * 64 + j); lcA[e4] = *(const f32x4*)(LgG + 63 * 64 + j); bbA[e4] = ld4bf(BB + (size_t)t * 512 + j); vvA[e4] = zs4(ZRb + (size_t)t * RWKV_COLS, 1024 + col0 + j, p.rwkv_mu); }
#pragma unroll
        for (int e4 = 0; e4 < 4; ++e4) {
            const int j = 16 * e4 + jq;
            const f32x4 lg = lgA[e4], lc = lcA[e4], bb = bbA[e4], vv = vvA[e4];
#pragma unroll
            for (int q = 0; q < 4; ++q) { const int o2 = swz(j + q, t >> 3) + (t & 7) * 2; *(bf16_t*)(BbT + o2) = (bf16_t)f2bf(bb[q] * __expf(lc[q] - lg[q])); *(bf16_t*)(VT + o2) = (bf16_t)f2bf(vv[q]); }
        }
    }
    LBAR();
    {
        f32x16 gy, gs, hs, hy;
#pragma unroll
        for (int g = 0; g < 4; ++g) { const f32x4 q4 = *(const f32x4*)(LgG + 4096 + ((wid * 4 + g) * 64 + lane) * 4); hy[4 * g] = q4.x; hy[4 * g + 1] = q4.y; hy[4 * g + 2] = q4.z; hy[4 * g + 3] = q4.w; }
        {
            const int tq = 32 * cb + l31;
            const float lcq = LgG[63 * 64 + tq]; const float elc = __expf(lcq);
#pragma unroll
            for (int g = 0; g < 4; ++g) { const int j0 = 32 * rb + 8 * g + 4 * h;
#pragma unroll
                for (int q = 0; q < 4; ++q) { gy[4 * g + q] = LgG[8192 + (j0 + q) * 64 + tq]; gs[4 * g + q] = (j0 + q == tq) ? elc : 0.f;
                    const int s = j0 + q; hs[4 * g + q] = ld1bf(K2 + (size_t)s * 512 + tq) * __expf(lcq - LgG[s * 64 + tq]); } }
        }
#pragma unroll
        for (int ks = 0; ks < 4; ++ks) {
            const bf16x8 aA = frag(R1, 32 * rb + l31, ks, h), aW = frag(R1 + 8192, 32 * rb + l31, ks, h), bQ = frag(R1 + 17408, 32 * cb + l31, ks, h), bB = frag(lds + 32768, 32 * cb + l31, ks, h);
            gy = __builtin_amdgcn_mfma_f32_32x32x16_bf16(aA, bQ, gy, 0, 0, 0); gs = __builtin_amdgcn_mfma_f32_32x32x16_bf16(aA, bB, gs, 0, 0, 0);
            hy = __builtin_amdgcn_mfma_f32_32x32x16_bf16(aW, bQ, hy, 0, 0, 0); hs = __builtin_amdgcn_mfma_f32_32x32x16_bf16(aW, bB, hs, 0, 0, 0);
        }
        const int cc = 32 * cb + l31;
#pragma unroll
        for (int g = 0; g < 4; ++g) { const int r0 = 32 * rb + 8 * g + 4 * h;
            *(u32x2*)(chk + swz(cc, 4 * rb + g) + 8 * h) = (u32x2){pk2(gy[4 * g], gy[4 * g + 1]), pk2(gy[4 * g + 2], gy[4 * g + 3])};
            *(u32x2*)(chk + 8192 + swz(cc, 4 * rb + g) + 8 * h) = (u32x2){pk2(gs[4 * g], gs[4 * g + 1]), pk2(gs[4 * g + 2], gs[4 * g + 3])};
            *(u32x2*)(lds + 49152 + swz(cc, 4 * rb + g) + 8 * h) = (u32x2){pk2(hs[4 * g], hs[4 * g + 1]), pk2(hs[4 * g + 2], hs[4 * g + 3])};
            *(u32x2*)(lds + 57344 + swz(cc, 4 * rb + g) + 8 * h) = (u32x2){pk2(hy[4 * g], hy[4 * g + 1]), pk2(hy[4 * g + 2], hy[4 * g + 3])}; }
    }
    LBAR();
    {
        f32x16 sl, yl;
#pragma unroll
        for (int r = 0; r < 16; ++r) { sl[r] = 0.f; yl[r] = 0.f; }
#pragma unroll
        for (int ks = 0; ks < 4; ++ks) {
            const bf16x8 aS = frag(lds + 49152, 32 * rb + l31, ks, h), aY = frag(lds + 57344, 32 * rb + l31, ks, h), bV = frag(lds + 40960, 32 * cb + l31, ks, h);
            sl = __builtin_amdgcn_mfma_f32_32x32x16_bf16(aS, bV, sl, 0, 0, 0); yl = __builtin_amdgcn_mfma_f32_32x32x16_bf16(aY, bV, yl, 0, 0, 0);
        }
#pragma unroll
        for (int q = 0; q < 2; ++q) {
            *(u32x4*)(chk + 16384 + wid * 2048 + lane * 32 + q * 16) = (u32x4){pk2(sl[8 * q], sl[8 * q + 1]), pk2(sl[8 * q + 2], sl[8 * q + 3]), pk2(sl[8 * q + 4], sl[8 * q + 5]), pk2(sl[8 * q + 6], sl[8 * q + 7])};
            *(u32x4*)(chk + 24576 + wid * 2048 + lane * 32 + q * 16) = (u32x4){pk2(yl[8 * q], yl[8 * q + 1]), pk2(yl[8 * q + 2], yl[8 * q + 3]), pk2(yl[8 * q + 4], yl[8 * q + 5]), pk2(yl[8 * q + 6], yl[8 * q + 7])}; }
    }
    LBAR();
}
DEVI void cumsum_job(const P& p, int bh, char* lds) {
    const int tid = otid(), lane = tid & 63, wid = tid >> 6, b = bh >> 3, h = bh & 7; float* part = (float*)lds;
    const float* LF = WSP(float, WS_LF) + (size_t)b * LP * 8 + h; float* CS = WSP(float, WS_CS) + (size_t)bh * LP;
    const int r0 = tid * 33; float v[33]; float s = 0.f;
#pragma unroll
    for (int i = 0; i < 33; ++i) v[i] = (r0 + i < LP) ? LF[(size_t)(r0 + i) * 8] : 0.f;
#pragma unroll
    for (int i = 0; i < 33; ++i) s += v[i];
    part[tid] = s; LBAR();
    if (wid == 0) { const f32x4 a = *(const f32x4*)(part + 4 * lane); const float tot = (a.x + a.y) + (a.z + a.w); float inc = tot;
#pragma unroll
        for (int o = 1; o < 64; o <<= 1) { const float u = __shfl_up(inc, o); if (lane >= o) inc += u; }
        const float ex = inc - tot; *(f32x4*)(part + 4 * lane) = (f32x4){ex, ex + a.x, ex + a.x + a.y, ex + a.x + a.y + a.z}; }
    LBAR();
    float pre = part[tid];
#pragma unroll
    for (int i = 0; i < 33; ++i) { pre += v[i]; if (r0 + i < LP) CS[r0 + i] = pre * LOG2E; }
    LBAR();
}
DEVI void phase2c(const P& p, int bid, int nb, char* lds) {
    if (bid < 16) cumsum_job(p, bid, lds);
    for (int q = bid; q < 16 * (NCHUNK - 1); q += nb) chunk_job(p, (q >> 7) * NCHUNK + 1 + (q & 127), lds);
}

constexpr size_t WS_SPREV = WS_Y;
DEVI void scanB_job(const P& p, int bh, char* lds) {
    typedef __attribute__((address_space(3))) unsigned lds_u32;
    const int tid = otid(), lane = tid & 63, wid = __builtin_amdgcn_readfirstlane(tid >> 6), l31 = lane & 31, h = lane >> 5, rb = wid >> 1, cb = wid & 1;
    const char* chk = (const char*)p.ws + WS_CHK + (size_t)bh * NCHUNK * CHUNK_BYTES + 8192 + wid * 8192 + lane * 16;
    char* sprev = (char*)p.ws + WS_SPREV + (size_t)bh * NCHUNK * 8192 + (wid & 1) * 4096 + lane * 16;
    f32x16 accS;
#pragma unroll
    for (int r = 0; r < 16; ++r) accS[r] = 0.f;
    auto dma = [&](int c, int slot) __attribute__((always_inline)) {
        if (wid < 2) {
            const char* g = chk + (size_t)c * CHUNK_BYTES; char* d = lds + 8192 + slot * 16384 + wid * 8192;
#pragma unroll
            for (int i = 0; i < 8; ++i) __builtin_amdgcn_global_load_lds((const unsigned*)(g + i * 1024), (lds_u32*)(d + i * 1024), 16, 0, 0);
        }
    };
    dma(0, 0); dma(1, 1); dma(2, 2); dma(3, 3);
    for (int c = 0; c < NCHUNK; ++c) {
        const int slot = c & 3;
#pragma unroll
        for (int g = 0; g < 4; ++g) *(u32x2*)(lds + swz(32 * cb + l31, 4 * rb + g) + 8 * h) = (u32x2){pk2(accS[4 * g], accS[4 * g + 1]), pk2(accS[4 * g + 2], accS[4 * g + 3])};
        if (wid < 2) { if (c + 3 < NCHUNK) asm volatile("s_waitcnt vmcnt(24)" ::: "memory"); else asm volatile("s_waitcnt vmcnt(0)" ::: "memory"); }
        asm volatile("s_waitcnt lgkmcnt(0)" ::: "memory"); __builtin_amdgcn_s_barrier(); asm volatile("" ::: "memory");
        const char* sl = lds + 8192 + slot * 16384;
        bf16x8 sb[4], gsf[4];
#pragma unroll
        for (int ks = 0; ks < 4; ++ks) { sb[ks] = frag(lds, 32 * cb + l31, ks, h); gsf[ks] = frag(sl, 32 * rb + l31, ks, h); }
#pragma unroll
        for (int q = 0; q < 2; ++q) { const u32x4 ws = *(const u32x4*)(sl + 8192 + wid * 2048 + lane * 32 + q * 16);
#pragma unroll
            for (int j = 0; j < 4; ++j) { accS[8 * q + 2 * j] = __uint_as_float(ws[j] << 16); accS[8 * q + 2 * j + 1] = __uint_as_float(ws[j] & 0xffff0000u); } }
        if (wid >= 2) {
            char* d = sprev + (size_t)c * 8192; const char* s = lds + (wid & 1) * 4096 + lane * 16;
#pragma unroll
            for (int i = 0; i < 4; ++i) *(u32x4*)(d + i * 1024) = *(const u32x4*)(s + i * 1024);
        }
#pragma unroll
        for (int ks = 0; ks < 4; ++ks) accS = __builtin_amdgcn_mfma_f32_32x32x16_bf16(gsf[ks], sb[ks], accS, 0, 0, 0);
        asm volatile("s_waitcnt lgkmcnt(0)" ::: "memory"); __builtin_amdgcn_s_barrier(); asm volatile("" ::: "memory");
        if (c + 4 < NCHUNK) dma(c + 4, slot);
    }
}

DEVI void phase4a(const P& p, int bid, int nb, char* lds) {
    typedef __attribute__((address_space(3))) unsigned lds_u32;
    const int tid = otid(), lane = tid & 63, wid = __builtin_amdgcn_readfirstlane(tid >> 6), l31 = lane & 31, h = lane >> 5, rb = wid >> 1, cb = wid & 1;
    for (int item = bid; item < 16 * (NCHUNK - 1); item += nb) {
        const int bh = item >> 7, c = 1 + (item & 127), b = bh >> 3, hh = bh & 7;
        const char* img = (const char*)p.ws + WS_CHK + ((size_t)bh * NCHUNK + c) * CHUNK_BYTES;
        const char* spv = (const char*)p.ws + WS_SPREV + ((size_t)bh * NCHUNK + c) * 8192;
#pragma unroll
        for (int i = 0; i < 2; ++i) { const int off = (wid * 2 + i) * 1024;
            __builtin_amdgcn_global_load_lds((const unsigned*)(img + off + lane * 16), (lds_u32*)(lds + off), 16, 0, 0);
            __builtin_amdgcn_global_load_lds((const unsigned*)(spv + off + lane * 16), (lds_u32*)(lds + 8192 + off), 16, 0, 0);
            __builtin_amdgcn_global_load_lds((const unsigned*)(img + 24576 + off + lane * 16), (lds_u32*)(lds + 16384 + off), 16, 0, 0); }
        asm volatile("s_waitcnt vmcnt(0)" ::: "memory"); __builtin_amdgcn_s_barrier(); asm volatile("" ::: "memory");
        f32x16 accY; bf16x8 sb[4], gyf[4];
#pragma unroll
        for (int ks = 0; ks < 4; ++ks) { sb[ks] = frag(lds + 8192, 32 * cb + l31, ks, h); gyf[ks] = frag(lds, 32 * rb + l31, ks, h); }
#pragma unroll
        for (int q = 0; q < 2; ++q) { const u32x4 wy = *(const u32x4*)(lds + 16384 + wid * 2048 + lane * 32 + q * 16);
#pragma unroll
            for (int j = 0; j < 4; ++j) { accY[8 * q + 2 * j] = __uint_as_float(wy[j] << 16); accY[8 * q + 2 * j + 1] = __uint_as_float(wy[j] & 0xffff0000u); } }
#pragma unroll
        for (int ks = 0; ks < 4; ++ks) accY = __builtin_amdgcn_mfma_f32_32x32x16_bf16(gyf[ks], sb[ks], accY, 0, 0, 0);
        float* YT = (float*)(lds + 24576);
#pragma unroll
        for (int r = 0; r < 16; ++r) YT[(32 * rb + crow(r, h)) * 68 + 32 * cb + l31] = accY[r];
        LBAR();
#pragma unroll
        for (int ps = 0; ps < 4; ++ps) {
            const int t = 16 * ps + (tid >> 4), c4 = (tid & 15) * 4, gc = hh * 64 + c4;
            const size_t row = (size_t)b * LP + 64 + 64 * c + t, o = row * 512 + gc;
            const bf16_t* zrow = WSP(bf16_t, WS_ZR) + row * RWKV_COLS;
            const f32x4 y = *(const f32x4*)(YT + t * 68 + c4), r = zs4(zrow, gc, p.rwkv_mu), k2 = ld4bf(WSP(bf16_t, WS_RK2) + o), v = zs4(zrow, 1024 + gc, p.rwkv_mu), g = ld4bf(WSP(bf16_t, WS_G) + o);
            const f32x4 rk = *(const f32x4*)(p.r_k + gc), lg = *(const f32x4*)(p.lnx_g + gc), lb = *(const f32x4*)(p.lnx_b + gc);
            const float mu = sum16((y.x + y.y) + (y.z + y.w)) * (1.f / 64.f);
            const f32x4 dy = y - mu;
            const float var = sum16((dy.x * dy.x + dy.y * dy.y) + (dy.z * dy.z + dy.w * dy.w)) * (1.f / 64.f);
            const float rs = rsqrtf(var + GN_EPS);
            const float bonus = sum16((r.x * k2.x * rk.x + r.y * k2.y * rk.y) + (r.z * k2.z * rk.z + r.w * k2.w * rk.w));
            const f32x4 ov = (dy * rs * lg + lb + bonus * v) * g;
            *(u32x2*)(WSP(bf16_t, WS_MIX) + row * 1024 + 512 + gc) = (u32x2){pk2(ov.x, ov.y), pk2(ov.z, ov.w)};
        }
        LBAR();
    }
}

struct EpiOutProj {
    const P& p; int tm, tn;
    DEVI void operator()(f32x4 (&acc)[4][4], int wm, int wn, int l15, int lq) const {
#pragma unroll
        for (int mt = 0; mt < 4; ++mt) { const size_t row = (size_t)tm * 128 + wm * 64 + mt * 16 + l15;
#pragma unroll
            for (int nt = 0; nt < 4; ++nt) { const size_t o = row * 1024 + tn * 128 + wn * 64 + nt * 16 + 4 * lq;
                const u32x2 w = *(const u32x2*)(WSP(bf16_t, WS_H0B) + o);
                const f32x4 h0 = (f32x4){__uint_as_float(w.x << 16), __uint_as_float(w.x & 0xffff0000u), __uint_as_float(w.y << 16), __uint_as_float(w.y & 0xffff0000u)};
                *(f32x4*)(WSP(float, WS_PRE1) + o) = h0 * ALPHA + acc[mt][nt]; } }
    }
};
DEVI void phase4b(const P& p, const Sched& sc, char* lds) {
    const int tid = otid(), srow = 16 * (tid >> 6) + ((tid & 63) >> 2);
    for_xcd_items(sc, [&](int x, int rank, int nloc) __attribute__((always_inline)) {
        const int r0 = 16 * x;
        for (int i = rank; i < 16 * 8; i += nloc) {
            const int tr = r0 + (i >> 3), tn = i & 7, tm = (tr >> 6) * NQB + 1 + (tr & 63);
            const bf16_t *ap[4], *bp[2];
#pragma unroll
            for (int q = 0; q < 2; ++q) { ap[q] = WSP(bf16_t, WS_MIX) + (size_t)(tm * 128 + srow + 64 * q) * 1024; bp[q] = WSP(bf16_t, WS_WOUTT) + (size_t)(tn * 128 + srow + 64 * q) * 1024; }
            ap[2] = ap[3] = ap[0];
            gemm256<false, 4>(ap, bp, 1024, lds, EpiOutProj{p, tm, tn});
        }
    });
}

DEVI void phase4c(const P& p, int bid, int nb, char* lds) {
    const int tid = otid(), lane = tid & 63, wid = tid >> 6;
    const int e = tid & 31, ks = tid >> 5;
    float* hrow = (float*)lds;
    float* part = (float*)(lds + 16384);
    unsigned* cnt = WSP(unsigned, WS_CTL) + CW_CNT;
    float wreg[128];
#pragma unroll
    for (int k = 0; k < 128; ++k) wreg[k] = p.w_router[(size_t)(ks * 128 + k) * 32 + e];
    const float br = p.b_router[e];
    for (int base = bid * 4; base < NP; base += nb * 4) {
        const int row = base + wid;
        const bool pad = (row % LP) < PADL + NMETA;
        {
            u32x2* hb = (u32x2*)(WSP(bf16_t, WS_H1B) + (size_t)row * 1024) + lane;
            if (pad) {
#pragma unroll
                for (int j = 0; j < 4; ++j) { hb[64 * j] = (u32x2){0u, 0u}; *(f32x4*)(hrow + wid * 1024 + lane * 4 + 256 * j) = (f32x4){0.f, 0.f, 0.f, 0.f}; }
            } else {
                const f32x4* src = (const f32x4*)(WSP(float, WS_PRE1) + (size_t)row * 1024) + lane;
                f32x4 v[4]; float s = 0.f;
#pragma unroll
                for (int j = 0; j < 4; ++j) { v[j] = src[64 * j]; s += (v[j].x + v[j].y) + (v[j].z + v[j].w); }
                const float mean = wave_sum(s) * (1.f / 1024.f); float s2 = 0.f;
#pragma unroll
                for (int j = 0; j < 4; ++j) { v[j] = v[j] - mean; s2 += (v[j].x * v[j].x + v[j].y * v[j].y) + (v[j].z * v[j].z + v[j].w * v[j].w); }
                const float rstd = rsqrtf(wave_sum(s2) * (1.f / 1024.f) + LN_EPS);
                if (lane == 0) { WSP(float, WS_ST1)[(size_t)row * 2] = mean; WSP(float, WS_ST1)[(size_t)row * 2 + 1] = rstd; }
#pragma unroll
                for (int j = 0; j < 4; ++j) {
                    const f32x4 g = ((const f32x4*)p.ln1_g)[lane + 64 * j], bb = ((const f32x4*)p.ln1_b)[lane + 64 * j];
                    const f32x4 o = v[j] * rstd * g + bb;
                    hb[64 * j] = (u32x2){pk2(o.x, o.y), pk2(o.z, o.w)};
                    *(f32x4*)(hrow + wid * 1024 + lane * 4 + 256 * j) = o;
                }
            }
        }
        LBAR();
        {
            float a0 = 0.f, a1 = 0.f, a2 = 0.f, a3 = 0.f;
            const float* h0 = hrow + ks * 128;
#pragma unroll
            for (int k = 0; k < 128; k += 4) {
                const f32x4 x0 = *(const f32x4*)(h0 + k), x1 = *(const f32x4*)(h0 + 1024 + k), x2 = *(const f32x4*)(h0 + 2048 + k), x3 = *(const f32x4*)(h0 + 3072 + k);
#pragma unroll
                for (int q = 0; q < 4; ++q) { a0 += wreg[k + q] * x0[q]; a1 += wreg[k + q] * x1[q]; a2 += wreg[k + q] * x2[q]; a3 += wreg[k + q] * x3[q]; }
            }
            part[(0 * 8 + ks) * 32 + e] = a0; part[(1 * 8 + ks) * 32 + e] = a1; part[(2 * 8 + ks) * 32 + e] = a2; part[(3 * 8 + ks) * 32 + e] = a3;
        }
        LBAR();
        {
            const int ee = lane & 31;
            float logit = br;
#pragma unroll
            for (int q = 0; q < 8; ++q) logit += part[(wid * 8 + q) * 32 + ee];
            float cur = logit; float tv[4]; int ti[4];
#pragma unroll
            for (int k = 0; k < 4; ++k) {
                float bv = cur; int bi = ee;
#pragma unroll
                for (int o = 16; o > 0; o >>= 1) { const float ov = __shfl_xor(bv, o); const int oi = __shfl_xor(bi, o); if (ov > bv || (ov == bv && oi < bi)) { bv = ov; bi = oi; } }
                tv[k] = bv; ti[k] = bi; if (ee == bi) cur = -INFINITY;
            }
            const float e1 = __expf(tv[1] - tv[0]), e2 = __expf(tv[2] - tv[0]), e3 = __expf(tv[3] - tv[0]); const float inv = 1.f / (1.f + e1 + e2 + e3);
            if (lane < 4 && !pad) {
                const int ex = lane == 0 ? ti[0] : lane == 1 ? ti[1] : lane == 2 ? ti[2] : ti[3];
                const float gt = (lane == 0 ? 1.f : lane == 1 ? e1 : lane == 2 ? e2 : e3) * inv;
                const unsigned rank = atomicAdd(cnt + ex, 1u);
                WSP(int, WS_LTOK)[(size_t)ex * CAP + rank] = row; WSP(float, WS_LGATE)[(size_t)ex * CAP + rank] = gt;
                WSP(int, WS_RTE)[(size_t)row * 4 + lane] = ex; WSP(int, WS_RTR)[(size_t)row * 4 + lane] = (int)rank;
            }
        }
    }
}

struct MoeTab { int* rb; int* cn; int* nf; int* ng; };
DEVI MoeTab moe_prefix(const P& p, char* lds) {
    MoeTab t; t.rb = (int*)(lds + LX); t.cn = t.rb + 33; t.nf = t.cn + 32; t.ng = t.nf + 32;
    if (threadIdx.x == 0) { const unsigned* cnt = WSP(unsigned, WS_CTL) + CW_CNT; int acc = 0;
        for (int e = 0; e < NEXP; ++e) { const int c = (int)cnt[e]; int f = c >> 8, g = 0; const int rem = c & 255; if (rem > 128) ++f; else g = (rem + 63) >> 6;
            t.cn[e] = c; t.nf[e] = f; t.ng[e] = g; t.rb[e] = acc; acc += f * 256 + g * 64; }
        t.rb[NEXP] = acc; }
    __syncthreads();
    return t;
}

template <int MT> struct EpiGU {
    const P& p; int e, row0, tn; char* lds;
    DEVI void operator()(f32x4 (&acc)[MT][4], int wm, int wn, int l15, int lq) const {
        const float* bg = p.b_gu + (size_t)e * 2048;
        const int lane = l15 + 16 * lq, wid = wm * 2 + wn; char* st = lds + wid * 18432;
#pragma unroll
        for (int mt = 0; mt < MT; ++mt) { const size_t row = (size_t)row0 + wm * (16 * MT) + mt * 16 + l15;
#pragma unroll
            for (int np = 0; np < 2; ++np) { const int jc = tn * 64 + wn * 32 + np * 16 + 4 * lq;
                const f32x4 bgt = *(const f32x4*)(bg + jc), bup = *(const f32x4*)(bg + 1024 + jc); float ov[4];
#pragma unroll
                for (int r = 0; r < 4; ++r) { const float gate = fminf(acc[mt][2 * np][r] + bgt[r], 7.f); const float up = fminf(fmaxf(acc[mt][2 * np + 1][r] + bup[r], -7.f), 7.f);
                    ov[r] = (up + 1.f) * (gate * sigmoidf(gate * 1.702f)); }
                const u32x2 w = (u32x2){pk2(ov[0], ov[1]), pk2(ov[2], ov[3])};
                if constexpr (MT == 8) *(u32x2*)(st + (mt * 16 + l15) * 80 + (np * 16 + 4 * lq) * 2) = w;
                else *(u32x2*)(WSP(bf16_t, WS_ACT) + row * 1024 + jc) = w; } }
        if constexpr (MT == 8) {
            asm volatile("s_waitcnt lgkmcnt(0)" ::: "memory");
            bf16_t* dst = WSP(bf16_t, WS_ACT) + ((size_t)row0 + wm * 128) * 1024 + tn * 64 + wn * 32;
#pragma unroll
            for (int i = 0; i < 8; ++i) { const int r = 16 * i + (lane >> 2), ch = lane & 3; *(u32x4*)(dst + (size_t)r * 1024 + ch * 8) = *(const u32x4*)(st + r * 80 + ch * 16); }
            LBAR();
        }
    }
};
template <int MT> struct EpiDown {
    const P& p; int e, row0, idx0, cnt_e, tn; char* lds;
    DEVI void operator()(f32x4 (&acc)[MT][4], int wm, int wn, int l15, int lq) const {
        const float* bd = p.b_down + (size_t)e * 1024;
        if constexpr (MT == 8) {
            const int lane = l15 + 16 * lq, wid = wm * 2 + wn; char* st = lds + wid * 18432;
#pragma unroll
            for (int mt = 0; mt < MT; ++mt) { const int ml = wm * 128 + mt * 16 + l15; const int idx = idx0 + ml; const float gt = idx < cnt_e ? WSP(float, WS_LGATE)[(size_t)e * CAP + idx] : 0.f;
#pragma unroll
                for (int nt = 0; nt < 4; ++nt) { const int c = tn * 128 + wn * 64 + nt * 16 + 4 * lq; const f32x4 o = (acc[mt][nt] + *(const f32x4*)(bd + c)) * gt;
                    *(u32x2*)(st + (mt * 16 + l15) * 144 + (nt * 16 + 4 * lq) * 2) = (u32x2){pk2(o.x, o.y), pk2(o.z, o.w)}; } }
            asm volatile("s_waitcnt lgkmcnt(0)" ::: "memory");
            bf16_t* dst = WSP(bf16_t, WS_YB) + ((size_t)row0 + wm * 128) * 1024 + tn * 128 + wn * 64;
#pragma unroll
            for (int i = 0; i < 16; ++i) { const int r = 8 * i + (lane >> 3), ch = lane & 7; *(u32x4*)(dst + (size_t)r * 1024 + ch * 8) = *(const u32x4*)(st + r * 144 + ch * 16); }
            LBAR();
        } else {
#pragma unroll
            for (int mt = 0; mt < MT; ++mt) { const int ml = wm * (16 * MT) + mt * 16 + l15; const int idx = idx0 + ml; const float gt = idx < cnt_e ? WSP(float, WS_LGATE)[(size_t)e * CAP + idx] : 0.f;
                const size_t row = (size_t)row0 + ml;
#pragma unroll
                for (int nt = 0; nt < 4; ++nt) { const int c = tn * 128 + wn * 64 + nt * 16 + 4 * lq; const f32x4 o = (acc[mt][nt] + *(const f32x4*)(bd + c)) * gt; *(u32x2*)(WSP(bf16_t, WS_YB) + row * 1024 + c) = (u32x2){pk2(o.x, o.y), pk2(o.z, o.w)}; } }
        }
    }
};
template <int NT, class FullFn, class SmallFn>
DEVI void moe_items(const MoeTab& T, int x, int rank, int nloc, FullFn&& full, SmallFn&& small) {
    const int f0 = T.nf[x], f1 = f0 + T.nf[x + 8], f2 = f1 + T.nf[x + 16], f3 = f2 + T.nf[x + 24];
    const int g0 = T.ng[x], g1 = g0 + T.ng[x + 8], g2 = g1 + T.ng[x + 16], g3 = g2 + T.ng[x + 24];
    for (int i = rank; i < (f3 + g3) * NT; i += nloc) {
        if (i < f3 * NT) { const int rbk = i / NT, tn = i % NT; const int j = rbk < f0 ? 0 : rbk < f1 ? 1 : rbk < f2 ? 2 : 3; const int e = x + 8 * j, mb = rbk - (j == 0 ? 0 : j == 1 ? f0 : j == 2 ? f1 : f2);
            full(e, mb * 256, tn); }
        else { const int k = i - f3 * NT, gk = k / NT, tn = k % NT; const int j = gk < g0 ? 0 : gk < g1 ? 1 : gk < g2 ? 2 : 3; const int e = x + 8 * j, gi = gk - (j == 0 ? 0 : j == 1 ? g0 : j == 2 ? g1 : g2);
            small(e, T.nf[e] * 256 + gi * 64, tn); }
    }
}
DEVI void phase5(const P& p, const Sched& sc, char* lds) {
    const MoeTab T = moe_prefix(p, lds);
    const int tid = otid(), lane = tid & 63, wid = tid >> 6, srow = 16 * wid + (lane >> 2);
    for_xcd_items(sc, [&](int x, int rank, int nloc) __attribute__((always_inline)) {
        moe_items<16>(T, x, rank, nloc,
            [&](int e, int idx0, int tn) __attribute__((always_inline)) {
                const bf16_t *ap[4], *bp[2];
#pragma unroll
                for (int q = 0; q < 4; ++q) { const int idx = idx0 + srow + 64 * q; const int tok = idx < T.cn[e] ? WSP(int, WS_LTOK)[(size_t)e * CAP + idx] : 0; ap[q] = WSP(bf16_t, WS_H1B) + (size_t)tok * 1024; }
#pragma unroll
                for (int q = 0; q < 2; ++q) bp[q] = WSP(bf16_t, WS_WGUT) + ((size_t)e * 2048 + tn * 128 + srow + 64 * q) * 1024;
                gemm256<false, 8>(ap, bp, 1024, lds, EpiGU<8>{p, e, T.rb[e] + idx0, tn, lds}); },
            [&](int e, int idx0, int tn) __attribute__((always_inline)) {
                const bf16_t *ap[4], *bp[2];
                { const int idx = idx0 + srow; const int tok = idx < T.cn[e] ? WSP(int, WS_LTOK)[(size_t)e * CAP + idx] : 0; ap[0] = WSP(bf16_t, WS_H1B) + (size_t)tok * 1024; ap[1] = ap[2] = ap[3] = ap[0]; }
#pragma unroll
                for (int q = 0; q < 2; ++q) bp[q] = WSP(bf16_t, WS_WGUT) + ((size_t)e * 2048 + tn * 128 + srow + 64 * q) * 1024;
                gemm256<false, 2>(ap, bp, 1024, lds, EpiGU<2>{p, e, T.rb[e] + idx0, tn, lds}); });
    });
}
DEVI void phase6(const P& p, const Sched& sc, char* lds) {
    const MoeTab T = moe_prefix(p, lds);
    const int tid = otid(), lane = tid & 63, wid = tid >> 6, srow = 16 * wid + (lane >> 2);
    for_xcd_items(sc, [&](int x, int rank, int nloc) __attribute__((always_inline)) {
        moe_items<8>(T, x, rank, nloc,
            [&](int e, int idx0, int tn) __attribute__((always_inline)) {
                const bf16_t *ap[4], *bp[2];
#pragma unroll
                for (int q = 0; q < 4; ++q) ap[q] = WSP(bf16_t, WS_ACT) + ((size_t)T.rb[e] + idx0 + srow + 64 * q) * 1024;
#pragma unroll
                for (int q = 0; q < 2; ++q) bp[q] = WSP(bf16_t, WS_WDT) + ((size_t)e * 1024 + tn * 128 + srow + 64 * q) * 1024;
                gemm256<false, 8>(ap, bp, 1024, lds, EpiDown<8>{p, e, T.rb[e] + idx0, idx0, T.cn[e], tn, lds}); },
            [&](int e, int idx0, int tn) __attribute__((always_inline)) {
                const bf16_t *ap[4], *bp[2];
                ap[0] = WSP(bf16_t, WS_ACT) + ((size_t)T.rb[e] + idx0 + srow) * 1024; ap[1] = ap[2] = ap[3] = ap[0];
#pragma unroll
                for (int q = 0; q < 2; ++q) bp[q] = WSP(bf16_t, WS_WDT) + ((size_t)e * 1024 + tn * 128 + srow + 64 * q) * 1024;
                gemm256<false, 2>(ap, bp, 1024, lds, EpiDown<2>{p, e, T.rb[e] + idx0, idx0, T.cn[e], tn, lds}); });
    });
}
DEVI void phase7(const P& p, int bid, int nb, char* lds) {
    const MoeTab T = moe_prefix(p, lds);
    const int tid = otid(), lane = tid & 63, wid = tid >> 6;
    for (int row = bid * 4 + wid; row < NP; row += nb * 4) {
        const int b = row / LP, pp = row % LP; if (pp < PADL + NMETA) continue;
        const int t = pp - PADL - NMETA;
        const f32x4* pre = (const f32x4*)(WSP(float, WS_PRE1) + (size_t)row * 1024) + lane;
        const float mean1 = WSP(float, WS_ST1)[(size_t)row * 2], rstd1 = WSP(float, WS_ST1)[(size_t)row * 2 + 1];
        f32x4 v[4];
#pragma unroll
        for (int j = 0; j < 4; ++j) v[j] = ((pre[64 * j] - mean1) * rstd1 * ((const f32x4*)p.ln1_g)[lane + 64 * j] + ((const f32x4*)p.ln1_b)[lane + 64 * j]) * ALPHA;
#pragma unroll
        for (int k = 0; k < 4; ++k) { const int e = WSP(int, WS_RTE)[(size_t)row * 4 + k], rk = WSP(int, WS_RTR)[(size_t)row * 4 + k];
            const u32x2* yb = (const u32x2*)(WSP(bf16_t, WS_YB) + ((size_t)T.rb[e] + rk) * 1024) + lane;
#pragma unroll
            for (int j = 0; j < 4; ++j) { const u32x2 w = yb[64 * j]; v[j] += (f32x4){__uint_as_float(w.x << 16), __uint_as_float(w.x & 0xffff0000u), __uint_as_float(w.y << 16), __uint_as_float(w.y & 0xffff0000u)}; } }
        float s = 0.f;
#pragma unroll
        for (int j = 0; j < 4; ++j) s += (v[j].x + v[j].y) + (v[j].z + v[j].w);
        const float mean = wave_sum(s) * (1.f / 1024.f); float s2 = 0.f;
#pragma unroll
        for (int j = 0; j < 4; ++j) { v[j] = v[j] - mean; s2 += (v[j].x * v[j].x + v[j].y * v[j].y) + (v[j].z * v[j].z + v[j].w * v[j].w); }
        const float rstd = rsqrtf(wave_sum(s2) * (1.f / 1024.f) + LN_EPS);
        f32x4* o = (f32x4*)(p.out + ((size_t)b * SEQ + t) * 1024) + lane;
#pragma unroll
        for (int j = 0; j < 4; ++j) o[64 * j] = v[j] * rstd * ((const f32x4*)p.ln2_g)[lane + 64 * j] + ((const f32x4*)p.ln2_b)[lane + 64 * j];
    }
}

#define LAS __attribute__((address_space(3)))
#define XB_TMO      128
#define XB_XCNT(j)  (256  + 64 * (j))
#define XB_XSUB(j)  (1280 + 64 * (j))
#define XB_XGEN(j)  (2304 + 64 * (j))
#define XB_TOP      3328
#define XB_TOPGEN   3392
#define XCD_BAR_WORDS 3456
#define XB_SPIN_CAP (1u << 18)
__device__ __forceinline__ unsigned xb_ld(unsigned* p)              { return __hip_atomic_load(p, __ATOMIC_RELAXED, __HIP_MEMORY_SCOPE_AGENT); }
__device__ __forceinline__ unsigned xb_add(unsigned* p, unsigned v) { return __hip_atomic_fetch_add(p, v, __ATOMIC_RELAXED, __HIP_MEMORY_SCOPE_AGENT); }
__device__ __forceinline__ unsigned xb_xcc_id() { return (unsigned)__builtin_amdgcn_s_getreg((3 << 11) | 20) & 0xFu; }
#define XB_SPIN(cond, bar) do { unsigned _sp = 0; while (cond) { __builtin_amdgcn_s_sleep(1); \
    if ((++_sp & 255u) == 0u) { if (xb_ld(&(bar)[XB_TMO])) break; if (_sp > XB_SPIN_CAP) { atomicAdd(&(bar)[XB_TMO], 1u); break; } } } } while (0)
struct XcdBarrier { unsigned* bar; unsigned x; volatile LAS unsigned* st; };
__device__ __forceinline__ XcdBarrier xcd_barrier_post(unsigned* bar, volatile LAS unsigned* st) {
    XcdBarrier b; b.bar = bar; b.x = xb_xcc_id(); b.st = st;
    if (threadIdx.x == 0) (void)xb_add(&bar[XB_XCNT(b.x)], 1u);
    return b;
}
__device__ __forceinline__ void xcd_barrier_complete(unsigned* bar, unsigned x, unsigned& nloc, unsigned& nx) {
    const unsigned G = gridDim.x * gridDim.y * gridDim.z;
    unsigned sum, cnt, mine, sp = 0u;
    for (;;) {
        sum = 0u; cnt = 0u; mine = 0u;
#pragma unroll
        for (unsigned j = 0; j < 16; ++j) { const unsigned c = xb_ld(&bar[XB_XCNT(j)]); sum += c; cnt += (c > 0u) ? 1u : 0u; mine = (j == x) ? c : mine; }
        if (sum == G) break;
        __builtin_amdgcn_s_sleep(1);
        if ((++sp & 255u) == 0u) { if (xb_ld(&bar[XB_TMO])) break; if (sp > XB_SPIN_CAP) { atomicAdd(&bar[XB_TMO], 1u); break; } }
    }
    nloc = mine > 0u ? mine : 1u; nx = cnt > 0u ? cnt : 1u;
}
__device__ __forceinline__ void xcd_barrier(const XcdBarrier& b) {
    asm volatile("s_waitcnt vmcnt(0)" ::: "memory");
    __syncthreads();
    if (threadIdx.x == 0) {
        unsigned* bar = b.bar;
        __builtin_amdgcn_s_waitcnt(0);
        unsigned nloc = b.st[0], nx = b.st[1];
        if (nloc == 0u) { xcd_barrier_complete(bar, b.x, nloc, nx); b.st[0] = nloc; b.st[1] = nx; }
        const unsigned old = xb_add(&bar[XB_XSUB(b.x)], 1u);
        const unsigned gen = old / nloc;
        if (old + 1u == (gen + 1u) * nloc) {
            __builtin_amdgcn_fence(__ATOMIC_RELEASE, "agent");
            asm volatile("s_waitcnt vmcnt(0)" ::: "memory");
            const unsigned og = xb_add(&bar[XB_TOP], 1u);
            const unsigned tg = og / nx;
            if (og + 1u == (tg + 1u) * nx) xb_add(&bar[XB_TOPGEN], 1u);
            else XB_SPIN(xb_ld(&bar[XB_TOPGEN]) == tg, bar);
            __builtin_amdgcn_fence(__ATOMIC_ACQUIRE, "agent");
            xb_add(&bar[XB_XGEN(b.x)], 1u);
            asm volatile("s_waitcnt vmcnt(0)" ::: "memory");
        } else {
            XB_SPIN(xb_ld(&bar[XB_XGEN(b.x)]) == gen, bar);
            __builtin_amdgcn_fence(__ATOMIC_ACQUIRE, "agent");
            asm volatile("s_waitcnt vmcnt(0)" ::: "memory");
        }
    }
    __syncthreads();
}

namespace cg = cooperative_groups;
constexpr int CW_BAR = 4096;
constexpr size_t CTL_ZERO_BYTES = 65536;
constexpr int N_SCAN_JOBS = 16, N_ATT_ITEMS = 16 * (NQB - 1);
DEVI void phase3(const P& p, char* lds, int qoff) {
    int* s_item = (int*)(lds + LX + 992);
    unsigned* q = WSP(unsigned, WS_CTL) + CW_QATT + qoff;
    for (;;) {
        if (threadIdx.x == 0) *s_item = (int)atomicAdd(q, 1u);
        __syncthreads();
        const int it = __builtin_amdgcn_readfirstlane(*s_item);
        __syncthreads();
        if (it >= N_SCAN_JOBS + N_ATT_ITEMS + N_CONV_ITEMS) break;
        if (it < N_SCAN_JOBS) {
            chunk_job(p, it * NCHUNK, lds);
            __threadfence(); __syncthreads();
            __builtin_amdgcn_s_setprio(3); scanB_job(p, it, lds); __builtin_amdgcn_s_setprio(0); continue; }
        const int r = it - N_SCAN_JOBS; int a;
        if (r < 3 * N_CONV_ITEMS) { if (r % 3 == 2) { conv_moe_item(p, r / 3, lds); continue; } a = 2 * (r / 3) + (r % 3); }
        else a = r - N_CONV_ITEMS;
        { const int qb = NQB - 1 - a / 16, bh = a % 16; attn_item(p, bh >> 3, bh & 7, qb, lds); }
    }
}
__global__ void __launch_bounds__(256, 2) k_mega(P p) {
    __shared__ __attribute__((aligned(16))) char lds[LDS_BYTES];
    const int bid = blockIdx.x, nb = gridDim.x;
    volatile LAS unsigned* st = (volatile LAS unsigned*)(LAS char*)(lds + LX + 1008);
    if (threadIdx.x < 2) st[threadIdx.x] = 0u;
    __syncthreads();
    if (p.ws == nullptr) cg::this_grid().sync();
    const XcdBarrier bar = xcd_barrier_post(WSP(unsigned, WS_CTL) + CW_BAR, st);
    int* s_rank = (int*)(lds + LX + 976);
    if (threadIdx.x == 0) *s_rank = (int)atomicAdd(WSP(unsigned, WS_CTL) + CW_XRANK + 64 * (bar.x & 15), 1u);
#ifndef PROBE_MASK
#define PROBE_MASK 0
#endif
#define RUNP(k, call) do { call; if (PROBE_MASK & (1 << (k))) { xcd_barrier(bar); call; } } while (0)
    RUNP(0, phase0(p, bid, nb, lds));  xcd_barrier(bar);
    Sched sc;
    { const int nloc = __builtin_amdgcn_readfirstlane((int)st[0]), nx = __builtin_amdgcn_readfirstlane((int)st[1]), rk = __builtin_amdgcn_readfirstlane(*s_rank); const bool ok = nx == 8 && bar.x < 8 && rk < nloc;
      sc.x = ok ? (int)bar.x : 0; sc.rank = ok ? rk : bid; sc.nloc = ok ? nloc : nb; sc.nxcd = ok ? 8 : 0; }
    RUNP(1, phase1(p, sc, lds));  xcd_barrier(bar);
    RUNP(4, phase2c(p, bid, nb, lds)); xcd_barrier(bar);
    phase3(p, lds, 0); if (PROBE_MASK & (1 << 5)) { xcd_barrier(bar); phase3(p, lds, 64); } xcd_barrier(bar);
    RUNP(6, phase4a(p, bid, nb, lds)); xcd_barrier(bar);
    RUNP(7, phase4b(p, sc, lds)); xcd_barrier(bar);
    phase4c(p, bid, nb, lds); xcd_barrier(bar);
    RUNP(9, phase5(p, sc, lds));  xcd_barrier(bar);
    RUNP(10, phase6(p, sc, lds));  xcd_barrier(bar);
    RUNP(11, phase7(p, bid, nb, lds));
}

extern "C" void kernel_launch(void* const* d_in, const int* in_sizes, int n_in, void* d_out, int out_size, void* d_ws, size_t ws_size, hipStream_t stream) {
    if (n_in != 29 || ws_size < WS_NEED) { fprintf(stderr, "kernel_launch: unexpected n_in %d or ws_size %zu (need %zu)\n", n_in, ws_size, (size_t)WS_NEED); return; }
    static int grid_blocks = 0;
    if (!grid_blocks) {
        int dev = 0, cus = 0, per_cu = 0;
        (void)hipGetDevice(&dev);
        (void)hipDeviceGetAttribute(&cus, hipDeviceAttributeMultiprocessorCount, dev);
        (void)hipOccupancyMaxActiveBlocksPerMultiprocessor(&per_cu, k_mega, 256, 0);
        if (per_cu > 2) per_cu = 2;
        grid_blocks = cus * per_cu;
        if (grid_blocks <= 0) { fprintf(stderr, "kernel_launch: occupancy query gave %d x %d\n", cus, per_cu); grid_blocks = 0; return; }
    }
    (void)hipMemsetAsync((char*)d_ws + WS_CTL, 0, CTL_ZERO_BYTES, stream);
    P p{};
    const float** pf = (const float**)&p;
    for (int i = 0; i < 29; ++i) pf[i] = (const float*)d_in[i];
    p.out = (float*)d_out; p.ws = (unsigned char*)d_ws;
    void* args[] = {&p};
    hipError_t e = hipLaunchCooperativeKernel((void*)k_mega, dim3(grid_blocks), dim3(256), args, 0, stream);
    if (e != hipSuccess) fprintf(stderr, "cooperative launch failed: %s (grid %d)\n", hipGetErrorString(e), grid_blocks);
}
```

```cpp
#include <hip/hip_runtime.h>
#include <hip/hip_cooperative_groups.h>
#include <stdint.h>
#include <stdio.h>

#define DEVI __device__ __forceinline__
typedef unsigned short bf16_t;
typedef short bf16x8 __attribute__((ext_vector_type(8)));
typedef float f32x4 __attribute__((ext_vector_type(4)));
typedef float f32x16 __attribute__((ext_vector_type(16)));
typedef unsigned u32x4 __attribute__((ext_vector_type(4)));
typedef unsigned u32x2 __attribute__((ext_vector_type(2)));

constexpr int BATCH = 2, SEQ = 8192, DM = 1024, NMETA = 16;
constexpr int LTOK = SEQ + NMETA;
constexpr int PADL = 112;
constexpr int LP = LTOK + PADL;
constexpr int NP = BATCH * LP;
constexpr int NQB = LP / 128;
constexpr int NH = 8, HD = 64;
constexpr int FOXW = 512, RWW = 512;
constexpr int RWKV_COLS = 1792;
constexpr int IN_COLS = 3336;
constexpr int WIN_N = 3456;
constexpr int NEXP = 32, TOPK = 4;
constexpr int CAP = BATCH * LTOK;
constexpr int MAXBLK = (BATCH * LTOK * TOPK) / 256 + NEXP + 1;
constexpr float ALPHA = 1.189207115002721f;
constexpr float LN_EPS = 1e-5f, GN_EPS = 64e-5f, RMS_EPS = 1e-6f;
constexpr float LOG2E = 1.4426950408889634f;
constexpr float QSCALE = 0.125f * LOG2E;
constexpr float NEGBIG = -1e30f;

constexpr size_t MiB = 1u << 20;
constexpr size_t al256(size_t x) { return (x + 255) & ~(size_t)255; }
constexpr size_t WS_CTL = 0;
constexpr size_t WS_WINT = 1 * MiB;
constexpr size_t WS_WOUTT = WS_WINT + (size_t)WIN_N * 1024 * 2;
constexpr size_t WS_W2T = WS_WOUTT + (size_t)1024 * 1024 * 2;
constexpr size_t WS_A2T = WS_W2T + 512 * 64 * 2;
constexpr size_t WS_G2T = WS_A2T + 512 * 64 * 2;
constexpr size_t WS_WGUT = al256(WS_G2T + 512 * 128 * 2);
constexpr size_t WS_WDT = WS_WGUT + (size_t)32 * 2048 * 1024 * 2;
constexpr size_t WS_ST1 = WS_WDT + (size_t)32 * 1024 * 1024 * 2;
constexpr size_t WS_H1B = WS_ST1 + (size_t)NP * 2 * 4;
constexpr size_t WS_RTE = WS_H1B + (size_t)NP * 1024 * 2;
constexpr size_t WS_RTR = WS_RTE + (size_t)NP * 16;
constexpr size_t WS_RTG = WS_RTR + (size_t)NP * 16;
constexpr size_t WS_LTOK = WS_RTG + (size_t)NP * 16;
constexpr size_t WS_LGATE = WS_LTOK + (size_t)32 * CAP * 4;
constexpr size_t WS_PRE1 = al256(WS_LGATE + (size_t)32 * CAP * 4);
constexpr size_t WS_EARLY = WS_PRE1 + (size_t)NP * 1024 * 4;
constexpr size_t WS_H0B = WS_EARLY;
constexpr size_t WS_QB = WS_H0B + (size_t)NP * 1024 * 2;
constexpr size_t WS_KB = WS_QB + (size_t)NP * 512 * 2;
constexpr size_t WS_VT = WS_KB + (size_t)NP * 512 * 2;
constexpr size_t WS_ZR = WS_VT + (size_t)NP * 512 * 2;
constexpr size_t WS_LF = WS_ZR + (size_t)NP * 1792 * 4;
constexpr size_t WS_CS = WS_LF + (size_t)NP * 8 * 4;
constexpr size_t WS_R = WS_CS + (size_t)NP * 8 * 4;
constexpr size_t WS_CHK = WS_R;
static_assert((size_t)16 * 129 * 32768 <= (size_t)4 * NP * 512 * 2, "chunk buffers fit");
constexpr size_t WS_KR = WS_R + (size_t)NP * 512 * 2;
constexpr size_t WS_VR = WS_KR + (size_t)NP * 512 * 2;
constexpr size_t WS_KK = WS_VR + (size_t)NP * 512 * 2;
constexpr size_t WS_TW = WS_KK + (size_t)NP * 512 * 2;
constexpr size_t WS_DA = WS_TW + (size_t)NP * 64 * 2;
constexpr size_t WS_SG = WS_DA + (size_t)NP * 64 * 2;
constexpr size_t WS_RW = WS_SG + (size_t)NP * 128 * 2;
constexpr size_t WS_RB = WS_RW + (size_t)NP * 512 * 4;
constexpr size_t WS_RK2 = WS_RB + (size_t)NP * 512 * 2;
constexpr size_t WS_G = WS_RK2 + (size_t)NP * 512 * 2;
constexpr size_t WS_Y = WS_G + (size_t)NP * 512 * 2;
constexpr size_t WS_MIX = WS_Y + (size_t)NP * 512 * 4;
constexpr size_t WS_LGS = WS_MIX + (size_t)NP * 1024 * 2;
constexpr size_t WS_EARLY_END = WS_LGS + (size_t)1024 * 81920;
constexpr size_t WS_ACT = WS_EARLY;
constexpr size_t WS_YB = WS_ACT + (size_t)MAXBLK * 256 * 1024 * 2;
constexpr size_t WS_LATE_END = WS_YB + (size_t)MAXBLK * 256 * 1024 * 2;
constexpr size_t WS_NEED = WS_EARLY_END > WS_LATE_END ? WS_EARLY_END : WS_LATE_END;
constexpr int CW_CNT = 0;
constexpr int CW_QATT = 64;
constexpr int CW_QK2 = 320;
constexpr int CW_XRANK = 1024;

struct P {
    const float *x, *meta, *ln0_g, *ln0_b, *w_in, *b_fgate, *fox_norm_g, *rwkv_mu, *w0, *w2, *a0, *a2, *g2, *k_k, *k_a, *r_k, *lnx_g,
        *lnx_b, *w_out, *ln1_g, *ln1_b, *w_router, *b_router, *w_gu, *b_gu, *w_down, *b_down, *ln2_g, *ln2_b;
    float* out;
    unsigned char* ws;
};
#define WSP(T, off) ((T*)(p.ws + (off)))

#define LAS __attribute__((address_space(3)))
constexpr int LDS_HALF = 73728, LDS_SMALL = 2 * LDS_HALF, LDS_BYTES = LDS_SMALL + 2048;
__shared__ __attribute__((aligned(16))) char g_lds[LDS_BYTES];
DEVI int half_id() { return __builtin_amdgcn_readfirstlane((int)(threadIdx.x >> 8)); }
DEVI char* smallw(int off) { return g_lds + LDS_SMALL + half_id() * 1024 + off; }
#define RBAR() do { asm volatile("s_waitcnt lgkmcnt(0)" ::: "memory"); __builtin_amdgcn_s_barrier(); asm volatile("" ::: "memory"); } while (0)
DEVI unsigned hbar() {
    asm volatile("" ::: "memory");
    unsigned tgt = 0u;
    if ((threadIdx.x & 63) == 0) {
        LAS unsigned* c = (LAS unsigned*)(LAS char*)smallw(1016);
        const unsigned old = __hip_atomic_fetch_add(c, 1u, __ATOMIC_RELAXED, __HIP_MEMORY_SCOPE_WORKGROUP);
        tgt = (old | 3u) + 1u;
        if ((old & 3u) != 3u) while ((int)(__hip_atomic_load(c, __ATOMIC_RELAXED, __HIP_MEMORY_SCOPE_WORKGROUP) - tgt) < 0) { }
    }
    asm volatile("" ::: "memory");
    return (unsigned)__builtin_amdgcn_readfirstlane((int)tgt);
}
DEVI unsigned fb_addr() { return (unsigned)(size_t)(LAS char*)smallw(960); }
DEVI unsigned fb_init() { return (unsigned)__builtin_amdgcn_readfirstlane((int)*(volatile LAS unsigned*)(LAS char*)(smallw(960) + 4 * ((threadIdx.x >> 6) & 3))); }
DEVI void fb_arrive(unsigned seq) { asm volatile("" ::: "memory"); if ((threadIdx.x & 63) == 0) { const unsigned a = fb_addr() + 4 * ((threadIdx.x >> 6) & 3); asm volatile("ds_write_b32 %0, %1" :: "v"(a), "v"(seq) : "memory"); } asm volatile("" ::: "memory"); }
DEVI void fb_wait(unsigned seq) { asm volatile("" ::: "memory");
    if ((threadIdx.x & 63) == 0) { const unsigned a = fb_addr(); u32x4 f;
        do { asm volatile("ds_read_b128 %0, %1\n\ts_waitcnt lgkmcnt(0)" : "=v"(f) : "v"(a) : "memory"); }
        while ((int)(f.x - seq) < 0 || (int)(f.y - seq) < 0 || (int)(f.z - seq) < 0 || (int)(f.w - seq) < 0); }
    asm volatile("" ::: "memory"); }
DEVI void harrive() { asm volatile("" ::: "memory"); if ((threadIdx.x & 63) == 0) (void)__hip_atomic_fetch_add((LAS unsigned*)(LAS char*)smallw(1016), 1u, __ATOMIC_RELAXED, __HIP_MEMORY_SCOPE_WORKGROUP); asm volatile("" ::: "memory"); }
DEVI void hwait(unsigned tgt) { asm volatile("" ::: "memory"); if ((threadIdx.x & 63) == 0) { LAS unsigned* c = (LAS unsigned*)(LAS char*)smallw(1016);
        while ((int)(__hip_atomic_load(c, __ATOMIC_RELAXED, __HIP_MEMORY_SCOPE_WORKGROUP) - tgt) < 0) { } } asm volatile("" ::: "memory"); }
#define LBAR() do { asm volatile("s_waitcnt lgkmcnt(0)" ::: "memory"); (void)hbar(); } while (0)
#define HSYNC() do { asm volatile("s_waitcnt vmcnt(0) lgkmcnt(0)" ::: "memory"); (void)hbar(); } while (0)
DEVI int otid() { int t = threadIdx.x & 255; asm volatile("" : "+v"(t)); return t; }
DEVI unsigned f2bf(float f) { unsigned u = __float_as_uint(f); u += 0x7fffu + ((u >> 16) & 1u); return u >> 16; }
typedef float f32x2 __attribute__((ext_vector_type(2)));
typedef __bf16 bf16x2_t __attribute__((ext_vector_type(2)));
DEVI unsigned pk2(float lo, float hi) { const f32x2 v = {lo, hi}; const bf16x2_t b = __builtin_convertvector(v, bf16x2_t); return __builtin_bit_cast(unsigned, b); }
DEVI f32x4 ld4bf(const bf16_t* p) { const u32x2 w = *(const u32x2*)p; return (f32x4){__uint_as_float(w.x << 16), __uint_as_float(w.x & 0xffff0000u), __uint_as_float(w.y << 16), __uint_as_float(w.y & 0xffff0000u)}; }
DEVI void st4bf(bf16_t* p, f32x4 v) { *(u32x2*)p = (u32x2){pk2(v.x, v.y), pk2(v.z, v.w)}; }
DEVI float ld1bf(const bf16_t* p) { return __uint_as_float((unsigned)(*p) << 16); }
template <int CTRL> DEVI float dpp_mov(float v) { return __int_as_float(__builtin_amdgcn_update_dpp(0, __float_as_int(v), CTRL, 0xF, 0xF, false)); }
template <int CTRL> DEVI int dpp_movi(int v) { return __builtin_amdgcn_update_dpp(0, v, CTRL, 0xF, 0xF, false); }
DEVI float rowsum16_dpp(float v) {
    v += dpp_mov<0xB1>(v);
    v += dpp_mov<0x4E>(v);
    v += dpp_mov<0x141>(v);
    v += dpp_mov<0x140>(v);
    return v;
}
DEVI float wave_sum(float v) {
    v = rowsum16_dpp(v);
    v += __int_as_float(__builtin_amdgcn_update_dpp(0, __float_as_int(v), 0x142, 0xA, 0xF, false));
    v += __int_as_float(__builtin_amdgcn_update_dpp(0, __float_as_int(v), 0x143, 0xC, 0xF, false));
    return __int_as_float(__builtin_amdgcn_readlane(__float_as_int(v), 63));
}
DEVI float sum16(float v) { return rowsum16_dpp(v); }
DEVI float softplusf(float x) { return fmaxf(x, 0.f) + log1pf(__expf(-fabsf(x))); }
DEVI float sigmoidf(float x) { return __builtin_amdgcn_rcpf(1.f + __expf(-x)); }
DEVI float tanh_fast(float x) { return 1.f - 2.f * __builtin_amdgcn_rcpf(__expf(2.f * x) + 1.f); }
DEVI f32x4 zs4(const bf16_t* zrow, int col, const float* mu) { const f32x4 zc = ld4bf(zrow + col), zp = ld4bf(zrow - RWKV_COLS + col); return zc + (zp - zc) * *(const f32x4*)(mu + col); }
DEVI float softplus_fast(float x) { return fmaxf(x, 0.f) + __logf(1.f + __expf(-fabsf(x))); }

constexpr int G5_STAGE = 32768;
DEVI int xf4(int r) { return (0x78 >> (2 * ((r >> 2) & 3))) & 3; }
template <bool SWAP, int MT, class Epi>
DEVI void gemm512(const bf16_t* (&ap)[2], const bf16_t* (&bp)[2], int K, char* lds, Epi&& epi) {
    typedef __attribute__((address_space(3))) unsigned lds_u32;
    constexpr int NA = MT == 8 ? 2 : 1;
    int tid = threadIdx.x; asm volatile("" : "+v"(tid));
    const int lane = tid & 63, wid = __builtin_amdgcn_readfirstlane(tid >> 6), wm = wid >> 2, wn = wid & 3;
    const int l15 = lane & 15, lq = lane >> 4;
    const int gko = ((lane & 3) ^ xf4(lane >> 2)) << 3;
    const int apiece = MT == 8 ? wid : (wid & 3);
    f32x4 acc[MT][4];
#pragma unroll
    for (int i = 0; i < MT; ++i)
#pragma unroll
        for (int j = 0; j < 4; ++j) acc[i][j] = (f32x4){0.f, 0.f, 0.f, 0.f};
    const int nk = K / 32;
#define G5_DMA_A(kt, s, i) __builtin_amdgcn_global_load_lds((const unsigned*)(ap[i] + (kt) * 32 + gko), (lds_u32*)(lds + (s) * G5_STAGE + (apiece + 8 * (i)) * 1024), 16, 0, 0)
#define G5_DMA_B(kt, s, i) __builtin_amdgcn_global_load_lds((const unsigned*)(bp[i] + (kt) * 32 + gko), (lds_u32*)(lds + (s) * G5_STAGE + 16384 + (wid + 8 * (i)) * 1024), 16, 0, 0)
#define G5_MMA(mt) do { _Pragma("unroll") for (int nt = 0; nt < 4; ++nt) { \
        if (SWAP) acc[mt][nt] = __builtin_amdgcn_mfma_f32_16x16x32_bf16(af[mt], bfr[nt], acc[mt][nt], 0, 0, 0); \
        else acc[mt][nt] = __builtin_amdgcn_mfma_f32_16x16x32_bf16(bfr[nt], af[mt], acc[mt][nt], 0, 0, 0); } } while (0)
#pragma unroll
    for (int st = 0; st < 3; ++st) { if (st < nk) {
#pragma unroll
        for (int i = 0; i < NA; ++i) G5_DMA_A(st, st, i);
        G5_DMA_B(st, st, 0); G5_DMA_B(st, st, 1); } }
    const int co = (lq ^ xf4(l15)) << 4;
    const int aoff = (wm * (16 * MT) + l15) * 64 + co, boff = 16384 + (wn * 64 + l15) * 64 + co;
    if (MT == 8) asm volatile("s_waitcnt vmcnt(8)" ::: "memory"); else asm volatile("s_waitcnt vmcnt(6)" ::: "memory");
    __builtin_amdgcn_s_barrier(); asm volatile("" ::: "memory");
    if (wm == 1) { __builtin_amdgcn_s_barrier(); asm volatile("" ::: "memory"); }
    for (int kt = 0; kt < nk; ++kt) {
        const char* base = lds + (kt & 3) * G5_STAGE;
        bf16x8 af[MT], bfr[4];
#pragma unroll
        for (int t = 0; t < 4; ++t) bfr[t] = *(const bf16x8*)(base + boff + t * 1024);
#pragma unroll
        for (int t = 0; t < MT; ++t) af[t] = *(const bf16x8*)(base + aoff + t * 1024);
        if (kt + 3 < nk) { const int s3 = (kt + 3) & 3;
#pragma unroll
            for (int i = 0; i < NA; ++i) G5_DMA_A(kt + 3, s3, i);
            G5_DMA_B(kt + 3, s3, 0); G5_DMA_B(kt + 3, s3, 1); }
        { const int yng = nk - 2 - kt;
          if (yng >= 2) { if (MT == 8) asm volatile("s_waitcnt vmcnt(8)" ::: "memory"); else asm volatile("s_waitcnt vmcnt(6)" ::: "memory"); }
          else if (yng == 1) { if (MT == 8) asm volatile("s_waitcnt vmcnt(4)" ::: "memory"); else asm volatile("s_waitcnt vmcnt(3)" ::: "memory"); }
          else asm volatile("s_waitcnt vmcnt(0)" ::: "memory"); }
        asm volatile("s_waitcnt lgkmcnt(0)" ::: "memory");
        __builtin_amdgcn_s_barrier(); asm volatile("" ::: "memory");
        __builtin_amdgcn_sched_barrier(0); __builtin_amdgcn_s_setprio(1);
#pragma unroll
        for (int mt = 0; mt < MT; ++mt) G5_MMA(mt);
        __builtin_amdgcn_s_setprio(0); __builtin_amdgcn_sched_barrier(0);
        __builtin_amdgcn_s_barrier(); asm volatile("" ::: "memory");
    }
    if (wm == 0) { __builtin_amdgcn_s_barrier(); asm volatile("" ::: "memory"); }
#undef G5_DMA_A
#undef G5_DMA_B
#undef G5_MMA
    __builtin_amdgcn_s_barrier(); asm volatile("" ::: "memory");
    epi(acc, wm, wn, l15, lq);
}

DEVI int g8_lds_byte(int r, int c) { const int st = (r >> 4) * 2 + (c >> 5), rr = r & 15, cc = c & 31, ob = rr * 64 + cc * 2; return st * 1024 + (ob ^ (((ob >> 9) & 1) << 5)); }
template <bool SWAP, class Epi>
DEVI void gemm8p(const char* abase, const unsigned (&aob)[4], const char* bbase, unsigned bob0, int K, char* lds, Epi&& epi) {
    typedef __attribute__((address_space(3))) unsigned lds_u32;
    constexpr int HTB = 16384;
    int tid = threadIdx.x; asm volatile("" : "+v"(tid));
    const int lane = tid & 63, wid = __builtin_amdgcn_readfirstlane(tid >> 6), wr = wid >> 2, wc = wid & 3, fr = lane & 15, fq = lane >> 4;
    f32x4 acc[8][4];
#pragma unroll
    for (int i = 0; i < 8; ++i)
#pragma unroll
        for (int j = 0; j < 4; ++j) acc[i][j] = (f32x4){0.f, 0.f, 0.f, 0.f};
    bf16x8 At[4][2], B0[2][2], B1[2][2];
    const int nt = K / 64;
#define G8_SA(b, h) (lds + ((b) * 2 + (h)) * HTB)
#define G8_SB(b, h) (lds + (4 + (b) * 2 + (h)) * HTB)
#define G8_STA(b, h, kt) do { _Pragma("unroll") for (int i_ = 0; i_ < 2; ++i_) \
        __builtin_amdgcn_global_load_lds((const unsigned*)(abase + (size_t)(aob[2 * (h) + i_] + (unsigned)(kt) * 128u)), (lds_u32*)(G8_SA(b, h) + wid * 1024 + i_ * 8192), 16, 0, 0); } while (0)
#define G8_STB(b, h, kt) do { _Pragma("unroll") for (int i_ = 0; i_ < 2; ++i_) \
        __builtin_amdgcn_global_load_lds((const unsigned*)(bbase + (size_t)(bob0 + (unsigned)((i_ * 128 + (h) * 32) * 2048) + (unsigned)(kt) * 128u)), (lds_u32*)(G8_SB(b, h) + wid * 1024 + i_ * 8192), 16, 0, 0); } while (0)
#define G8_LDA(b, h) do { _Pragma("unroll") for (int m = 0; m < 4; ++m) _Pragma("unroll") for (int k = 0; k < 2; ++k) \
        At[m][k] = *(const bf16x8*)(G8_SA(b, h) + g8_lds_byte(wr * 64 + m * 16 + fr, k * 32 + fq * 8)); } while (0)
#define G8_LDB(dst, b, h) do { _Pragma("unroll") for (int n = 0; n < 2; ++n) _Pragma("unroll") for (int k = 0; k < 2; ++k) \
        dst[n][k] = *(const bf16x8*)(G8_SB(b, h) + g8_lds_byte(wc * 32 + n * 16 + fr, k * 32 + fq * 8)); } while (0)
#define G8_MMA(ai, bj, Bt) do { __builtin_amdgcn_s_setprio(1); \
        _Pragma("unroll") for (int m = 0; m < 4; ++m) _Pragma("unroll") for (int n = 0; n < 2; ++n) _Pragma("unroll") for (int k = 0; k < 2; ++k) { \
            if (SWAP) acc[4 * (ai) + m][2 * (bj) + n] = __builtin_amdgcn_mfma_f32_16x16x32_bf16(At[m][k], Bt[n][k], acc[4 * (ai) + m][2 * (bj) + n], 0, 0, 0); \
            else acc[4 * (ai) + m][2 * (bj) + n] = __builtin_amdgcn_mfma_f32_16x16x32_bf16(Bt[n][k], At[m][k], acc[4 * (ai) + m][2 * (bj) + n], 0, 0, 0); } \
        __builtin_amdgcn_s_setprio(0); } while (0)
#define G8_WV(n) asm volatile("s_waitcnt vmcnt(" #n ")" ::: "memory")
#define G8_WL(n) asm volatile("s_waitcnt lgkmcnt(" #n ")" ::: "memory")
#define G8_BAR __builtin_amdgcn_s_barrier()
#define G8_SCHED __builtin_amdgcn_sched_barrier(0)
    G8_STB(0, 0, 0); G8_STA(0, 0, 0); G8_STB(0, 1, 0); G8_STA(0, 1, 0);
    if (wr == 1) G8_BAR;
    G8_WV(4); G8_BAR;
    G8_STB(1, 0, 1); G8_STA(1, 0, 1); G8_STB(1, 1, 1);
    G8_WV(6); G8_BAR;
    for (int t = 0; t < nt - 2; t += 2) {
        G8_LDB(B0, 0, 0); G8_SCHED; G8_LDA(0, 0); G8_STA(1, 1, t + 1);
        G8_WL(8); G8_BAR; G8_WL(0); G8_MMA(0, 0, B0); G8_BAR; G8_SCHED;
        G8_LDB(B1, 0, 1); G8_STB(0, 0, t + 2);
        G8_BAR; G8_WL(0); G8_MMA(0, 1, B1); G8_BAR;
        G8_LDA(0, 1); G8_STA(0, 0, t + 2);
        G8_BAR; G8_WL(0); G8_MMA(1, 0, B0); G8_BAR; G8_SCHED;
        G8_STB(0, 1, t + 2);
        G8_WV(6); G8_BAR; G8_MMA(1, 1, B1); G8_BAR;
        G8_LDB(B0, 1, 0); G8_SCHED; G8_LDA(1, 0); G8_STA(0, 1, t + 2);
        G8_WL(8); G8_BAR; G8_WL(0); G8_MMA(0, 0, B0); G8_BAR; G8_SCHED;
        G8_LDB(B1, 1, 1); G8_STB(1, 0, t + 3);
        G8_BAR; G8_WL(0); G8_MMA(0, 1, B1); G8_BAR;
        G8_LDA(1, 1); G8_STA(1, 0, t + 3);
        G8_BAR; G8_WL(0); G8_MMA(1, 0, B0); G8_BAR; G8_SCHED;
        G8_STB(1, 1, t + 3);
        G8_WV(6); G8_BAR; G8_MMA(1, 1, B1); G8_BAR;
    }
    { G8_LDB(B0, 0, 0); G8_LDA(0, 0); G8_STA(1, 1, nt - 1);
      G8_BAR; G8_WL(0); G8_MMA(0, 0, B0); G8_BAR;
      G8_LDB(B1, 0, 1); G8_BAR; G8_WL(0); G8_MMA(0, 1, B1); G8_BAR;
      G8_LDA(0, 1); G8_WV(4); G8_BAR; G8_WL(0); G8_MMA(1, 0, B0); G8_MMA(1, 1, B1); G8_BAR; }
    { G8_LDB(B0, 1, 0); G8_LDA(1, 0); G8_WV(2); G8_BAR; G8_WL(0); G8_MMA(0, 0, B0); G8_BAR;
      G8_LDB(B1, 1, 1); G8_WV(0); G8_BAR; G8_WL(0); G8_MMA(0, 1, B1); G8_BAR;
      G8_LDA(1, 1); G8_BAR; G8_WL(0); G8_MMA(1, 0, B0); G8_MMA(1, 1, B1); G8_BAR; }
    if (wr == 0) G8_BAR;
    G8_BAR; asm volatile("" ::: "memory");
#undef G8_SA
#undef G8_SB
#undef G8_STA
#undef G8_STB
#undef G8_LDA
#undef G8_LDB
#undef G8_MMA
#undef G8_WV
#undef G8_WL
#undef G8_BAR
#undef G8_SCHED
    epi(acc, wr, wc, fr, fq);
}
DEVI int g8_arow(int tid, int h, int i) { const int r0 = ((tid >> 7) * 16) + ((tid & 63) >> 2); return i * 128 + h * 64 + r0; }
DEVI unsigned g8_c0b(int tid) { const int lane = tid & 63; return (unsigned)((((tid >> 6) & 1) * 32 + (((lane & 3) * 8) ^ ((lane >> 5) * 16))) * 2); }
DEVI unsigned g8_bob0(int tid) { const int r0 = ((tid >> 7) * 16) + ((tid & 63) >> 2); return (unsigned)(((r0 >> 5) * 64 + (r0 & 31)) * 2048) + g8_c0b(tid); }

DEVI int srccol(int kind, int n) {
    if (kind == 0) return n;
    if (kind == 1) { if (n < 1536) return n; if (n < 3328) return n + 8; if (n < 3336) return 1536 + (n - 3328); return -1; }
    const int T = n >> 5, w = n & 31;
    return w < 16 ? T * 16 + w : 1024 + T * 16 + (w - 16);
}
DEVI void conv_tile(const float* src, int K, int NS, bf16_t* dst, int kind, int kt, int nt, float* scr  ) {
    const int tid = otid();
    const int nl = tid & 63, n = nt * 64 + nl, sc = srccol(kind, n);
    float v[16];
#pragma unroll
    for (int i = 0; i < 16; ++i) { const int k = i * 4 + (tid >> 6); v[i] = sc >= 0 ? src[(size_t)(kt * 64 + k) * NS + sc] : 0.f; }
#pragma unroll
    for (int i = 0; i < 16; ++i) { const int k = i * 4 + (tid >> 6); scr[k * 65 + nl] = v[i]; }
    LBAR();
    const int on = tid >> 2, kc = (tid & 3) * 16;
    u32x4 o0, o1;
    const float* s = scr + kc * 65 + on;
    o0.x = pk2(s[0 * 65], s[1 * 65]); o0.y = pk2(s[2 * 65], s[3 * 65]); o0.z = pk2(s[4 * 65], s[5 * 65]); o0.w = pk2(s[6 * 65], s[7 * 65]);
    o1.x = pk2(s[8 * 65], s[9 * 65]); o1.y = pk2(s[10 * 65], s[11 * 65]); o1.z = pk2(s[12 * 65], s[13 * 65]); o1.w = pk2(s[14 * 65], s[15 * 65]);
    bf16_t* d = dst + (size_t)(nt * 64 + on) * K + kt * 64 + kc;
    *(u32x4*)d = o0; *(u32x4*)(d + 8) = o1;
    LBAR();
}
DEVI void phase0(const P& p, int bid, int nb, char* lds) {
    const int tid = otid(), lane = tid & 63, wid = tid >> 6;
    {
        bf16_t* H0B = WSP(bf16_t, WS_H0B);
        auto srcof = [&](int row) __attribute__((always_inline)) -> const float* {
            if (row >= NP) return nullptr;
            const int b = row / LP, pp = row % LP; if (pp < PADL) return nullptr;
            const int t = pp - PADL;
            return t < NMETA ? p.meta + (size_t)t * 1024 : p.x + ((size_t)b * SEQ + (t - NMETA)) * 1024;
        };
        f32x4 vn[4];
        { const float* s0 = srcof(bid * 4 + wid); if (s0) {
#pragma unroll
            for (int j = 0; j < 4; ++j) vn[j] = ((const f32x4*)s0)[lane + 64 * j]; } }
        for (int row = bid * 4 + wid; row < NP; row += nb * 4) {
            const bool padrow = (row % LP) < PADL;
            u32x2* hb = (u32x2*)(H0B + (size_t)row * 1024) + lane;
            f32x4 v[4];
#pragma unroll
            for (int j = 0; j < 4; ++j) v[j] = vn[j];
            { const float* s1 = srcof(row + nb * 4); if (s1) {
#pragma unroll
                for (int j = 0; j < 4; ++j) vn[j] = ((const f32x4*)s1)[lane + 64 * j]; } }
            if (padrow) {
#pragma unroll
                for (int j = 0; j < 4; ++j) hb[64 * j] = (u32x2){0u, 0u};
                continue;
            }
            float s = 0.f;
#pragma unroll
            for (int j = 0; j < 4; ++j) s += (v[j].x + v[j].y) + (v[j].z + v[j].w);
            const float mean = wave_sum(s) * (1.f / 1024.f); float s2 = 0.f;
#pragma unroll
            for (int j = 0; j < 4; ++j) { v[j] = v[j] - mean; s2 += (v[j].x * v[j].x + v[j].y * v[j].y) + (v[j].z * v[j].z + v[j].w * v[j].w); }
            const float rstd = rsqrtf(wave_sum(s2) * (1.f / 1024.f) + LN_EPS);
#pragma unroll
            for (int j = 0; j < 4; ++j) {
                const f32x4 g = ((const f32x4*)p.ln0_g)[lane + 64 * j], bb = ((const f32x4*)p.ln0_b)[lane + 64 * j];
                const f32x4 o = v[j] * rstd * g + bb;
                hb[64 * j] = (u32x2){pk2(o.x, o.y), pk2(o.z, o.w)};
            }
        }
    }
    {
        float* scr = (float*)lds;
        constexpr int T_IN = 16 * 54, T_OUT = 16 * 16, T_W2 = 8, T_A2 = 8, T_G2 = 16;
        constexpr int TOT = T_IN + T_OUT + T_W2 + T_A2 + T_G2;
        for (int it = bid; it < TOT; it += nb) {
            int r = it;
            if (r < T_IN) { conv_tile(p.w_in, 1024, IN_COLS, WSP(bf16_t, WS_WINT), 1, r / 54, r % 54, scr); continue; } r -= T_IN;
            if (r < T_OUT) { conv_tile(p.w_out, 1024, 1024, WSP(bf16_t, WS_WOUTT), 0, r / 16, r % 16, scr); continue; } r -= T_OUT;
            if (r < T_W2) { conv_tile(p.w2, 64, 512, WSP(bf16_t, WS_W2T), 0, 0, r, scr); continue; } r -= T_W2;
            if (r < T_A2) { conv_tile(p.a2, 64, 512, WSP(bf16_t, WS_A2T), 0, 0, r, scr); continue; } r -= T_A2;
            conv_tile(p.g2, 128, 512, WSP(bf16_t, WS_G2T), 0, r / 8, r % 8, scr);
        }
    }
}
DEVI void conv_wide(const float* src, int NS, bf16_t* dst, int kind, int kt, int nt, float* scr) {
    const int tid = otid(), kq = tid >> 6, n4 = tid & 63;
    const int sc = srccol(kind, nt * 256 + 4 * n4);
    const float* sp = src + (size_t)(kt * 64 + kq) * NS + sc;
    f32x4 v[16];
#pragma unroll
    for (int i = 0; i < 16; ++i) v[i] = *(const f32x4*)(sp + (size_t)(4 * i) * NS);
#pragma unroll
    for (int i = 0; i < 16; ++i) { const int k = 4 * i + kq; *(f32x4*)(scr + k * 260 + ((4 * n4 + 4 * (k >> 3)) & 255)) = v[i]; }
    LBAR();
    const int ch = tid & 7, r0 = tid >> 3;
#pragma unroll
    for (int j = 0; j < 8; ++j) { const int row = j * 32 + r0; const float* s = scr + (8 * ch) * 260 + ((row + 4 * ch) & 255);
        *(u32x4*)(dst + (size_t)(nt * 256 + row) * 1024 + kt * 64 + 8 * ch) = (u32x4){pk2(s[0], s[260]), pk2(s[2 * 260], s[3 * 260]), pk2(s[4 * 260], s[5 * 260]), pk2(s[6 * 260], s[7 * 260])}; }
    LBAR();
}
constexpr int CONV_TILES = 12, N_CONV_ITEMS = (32 * 16 * 8 + 32 * 16 * 4) / CONV_TILES;
static_assert(2 * N_CONV_ITEMS <= 16 * (NQB - 1), "interleave pattern needs 2 attention items per conversion item");
DEVI void conv_moe_item(const P& p, int item, char* lds) {
    float* scr = (float*)lds;
    for (int t = 0; t < CONV_TILES; ++t) {
        int r = item * CONV_TILES + t;
        if (r < 32 * 128) { const int e = r / 128, q = r % 128; conv_wide(p.w_gu + (size_t)e * 1024 * 2048, 2048, WSP(bf16_t, WS_WGUT) + (size_t)e * 2048 * 1024, 2, q / 8, q % 8, scr); }
        else { r -= 32 * 128; const int e = r / 64, q = r % 64; conv_wide(p.w_down + (size_t)e * 1024 * 1024, 1024, WSP(bf16_t, WS_WDT) + (size_t)e * 1024 * 1024, 0, q / 4, q % 4, scr); }
    }
}

struct Sched { int x, rank, nloc, nxcd; };
template <class F> DEVI void for_xcd_items(const Sched& sc, F&& f) {
    const int x0 = sc.nxcd == 8 ? sc.x : 0, x1 = sc.nxcd == 8 ? sc.x + 1 : 8;
    for (int x = x0; x < x1; ++x) f(x, sc.rank, sc.nloc);
}

DEVI void stage_out64(char* lds, int wid, int lane, bf16_t* dst  , size_t ld) {
    const char* st = lds + wid * 18432;
    asm volatile("s_waitcnt lgkmcnt(0)" ::: "memory");
#pragma unroll
    for (int i = 0; i < 16; ++i) { const int r = 8 * i + (lane >> 3), ch = lane & 7; *(u32x4*)(dst + (size_t)r * ld + ch * 8) = *(const u32x4*)(st + r * 144 + ch * 16); }
    RBAR();
}
struct EpiInProj {
    const P& p; int tm, tn2; char* lds;
    DEVI void operator()(f32x4 (&acc)[8][4], int wm, int wn4, int l15, int lq) const {
        const int tn = 2 * tn2 + (wn4 >> 1), wn = wn4 & 1;
        if (tn < 8) {
            bf16_t* dst = tn < 4 ? WSP(bf16_t, WS_QB) : WSP(bf16_t, WS_KB); const float sc = tn < 4 ? QSCALE : 1.f;
            const int wid = wm * 4 + wn4; char* st = lds + wid * 18432;
            float mx = 0.f;
#pragma unroll
            for (int mt = 0; mt < 8; ++mt) { float ssq = 0.f;
#pragma unroll
                for (int nt = 0; nt < 4; ++nt) { const f32x4 a = acc[mt][nt] * sc; ssq += (a.x * a.x + a.y * a.y) + (a.z * a.z + a.w * a.w); *(u32x2*)(st + (mt * 16 + l15) * 144 + (nt * 16 + 4 * lq) * 2) = (u32x2){pk2(a.x, a.y), pk2(a.z, a.w)}; }
                ssq += __shfl_xor(ssq, 16); ssq += __shfl_xor(ssq, 32); mx = fmaxf(mx, ssq); }
            stage_out64(lds, wid, l15 + 16 * lq, dst + ((size_t)tm * 256 + wm * 128) * 512 + (tn & 3) * 128 + wn * 64, 512);
            mx = fmaxf(mx, dpp_mov<0xB1>(mx)); mx = fmaxf(mx, dpp_mov<0x4E>(mx)); mx = fmaxf(mx, dpp_mov<0x141>(mx)); mx = fmaxf(mx, dpp_mov<0x140>(mx));
            if ((threadIdx.x & 63) == 0) atomicMax(WSP(unsigned, WS_CTL) + CW_QK2 + (tn < 4 ? 0 : 8) + 2 * (tn & 3) + wn, __float_as_uint(mx));
        } else if (tn < 12) {
            bf16_t* VT = WSP(bf16_t, WS_VT); const int row0 = tm * 256 + wm * 128;
#pragma unroll
            for (int mt = 0; mt < 8; ++mt) { const int row = row0 + mt * 16 + 4 * lq, b = row / LP, pp = row % LP;
#pragma unroll
                for (int nt = 0; nt < 4; ++nt) { const int n = (tn - 8) * 128 + wn * 64 + nt * 16 + l15; const f32x4 a = acc[mt][nt];
                    *(u32x2*)(VT + (size_t)(b * 512 + n) * LP + pp) = (u32x2){pk2(a.x, a.y), pk2(a.z, a.w)}; } }
        } else if (tn < 26) {
            bf16_t* ZR = WSP(bf16_t, WS_ZR); const int wid = wm * 4 + wn4; char* st = lds + wid * 18432;
#pragma unroll
            for (int mt = 0; mt < 8; ++mt)
#pragma unroll
                for (int nt = 0; nt < 4; ++nt) { const f32x4 a = acc[mt][nt]; *(u32x2*)(st + (mt * 16 + l15) * 144 + (nt * 16 + 4 * lq) * 2) = (u32x2){pk2(a.x, a.y), pk2(a.z, a.w)}; }
            stage_out64(lds, wid, l15 + 16 * lq, ZR + ((size_t)tm * 256 + wm * 128) * RWKV_COLS + (tn - 12) * 128 + wn * 64, RWKV_COLS);
        } else {
            if (tn == 26 && wn == 0 && lq < 2) { float* LF = WSP(float, WS_LF);
#pragma unroll
                for (int mt = 0; mt < 8; ++mt) { const int row = tm * 256 + wm * 128 + mt * 16 + l15; const bool pad = (row % LP) < PADL; f32x4 o;
#pragma unroll
                    for (int r = 0; r < 4; ++r) { const float xv = acc[mt][0][r] + p.b_fgate[4 * lq + r]; o[r] = pad ? 0.f : -softplusf(-xv); }
                    *(f32x4*)(LF + (size_t)row * 8 + 4 * lq) = o; } }
        }
    }
};
DEVI void phase1(const P& p, const Sched& sc, char* lds) {
    int tid = threadIdx.x; asm volatile("" : "+v"(tid));
    const int srow_ = 16 * (tid >> 6) + ((tid & 63) >> 2);
    for_xcd_items(sc, [&](int x, int rank, int nloc) __attribute__((always_inline)) {
        const int r0 = 65 * x / 8, nr = 65 * (x + 1) / 8 - r0;
        for (int i = rank; i < nr * 14; i += nloc) {
            const int tn = i / nr, tm = r0 + i % nr;
            unsigned aob[4];
            int tq = threadIdx.x; asm volatile("" : "+v"(tq));
#pragma unroll
            for (int q = 0; q < 4; ++q) aob[q] = (unsigned)((tm * 256 + g8_arow(tq, q >> 1, q & 1)) * 2048) + g8_c0b(tq);
            const char* abase = (const char*)WSP(bf16_t, WS_H0B); const char* bbase = (const char*)(WSP(bf16_t, WS_WINT) + (size_t)tn * 256 * 1024);
            if (tn == 4 || tn == 5) gemm8p<true>(abase, aob, bbase, g8_bob0(tq), 1024, lds, EpiInProj{p, tm, tn, lds});
            else gemm8p<false>(abase, aob, bbase, g8_bob0(tq), 1024, lds, EpiInProj{p, tm, tn, lds});
        }
    });
}

DEVI float vadd1(float a, float b) { float r; asm("v_add_f32 %0, %1, %2" : "=v"(r) : "v"(a), "v"(b)); return r; }
DEVI float vsub1(float a, float b) { float r; asm("v_sub_f32 %0, %1, %2" : "=v"(r) : "v"(a), "v"(b)); return r; }
DEVI int pi_swap(int i) { return (i & ~12) | ((i & 4) << 1) | ((i & 8) >> 1); }
DEVI void attn_item(const P& p, int b, int h, int qb, char* lds) {
    int tid = threadIdx.x; asm volatile("" : "+v"(tid));
    const int lane = tid & 63, ql = lane & 31, hi = lane >> 5;
    const int w8 = __builtin_amdgcn_readfirstlane(tid >> 6), grp = w8 >> 2, wu = w8 & 3;
    const int q_pp = qb * 128 + wu * 32 + ql; const size_t qrow = (size_t)b * LP + q_pp;
    const bf16_t* QB = WSP(bf16_t, WS_QB); const bf16_t* KB = WSP(bf16_t, WS_KB); const bf16_t* VT = WSP(bf16_t, WS_VT); const float* CS = WSP(float, WS_CS);
    bf16x8 qf[4];
#pragma unroll
    for (int d0 = 0; d0 < 4; ++d0) qf[d0] = *(const bf16x8*)(QB + qrow * 512 + h * 64 + 16 * d0 + 8 * hi);
    const float* CSh = CS + (size_t)(b * 8 + h) * LP;
    const float cref = CSh[qb * 128];
    const int nkt = 2 * qb + 1;
    int kstart = 1; float qkmax;
    {
        const unsigned* qk2 = WSP(unsigned, WS_CTL) + CW_QK2;
        qkmax = 1.02f * sqrtf(__uint_as_float(qk2[h]) * __uint_as_float(qk2[8 + h]));
        const float bnd = 64.f + 2.f * qkmax;
        int cnt = 0;
#pragma unroll
        for (int i = 0; i < 3; ++i) { const int kt = lane + 1 + 64 * i; bool skip = false;
            if (kt <= nkt) skip = CSh[64 * kt + 63] - cref > bnd;
            cnt += __popcll(__ballot(skip)); }
        kstart = 1 + __builtin_amdgcn_readfirstlane(cnt);
        if (kstart > 2 * qb) kstart = 2 * qb;
    }
    typedef __attribute__((address_space(3))) unsigned lds_u32;
    constexpr int ABUF = 33280;
    auto dma = [&](int st, int bsel) __attribute__((always_inline)) {
        char* bs = lds + bsel * ABUF;
#pragma unroll
        for (int i = 0; i < 2; ++i) { const int pi = w8 + 8 * i;
            { const int R = 8 * pi + (lane >> 3), pc = lane & 7;
              __builtin_amdgcn_global_load_lds((const unsigned*)(KB + ((size_t)b * LP + 128 * st + R) * 512 + h * 64 + ((pc ^ ((R >> 1) & 7)) << 3)), (lds_u32*)(bs + pi * 1024), 16, 0, 0); }
            { const int R = 4 * pi + (lane >> 4), sl = lane & 15;
              __builtin_amdgcn_global_load_lds((const unsigned*)(VT + (size_t)(b * 512 + h * 64 + R) * LP + 128 * st + ((sl ^ (R & 15)) << 3)), (lds_u32*)(bs + 16384 + pi * 1024), 16, 0, 0); } }
        __builtin_amdgcn_global_load_lds((const unsigned*)(CSh + 128 * st + 64 * (w8 & 1) + lane), (lds_u32*)(bs + 32768 + (w8 & 1) * 256), 4, 0, 0);
    };
    const float negm = CSh[q_pp] - fminf(qkmax, 60.f);
    float l = 0.f; f32x16 o[2];
#pragma unroll
    for (int r = 0; r < 16; ++r) { o[0][r] = 0.f; o[1][r] = 0.f; }
    const int krow0 = pi_swap(ql);
    const int koff = krow0 * 128 + grp * 8192, ksw = (krow0 >> 1) & 7;
    const int vsw = ql & 15;
    const int voff = 16384 + ql * 256 + (((vsw >> 3) ^ grp) << 7);
    const int lim = qb * 128 + wu * 32 + 31;
    const int st0 = kstart >> 1;
#pragma unroll
    for (int j = 0; j < 3; ++j) if (st0 + j <= qb) dma(st0 + j, j);
#define SB() __builtin_amdgcn_sched_barrier(0)
    for (int st = st0; st <= qb; ++st) {
        const int bi = (st - st0) & 3; const char* bs0 = lds + bi * ABUF;
        { const int rem = qb - st;
          if (rem >= 2) asm volatile("s_waitcnt vmcnt(10)" ::: "memory"); else if (rem == 1) asm volatile("s_waitcnt vmcnt(5)" ::: "memory"); else asm volatile("s_waitcnt vmcnt(0)" ::: "memory"); }
        asm volatile("s_waitcnt lgkmcnt(0)" ::: "memory"); __builtin_amdgcn_s_barrier(); asm volatile("" ::: "memory");
        if (st + 3 <= qb) dma(st + 3, (bi + 3) & 3);
        const int kt = 2 * st + grp;
        if (kt >= kstart && 64 * kt <= lim) {
            bf16x8 kf[2][4], vf[2][2][2]; f32x4 cv[2][4]; f32x16 sc[2];
#pragma unroll
            for (int d0 = 0; d0 < 4; ++d0)
#pragma unroll
                for (int kh = 0; kh < 2; ++kh) kf[kh][d0] = *(const bf16x8*)(bs0 + kh * 4096 + koff + (((2 * d0 + hi) ^ ksw) << 4));
            { const float* csl = (const float*)(bs0 + 32768) + 64 * grp;
#pragma unroll
              for (int kh = 0; kh < 2; ++kh)
#pragma unroll
                for (int g = 0; g < 4; ++g) cv[kh][g] = *(const f32x4*)(csl + 32 * kh + 16 * (g >> 1) + 8 * hi + 4 * (g & 1)); }
            SB();
#pragma unroll
            for (int r = 0; r < 16; ++r) { sc[0][r] = negm; sc[1][r] = negm; }
#pragma unroll
            for (int d0 = 0; d0 < 4; ++d0)
#pragma unroll
                for (int kh = 0; kh < 2; ++kh) sc[kh] = __builtin_amdgcn_mfma_f32_32x32x16_bf16(kf[kh][d0], qf[d0], sc[kh], 0, 0, 0);
#pragma unroll
            for (int kh = 0; kh < 2; ++kh)
#pragma unroll
                for (int s2 = 0; s2 < 2; ++s2)
#pragma unroll
                    for (int dh = 0; dh < 2; ++dh) vf[dh][kh][s2] = *(const bf16x8*)(bs0 + voff + dh * 8192 + (((4 * kh + 2 * s2 + hi) ^ (vsw & 7)) << 4));
            SB();
            f32x2 xv[2][8];
#pragma unroll
            for (int kh = 0; kh < 2; ++kh)
#pragma unroll
                for (int g = 0; g < 4; ++g) {
                    xv[kh][2 * g] = (f32x2){vsub1(sc[kh][4 * g], cv[kh][g].x), vsub1(sc[kh][4 * g + 1], cv[kh][g].y)};
                    xv[kh][2 * g + 1] = (f32x2){vsub1(sc[kh][4 * g + 2], cv[kh][g].z), vsub1(sc[kh][4 * g + 3], cv[kh][g].w)}; }
            if (kt == 1 || kt >= 2 * qb) {
#pragma unroll
                for (int kh = 0; kh < 2; ++kh)
#pragma unroll
                    for (int g = 0; g < 4; ++g) { const int key0 = 32 * kh + 16 * (g >> 1) + 8 * hi + 4 * (g & 1);
#pragma unroll
                        for (int c = 0; c < 4; ++c) { const int kp = 64 * kt + key0 + c; if (kp > q_pp || kp < PADL) xv[kh][2 * g + (c >> 1)][c & 1] = NEGBIG; } }
            }
            bf16x8 pf[2][2]; f32x2 ls2 = (f32x2){0.f, 0.f};
#pragma unroll
            for (int kh = 0; kh < 2; ++kh)
#pragma unroll
                for (int s2 = 0; s2 < 2; ++s2) { u32x4 w;
#pragma unroll
                    for (int j = 0; j < 4; ++j) { const f32x2 d = xv[kh][4 * s2 + j]; f32x2 e; e.x = __builtin_amdgcn_exp2f(d.x); e.y = __builtin_amdgcn_exp2f(d.y); ls2.x = vadd1(ls2.x, e.x); ls2.y = vadd1(ls2.y, e.y); w[j] = pk2(e.x, e.y); }
                    pf[kh][s2] = __builtin_bit_cast(bf16x8, w); }
            l += ls2.x + ls2.y;
            SB();
#pragma unroll
            for (int kh = 0; kh < 2; ++kh)
#pragma unroll
                for (int s2 = 0; s2 < 2; ++s2)
#pragma unroll
                    for (int dh = 0; dh < 2; ++dh) o[dh] = __builtin_amdgcn_mfma_f32_32x32x16_bf16(vf[dh][kh][s2], pf[kh][s2], o[dh], 0, 0, 0);
        }
    }
#undef SB
    l += __shfl_xor(l, 32);
    asm volatile("s_waitcnt lgkmcnt(0)" ::: "memory"); __builtin_amdgcn_s_barrier(); asm volatile("" ::: "memory");
    if (grp == 1) { float* mg = (float*)(lds + wu * 8448) + lane;
#pragma unroll
        for (int r = 0; r < 16; ++r) { mg[r * 64] = o[0][r]; mg[(16 + r) * 64] = o[1][r]; }
        mg[32 * 64] = l; }
    asm volatile("s_waitcnt lgkmcnt(0)" ::: "memory"); __builtin_amdgcn_s_barrier(); asm volatile("" ::: "memory");
    if (grp == 0) {
        const float* mg = (const float*)(lds + wu * 8448) + lane;
        l += mg[32 * 64];
#pragma unroll
        for (int r = 0; r < 16; ++r) { o[0][r] += mg[r * 64]; o[1][r] += mg[(16 + r) * 64]; }
        const float inv = 1.f / l; float ss = 0.f;
#pragma unroll
        for (int r = 0; r < 16; ++r) { o[0][r] *= inv; o[1][r] *= inv; ss += o[0][r] * o[0][r] + o[1][r] * o[1][r]; }
        ss += __shfl_xor(ss, 32);
        const float rs = rsqrtf(ss * (1.f / 64.f) + RMS_EPS);
        bf16_t* MIX = WSP(bf16_t, WS_MIX); const bool padq = q_pp < PADL;
        char* sg = lds + 34816 + wu * 4608;
#pragma unroll
        for (int dh = 0; dh < 2; ++dh)
#pragma unroll
            for (int g = 0; g < 4; ++g) { const int d = 32 * dh + 8 * g + 4 * hi; const f32x4 gn = *(const f32x4*)(p.fox_norm_g + h * 64 + d);
                float v0 = o[dh][4 * g] * rs * gn.x, v1 = o[dh][4 * g + 1] * rs * gn.y, v2 = o[dh][4 * g + 2] * rs * gn.z, v3 = o[dh][4 * g + 3] * rs * gn.w;
                if (padq) { v0 = v1 = v2 = v3 = 0.f; }
                *(u32x2*)(sg + ql * 144 + d * 2) = (u32x2){pk2(v0, v1), pk2(v2, v3)}; }
        asm volatile("s_waitcnt lgkmcnt(0)" ::: "memory");
        { bf16_t* dst = MIX + ((size_t)b * LP + qb * 128 + wu * 32) * 1024 + h * 64;
#pragma unroll
          for (int i = 0; i < 4; ++i) { const int r = 8 * i + (lane >> 3), ch = lane & 7; *(u32x4*)(dst + (size_t)r * 1024 + ch * 8) = *(const u32x4*)(sg + r * 144 + ch * 16); } }
    }
    __syncthreads();
}

constexpr int NCHUNK = 129;
constexpr int CHUNK_BYTES = 32768;
constexpr int C_XL = 32768, C_LG = 50176, C_PART = 67584, C_END = 68608;
DEVI int swz(int row, int chunk) { return row * 128 + ((chunk ^ ((row >> 1) & 7)) << 4); }
DEVI int crow(int r, int h) { return (r & 3) + 8 * (r >> 2) + 4 * h; }
DEVI bf16x8 frag(const char* base, int row, int ks, int h) { return *(const bf16x8*)(base + swz(row, 2 * ks + h)); }
#define FBAR() do { if constexpr (RB) { RBAR(); } else { ++fbs; fb_arrive(fbs); fb_wait(fbs); } } while (0)
template <bool RB>
DEVI void chunk_job(const P& p, int job, char* lds, int s2mode = 0) {
    int tid_ = threadIdx.x & 255; asm volatile("" : "+v"(tid_));
    unsigned fbs = fb_init();
    const int tid = tid_, lane = tid & 63, wid = tid >> 6, l31 = lane & 31, h = lane >> 5, rb = wid >> 1, cb = wid & 1;
    const int bh = job / NCHUNK, c = job % NCHUNK, b = bh >> 3, hh = bh & 7;
    const size_t row0 = (size_t)b * LP + 64 + 64 * c; const int col0 = hh * 64;
    const bf16_t* BB = WSP(bf16_t, WS_RB) + row0 * 512 + col0; const bf16_t* K2 = WSP(bf16_t, WS_RK2) + row0 * 512 + col0;
    const bf16_t* ZRb = WSP(bf16_t, WS_ZR) + row0 * RWKV_COLS;
    float* LgG = WSP(float, WS_LGS) + (size_t)(blockIdx.x * 2 + half_id()) * 20480;
    char* chk = (char*)p.ws + WS_CHK + (size_t)job * CHUNK_BYTES;
    char* R1 = lds; float* XL = (float*)(lds + C_XL); float* Lg = (float*)(lds + C_LG); float* part = (float*)(lds + C_PART);
    if (s2mode == 2) {
        typedef __attribute__((address_space(3))) unsigned lds_u32;
        const char* g = (const char*)(LgG + 12288) + (tid >> 6) * 8192 + (tid & 63) * 16;
#pragma unroll
        for (int i = 0; i < 8; ++i) __builtin_amdgcn_global_load_lds((const unsigned*)(g + i * 1024), (lds_u32*)(R1 + (tid >> 6) * 8192 + i * 1024), 16, 0, 0);
        asm volatile("s_waitcnt vmcnt(0)" ::: "memory");
    } else
    {
        const int t = tid >> 2, q = tid & 3; const bf16_t* zrow = ZRb + (size_t)t * RWKV_COLS;
#pragma unroll 4
        for (int i = 0; i < 16; ++i) { const int c = 16 * i + 4 * q;
            f32x4 z = zs4(zrow, 1536 + c, p.rwkv_mu);
            if (i < 4) z = (f32x4){tanh_fast(z.x), tanh_fast(z.y), tanh_fast(z.z), tanh_fast(z.w)};
            else if (i >= 8) z = (f32x4){sigmoidf(z.x), sigmoidf(z.y), sigmoidf(z.z), sigmoidf(z.w)};
            *(u32x2*)(R1 + (i >> 2) * 8192 + swz(t, (c & 63) >> 3) + (c & 7) * 2) = (u32x2){pk2(z.x, z.y), pk2(z.z, z.w)}; }
    }
    FBAR();
    if (s2mode == 1) {
        char* g = (char*)(LgG + 12288) + tid * 16;
#pragma unroll
        for (int i = 0; i < 8; ++i) *(u32x4*)(g + i * 4096) = *(const u32x4*)(R1 + tid * 16 + i * 4096);
    }
    {
        const bf16_t* W2T = WSP(bf16_t, WS_W2T) + (size_t)(col0 + 32 * cb + l31) * 64 + 8 * h; const bf16_t* A2T = WSP(bf16_t, WS_A2T) + (size_t)(col0 + 32 * cb + l31) * 64 + 8 * h;
        const bf16_t* G2T = WSP(bf16_t, WS_G2T) + (size_t)(col0 + 32 * cb + l31) * 128 + 8 * h;
        f32x16 dw, da, dg;
#pragma unroll
        for (int r = 0; r < 16; ++r) { dw[r] = 0.f; da[r] = 0.f; dg[r] = 0.f; }
#pragma unroll
        for (int ks = 0; ks < 4; ++ks) {
            dw = __builtin_amdgcn_mfma_f32_32x32x16_bf16(frag(R1, 32 * rb + l31, ks, h), *(const bf16x8*)(W2T + 16 * ks), dw, 0, 0, 0);
            da = __builtin_amdgcn_mfma_f32_32x32x16_bf16(frag(R1 + 8192, 32 * rb + l31, ks, h), *(const bf16x8*)(A2T + 16 * ks), da, 0, 0, 0);
        }
#pragma unroll
        for (int ks = 0; ks < 8; ++ks) dg = __builtin_amdgcn_mfma_f32_32x32x16_bf16(frag(R1 + 16384 + (ks >> 2) * 8192, 32 * rb + l31, ks & 3, h), *(const bf16x8*)(G2T + 16 * ks), dg, 0, 0, 0);
        FBAR();
        const int j = 32 * cb + l31; const float w0v = p.w0[col0 + j], a0v = p.a0[col0 + j]; float* At = (float*)R1;
#pragma unroll
        for (int r = 0; r < 16; ++r) { const int t = 32 * rb + crow(r, h);
            const float wl = -softplus_fast(-(w0v + dw[r])) - 0.5f; Lg[t * 64 + j] = -__expf(wl);
            At[t * 64 + j] = sigmoidf(a0v + da[r]);
            { int tg = t; asm volatile("" : "+v"(tg));
              (WSP(bf16_t, WS_G) + row0 * 512 + col0)[(size_t)tg * 512 + j] = (bf16_t)f2bf(dg[r]); } }
    }
    FBAR();
    {
        const int cq = tid >> 6, cj = tid & 63; float cs[16]; float run = 0.f;
#pragma unroll
        for (int u = 0; u < 16; ++u) { run += Lg[(16 * cq + u) * 64 + cj]; cs[u] = run; }
        part[cq * 64 + cj] = run; FBAR();
        float off = 0.f;
        for (int q = 0; q < cq; ++q) off += part[q * 64 + cj];
#pragma unroll
        for (int u = 0; u < 16; ++u) { Lg[(16 * cq + u) * 64 + cj] = cs[u] + off; LgG[(16 * cq + u) * 64 + cj] = cs[u] + off; }
        FBAR();
    }
    {
        const int t = tid >> 2, jq = (tid & 3) * 4;
        f32x4 av4[4];
#pragma unroll
        for (int e4 = 0; e4 < 4; ++e4) av4[e4] = *(const f32x4*)((const float*)R1 + t * 64 + 16 * e4 + jq);
        FBAR();
        const bf16_t* zrow = ZRb + (size_t)t * RWKV_COLS;
        f32x4 kr4[4], kk4[4], rr4[4], ka4[4]; float ss = 0.f;
        const int tp = t > 0 ? t - 1 : 0; const float pm = t > 0 ? 1.f : 0.f;
#pragma unroll
        for (int e4 = 0; e4 < 4; ++e4) { const int j = 16 * e4 + jq;
            kr4[e4] = zs4(zrow, 512 + col0 + j, p.rwkv_mu); rr4[e4] = zs4(zrow, col0 + j, p.rwkv_mu); ka4[e4] = *(const f32x4*)(p.k_a + col0 + j);
            kk4[e4] = kr4[e4] * *(const f32x4*)(p.k_k + col0 + j);
            ss += (kk4[e4].x * kk4[e4].x + kk4[e4].y * kk4[e4].y) + (kk4[e4].z * kk4[e4].z + kk4[e4].w * kk4[e4].w); }
        ss += dpp_mov<0xB1>(ss); ss += dpp_mov<0x4E>(ss);
        const float kinv = 1.f / fmaxf(sqrtf(ss), 1e-12f);
#pragma unroll
        for (int e4 = 0; e4 < 4; ++e4) {
            const int j = 16 * e4 + jq;
            const f32x4 lg = *(const f32x4*)(Lg + t * 64 + j), lgp = *(const f32x4*)(Lg + tp * 64 + j) * pm;
            const f32x4 kk = kk4[e4] * kinv, kr = kr4[e4], rr = rr4[e4], ka = ka4[e4];
            const f32x4 bb = kk * av4[e4], k2 = kr * (1.f + (av4[e4] - 1.f) * ka);
            st4bf((bf16_t*)BB + (size_t)t * 512 + j, bb); st4bf((bf16_t*)K2 + (size_t)t * 512 + j, k2);
            float at[4], rt[4], bt[4], kt[4];
#pragma unroll
            for (int q = 0; q < 4; ++q) { const float en = __expf(-lg[q]); at[q] = -kk[q] * __expf(lgp[q]); rt[q] = rr[q] * __expf(lg[q]); bt[q] = bb[q] * en; kt[q] = k2[q] * en; }
            const int o = swz(t, j >> 3) + (j & 7) * 2;
            *(u32x2*)(R1 + 0 + o) = (u32x2){pk2(bt[0], bt[1]), pk2(bt[2], bt[3])};
            *(u32x2*)(R1 + 8192 + o) = (u32x2){pk2(kt[0], kt[1]), pk2(kt[2], kt[3])};
            *(u32x2*)(R1 + 16384 + o) = (u32x2){pk2(at[0], at[1]), pk2(at[2], at[3])};
            *(u32x2*)(R1 + 24576 + o) = (u32x2){pk2(rt[0], rt[1]), pk2(rt[2], rt[3])};
#pragma unroll
            for (int q = 0; q < 4; ++q) { XL[(j + q) * 68 + t] = at[q]; LgG[8192 + (j + q) * 64 + t] = rt[q]; }
        }
    }
    FBAR();
    {
        f32x16 tb, tk, qb, hy;
#pragma unroll
        for (int r = 0; r < 16; ++r) { tb[r] = 0.f; tk[r] = 0.f; qb[r] = 0.f; hy[r] = 0.f; }
#pragma unroll
        for (int ks = 0; ks < 4; ++ks) {
            const bf16x8 aB = frag(R1, 32 * rb + l31, ks, h), aK = frag(R1 + 8192, 32 * rb + l31, ks, h), bA = frag(R1 + 16384, 32 * cb + l31, ks, h), bR = frag(R1 + 24576, 32 * cb + l31, ks, h);
            tb = __builtin_amdgcn_mfma_f32_32x32x16_bf16(aB, bA, tb, 0, 0, 0); tk = __builtin_amdgcn_mfma_f32_32x32x16_bf16(aK, bA, tk, 0, 0, 0);
            qb = __builtin_amdgcn_mfma_f32_32x32x16_bf16(aB, bR, qb, 0, 0, 0); hy = __builtin_amdgcn_mfma_f32_32x32x16_bf16(aK, bR, hy, 0, 0, 0);
        }
        const int t = 32 * cb + l31;
#pragma unroll
        for (int r = 0; r < 16; ++r) { const int s = 32 * rb + crow(r, h); if (!(s < t)) { tb[r] = 0.f; tk[r] = 0.f; } if (!(s <= t)) { qb[r] = 0.f; hy[r] = 0.f; } }
        FBAR();
        float* TbT = (float*)R1;
#pragma unroll
        for (int g = 0; g < 4; ++g) { const int s0 = 32 * rb + 8 * g + 4 * h;
            *(f32x4*)(TbT + t * 68 + s0) = (f32x4){tb[4 * g], tb[4 * g + 1], tb[4 * g + 2], tb[4 * g + 3]};
#pragma unroll
            for (int q = 0; q < 4; ++q) XL[(64 + s0 + q) * 68 + t] = tk[4 * g + q];
            *(u32x2*)(R1 + 17408 + swz(t, 4 * rb + g) + 8 * h) = (u32x2){pk2(qb[4 * g], qb[4 * g + 1]), pk2(qb[4 * g + 2], qb[4 * g + 3])};
            *(f32x4*)(LgG + 4096 + ((wid * 4 + g) * 64 + lane) * 4) = (f32x4){hy[4 * g], hy[4 * g + 1], hy[4 * g + 2], hy[4 * g + 3]}; }
    }
    FBAR();
    {
        float* xr = XL + (32 * wid + l31) * 68; const float* TbT = (const float*)R1;
        auto upd = [&](int bi, int c0, const bf16x8 af) __attribute__((always_inline)) {
            const bool valid = c0 + l31 >= 16 * (bi + 1);
            const float* tb = TbT + (c0 + l31) * 68 + 16 * bi + 8 * h;
            const f32x4 b0 = *(const f32x4*)tb, b1 = *(const f32x4*)(tb + 4);
            u32x4 bw = (u32x4){pk2(b0.x, b0.y), pk2(b0.z, b0.w), pk2(b1.x, b1.y), pk2(b1.z, b1.w)};
            if (!valid) bw = (u32x4){0u, 0u, 0u, 0u};
            float* xc = XL + (32 * wid + 4 * h) * 68 + c0 + l31;
            f32x16 cacc;
#pragma unroll
            for (int r = 0; r < 16; ++r) cacc[r] = xc[((r & 3) + 8 * (r >> 2)) * 68];
            cacc = __builtin_amdgcn_mfma_f32_32x32x16_bf16(af, __builtin_bit_cast(bf16x8, bw), cacc, 0, 0, 0);
            if (valid) {
#pragma unroll
                for (int r = 0; r < 16; ++r) xc[((r & 3) + 8 * (r >> 2)) * 68] = cacc[r]; }
        };
#pragma unroll
        for (int bi = 0; bi < 4; ++bi) {
            float y[16];
#pragma unroll
            for (int q = 0; q < 4; ++q) { const f32x4 v = *(const f32x4*)(xr + 16 * bi + 4 * q); y[4 * q] = v.x; y[4 * q + 1] = v.y; y[4 * q + 2] = v.z; y[4 * q + 3] = v.w; }
            const float* td = TbT + (16 * bi) * 68 + 16 * bi;
#pragma unroll
            for (int t = 1; t < 16; ++t) { float a0 = y[t];
#pragma unroll
                for (int u = 0; u < 16; ++u) if (u < t) a0 += y[u] * td[t * 68 + u];
                y[t] = a0; }
            if (h == 0) {
#pragma unroll
                for (int q = 0; q < 4; ++q) *(f32x4*)(xr + 16 * bi + 4 * q) = (f32x4){y[4 * q], y[4 * q + 1], y[4 * q + 2], y[4 * q + 3]};
            }
            if (bi < 3) {
                const u32x4 aw = h ? (u32x4){pk2(y[8], y[9]), pk2(y[10], y[11]), pk2(y[12], y[13]), pk2(y[14], y[15])} : (u32x4){pk2(y[0], y[1]), pk2(y[2], y[3]), pk2(y[4], y[5]), pk2(y[6], y[7])};
                const bf16x8 af = __builtin_bit_cast(bf16x8, aw);
                if (bi == 0) upd(0, 0, af);
                upd(bi, 32, af);
            }
            asm volatile("s_waitcnt lgkmcnt(0)" ::: "memory");
        }
    }
    FBAR();
    {
        const int row = tid >> 1, hf = tid & 1; const float* xr = XL + row * 68 + 32 * hf; char* dst = R1 + (row >> 6) * 8192;
#pragma unroll
        for (int c8 = 0; c8 < 4; ++c8) { const f32x4 a = *(const f32x4*)(xr + 8 * c8), bq = *(const f32x4*)(xr + 8 * c8 + 4);
            *(u32x4*)(dst + swz(row & 63, 4 * hf + c8)) = (u32x4){pk2(a.x, a.y), pk2(a.z, a.w), pk2(bq.x, bq.y), pk2(bq.z, bq.w)}; }
    }
    if constexpr (RB) __syncthreads(); else HSYNC();
    {
        const int t = tid >> 2, jq = (tid & 3) * 4; char* BbT = lds + 32768; char* VT = lds + 40960;
        f32x4 lgA[4], lcA[4], bbA[4], vvA[4];
#pragma unroll
        for (int e4 = 0; e4 < 4; ++e4) { const int j = 16 * e4 + jq;
            lgA[e4] = *(const f32x4*)(LgG + t * 64 + j); lcA[e4] = *(const f32x4*)(LgG + 63 * 64 + j); bbA[e4] = ld4bf(BB + (size_t)t * 512 + j); vvA[e4] = zs4(ZRb + (size_t)t * RWKV_COLS, 1024 + col0 + j, p.rwkv_mu); }
#pragma unroll
        for (int e4 = 0; e4 < 4; ++e4) {
            const int j = 16 * e4 + jq;
            const f32x4 lg = lgA[e4], lc = lcA[e4], bb = bbA[e4], vv = vvA[e4];
#pragma unroll
            for (int q = 0; q < 4; ++q) { const int o2 = swz(j + q, t >> 3) + (t & 7) * 2; *(bf16_t*)(BbT + o2) = (bf16_t)f2bf(bb[q] * __expf(lc[q] - lg[q])); *(bf16_t*)(VT + o2) = (bf16_t)f2bf(vv[q]); }
        }
    }
    FBAR();
    {
        f32x16 gy, gs, hs, hy;
#pragma unroll
        for (int g = 0; g < 4; ++g) { const f32x4 q4 = *(const f32x4*)(LgG + 4096 + ((wid * 4 + g) * 64 + lane) * 4); hy[4 * g] = q4.x; hy[4 * g + 1] = q4.y; hy[4 * g + 2] = q4.z; hy[4 * g + 3] = q4.w; }
        {
            const int tq = 32 * cb + l31;
            const float lcq = LgG[63 * 64 + tq]; const float elc = __expf(lcq);
#pragma unroll
            for (int g = 0; g < 4; ++g) { const int j0 = 32 * rb + 8 * g + 4 * h;
#pragma unroll
                for (int q = 0; q < 4; ++q) { gy[4 * g + q] = LgG[8192 + (j0 + q) * 64 + tq]; gs[4 * g + q] = (j0 + q == tq) ? elc : 0.f;
                    const int s = j0 + q; hs[4 * g + q] = ld1bf(K2 + (size_t)s * 512 + tq) * __expf(lcq - LgG[s * 64 + tq]); } }
        }
#pragma unroll
        for (int ks = 0; ks < 4; ++ks) {
            const bf16x8 aA = frag(R1, 32 * rb + l31, ks, h), aW = frag(R1 + 8192, 32 * rb + l31, ks, h), bQ = frag(R1 + 17408, 32 * cb + l31, ks, h), bB = frag(lds + 32768, 32 * cb + l31, ks, h);
            gy = __builtin_amdgcn_mfma_f32_32x32x16_bf16(aA, bQ, gy, 0, 0, 0); gs = __builtin_amdgcn_mfma_f32_32x32x16_bf16(aA, bB, gs, 0, 0, 0);
            hy = __builtin_amdgcn_mfma_f32_32x32x16_bf16(aW, bQ, hy, 0, 0, 0); hs = __builtin_amdgcn_mfma_f32_32x32x16_bf16(aW, bB, hs, 0, 0, 0);
        }
        const int cc = 32 * cb + l31;
#pragma unroll
        for (int g = 0; g < 4; ++g) { const int r0 = 32 * rb + 8 * g + 4 * h;
            *(u32x2*)(chk + swz(cc, 4 * rb + g) + 8 * h) = (u32x2){pk2(gy[4 * g], gy[4 * g + 1]), pk2(gy[4 * g + 2], gy[4 * g + 3])};
            *(u32x2*)(chk + 8192 + swz(cc, 4 * rb + g) + 8 * h) = (u32x2){pk2(gs[4 * g], gs[4 * g + 1]), pk2(gs[4 * g + 2], gs[4 * g + 3])};
            *(u32x2*)(lds + 49152 + swz(cc, 4 * rb + g) + 8 * h) = (u32x2){pk2(hs[4 * g], hs[4 * g + 1]), pk2(hs[4 * g + 2], hs[4 * g + 3])};
            *(u32x2*)(lds + 57344 + swz(cc, 4 * rb + g) + 8 * h) = (u32x2){pk2(hy[4 * g], hy[4 * g + 1]), pk2(hy[4 * g + 2], hy[4 * g + 3])}; }
    }
    FBAR();
    {
        f32x16 sl, yl;
#pragma unroll
        for (int r = 0; r < 16; ++r) { sl[r] = 0.f; yl[r] = 0.f; }
#pragma unroll
        for (int ks = 0; ks < 4; ++ks) {
            const bf16x8 aS = frag(lds + 49152, 32 * rb + l31, ks, h), aY = frag(lds + 57344, 32 * rb + l31, ks, h), bV = frag(lds + 40960, 32 * cb + l31, ks, h);
            sl = __builtin_amdgcn_mfma_f32_32x32x16_bf16(aS, bV, sl, 0, 0, 0); yl = __builtin_amdgcn_mfma_f32_32x32x16_bf16(aY, bV, yl, 0, 0, 0);
        }
#pragma unroll
        for (int q = 0; q < 2; ++q) {
            *(u32x4*)(chk + 16384 + wid * 2048 + lane * 32 + q * 16) = (u32x4){pk2(sl[8 * q], sl[8 * q + 1]), pk2(sl[8 * q + 2], sl[8 * q + 3]), pk2(sl[8 * q + 4], sl[8 * q + 5]), pk2(sl[8 * q + 6], sl[8 * q + 7])};
            *(u32x4*)(chk + 24576 + wid * 2048 + lane * 32 + q * 16) = (u32x4){pk2(yl[8 * q], yl[8 * q + 1]), pk2(yl[8 * q + 2], yl[8 * q + 3]), pk2(yl[8 * q + 4], yl[8 * q + 5]), pk2(yl[8 * q + 6], yl[8 * q + 7])}; }
    }
    FBAR();
}
#undef FBAR
DEVI void cumsum_job(const P& p, int bh, char* lds) {
    const int tid = otid(), lane = tid & 63, wid = tid >> 6, b = bh >> 3, h = bh & 7; float* part = (float*)lds;
    const float* LF = WSP(float, WS_LF) + (size_t)b * LP * 8 + h; float* CS = WSP(float, WS_CS) + (size_t)bh * LP;
    const int r0 = tid * 33; float v[33]; float s = 0.f;
#pragma unroll
    for (int i = 0; i < 33; ++i) v[i] = (r0 + i < LP) ? LF[(size_t)(r0 + i) * 8] : 0.f;
#pragma unroll
    for (int i = 0; i < 33; ++i) s += v[i];
    part[tid] = s; LBAR();
    if (wid == 0) { const f32x4 a = *(const f32x4*)(part + 4 * lane); const float tot = (a.x + a.y) + (a.z + a.w); float inc = tot;
#pragma unroll
        for (int o = 1; o < 64; o <<= 1) { const float u = __shfl_up(inc, o); if (lane >= o) inc += u; }
        const float ex = inc - tot; *(f32x4*)(part + 4 * lane) = (f32x4){ex, ex + a.x, ex + a.x + a.y, ex + a.x + a.y + a.z}; }
    LBAR();
    float pre = part[tid];
#pragma unroll
    for (int i = 0; i < 33; ++i) { pre += v[i]; if (r0 + i < LP) CS[r0 + i] = pre * LOG2E; }
    LBAR();
}
DEVI void phase2c(const P& p, int bid, int nb, char* lds) {
    if (bid < 16) cumsum_job(p, bid, lds);
    if (nb == 512) {
        const int grp = bid >> 1, b = grp >> 7, c = 1 + (grp & 127);
        for (int j = 0; j < 4; ++j) chunk_job<true>(p, (b * 8 + 4 * (bid & 1) + j) * NCHUNK + c, lds, j == 0 ? 1 : 2);
    } else
    for (int q = bid; q < 16 * (NCHUNK - 1); q += nb) chunk_job<false>(p, (q >> 7) * NCHUNK + 1 + (q & 127), lds);
}

constexpr size_t WS_SPREV = WS_Y;
DEVI void scanB_job(const P& p, int bh, char* lds) {
    typedef __attribute__((address_space(3))) unsigned lds_u32;
    const int tid = otid(), lane = tid & 63, wid = __builtin_amdgcn_readfirstlane(tid >> 6), l31 = lane & 31, h = lane >> 5, rb = wid >> 1, cb = wid & 1;
    const char* chk = (const char*)p.ws + WS_CHK + (size_t)bh * NCHUNK * CHUNK_BYTES + 8192 + wid * 8192 + lane * 16;
    char* sprev = (char*)p.ws + WS_SPREV + (size_t)bh * NCHUNK * 8192 + (wid & 1) * 4096 + lane * 16;
    f32x16 accS;
#pragma unroll
    for (int r = 0; r < 16; ++r) accS[r] = 0.f;
    auto dma = [&](int c, int slot) __attribute__((always_inline)) {
        if (wid < 2) {
            const char* g = chk + (size_t)c * CHUNK_BYTES; char* d = lds + 8192 + slot * 16384 + wid * 8192;
#pragma unroll
            for (int i = 0; i < 8; ++i) __builtin_amdgcn_global_load_lds((const unsigned*)(g + i * 1024), (lds_u32*)(d + i * 1024), 16, 0, 0);
        }
    };
    dma(0, 0); dma(1, 1); dma(2, 2); dma(3, 3);
    unsigned seq = fb_init();
    for (int c = 0; c < NCHUNK; ++c) {
        const int slot = c & 3;
#pragma unroll
        for (int g = 0; g < 4; ++g) *(u32x2*)(lds + swz(32 * cb + l31, 4 * rb + g) + 8 * h) = (u32x2){pk2(accS[4 * g], accS[4 * g + 1]), pk2(accS[4 * g + 2], accS[4 * g + 3])};
        if (wid < 2) { if (c + 3 < NCHUNK) asm volatile("s_waitcnt vmcnt(24)" ::: "memory"); else asm volatile("s_waitcnt vmcnt(0)" ::: "memory"); }
        ++seq; fb_arrive(seq); fb_wait(seq);
        const char* sl = lds + 8192 + slot * 16384;
        bf16x8 sb[4], gsf[4];
#pragma unroll
        for (int ks = 0; ks < 4; ++ks) { sb[ks] = frag(lds, 32 * cb + l31, ks, h); gsf[ks] = frag(sl, 32 * rb + l31, ks, h); }
#pragma unroll
        for (int q = 0; q < 2; ++q) { const u32x4 ws = *(const u32x4*)(sl + 8192 + wid * 2048 + lane * 32 + q * 16);
#pragma unroll
            for (int j = 0; j < 4; ++j) { accS[8 * q + 2 * j] = __uint_as_float(ws[j] << 16); accS[8 * q + 2 * j + 1] = __uint_as_float(ws[j] & 0xffff0000u); } }
        if (wid >= 2) {
            char* d = sprev + (size_t)c * 8192; const char* s = lds + (wid & 1) * 4096 + lane * 16;
#pragma unroll
            for (int i = 0; i < 4; ++i) *(u32x4*)(d + i * 1024) = *(const u32x4*)(s + i * 1024);
        }
        ++seq; fb_arrive(seq);
#pragma unroll
        for (int ks = 0; ks < 4; ++ks) accS = __builtin_amdgcn_mfma_f32_32x32x16_bf16(gsf[ks], sb[ks], accS, 0, 0, 0);
        fb_wait(seq);
        if (c + 4 < NCHUNK) dma(c + 4, slot);
    }
}

DEVI void phase4a(const P& p, int bid, int nb, char* lds) {
    typedef __attribute__((address_space(3))) unsigned lds_u32;
    const int tid = otid(), lane = tid & 63, wid = __builtin_amdgcn_readfirstlane(tid >> 6), l31 = lane & 31, h = lane >> 5, rb = wid >> 1, cb = wid & 1;
    for (int item = bid; item < 16 * (NCHUNK - 1); item += nb) {
        const int bh = item >> 7, c = 1 + (item & 127), b = bh >> 3, hh = bh & 7;
        const char* img = (const char*)p.ws + WS_CHK + ((size_t)bh * NCHUNK + c) * CHUNK_BYTES;
        const char* spv = (const char*)p.ws + WS_SPREV + ((size_t)bh * NCHUNK + c) * 8192;
#pragma unroll
        for (int i = 0; i < 2; ++i) { const int off = (wid * 2 + i) * 1024;
            __builtin_amdgcn_global_load_lds((const unsigned*)(img + off + lane * 16), (lds_u32*)(lds + off), 16, 0, 0);
            __builtin_amdgcn_global_load_lds((const unsigned*)(spv + off + lane * 16), (lds_u32*)(lds + 8192 + off), 16, 0, 0);
            __builtin_amdgcn_global_load_lds((const unsigned*)(img + 24576 + off + lane * 16), (lds_u32*)(lds + 16384 + off), 16, 0, 0); }
        asm volatile("s_waitcnt vmcnt(0)" ::: "memory"); hbar(); asm volatile("" ::: "memory");
        f32x16 accY; bf16x8 sb[4], gyf[4];
#pragma unroll
        for (int ks = 0; ks < 4; ++ks) { sb[ks] = frag(lds + 8192, 32 * cb + l31, ks, h); gyf[ks] = frag(lds, 32 * rb + l31, ks, h); }
#pragma unroll
        for (int q = 0; q < 2; ++q) { const u32x4 wy = *(const u32x4*)(lds + 16384 + wid * 2048 + lane * 32 + q * 16);
#pragma unroll
            for (int j = 0; j < 4; ++j) { accY[8 * q + 2 * j] = __uint_as_float(wy[j] << 16); accY[8 * q + 2 * j + 1] = __uint_as_float(wy[j] & 0xffff0000u); } }
#pragma unroll
        for (int ks = 0; ks < 4; ++ks) accY = __builtin_amdgcn_mfma_f32_32x32x16_bf16(gyf[ks], sb[ks], accY, 0, 0, 0);
        float* YT = (float*)(lds + 24576);
#pragma unroll
        for (int r = 0; r < 16; ++r) YT[(32 * rb + crow(r, h)) * 68 + 32 * cb + l31] = accY[r];
        LBAR();
#pragma unroll
        for (int ps = 0; ps < 4; ++ps) {
            const int t = 16 * ps + (tid >> 4), c4 = (tid & 15) * 4, gc = hh * 64 + c4;
            const size_t row = (size_t)b * LP + 64 + 64 * c + t, o = row * 512 + gc;
            const bf16_t* zrow = WSP(bf16_t, WS_ZR) + row * RWKV_COLS;
            const f32x4 y = *(const f32x4*)(YT + t * 68 + c4), r = zs4(zrow, gc, p.rwkv_mu), k2 = ld4bf(WSP(bf16_t, WS_RK2) + o), v = zs4(zrow, 1024 + gc, p.rwkv_mu), g = ld4bf(WSP(bf16_t, WS_G) + o);
            const f32x4 rk = *(const f32x4*)(p.r_k + gc), lg = *(const f32x4*)(p.lnx_g + gc), lb = *(const f32x4*)(p.lnx_b + gc);
            const float mu = sum16((y.x + y.y) + (y.z + y.w)) * (1.f / 64.f);
            const f32x4 dy = y - mu;
            const float var = sum16((dy.x * dy.x + dy.y * dy.y) + (dy.z * dy.z + dy.w * dy.w)) * (1.f / 64.f);
            const float rs = rsqrtf(var + GN_EPS);
            const float bonus = sum16((r.x * k2.x * rk.x + r.y * k2.y * rk.y) + (r.z * k2.z * rk.z + r.w * k2.w * rk.w));
            const f32x4 ov = (dy * rs * lg + lb + bonus * v) * g;
            *(u32x2*)(WSP(bf16_t, WS_MIX) + row * 1024 + 512 + gc) = (u32x2){pk2(ov.x, ov.y), pk2(ov.z, ov.w)};
        }
        LBAR();
    }
}

struct EpiOutProj {
    const P& p; int rowbase, tn; char* lds;
    DEVI void operator()(f32x4 (&acc)[8][4], int wm, int wn, int l15, int lq) const {
        const int wid = wm * 4 + wn; char* st = lds + wid * 18432;
#pragma unroll
        for (int mt = 0; mt < 8; ++mt) { const size_t row = (size_t)rowbase + wm * 128 + mt * 16 + l15;
#pragma unroll
            for (int nt = 0; nt < 4; ++nt) { const size_t o = row * 1024 + tn * 256 + wn * 64 + nt * 16 + 4 * lq;
                const u32x2 w = *(const u32x2*)(WSP(bf16_t, WS_H0B) + o);
                const f32x4 h0 = (f32x4){__uint_as_float(w.x << 16), __uint_as_float(w.x & 0xffff0000u), __uint_as_float(w.y << 16), __uint_as_float(w.y & 0xffff0000u)};
                const f32x4 v = h0 * ALPHA + acc[mt][nt];
                *(u32x2*)(st + (mt * 16 + l15) * 144 + (nt * 16 + 4 * lq) * 2) = (u32x2){pk2(v.x, v.y), pk2(v.z, v.w)}; } }
        stage_out64(lds, wid, l15 + 16 * lq, WSP(bf16_t, WS_PRE1) + ((size_t)rowbase + wm * 128) * 1024 + tn * 256 + wn * 64, 1024);
    }
};
DEVI void phase4b(const P& p, const Sched& sc, char* lds) {
    int tid = threadIdx.x; asm volatile("" : "+v"(tid));
    const int srow = 16 * (tid >> 6) + ((tid & 63) >> 2);
    for_xcd_items(sc, [&](int x, int rank, int nloc) __attribute__((always_inline)) {
        for (int i = rank; i < 8 * 4; i += nloc) {
            const int tr = 8 * x + (i >> 2), tn = i & 3, rowbase = (tr >> 5) * LP + 128 + (tr & 31) * 256;
            unsigned aob[4]; int tq = threadIdx.x; asm volatile("" : "+v"(tq));
#pragma unroll
            for (int q = 0; q < 4; ++q) aob[q] = (unsigned)((rowbase + g8_arow(tq, q >> 1, q & 1)) * 2048) + g8_c0b(tq);
            gemm8p<false>((const char*)WSP(bf16_t, WS_MIX), aob, (const char*)(WSP(bf16_t, WS_WOUTT) + (size_t)tn * 256 * 1024), g8_bob0(tq), 1024, lds, EpiOutProj{p, rowbase, tn, lds});
        }
    });
}

DEVI void phase4c(const P& p, int bid, int nb, char* lds) {
    const int tid = otid(), lane = tid & 63, wid = tid >> 6, l15 = lane & 15, lq = lane >> 4;
    constexpr int AST = 2064;
    char* AH = lds; char* AL = lds + 8 * AST;
    float* part = (float*)(lds + 16 * AST);
    unsigned* cnt = WSP(unsigned, WS_CTL) + CW_CNT;
    int* lcnt = (int*)(lds + 16 * AST + 4096);
    int* lbase = lcnt + 32;
    int* ent = (int*)(lds + 16 * AST + 4096 + 256);
    if (tid < 32) lcnt[tid] = 0;
    int nit = 0;
    bf16x8 wh[8][2], wl[8][2];
#pragma unroll
    for (int ks = 0; ks < 8; ++ks)
#pragma unroll
        for (int nt = 0; nt < 2; ++nt) { u32x4 h4, l4;
#pragma unroll
            for (int j = 0; j < 4; ++j) { const float* wp = p.w_router + (size_t)(256 * wid + 32 * ks + 8 * lq + 2 * j) * 32 + 16 * nt + l15;
                const float a0 = wp[0], a1 = wp[32]; const unsigned hb = pk2(a0, a1);
                h4[j] = hb; l4[j] = pk2(a0 - __uint_as_float(hb << 16), a1 - __uint_as_float(hb & 0xffff0000u)); }
            wh[ks][nt] = __builtin_bit_cast(bf16x8, h4); wl[ks][nt] = __builtin_bit_cast(bf16x8, l4); }
    const float br = p.b_router[lane & 31];
    const int stride = nb * 8;
    auto load_row = [&](int row, u32x2 (&v)[4]) __attribute__((always_inline)) {
        if (row < NP && (row % LP) >= PADL + NMETA) { const u32x2* src = (const u32x2*)(WSP(bf16_t, WS_PRE1) + (size_t)row * 1024) + lane;
#pragma unroll
            for (int j = 0; j < 4; ++j) v[j] = src[64 * j]; }
    };
    auto ln_row = [&](int row, const u32x2 (&vin)[4], int hr) __attribute__((always_inline)) {
        const bool pad = (row % LP) < PADL + NMETA;
        u32x2* hb = (u32x2*)(WSP(bf16_t, WS_H1B) + (size_t)row * 1024) + lane;
        if (pad) {
#pragma unroll
            for (int j = 0; j < 4; ++j) { hb[64 * j] = (u32x2){0u, 0u}; *(u32x2*)(AH + hr * AST + (lane * 4 + 256 * j) * 2) = (u32x2){0u, 0u}; *(u32x2*)(AL + hr * AST + (lane * 4 + 256 * j) * 2) = (u32x2){0u, 0u}; }
        } else {
            f32x4 v[4]; float s = 0.f;
#pragma unroll
            for (int j = 0; j < 4; ++j) { const u32x2 w = vin[j]; v[j] = (f32x4){__uint_as_float(w.x << 16), __uint_as_float(w.x & 0xffff0000u), __uint_as_float(w.y << 16), __uint_as_float(w.y & 0xffff0000u)}; s += (v[j].x + v[j].y) + (v[j].z + v[j].w); }
            const float mean = wave_sum(s) * (1.f / 1024.f); float s2 = 0.f;
#pragma unroll
            for (int j = 0; j < 4; ++j) { v[j] = v[j] - mean; s2 += (v[j].x * v[j].x + v[j].y * v[j].y) + (v[j].z * v[j].z + v[j].w * v[j].w); }
            const float rstd = rsqrtf(wave_sum(s2) * (1.f / 1024.f) + LN_EPS);
            if (lane == 0) { WSP(float, WS_ST1)[(size_t)row * 2] = mean; WSP(float, WS_ST1)[(size_t)row * 2 + 1] = rstd; }
#pragma unroll
            for (int j = 0; j < 4; ++j) {
                const f32x4 g = ((const f32x4*)p.ln1_g)[lane + 64 * j], bb = ((const f32x4*)p.ln1_b)[lane + 64 * j];
                const f32x4 o = v[j] * rstd * g + bb;
                const unsigned h0 = pk2(o.x, o.y), h1 = pk2(o.z, o.w);
                hb[64 * j] = (u32x2){h0, h1};
                *(u32x2*)(AH + hr * AST + (lane * 4 + 256 * j) * 2) = (u32x2){h0, h1};
                *(u32x2*)(AL + hr * AST + (lane * 4 + 256 * j) * 2) = (u32x2){pk2(o.x - __uint_as_float(h0 << 16), o.y - __uint_as_float(h0 & 0xffff0000u)), pk2(o.z - __uint_as_float(h1 << 16), o.w - __uint_as_float(h1 & 0xffff0000u))};
            }
        }
    };
    u32x2 vn[2][4];
#pragma unroll
    for (int u = 0; u < 2; ++u) load_row(bid * 8 + 4 * u + wid, vn[u]);
    for (int base = bid * 8; base < NP; base += stride) {
#pragma unroll
        for (int u = 0; u < 2; ++u) ln_row(base + 4 * u + wid, vn[u], 4 * u + wid);
        LBAR();
#pragma unroll
        for (int u = 0; u < 2; ++u) load_row(base + stride + 4 * u + wid, vn[u]);
        {
            f32x4 acc[2] = {(f32x4){0.f, 0.f, 0.f, 0.f}, (f32x4){0.f, 0.f, 0.f, 0.f}};
            const char* ah = AH + (l15 & 7) * AST + (256 * wid + 8 * lq) * 2; const char* al = AL + (l15 & 7) * AST + (256 * wid + 8 * lq) * 2;
#pragma unroll
            for (int ks = 0; ks < 8; ++ks) { const bf16x8 xh = *(const bf16x8*)(ah + ks * 64), xl = *(const bf16x8*)(al + ks * 64);
#pragma unroll
                for (int nt = 0; nt < 2; ++nt) {
                    acc[nt] = __builtin_amdgcn_mfma_f32_16x16x32_bf16(wl[ks][nt], xh, acc[nt], 0, 0, 0);
                    acc[nt] = __builtin_amdgcn_mfma_f32_16x16x32_bf16(wh[ks][nt], xl, acc[nt], 0, 0, 0);
                    acc[nt] = __builtin_amdgcn_mfma_f32_16x16x32_bf16(wh[ks][nt], xh, acc[nt], 0, 0, 0); } }
            if (l15 < 8) {
                *(f32x4*)(part + (l15 * 4 + wid) * 32 + 4 * lq) = acc[0]; *(f32x4*)(part + (l15 * 4 + wid) * 32 + 16 + 4 * lq) = acc[1]; }
        }
        LBAR();
#pragma unroll
        for (int u = 0; u < 2; ++u) {
            const int row = base + 4 * u + wid, hr = 4 * u + wid;
            const bool pad = (row % LP) < PADL + NMETA;
            const int ee = lane & 31;
            float logit = br;
#pragma unroll
            for (int q = 0; q < 4; ++q) logit += part[(hr * 4 + q) * 32 + ee];
            float cur = logit; float tv[4]; int ti[4];
#pragma unroll
            for (int k = 0; k < 4; ++k) {
                float bv = cur; int bi = ee;
#define P4C_STEP(GETV, GETI) { const float ov = GETV; const int oi = GETI; if (ov > bv || (ov == bv && oi < bi)) { bv = ov; bi = oi; } }
                P4C_STEP(dpp_mov<0xB1>(bv), dpp_movi<0xB1>(bi)) P4C_STEP(dpp_mov<0x4E>(bv), dpp_movi<0x4E>(bi))
                P4C_STEP(dpp_mov<0x141>(bv), dpp_movi<0x141>(bi)) P4C_STEP(dpp_mov<0x140>(bv), dpp_movi<0x140>(bi))
                P4C_STEP(__shfl_xor(bv, 16), __shfl_xor(bi, 16))
#undef P4C_STEP
                tv[k] = bv; ti[k] = bi; if (ee == bi) cur = -INFINITY;
            }
            const float e1 = __expf(tv[1] - tv[0]), e2 = __expf(tv[2] - tv[0]), e3 = __expf(tv[3] - tv[0]); const float inv = 1.f / (1.f + e1 + e2 + e3);
            if (lane < 4 && !pad) {
                const int ex = lane == 0 ? ti[0] : lane == 1 ? ti[1] : lane == 2 ? ti[2] : ti[3];
                const float gt = (lane == 0 ? 1.f : lane == 1 ? e1 : lane == 2 ? e2 : e3) * inv;
                const int lr = atomicAdd(lcnt + ex, 1);
                *(int4*)(ent + ((nit * 8 + hr) * 4 + lane) * 4) = make_int4(row, ex, lr, __float_as_int(gt));
            } else if (lane < 4) *(int4*)(ent + ((nit * 8 + hr) * 4 + lane) * 4) = make_int4(0, -1, 0, 0);
        }
        ++nit;
    }
    LBAR();
    if (tid < 32) { const int c = lcnt[tid]; lbase[tid] = c ? (int)atomicAdd(cnt + tid, (unsigned)c) : 0; }
    LBAR();
    for (int id = tid; id < nit * 32; id += 256) {
        const int4 en = *(const int4*)(ent + id * 4);
        if (en.y >= 0) { const int rank = lbase[en.y] + en.z;
            WSP(int, WS_LTOK)[(size_t)en.y * CAP + rank] = en.x; WSP(float, WS_LGATE)[(size_t)en.y * CAP + rank] = __int_as_float(en.w);
            WSP(int, WS_RTE)[(size_t)en.x * 4 + (id & 3)] = en.y; WSP(int, WS_RTR)[(size_t)en.x * 4 + (id & 3)] = rank; WSP(float, WS_RTG)[(size_t)en.x * 4 + (id & 3)] = __int_as_float(en.w); }
    }
}

struct MoeTab { int* rb; int* cn; int* nf; int* ng; };
DEVI MoeTab moe_prefix(const P& p, char* lds) {
    MoeTab t; t.rb = (int*)smallw(0); t.cn = t.rb + 33; t.nf = t.cn + 32; t.ng = t.nf + 32;
    if (otid() < 64) {
        const int e = otid() & 31; const unsigned* cnt = WSP(unsigned, WS_CTL) + CW_CNT;
        const int c = (int)cnt[e]; int f = c >> 8, g = 0; const int rem = c & 255; if (rem > 128) ++f; else g = (rem + 63) >> 6;
        const int rows = f * 256 + g * 64; int inc = rows;
#pragma unroll
        for (int o = 1; o < 32; o <<= 1) { const int u = __shfl_up(inc, o, 32); if (e >= o) inc += u; }
        if (otid() < 32) { t.cn[e] = c; t.nf[e] = f; t.ng[e] = g; t.rb[e] = inc - rows; if (e == 31) t.rb[NEXP] = inc; }
    }
    HSYNC();
    return t;
}

template <int MT> struct EpiGU {
    const P& p; int e, row0, tn2; char* lds;
    DEVI void operator()(f32x4 (&acc)[MT][4], int wm, int wn4, int l15, int lq) const {
        const int tn = 2 * tn2 + (wn4 >> 1), wn = wn4 & 1;
        const float* bg = p.b_gu + (size_t)e * 2048;
        const int lane = l15 + 16 * lq, wid = wm * 4 + wn4; char* st = lds + wid * 18432;
#pragma unroll
        for (int mt = 0; mt < MT; ++mt) { const size_t row = (size_t)row0 + wm * (16 * MT) + mt * 16 + l15;
#pragma unroll
            for (int np = 0; np < 2; ++np) { const int jc = tn * 64 + wn * 32 + np * 16 + 4 * lq;
                const f32x4 bgt = *(const f32x4*)(bg + jc), bup1 = *(const f32x4*)(bg + 1024 + jc) + 1.f; float ov[4];
#pragma unroll
                for (int r = 0; r < 4; ++r) { const float gate = fminf(acc[mt][2 * np][r] + bgt[r], 7.f); const float up1 = fminf(fmaxf(acc[mt][2 * np + 1][r] + bup1[r], -6.f), 8.f);
                    const float sg = __builtin_amdgcn_rcpf(1.f + __builtin_amdgcn_exp2f(gate * (-1.702f * 1.4426950408889634f)));
                    ov[r] = up1 * (gate * sg); }
                const u32x2 w = (u32x2){pk2(ov[0], ov[1]), pk2(ov[2], ov[3])};
                if constexpr (MT == 8) *(u32x2*)(st + (mt * 16 + l15) * 80 + (np * 16 + 4 * lq) * 2) = w;
                else *(u32x2*)(WSP(bf16_t, WS_ACT) + row * 1024 + jc) = w; } }
        if constexpr (MT == 8) {
            asm volatile("s_waitcnt lgkmcnt(0)" ::: "memory");
            bf16_t* dst = WSP(bf16_t, WS_ACT) + ((size_t)row0 + wm * 128) * 1024 + tn * 64 + wn * 32;
#pragma unroll
            for (int i = 0; i < 8; ++i) { const int r = 16 * i + (lane >> 2), ch = lane & 3; *(u32x4*)(dst + (size_t)r * 1024 + ch * 8) = *(const u32x4*)(st + r * 80 + ch * 16); }
            RBAR();
        }
    }
};
template <int MT> struct EpiDown {
    const P& p; int e, row0, idx0, cnt_e, tn2; char* lds;
    DEVI void operator()(f32x4 (&acc)[MT][4], int wm, int wn4, int l15, int lq) const {
        const int tn = 2 * tn2 + (wn4 >> 1), wn = wn4 & 1;
        const float* bd = p.b_down + (size_t)e * 1024;
        if constexpr (MT == 8) {
            const int lane = l15 + 16 * lq, wid = wm * 4 + wn4; char* st = lds + wid * 18432;
#pragma unroll
            for (int mt = 0; mt < MT; ++mt) {
#pragma unroll
                for (int nt = 0; nt < 4; ++nt) { const int c = tn * 128 + wn * 64 + nt * 16 + 4 * lq; const f32x4 o = acc[mt][nt] + *(const f32x4*)(bd + c);
                    *(u32x2*)(st + (mt * 16 + l15) * 144 + (nt * 16 + 4 * lq) * 2) = (u32x2){pk2(o.x, o.y), pk2(o.z, o.w)}; } }
            asm volatile("s_waitcnt lgkmcnt(0)" ::: "memory");
            bf16_t* dst = WSP(bf16_t, WS_YB) + ((size_t)row0 + wm * 128) * 1024 + tn * 128 + wn * 64;
#pragma unroll
            for (int i = 0; i < 16; ++i) { const int r = 8 * i + (lane >> 3), ch = lane & 7; *(u32x4*)(dst + (size_t)r * 1024 + ch * 8) = *(const u32x4*)(st + r * 144 + ch * 16); }
            RBAR();
        } else {
#pragma unroll
            for (int mt = 0; mt < MT; ++mt) { const int ml = wm * (16 * MT) + mt * 16 + l15;
                const size_t row = (size_t)row0 + ml;
#pragma unroll
                for (int nt = 0; nt < 4; ++nt) { const int c = tn * 128 + wn * 64 + nt * 16 + 4 * lq; const f32x4 o = acc[mt][nt] + *(const f32x4*)(bd + c);     *(u32x2*)(WSP(bf16_t, WS_YB) + row * 1024 + c) = (u32x2){pk2(o.x, o.y), pk2(o.z, o.w)}; } }
        }
    }
};
template <int NT, class FullFn, class SmallFn>
DEVI void moe_items(const MoeTab& T, int x, int rank, int nloc, FullFn&& full, SmallFn&& small) {
    const int f0 = T.nf[x], f1 = f0 + T.nf[x + 8], f2 = f1 + T.nf[x + 16], f3 = f2 + T.nf[x + 24];
    const int g0 = T.ng[x], g1 = g0 + T.ng[x + 8], g2 = g1 + T.ng[x + 16], g3 = g2 + T.ng[x + 24];
    for (int i = rank; i < (f3 + g3) * NT; i += nloc) {
        if (i < f3 * NT) { const int rbk = i / NT, tn = i % NT; const int j = rbk < f0 ? 0 : rbk < f1 ? 1 : rbk < f2 ? 2 : 3; const int e = x + 8 * j, mb = rbk - (j == 0 ? 0 : j == 1 ? f0 : j == 2 ? f1 : f2);
            full(e, mb * 256, tn); }
        else { const int k = i - f3 * NT, gk = k / NT, tn = k % NT; const int j = gk < g0 ? 0 : gk < g1 ? 1 : gk < g2 ? 2 : 3; const int e = x + 8 * j, gi = gk - (j == 0 ? 0 : j == 1 ? g0 : j == 2 ? g1 : g2);
            small(e, T.nf[e] * 256 + gi * 64, tn); }
    }
}
DEVI void phase5(const P& p, const Sched& sc, char* lds) {
    const MoeTab T = moe_prefix(p, lds);
    for_xcd_items(sc, [&](int x, int rank, int nloc) __attribute__((always_inline)) {
        moe_items<8>(T, x, rank, nloc,
            [&](int e, int idx0, int tn) __attribute__((always_inline)) {
                unsigned aob[4]; int tq = threadIdx.x; asm volatile("" : "+v"(tq));
#pragma unroll
                for (int q = 0; q < 4; ++q) { const int idx = idx0 + g8_arow(tq, q >> 1, q & 1); const int tok = idx < T.cn[e] ? WSP(int, WS_LTOK)[(size_t)e * CAP + idx] : 0; aob[q] = (unsigned)tok * 2048u + g8_c0b(tq); }
                gemm8p<false>((const char*)WSP(bf16_t, WS_H1B), aob, (const char*)(WSP(bf16_t, WS_WGUT) + ((size_t)e * 2048 + tn * 256) * 1024), g8_bob0(tq), 1024, lds, EpiGU<8>{p, e, T.rb[e] + idx0, tn, lds}); },
            [&](int e, int idx0, int tn) __attribute__((always_inline)) {
                const bf16_t *ap[2], *bp[2];
                int ts = threadIdx.x; asm volatile("" : "+v"(ts)); const int srow = 16 * (ts >> 6) + ((ts & 63) >> 2), srow4 = 16 * ((ts >> 6) & 3) + ((ts & 63) >> 2);
                { const int idx = idx0 + srow4; const int tok = idx < T.cn[e] ? WSP(int, WS_LTOK)[(size_t)e * CAP + idx] : 0; ap[0] = WSP(bf16_t, WS_H1B) + (size_t)tok * 1024; ap[1] = ap[0]; }
#pragma unroll
                for (int q = 0; q < 2; ++q) bp[q] = WSP(bf16_t, WS_WGUT) + ((size_t)e * 2048 + tn * 256 + srow + 128 * q) * 1024;
                gemm512<false, 2>(ap, bp, 1024, lds, EpiGU<2>{p, e, T.rb[e] + idx0, tn, lds}); });
    });
}
DEVI void phase6(const P& p, const Sched& sc, char* lds) {
    const MoeTab T = moe_prefix(p, lds);
    for_xcd_items(sc, [&](int x, int rank, int nloc) __attribute__((always_inline)) {
        moe_items<4>(T, x, rank, nloc,
            [&](int e, int idx0, int tn) __attribute__((always_inline)) {
                unsigned aob[4]; int tq = threadIdx.x; asm volatile("" : "+v"(tq));
#pragma unroll
                for (int q = 0; q < 4; ++q) aob[q] = (unsigned)(T.rb[e] + idx0 + g8_arow(tq, q >> 1, q & 1)) * 2048u + g8_c0b(tq);
                gemm8p<false>((const char*)WSP(bf16_t, WS_ACT), aob, (const char*)(WSP(bf16_t, WS_WDT) + ((size_t)e * 1024 + tn * 256) * 1024), g8_bob0(tq), 1024, lds, EpiDown<8>{p, e, T.rb[e] + idx0, idx0, T.cn[e], tn, lds}); },
            [&](int e, int idx0, int tn) __attribute__((always_inline)) {
                const bf16_t *ap[2], *bp[2];
                int ts = threadIdx.x; asm volatile("" : "+v"(ts)); const int srow = 16 * (ts >> 6) + ((ts & 63) >> 2), srow4 = 16 * ((ts >> 6) & 3) + ((ts & 63) >> 2);
                ap[0] = WSP(bf16_t, WS_ACT) + ((size_t)T.rb[e] + idx0 + srow4) * 1024; ap[1] = ap[0];
#pragma unroll
                for (int q = 0; q < 2; ++q) bp[q] = WSP(bf16_t, WS_WDT) + ((size_t)e * 1024 + tn * 256 + srow + 128 * q) * 1024;
                gemm512<false, 2>(ap, bp, 1024, lds, EpiDown<2>{p, e, T.rb[e] + idx0, idx0, T.cn[e], tn, lds}); });
    });
}
DEVI void phase7(const P& p, int bid, int nb, char* lds) {
    const MoeTab T = moe_prefix(p, lds);
    const int tid = otid(), lane = tid & 63, wid = tid >> 6;
    constexpr int NREAL = BATCH * SEQ;
    const int stride = nb * 4, rr0 = bid * 4 + wid;
    auto rowof = [&](int rr) __attribute__((always_inline)) { return (rr >> 13) * LP + PADL + NMETA + (rr & (SEQ - 1)); };
    auto idx_load = [&](int rr, int (&sr)[4], float (&gk)[4]) __attribute__((always_inline)) {
        const int row = rowof(rr);
#pragma unroll
        for (int k = 0; k < 4; ++k) { const int e = WSP(int, WS_RTE)[(size_t)row * 4 + k], rk = WSP(int, WS_RTR)[(size_t)row * 4 + k]; sr[k] = T.rb[e] + rk; gk[k] = WSP(float, WS_RTG)[(size_t)row * 4 + k]; }
    };
    auto data_load = [&](int rr, const int (&sr)[4], u32x2 (&pre)[4], u32x2 (&yb)[4][4], float& mean1, float& rstd1) __attribute__((always_inline)) {
        const int row = rowof(rr);
        const u32x2* ps = (const u32x2*)(WSP(bf16_t, WS_PRE1) + (size_t)row * 1024) + lane;
        mean1 = WSP(float, WS_ST1)[(size_t)row * 2]; rstd1 = WSP(float, WS_ST1)[(size_t)row * 2 + 1];
#pragma unroll
        for (int j = 0; j < 4; ++j) pre[j] = ps[64 * j];
#pragma unroll
        for (int k = 0; k < 4; ++k) { const u32x2* y = (const u32x2*)(WSP(bf16_t, WS_YB) + (size_t)sr[k] * 1024) + lane;
#pragma unroll
            for (int j = 0; j < 4; ++j) yb[k][j] = y[64 * j]; }
    };
    int srA[4], srB[4]; u32x2 preA[4], preB[4]; u32x2 ybA[4][4], ybB[4][4]; float m1A, r1A, m1B, r1B;
    float gkA[4], gkB[4], gdA[4], gdB[4];
    auto step = [&](int rr, int (&srC)[4], u32x2 (&preC)[4], u32x2 (&ybC)[4][4], float& m1C, float& r1C, float (&gkC)[4], float (&gdC)[4], int (&srN)[4], u32x2 (&preN)[4], u32x2 (&ybN)[4][4], float& m1N, float& r1N, float (&gkN)[4], float (&gdN)[4]) __attribute__((always_inline)) {
        if (rr + stride < NREAL) { data_load(rr + stride, srN, preN, ybN, m1N, r1N);
#pragma unroll
            for (int k = 0; k < 4; ++k) gdN[k] = gkN[k]; }
        if (rr + 2 * stride < NREAL) idx_load(rr + 2 * stride, srC, gkC);
        f32x4 v[4];
#pragma unroll
        for (int j = 0; j < 4; ++j) { const u32x2 w = preC[j]; const f32x4 pf = (f32x4){__uint_as_float(w.x << 16), __uint_as_float(w.x & 0xffff0000u), __uint_as_float(w.y << 16), __uint_as_float(w.y & 0xffff0000u)};
            v[j] = ((pf - m1C) * r1C * ((const f32x4*)p.ln1_g)[lane + 64 * j] + ((const f32x4*)p.ln1_b)[lane + 64 * j]) * ALPHA; }
#pragma unroll
        for (int k = 0; k < 4; ++k)
#pragma unroll
            for (int j = 0; j < 4; ++j) { const u32x2 w = ybC[k][j]; v[j] += (f32x4){__uint_as_float(w.x << 16), __uint_as_float(w.x & 0xffff0000u), __uint_as_float(w.y << 16), __uint_as_float(w.y & 0xffff0000u)} * gdC[k]; }
        float s = 0.f;
#pragma unroll
        for (int j = 0; j < 4; ++j) s += (v[j].x + v[j].y) + (v[j].z + v[j].w);
        const float mean = wave_sum(s) * (1.f / 1024.f); float s2 = 0.f;
#pragma unroll
        for (int j = 0; j < 4; ++j) { v[j] = v[j] - mean; s2 += (v[j].x * v[j].x + v[j].y * v[j].y) + (v[j].z * v[j].z + v[j].w * v[j].w); }
        const float rstd = rsqrtf(wave_sum(s2) * (1.f / 1024.f) + LN_EPS);
        f32x4* o = (f32x4*)(p.out + (size_t)rr * 1024) + lane;
#pragma unroll
        for (int j = 0; j < 4; ++j) o[64 * j] = v[j] * rstd * ((const f32x4*)p.ln2_g)[lane + 64 * j] + ((const f32x4*)p.ln2_b)[lane + 64 * j];
    };
    if (rr0 < NREAL) { idx_load(rr0, srA, gkA); data_load(rr0, srA, preA, ybA, m1A, r1A);
#pragma unroll
        for (int k = 0; k < 4; ++k) gdA[k] = gkA[k]; }
    if (rr0 + stride < NREAL) idx_load(rr0 + stride, srB, gkB);
    for (int rr = rr0; rr < NREAL; rr += 2 * stride) {
        step(rr, srA, preA, ybA, m1A, r1A, gkA, gdA, srB, preB, ybB, m1B, r1B, gkB, gdB);
        if (rr + stride < NREAL) step(rr + stride, srB, preB, ybB, m1B, r1B, gkB, gdB, srA, preA, ybA, m1A, r1A, gkA, gdA);
    }
}

#define XB_TMO      128
#define XB_XCNT(j)  (256  + 64 * (j))
#define XB_XSUB(j)  (1280 + 64 * (j))
#define XB_XGEN(j)  (2304 + 64 * (j))
#define XB_TOP      3328
#define XB_TOPGEN   3392
#define XCD_BAR_WORDS 3456
#define XB_SPIN_CAP (1u << 18)
__device__ __forceinline__ unsigned xb_ld(unsigned* p)              { return __hip_atomic_load(p, __ATOMIC_RELAXED, __HIP_MEMORY_SCOPE_AGENT); }
__device__ __forceinline__ unsigned xb_add(unsigned* p, unsigned v) { return __hip_atomic_fetch_add(p, v, __ATOMIC_RELAXED, __HIP_MEMORY_SCOPE_AGENT); }
__device__ __forceinline__ unsigned xb_xcc_id() { return (unsigned)__builtin_amdgcn_s_getreg((3 << 11) | 20) & 0xFu; }
#define XB_SPIN(cond, bar) do { unsigned _sp = 0; while (cond) { __builtin_amdgcn_s_sleep(1); \
    if ((++_sp & 255u) == 0u) { if (xb_ld(&(bar)[XB_TMO])) break; if (_sp > XB_SPIN_CAP) { atomicAdd(&(bar)[XB_TMO], 1u); break; } } } } while (0)
struct XcdBarrier { unsigned* bar; unsigned x; volatile LAS unsigned* st; };
__device__ __forceinline__ XcdBarrier xcd_barrier_post(unsigned* bar, volatile LAS unsigned* st) {
    XcdBarrier b; b.bar = bar; b.x = xb_xcc_id(); b.st = st;
    if (threadIdx.x == 0) (void)xb_add(&bar[XB_XCNT(b.x)], 1u);
    return b;
}
__device__ __forceinline__ void xcd_barrier_complete(unsigned* bar, unsigned x, unsigned& nloc, unsigned& nx) {
    const unsigned G = gridDim.x * gridDim.y * gridDim.z;
    unsigned sum, cnt, mine, sp = 0u;
    for (;;) {
        sum = 0u; cnt = 0u; mine = 0u;
#pragma unroll
        for (unsigned j = 0; j < 16; ++j) { const unsigned c = xb_ld(&bar[XB_XCNT(j)]); sum += c; cnt += (c > 0u) ? 1u : 0u; mine = (j == x) ? c : mine; }
        if (sum == G) break;
        __builtin_amdgcn_s_sleep(1);
        if ((++sp & 255u) == 0u) { if (xb_ld(&bar[XB_TMO])) break; if (sp > XB_SPIN_CAP) { atomicAdd(&bar[XB_TMO], 1u); break; } }
    }
    nloc = mine > 0u ? mine : 1u; nx = cnt > 0u ? cnt : 1u;
}
__device__ __forceinline__ void xcd_barrier(const XcdBarrier& b) {
    asm volatile("s_waitcnt vmcnt(0)" ::: "memory");
    __syncthreads();
    if (threadIdx.x == 0) {
        unsigned* bar = b.bar;
        __builtin_amdgcn_s_waitcnt(0);
        unsigned nloc = b.st[0], nx = b.st[1];
        if (nloc == 0u) { xcd_barrier_complete(bar, b.x, nloc, nx); b.st[0] = nloc; b.st[1] = nx; }
        const unsigned old = xb_add(&bar[XB_XSUB(b.x)], 1u);
        const unsigned gen = old / nloc;
        if (old + 1u == (gen + 1u) * nloc) {
            __builtin_amdgcn_fence(__ATOMIC_RELEASE, "agent");
            asm volatile("s_waitcnt vmcnt(0)" ::: "memory");
            const unsigned og = xb_add(&bar[XB_TOP], 1u);
            const unsigned tg = og / nx;
            if (og + 1u == (tg + 1u) * nx) xb_add(&bar[XB_TOPGEN], 1u);
            else XB_SPIN(xb_ld(&bar[XB_TOPGEN]) == tg, bar);
            __builtin_amdgcn_fence(__ATOMIC_ACQUIRE, "agent");
            xb_add(&bar[XB_XGEN(b.x)], 1u);
            asm volatile("s_waitcnt vmcnt(0)" ::: "memory");
        } else {
            XB_SPIN(xb_ld(&bar[XB_XGEN(b.x)]) == gen, bar);
            __builtin_amdgcn_fence(__ATOMIC_ACQUIRE, "agent");
            asm volatile("s_waitcnt vmcnt(0)" ::: "memory");
        }
    }
    __syncthreads();
}

namespace cg = cooperative_groups;
constexpr int CW_BAR = 4096;
constexpr size_t CTL_ZERO_BYTES = 65536;
constexpr int N_SCAN_JOBS = 16, N_ATT_ITEMS = 16 * (NQB - 1);
DEVI void phase3(const P& p, char* lds, char* vlds, int qoff) {
    int* s_item = (int*)(g_lds + LDS_SMALL + 992);
    const int half = half_id();
    unsigned* q = WSP(unsigned, WS_CTL) + CW_QATT + qoff;
    constexpr int NSP = N_SCAN_JOBS / 2, NCP = N_CONV_ITEMS / 2;
    for (;;) {
        if (threadIdx.x == 0) *s_item = (int)atomicAdd(q, 1u);
        __syncthreads();
        const int it = __builtin_amdgcn_readfirstlane(*s_item);
        __syncthreads();
        if (it >= NSP + N_ATT_ITEMS + NCP) break;
        if (it < NSP) {
            const int job = 2 * it + half;
            chunk_job<false>(p, job * NCHUNK, vlds);
            __threadfence(); HSYNC();
            __builtin_amdgcn_s_setprio(3); scanB_job(p, job, vlds); __builtin_amdgcn_s_setprio(0); continue; }
        const int r = it - NSP; int a;
        if (r < 3 * NCP) { if (r % 3 == 2) { conv_moe_item(p, 2 * (r / 3) + half, vlds); continue; } a = 2 * (r / 3) + (r % 3); }
        else a = r - NCP;
        { const int qb = NQB - 1 - a / 16, bh = a % 16; attn_item(p, bh >> 3, bh & 7, qb, lds); }
    }
}
__global__ void __launch_bounds__(512, 1) k_mega(P p) {
    char* lds = g_lds;
    const int half = half_id(), vbid = blockIdx.x * 2 + half, vnb = gridDim.x * 2;
    char* vlds = g_lds + half * LDS_HALF;
    volatile LAS unsigned* st = (volatile LAS unsigned*)(LAS char*)(g_lds + LDS_SMALL + 1008);
    if (threadIdx.x < 2) st[threadIdx.x] = 0u;
    if ((threadIdx.x & 255) == 0) *(volatile LAS unsigned*)(LAS char*)smallw(1016) = 0u;
    if ((threadIdx.x & 255) < 4) *(volatile LAS unsigned*)(LAS char*)(smallw(960) + 4 * (threadIdx.x & 255)) = 0u;
    __syncthreads();
    if (p.ws == nullptr) cg::this_grid().sync();
    const XcdBarrier bar = xcd_barrier_post(WSP(unsigned, WS_CTL) + CW_BAR, st);
    int* s_rank = (int*)(g_lds + LDS_SMALL + 976);
    if (threadIdx.x == 0) *s_rank = (int)atomicAdd(WSP(unsigned, WS_CTL) + CW_XRANK + 64 * (bar.x & 15), 1u);
#ifndef PROBE_MASK
#define PROBE_MASK 0
#endif
#define RUNP(k, call) do { call; if (PROBE_MASK & (1 << (k))) { xcd_barrier(bar); call; } } while (0)
    RUNP(0, phase0(p, vbid, vnb, vlds));  xcd_barrier(bar);
    Sched sc;
    { const int nloc = __builtin_amdgcn_readfirstlane((int)st[0]), nx = __builtin_amdgcn_readfirstlane((int)st[1]), rk = __builtin_amdgcn_readfirstlane(*s_rank); const bool ok = nx == 8 && bar.x < 8 && rk < nloc;
      sc.x = ok ? (int)bar.x : 0; sc.rank = ok ? rk : (int)blockIdx.x; sc.nloc = ok ? nloc : (int)gridDim.x; sc.nxcd = ok ? 8 : 0; }
    RUNP(1, phase1(p, sc, lds));  xcd_barrier(bar);
    RUNP(4, phase2c(p, vbid, vnb, vlds)); xcd_barrier(bar);
    phase3(p, lds, vlds, 0); if (PROBE_MASK & (1 << 5)) { xcd_barrier(bar); phase3(p, lds, vlds, 64); } xcd_barrier(bar);
    RUNP(6, phase4a(p, vbid, vnb, vlds)); xcd_barrier(bar);
    RUNP(7, phase4b(p, sc, lds)); xcd_barrier(bar);
    phase4c(p, vbid, vnb, vlds); xcd_barrier(bar);
    RUNP(9, phase5(p, sc, lds));  xcd_barrier(bar);
    RUNP(10, phase6(p, sc, lds));  xcd_barrier(bar);
    RUNP(11, phase7(p, vbid, vnb, vlds));
}

extern "C" void kernel_launch(void* const* d_in, const int* in_sizes, int n_in, void* d_out, int out_size, void* d_ws, size_t ws_size, hipStream_t stream) {
    if (n_in != 29 || ws_size < WS_NEED) { fprintf(stderr, "kernel_launch: unexpected n_in %d or ws_size %zu (need %zu)\n", n_in, ws_size, (size_t)WS_NEED); return; }
    static int grid_blocks = 0;
    if (!grid_blocks) {
        int dev = 0, cus = 0, per_cu = 0;
        (void)hipGetDevice(&dev);
        (void)hipDeviceGetAttribute(&cus, hipDeviceAttributeMultiprocessorCount, dev);
        (void)hipOccupancyMaxActiveBlocksPerMultiprocessor(&per_cu, k_mega, 512, 0);
        if (per_cu > 1) per_cu = 1;
        grid_blocks = cus * per_cu;
        if (grid_blocks <= 0) { fprintf(stderr, "kernel_launch: occupancy query gave %d x %d\n", cus, per_cu); grid_blocks = 0; return; }
    }
    (void)hipMemsetAsync((char*)d_ws + WS_CTL, 0, CTL_ZERO_BYTES, stream);
    P p{};
    const float** pf = (const float**)&p;
    for (int i = 0; i < 29; ++i) pf[i] = (const float*)d_in[i];
    p.out = (float*)d_out; p.ws = (unsigned char*)d_ws;
    void* args[] = {&p};
    hipError_t e = hipLaunchCooperativeKernel((void*)k_mega, dim3(grid_blocks), dim3(512), args, 0, stream);
    if (e != hipSuccess) fprintf(stderr, "cooperative launch failed: %s (grid %d)\n", hipGetErrorString(e), grid_blocks);
}
```
